# Optimizing an MI355X kernel written in HIP

```python
import math
import jax, jax.numpy as jnp
from jax import lax
import numpy as np

D_MODEL = 1024
BATCH = 32
SEQ = 2048
DEPTH = 1

DA_HEADS = 4
DA_HEAD_DIM = 64
DA_V_DIM = 2 * DA_HEAD_DIM
MLA_HEADS = 4
MLA_Q_RANK = 256
MLA_KV_RANK = 128
MLA_NOPE_DIM = 128
MLA_ROPE_DIM = 64
MLA_V_DIM = 128
ROPE_THETA = 10000.0
MIX_WIDTH = DA_HEADS * DA_V_DIM + MLA_HEADS * MLA_V_DIM
DA_QK_COLS = 2 * DA_HEADS * DA_HEAD_DIM
IN_SPLITS = [DA_QK_COLS, 2 * DA_QK_COLS, 3 * DA_QK_COLS,
             3 * DA_QK_COLS + MLA_Q_RANK,
             3 * DA_QK_COLS + MLA_Q_RANK + MLA_KV_RANK]
IN_COLS = 3 * DA_QK_COLS + MLA_Q_RANK + MLA_KV_RANK + MLA_ROPE_DIM
REL_BUCKETS = 32
REL_MAX_DIST = 128
N_EXPERTS = 32
TOP_K = 4
D_FF = D_MODEL
SWIGLU_LIMIT = 7.0
SWIGLU_ALPHA = 1.702
MOE_BLOCK = 512
Q_BLOCK = 128
NORM_EPS = 1e-5

kernel_name = 'hymba_diffattn_mla_moe_encoder'


def rmsnorm(x, g):
    xf = x.astype(jnp.float32)
    y = xf * lax.rsqrt(jnp.mean(xf * xf, axis=-1, keepdims=True) + NORM_EPS)
    return (y * g.astype(jnp.float32)).astype(x.dtype)


def t5_bucket(rel):
    half = REL_BUCKETS // 2
    max_exact = half // 2
    n = jnp.abs(rel)
    nf = jnp.maximum(n, 1).astype(jnp.float32)
    large = max_exact + (jnp.log(nf / max_exact) / math.log(REL_MAX_DIST / max_exact)
                         * (half - max_exact)).astype(jnp.int32)
    large = jnp.minimum(large, half - 1)
    return jnp.where(rel > 0, half, 0) + jnp.where(n < max_exact, n, large)


def rope_tables(s):
    inv = ROPE_THETA ** (-jnp.arange(0, MLA_ROPE_DIM, 2, dtype=jnp.float32) / MLA_ROPE_DIM)
    ang = jnp.arange(s, dtype=jnp.float32)[:, None] * inv[None, :]
    return jnp.cos(ang), jnp.sin(ang)


def apply_rope(x, cos, sin):
    x1, x2 = jnp.split(x, 2, axis=-1)
    cos = cos.astype(x.dtype)
    sin = sin.astype(x.dtype)
    return jnp.concatenate([x1 * cos - x2 * sin, x1 * sin + x2 * cos], axis=-1)


def sweep_query_blocks(block_fn, q):
    b, h, s, d = q.shape
    nq = s // Q_BLOCK
    qb = q.reshape(b, h, nq, Q_BLOCK, d).transpose(2, 0, 1, 3, 4)
    out = lax.map(lambda a: block_fn(a[0], a[1]), (qb, jnp.arange(nq) * Q_BLOCK))
    return out.transpose(1, 0, 3, 2, 4).reshape(b, s, out.shape[2], out.shape[4])


def diff_attention(q, k, v, lam, rel_bias_table, subln_g, lambda_init):
    b, s = q.shape[:2]
    qh = q.transpose(0, 2, 1, 3)
    kh = k.transpose(0, 2, 1, 3)
    vh = v.transpose(0, 2, 1, 3)
    kpos = jnp.arange(s)
    scale = DA_HEAD_DIM ** -0.5
    table = rel_bias_table.astype(jnp.float32)

    def block(qblk, q0):
        qpos = q0 + jnp.arange(Q_BLOCK)
        bias = table[t5_bucket(kpos[None, :] - qpos[:, None])].transpose(2, 0, 1)
        logits = jnp.einsum('bhqd,bhkd->bhqk', qblk, kh).astype(jnp.float32) * scale + bias
        p = jax.nn.softmax(logits, axis=-1).reshape(b, DA_HEADS, 2, Q_BLOCK, s)
        w = (p[:, :, 0] - lam * p[:, :, 1]).astype(vh.dtype)
        return jnp.einsum('bhqk,bhkd->bhqd', w, vh)

    o = sweep_query_blocks(block, qh)
    return rmsnorm(o, subln_g) * (1.0 - lambda_init)


def mla_attention(c_q, c_kv, k_rope, q_norm_g, w_uq, kv_norm_g, w_ukv, cos, sin):
    b, s = c_q.shape[:2]
    q = (rmsnorm(c_q, q_norm_g) @ w_uq).reshape(b, s, MLA_HEADS, MLA_NOPE_DIM + MLA_ROPE_DIM)
    q_nope, q_pe = q[..., :MLA_NOPE_DIM], q[..., MLA_NOPE_DIM:]
    q_pe = apply_rope(q_pe, cos[:, None, :], sin[:, None, :])
    kv = (rmsnorm(c_kv, kv_norm_g) @ w_ukv).reshape(b, s, MLA_HEADS, MLA_NOPE_DIM + MLA_V_DIM)
    k_nope, v = kv[..., :MLA_NOPE_DIM], kv[..., MLA_NOPE_DIM:]
    k_pe = apply_rope(k_rope, cos, sin)
    k_pe = jnp.broadcast_to(k_pe[:, :, None, :], (b, s, MLA_HEADS, MLA_ROPE_DIM))
    qh = jnp.concatenate([q_nope, q_pe], axis=-1).transpose(0, 2, 1, 3)
    kh = jnp.concatenate([k_nope, k_pe], axis=-1).transpose(0, 2, 1, 3)
    vh = v.transpose(0, 2, 1, 3)
    scale = (MLA_NOPE_DIM + MLA_ROPE_DIM) ** -0.5

    def block(qblk, q0):
        logits = jnp.einsum('bhqd,bhkd->bhqk', qblk, kh).astype(jnp.float32) * scale
        p = jax.nn.softmax(logits, axis=-1).astype(vh.dtype)
        return jnp.einsum('bhqk,bhkd->bhqd', p, vh)

    return sweep_query_blocks(block, qh)


def moe_ffn(h, w_router, b_router, w_gate_up, b_gate_up, w_down, b_down):
    b, s, d = h.shape
    t = b * s
    xf = h.reshape(t, d)
    logits = (xf @ w_router + b_router).astype(jnp.float32)
    top_val, top_idx = lax.top_k(logits, TOP_K)
    gates = jax.nn.softmax(top_val, axis=-1)
    n_assign = t * TOP_K
    flat_e = top_idx.reshape(-1)
    flat_t = jnp.arange(n_assign, dtype=jnp.int32) // TOP_K
    flat_g = gates.reshape(-1)
    order = jnp.argsort(flat_e, stable=True)
    sorted_e = flat_e[order]
    counts = jnp.bincount(flat_e, length=N_EXPERTS)
    padded = ((counts + MOE_BLOCK - 1) // MOE_BLOCK) * MOE_BLOCK
    group_start = jnp.cumsum(counts) - counts
    pad_end = jnp.cumsum(padded)
    pad_start = pad_end - padded
    dest = pad_start[sorted_e] + (jnp.arange(n_assign) - group_start[sorted_e])
    n_blocks = -(-n_assign // MOE_BLOCK) + N_EXPERTS
    n_rows = n_blocks * MOE_BLOCK
    row_tok = jnp.zeros((n_rows,), jnp.int32).at[dest].set(flat_t[order])
    row_gate = jnp.zeros((n_rows,), jnp.float32).at[dest].set(flat_g[order])
    block_e = jnp.minimum(jnp.searchsorted(pad_end, jnp.arange(n_blocks) * MOE_BLOCK, side='right'),
                          N_EXPERTS - 1)

    def expert_block(args):
        tok, g, e = args
        xb = xf[tok]
        gu = xb @ w_gate_up[e] + b_gate_up[e]
        gate, up = gu[:, :D_FF], gu[:, D_FF:]
        gate = jnp.minimum(gate, SWIGLU_LIMIT)
        up = jnp.clip(up, -SWIGLU_LIMIT, SWIGLU_LIMIT)
        act = (up + 1.0) * (gate * jax.nn.sigmoid(SWIGLU_ALPHA * gate))
        y = act @ w_down[e] + b_down[e]
        return y * g.astype(y.dtype)[:, None]

    ys = lax.map(expert_block, (row_tok.reshape(n_blocks, MOE_BLOCK),
                                row_gate.reshape(n_blocks, MOE_BLOCK), block_e))
    out = jnp.zeros((t, d), h.dtype).at[row_tok].add(ys.reshape(n_rows, d).astype(h.dtype))
    return out.reshape(b, s, d)


def setup_inputs(seed: int = 0) -> dict:
    key = jax.random.key(seed)
    ks = jax.random.split(key, 24)
    f32 = jnp.float32
    L = DEPTH

    def nrm(k, shape, scale):
        return jax.random.normal(k, shape, f32) * scale

    return {
        'x': nrm(ks[0], (BATCH, SEQ, D_MODEL), 1.0),
        'rel_bias_table': nrm(ks[1], (REL_BUCKETS, 2 * DA_HEADS), 0.2),
        'attn_norm_g': 1.0 + nrm(ks[2], (L, D_MODEL), 0.01),
        'w_in': nrm(ks[3], (L, D_MODEL, IN_COLS), D_MODEL ** -0.5),
        'lam_q1': nrm(ks[4], (L, DA_HEAD_DIM), 0.1),
        'lam_k1': nrm(ks[5], (L, DA_HEAD_DIM), 0.1),
        'lam_q2': nrm(ks[6], (L, DA_HEAD_DIM), 0.1),
        'lam_k2': nrm(ks[7], (L, DA_HEAD_DIM), 0.1),
        'subln_g': 1.0 + nrm(ks[8], (L, DA_V_DIM), 0.01),
        'q_norm_g': 1.0 + nrm(ks[9], (L, MLA_Q_RANK), 0.01),
        'w_uq': nrm(ks[10], (L, MLA_Q_RANK, MLA_HEADS * (MLA_NOPE_DIM + MLA_ROPE_DIM)), MLA_Q_RANK ** -0.5),
        'kv_norm_g': 1.0 + nrm(ks[11], (L, MLA_KV_RANK), 0.01),
        'w_ukv': nrm(ks[12], (L, MLA_KV_RANK, MLA_HEADS * (MLA_NOPE_DIM + MLA_V_DIM)), MLA_KV_RANK ** -0.5),
        'w_o': nrm(ks[13], (L, MIX_WIDTH, D_MODEL), MIX_WIDTH ** -0.5),
        'ffn_norm_g': 1.0 + nrm(ks[14], (L, D_MODEL), 0.01),
        'w_router': nrm(ks[15], (L, D_MODEL, N_EXPERTS), D_MODEL ** -0.5),
        'b_router': nrm(ks[16], (L, N_EXPERTS), 0.01),
        'w_gate_up': nrm(ks[17], (L, N_EXPERTS, D_MODEL, 2 * D_FF), D_MODEL ** -0.5),
        'b_gate_up': nrm(ks[18], (L, N_EXPERTS, 2 * D_FF), 0.01),
        'w_down': nrm(ks[19], (L, N_EXPERTS, D_FF, D_MODEL), D_FF ** -0.5),
        'b_down': nrm(ks[20], (L, N_EXPERTS, D_MODEL), 0.01),
        'final_norm_g': 1.0 + nrm(ks[21], (D_MODEL,), 0.01),
    }


def reference(x, rel_bias_table, attn_norm_g, w_in, lam_q1, lam_k1, lam_q2, lam_k2, subln_g,
              q_norm_g, w_uq, kv_norm_g, w_ukv, w_o, ffn_norm_g, w_router, b_router,
              w_gate_up, b_gate_up, w_down, b_down, final_norm_g):
    b, s, _ = x.shape
    cos, sin = rope_tables(s)
    for l in range(DEPTH):
        lambda_init = 0.8 - 0.6 * math.exp(-0.3 * l)
        n = rmsnorm(x, attn_norm_g[l])
        proj = n @ w_in[l]
        qa, ka, va, c_q, c_kv, k_rope = jnp.split(proj, IN_SPLITS, axis=-1)
        lam = (jnp.exp(jnp.sum(lam_q1[l].astype(jnp.float32) * lam_k1[l].astype(jnp.float32)))
               - jnp.exp(jnp.sum(lam_q2[l].astype(jnp.float32) * lam_k2[l].astype(jnp.float32)))
               + lambda_init)
        oa = diff_attention(qa.reshape(b, s, 2 * DA_HEADS, DA_HEAD_DIM),
                            ka.reshape(b, s, 2 * DA_HEADS, DA_HEAD_DIM),
                            va.reshape(b, s, DA_HEADS, DA_V_DIM),
                            lam, rel_bias_table, subln_g[l], lambda_init)
        ob = mla_attention(c_q, c_kv, k_rope, q_norm_g[l], w_uq[l], kv_norm_g[l], w_ukv[l], cos, sin)
        mixed = jnp.concatenate([oa.reshape(b, s, -1), ob.reshape(b, s, -1)], axis=-1)
        x = x + mixed @ w_o[l]
        x = x + moe_ffn(rmsnorm(x, ffn_norm_g[l]), w_router[l], b_router[l],
                        w_gate_up[l], b_gate_up[l], w_down[l], b_down[l])
    return rmsnorm(x, final_norm_g)
```

```cpp
#include <hip/hip_runtime.h>
#include <cstdio>
#include <cstdint>

namespace pg8 {
#define PG8_LAS __attribute__((address_space(3)))
typedef unsigned short bf16_t;
typedef short bf16x8 __attribute__((ext_vector_type(8)));
typedef float f32x4 __attribute__((ext_vector_type(4)));
typedef unsigned u32x4 __attribute__((ext_vector_type(4)));
typedef unsigned u32x2 __attribute__((ext_vector_type(2)));
constexpr int BM = 256, BK = 64, HALF = 128, HTB = HALF * BK * 2  , STAGE_BYTES = 8 * HTB, NXCD = 8, WGM = 8;

__host__ __device__ __forceinline__ int lds_byte(int r, int c) { const int st = (r >> 4) * 2 + (c >> 5), rr = r & 15, cc = c & 31, ob = rr * 64 + cc * 2; return st * 1024 + (ob ^ (((ob >> 9) & 1) << 5)); }
__host__ __device__ __forceinline__ void stage_rc(int b, int& R, int& C) { const int st = b / 1024, sb = b % 1024, swz = sb ^ (((sb >> 9) & 1) << 5); R = (st >> 1) * 16 + swz / 64; C = (st & 1) * 32 + (swz % 64) / 2; }
__host__ __device__ __forceinline__ int perm32(int rho) { const int n = rho >> 4, i = rho & 15; return 8 * (i >> 2) + 4 * n + (i & 3); }

struct Unit { int pm, pn; };
struct Gemm { const bf16_t* A; const bf16_t* Bt; int M, N, K; };

struct StaticOrder {
    int nM, nN, nwg, G, c;
    __host__ __device__ void init(int M, int N, int G_, int c_) { nM = M / BM; nN = N / BM; nwg = nM * nN; G = G_; c = c_; }
    __host__ __device__ bool next(int i, Unit& u) const {
        const long L = (long)i * G + c; if (L >= nwg) return false;
        int wgid = (int)L; { const int q = nwg / NXCD, r = nwg % NXCD, xcd = wgid % NXCD, off = wgid / NXCD; wgid = (xcd < r ? xcd * (q + 1) : r * (q + 1) + (xcd - r) * q) + off; }
        const int nig = WGM * nN, gid = wgid / nig, fm = gid * WGM, gsz = (nM - fm) < WGM ? (nM - fm) : WGM;
        u.pm = fm + ((wgid % nig) % gsz); u.pn = (wgid % nig) / gsz; return true;
    }
    __device__ __forceinline__ int gather_row(const Unit&, int) const { return 0; }
};

__device__ __forceinline__ unsigned cvt_pk_bf16(float lo, float hi) { unsigned r; asm volatile("v_cvt_pk_bf16_f32 %0, %1, %2" : "=v"(r) : "v"(lo), "v"(hi)); return r; }

struct EpiBf16 {
    static constexpr bool PERM = true;
    bf16_t* O; int ldc;
    __device__ __forceinline__ void operator()(const f32x4 (&acc)[2][2][4][2], const Unit& u, int wr, int wc, int fr, int fq) const {
        const int row0 = u.pm * BM + wr * 64 + fr; const int col0 = u.pn * BM + wc * 32 + 8 * fq;
#pragma unroll
        for (int ai = 0; ai < 2; ++ai)
#pragma unroll
            for (int m = 0; m < 4; ++m) { bf16_t* rowp = O + (size_t)(row0 + ai * HALF + m * 16) * ldc + col0;
#pragma unroll
                for (int bj = 0; bj < 2; ++bj) { const f32x4 v0 = acc[ai][bj][m][0], v1 = acc[ai][bj][m][1];
                    u32x4 w; w.x = cvt_pk_bf16(v0[0], v0[1]); w.y = cvt_pk_bf16(v0[2], v0[3]); w.z = cvt_pk_bf16(v1[0], v1[1]); w.w = cvt_pk_bf16(v1[2], v1[3]);
                    *(u32x4*)(rowp + bj * HALF) = w; } }
    }
};
struct EpiResid {
    static constexpr bool PERM = false;
    const float* base; float* out; int ldc;
    __device__ __forceinline__ void operator()(const f32x4 (&acc)[2][2][4][2], const Unit& u, int wr, int wc, int fr, int fq) const {
        const int row0 = u.pm * BM + wr * 64 + fr; const int col0 = u.pn * BM + wc * 32 + 4 * fq;
#pragma unroll
        for (int ai = 0; ai < 2; ++ai)
#pragma unroll
            for (int m = 0; m < 4; ++m) { const size_t off = (size_t)(row0 + ai * HALF + m * 16) * ldc + col0;
#pragma unroll
                for (int bj = 0; bj < 2; ++bj)
#pragma unroll
                    for (int n = 0; n < 2; ++n) { const f32x4 bs = *(const f32x4*)(base + off + bj * HALF + n * 16); *(f32x4*)(out + off + bj * HALF + n * 16) = bs + acc[ai][bj][m][n]; } }
    }
};

template <class Epi, class Sched, bool ALIGN_EPI = false, bool GATHER = false>
__device__ __forceinline__ void gemm_phase(PG8_LAS unsigned char* lds, const Gemm g, const Sched& S, const Epi& E) {
    const int tid = threadIdx.x, wid = __builtin_amdgcn_readfirstlane(tid >> 6), lane = tid & 63, wr = wid >> 2, wc = wid & 3, fr = lane & 15, fq = lane >> 4;
    const int K = g.K, nt = K / BK;
    unsigned voffA[2], voffB[2]; int RA[2], CA[2];
#pragma unroll
    for (int i = 0; i < 2; ++i) { int R, C; stage_rc(tid * 16 + i * 8192, R, C); const int Rb = Epi::PERM ? ((R & ~31) + perm32(R & 31)) : R;
        voffA[i] = (unsigned)(R * K + C) * 2u; voffB[i] = (unsigned)(Rb * K + C) * 2u; RA[i] = R; CA[i] = C; }
    const size_t kstep = (size_t)(BK * 2);
    const size_t hstep = (size_t)HALF * K * 2;
    const size_t tstep = 2 * hstep;
    const unsigned ldsw = (unsigned)wid * 1024u;
    const int aoff = lds_byte(wr * 64 + fr, fq * 8), boff = lds_byte(wc * 32 + fr, fq * 8);
#define PG8_SA(b, h) (((b) * 2 + (h)) * HTB)
#define PG8_SB(b, h) ((4 + (b) * 2 + (h)) * HTB)
#define PG8_STAGE(bufoff, gbase, voff) do { _Pragma("unroll") for (int _i = 0; _i < 2; ++_i) \
        __builtin_amdgcn_global_load_lds((const unsigned*)((const char*)(gbase) + (voff)[_i]), (PG8_LAS unsigned*)(lds + (bufoff) + ldsw + _i * 8192), 16, 0, 0); } while (0)
#define PG8_STAGE_A(bufoff, h, base, O) do { if constexpr (GATHER) { PG8_STAGE(bufoff, base, O[h]); } else { PG8_STAGE(bufoff, (base) + (h) * hstep, voffA); } } while (0)
#define PG8_LDA(dst, b, h) do { _Pragma("unroll") for (int m = 0; m < 4; ++m) _Pragma("unroll") for (int k = 0; k < 2; ++k) dst[m][k] = *(const PG8_LAS bf16x8*)(lds + PG8_SA(b, h) + aoff + m * 2048 + k * 1024); } while (0)
#define PG8_LDB(dst, b, h) do { _Pragma("unroll") for (int n = 0; n < 2; ++n) _Pragma("unroll") for (int k = 0; k < 2; ++k) dst[n][k] = *(const PG8_LAS bf16x8*)(lds + PG8_SB(b, h) + boff + n * 2048 + k * 1024); } while (0)
#define PG8_MMA(ai, bj, At, Bt) do { __builtin_amdgcn_s_setprio(1); _Pragma("unroll") for (int m = 0; m < 4; ++m) _Pragma("unroll") for (int n = 0; n < 2; ++n) _Pragma("unroll") for (int k = 0; k < 2; ++k) \
        acc[ai][bj][m][n] = __builtin_amdgcn_mfma_f32_16x16x32_bf16(Bt[n][k], At[m][k], acc[ai][bj][m][n], 0, 0, 0); __builtin_amdgcn_s_setprio(0); } while (0)
#define PG8_WAIT_V(n) asm volatile("s_waitcnt vmcnt(" #n ")" ::: "memory")
#define PG8_WAIT_L(n) asm volatile("s_waitcnt lgkmcnt(" #n ")" ::: "memory")
#define PG8_BAR __builtin_amdgcn_s_barrier()
#define PG8_SCHED __builtin_amdgcn_sched_barrier(0)
    Unit cur, nxt; int ui = 0;
    if (!S.next(0, cur)) return;
    f32x4 acc[2][2][4][2];
#pragma unroll
    for (int a = 0; a < 2; ++a)
#pragma unroll
        for (int b = 0; b < 2; ++b)
#pragma unroll
            for (int m = 0; m < 4; ++m)
#pragma unroll
                for (int n = 0; n < 2; ++n) acc[a][b][m][n] = (f32x4){0.f, 0.f, 0.f, 0.f};
    bf16x8 At[4][2], B0[2][2], B1[2][2];
    unsigned gC[2][2], gN[2][2];
#pragma unroll
    for (int h = 0; h < 2; ++h)
#pragma unroll
        for (int i = 0; i < 2; ++i) { gC[h][i] = 0u; gN[h][i] = 0u; }
    if constexpr (GATHER) {
#pragma unroll
        for (int h = 0; h < 2; ++h)
#pragma unroll
            for (int i = 0; i < 2; ++i) gC[h][i] = (unsigned)S.gather_row(cur, h * HALF + RA[i]) * (unsigned)(K * 2) + (unsigned)(CA[i] * 2);
    }
    const char* cA = GATHER ? (const char*)g.A : (const char*)g.A + (size_t)cur.pm * tstep; const char* cB = (const char*)g.Bt + (size_t)cur.pn * tstep;
    PG8_STAGE(PG8_SB(0, 0), cB, voffB); PG8_STAGE(PG8_SB(0, 1), cB + hstep, voffB); PG8_STAGE_A(PG8_SA(0, 0), 0, cA, gC); PG8_STAGE_A(PG8_SA(0, 1), 1, cA, gC);
    if (wr == 1) PG8_BAR;
    PG8_WAIT_V(2); PG8_BAR;
    PG8_STAGE(PG8_SB(1, 0), cB + kstep, voffB); PG8_STAGE_A(PG8_SA(1, 0), 0, cA + kstep, gC); PG8_STAGE(PG8_SB(1, 1), cB + hstep + kstep, voffB);
    PG8_WAIT_V(6); PG8_BAR;
    for (;;) {
        const bool has_next = S.next(ui + 1, nxt);
        if constexpr (GATHER) {
            if (has_next) {
#pragma unroll
                for (int h = 0; h < 2; ++h)
#pragma unroll
                    for (int i = 0; i < 2; ++i) gN[h][i] = (unsigned)S.gather_row(nxt, h * HALF + RA[i]) * (unsigned)(K * 2) + (unsigned)(CA[i] * 2);
            } else {
#pragma unroll
                for (int h = 0; h < 2; ++h)
#pragma unroll
                    for (int i = 0; i < 2; ++i) gN[h][i] = gC[h][i];
            }
        }
        const char* nA = GATHER ? (const char*)g.A : (has_next ? (const char*)g.A + (size_t)nxt.pm * tstep : cA); const char* nB = has_next ? (const char*)g.Bt + (size_t)nxt.pn * tstep : cB;
        for (int t = 0; t < nt; t += 2) {
            const bool last = (t == nt - 2);
            const char* a1 = cA + (size_t)(t + 1) * kstep;
            const char* a2 = last ? nA : cA + (size_t)(t + 2) * kstep; const char* b2 = last ? nB : cB + (size_t)(t + 2) * kstep;
            const char* a3 = a2 + kstep; const char* b3 = b2 + kstep;
            unsigned g2[2][2];
#pragma unroll
            for (int h = 0; h < 2; ++h)
#pragma unroll
                for (int i = 0; i < 2; ++i) g2[h][i] = last ? gN[h][i] : gC[h][i];
            PG8_LDB(B0, 0, 0); PG8_LDB(B1, 0, 1); PG8_SCHED; PG8_LDA(At, 0, 0); PG8_STAGE_A(PG8_SA(1, 1), 1, a1, gC);
            PG8_WAIT_V(8); PG8_WAIT_L(0); PG8_BAR; PG8_MMA(0, 0, At, B0); PG8_MMA(0, 1, At, B1); PG8_BAR; PG8_SCHED;
            PG8_LDA(At, 0, 1); PG8_STAGE(PG8_SB(0, 0), b2, voffB); PG8_STAGE(PG8_SB(0, 1), b2 + hstep, voffB); PG8_STAGE_A(PG8_SA(0, 0), 0, a2, g2);
            PG8_WAIT_V(8); PG8_WAIT_L(0); PG8_BAR; PG8_MMA(1, 0, At, B0); PG8_MMA(1, 1, At, B1); PG8_BAR; PG8_SCHED;
            PG8_LDB(B0, 1, 0); PG8_LDB(B1, 1, 1); PG8_SCHED; PG8_LDA(At, 1, 0); PG8_STAGE_A(PG8_SA(0, 1), 1, a2, g2);
            PG8_WAIT_V(8); PG8_WAIT_L(0); PG8_BAR; PG8_MMA(0, 0, At, B0); PG8_MMA(0, 1, At, B1); PG8_BAR; PG8_SCHED;
            PG8_LDA(At, 1, 1); PG8_STAGE(PG8_SB(1, 0), b3, voffB); PG8_STAGE(PG8_SB(1, 1), b3 + hstep, voffB); PG8_STAGE_A(PG8_SA(1, 0), 0, a3, g2);
            PG8_WAIT_V(8); PG8_WAIT_L(0); PG8_BAR; PG8_MMA(1, 0, At, B0); PG8_MMA(1, 1, At, B1); PG8_BAR; PG8_SCHED;
        }
        if constexpr (ALIGN_EPI) { if (wr == 0) PG8_BAR; }
        E(acc, cur, wr, wc, fr, fq);
        if (!has_next) break;
#pragma unroll
        for (int a = 0; a < 2; ++a)
#pragma unroll
            for (int b = 0; b < 2; ++b)
#pragma unroll
                for (int m = 0; m < 4; ++m)
#pragma unroll
                    for (int n = 0; n < 2; ++n) acc[a][b][m][n] = (f32x4){0.f, 0.f, 0.f, 0.f};
        cur = nxt; cA = nA; cB = nB; ++ui;
#pragma unroll
        for (int h = 0; h < 2; ++h)
#pragma unroll
            for (int i = 0; i < 2; ++i) gC[h][i] = gN[h][i];
        if constexpr (ALIGN_EPI) { if (wr == 1) PG8_BAR; }
    }
    PG8_WAIT_V(0);
    if constexpr (!ALIGN_EPI) { if (wr == 0) PG8_BAR; }
    PG8_BAR;
#undef PG8_SA
#undef PG8_SB
#undef PG8_STAGE
#undef PG8_STAGE_A
#undef PG8_LDA
#undef PG8_LDB
#undef PG8_MMA
#undef PG8_WAIT_V
#undef PG8_WAIT_L
#undef PG8_BAR
#undef PG8_SCHED
}
}

namespace att {
#define ALAS __attribute__((address_space(3)))
using bf16 = unsigned short;
using bf16x8 = __attribute__((ext_vector_type(8))) short;
using s16x4  = __attribute__((ext_vector_type(4))) short;
using f32x16 = __attribute__((ext_vector_type(16))) float;
using f32x2  = __attribute__((ext_vector_type(2))) float;
using u32x4  = __attribute__((ext_vector_type(4))) unsigned;
#define SBAR() __builtin_amdgcn_sched_barrier(0)
constexpr int SHM_V = 64 * 128 * 2;
constexpr int OFF_V = 0, OFF_K = 2 * SHM_V;
template <int MODE> struct L { static constexpr int SHM_K = 64 * (MODE == 0 ? 384 : 128), OFF_WS = OFF_K + 2 * SHM_K; };
constexpr int OFF_LUT = L<1>::OFF_WS + 2048;
constexpr int OFF_STASH = OFF_LUT + 16384;
constexpr int ATT_LDS = OFF_STASH + 65536;
__device__ __forceinline__ int crow(int r, int hi) { return (r & 3) + 8 * (r >> 2) + 4 * hi; }
__device__ __forceinline__ unsigned cvtpk(float lo, float hi) { unsigned r; asm volatile("v_cvt_pk_bf16_f32 %0, %1, %2" : "=v"(r) : "v"(lo), "v"(hi)); return r; }
__device__ __forceinline__ float bf2f(short v) { return __uint_as_float(((unsigned)(unsigned short)v) << 16); }
template <int RB> __device__ __forceinline__ int kaddr(int row, int colB) { return row * RB + (colB ^ (((row >> 1) & 7) << 4)); }

template <bool BIAS>
__device__ __forceinline__ void partialSM(f32x16& p0, f32x16& p1, float& m_reg, float& mn, float& alpha, float C, const ALAS float* lut  ) {
  constexpr float THR2 = 8.f * 1.4426950408889634f;
  if constexpr (BIAS) {
#pragma unroll
    for (int r = 0; r < 16; ++r) { const int o = (r & 3) + 8 * (r >> 2); p0[r] = fmaf(p0[r], C, lut[o]); p1[r] = fmaf(p1[r], C, lut[32 + o]); }
  } else {
#pragma unroll
    for (int r = 0; r < 16; ++r) { p0[r] *= C; p1[r] *= C; }
  }
  float pmax = p0[0];
#pragma unroll
  for (int r = 1; r < 16; ++r) pmax = fmaxf(pmax, p0[r]);
#pragma unroll
  for (int r = 0; r < 16; ++r) pmax = fmaxf(pmax, p1[r]);
  { auto rr = __builtin_amdgcn_permlane32_swap(__float_as_uint(pmax), __float_as_uint(pmax), false, false);
    pmax = fmaxf(__uint_as_float(rr[0]), __uint_as_float(rr[1])); }
  if (__builtin_expect(__all(pmax - m_reg <= THR2), 1)) { mn = m_reg; alpha = 1.f; }
  else { mn = fmaxf(m_reg, pmax); alpha = __builtin_amdgcn_exp2f(m_reg - mn); m_reg = mn; }
#pragma unroll
  for (int r = 0; r < 16; ++r) p0[r] = __builtin_amdgcn_exp2f(p0[r] - mn);
#pragma unroll
  for (int r = 0; r < 16; ++r) p1[r] = p1[r] - mn;
}
__device__ __forceinline__ void finishSM(f32x16& p0, f32x16& p1, float alpha, float& l_reg, bf16x8& pa0, bf16x8& pa1, bf16x8& pa2, bf16x8& pa3) {
#pragma unroll
  for (int r = 0; r < 16; ++r) p1[r] = __builtin_amdgcn_exp2f(p1[r]);
  float ps = 0;
#pragma unroll
  for (int r = 0; r < 16; ++r) ps += p0[r];
#pragma unroll
  for (int r = 0; r < 16; ++r) ps += p1[r];
  { auto rr = __builtin_amdgcn_permlane32_swap(__float_as_uint(ps), __float_as_uint(ps), false, false);
    ps = __uint_as_float(rr[0]) + __uint_as_float(rr[1]); }
  l_reg = l_reg * alpha + ps;
#define PK4(P, BASE, OUT) do { unsigned a0 = cvtpk(P[BASE + 0], P[BASE + 1]), a1 = cvtpk(P[BASE + 2], P[BASE + 3]);   \
    unsigned b0 = cvtpk(P[BASE + 4], P[BASE + 5]), b1 = cvtpk(P[BASE + 6], P[BASE + 7]);                              \
    auto r0 = __builtin_amdgcn_permlane32_swap(a0, b0, false, false); auto r1 = __builtin_amdgcn_permlane32_swap(a1, b1, false, false); \
    u32x4 w = {r0[0], r1[0], r0[1], r1[1]}; OUT = __builtin_bit_cast(bf16x8, w); } while (0)
  PK4(p0, 0, pa0); PK4(p0, 8, pa1); PK4(p1, 0, pa2); PK4(p1, 8, pa3);
#undef PK4
}
template <int NQ, int RB>
__device__ __forceinline__ void qkt(f32x16& p0, f32x16& p1, const ALAS char* Ks, const bf16x8* qr, int r32, int hi) {
  p0 = f32x16{}; p1 = f32x16{};
#pragma unroll
  for (int d0 = 0; d0 < NQ; ++d0) { const int cb = (d0 * 16 + hi * 8) * 2;
    const bf16x8 b0 = *reinterpret_cast<const ALAS bf16x8*>(Ks + kaddr<RB>(r32, cb));
    const bf16x8 b1 = *reinterpret_cast<const ALAS bf16x8*>(Ks + kaddr<RB>(32 + r32, cb));
    p0 = __builtin_amdgcn_mfma_f32_32x32x16_bf16(b0, qr[d0], p0, 0, 0, 0);
    p1 = __builtin_amdgcn_mfma_f32_32x32x16_bf16(b1, qr[d0], p1, 0, 0, 0); }
}
__device__ __forceinline__ int v_st(int k, int c) { const int kk = (k & ~0xC) | ((k & 4) << 1) | ((k & 8) >> 1); return ((kk >> 3) * 4 + (c >> 5)) * 512 + ((kk & 7) * 32 + (c & 31)) * 2; }
__device__ __forceinline__ int v_rd_base(int lane) { return ((lane & 3) << 3) | (((lane >> 2) & 3) << 6) | (((lane >> 4) & 1) << 5) | (((lane >> 5) & 1) << 8); }
constexpr int v_rd_off(int d0, int ks, int half) { return d0 * 512 + ks * 4096 + half * 2048; }
template <int OFF> __device__ __forceinline__ s16x4 tr_read(int vb) {
  s16x4 r; asm volatile("ds_read_b64_tr_b16 %0, %1 offset:%2" : "=&v"(r) : "v"(vb), "i"(OFF) : "memory"); return r;
}
template <int D0> __device__ __forceinline__ void pv_one(f32x16& od, int vb, bf16x8 pa0, bf16x8 pa1, bf16x8 pa2, bf16x8 pa3) {
  const s16x4 l0 = tr_read<v_rd_off(D0, 0, 0)>(vb), h0 = tr_read<v_rd_off(D0, 0, 1)>(vb), l1 = tr_read<v_rd_off(D0, 1, 0)>(vb), h1 = tr_read<v_rd_off(D0, 1, 1)>(vb);
  const s16x4 l2 = tr_read<v_rd_off(D0, 2, 0)>(vb), h2 = tr_read<v_rd_off(D0, 2, 1)>(vb), l3 = tr_read<v_rd_off(D0, 3, 0)>(vb), h3 = tr_read<v_rd_off(D0, 3, 1)>(vb);
  asm volatile("s_waitcnt lgkmcnt(0)" ::: "memory"); SBAR();
#define PK(L, H) (bf16x8){L[0], L[1], L[2], L[3], H[0], H[1], H[2], H[3]}
  od = __builtin_amdgcn_mfma_f32_32x32x16_bf16(pa0, PK(l0, h0), od, 0, 0, 0);
  od = __builtin_amdgcn_mfma_f32_32x32x16_bf16(pa1, PK(l1, h1), od, 0, 0, 0);
  od = __builtin_amdgcn_mfma_f32_32x32x16_bf16(pa2, PK(l2, h2), od, 0, 0, 0);
  od = __builtin_amdgcn_mfma_f32_32x32x16_bf16(pa3, PK(l3, h3), od, 0, 0, 0);
#undef PK
}
__device__ __forceinline__ void pv_d0(f32x16* o, int vb, bf16x8 pa0, bf16x8 pa1, bf16x8 pa2, bf16x8 pa3) {
  pv_one<0>(o[0], vb, pa0, pa1, pa2, pa3); pv_one<1>(o[1], vb, pa0, pa1, pa2, pa3); pv_one<2>(o[2], vb, pa0, pa1, pa2, pa3); pv_one<3>(o[3], vb, pa0, pa1, pa2, pa3);
}

__device__ __forceinline__ int kw_addr(int row, int colB) { return row * 256 + (colB ^ ((row & 15) << 4)); }
__device__ __forceinline__ int kn_addr(int row, int colB) { return row * 128 + (colB ^ (((row >> 1) & 7) << 4)); }
template <int MODE, int PD>
__device__ __forceinline__ void attn_unit(const bf16* __restrict__ Qb, int ldq, const bf16* __restrict__ Kh, int ldk, const bf16* __restrict__ Kp, const bf16* __restrict__ Vh, int ldv,
                                          int seq, ALAS char* lds, float C, const f32x2* __restrict__ cs, int qpos0, f32x16 (&o)[4]) {
  constexpr int DQK = MODE == 0 ? 192 : 64, NQ = DQK / 16;
  constexpr int SHM_KW = MODE == 0 ? 64 * 256 : 0, SHM_KN = 64 * 128, SHM_K = SHM_KW + SHM_KN;
  static_assert(2 * SHM_K == 2 * L<MODE>::SHM_K, "K buffers");
  const int tid = threadIdx.x, wid = __builtin_amdgcn_readfirstlane(tid >> 6), lane = tid & 63, r32 = lane & 31, hi = lane >> 5;
  ALAS char* V_lds = lds + OFF_V; ALAS char* K_lds = lds + OFF_K;
  ALAS float* ws = (ALAS float*)(lds + L<MODE>::OFF_WS) + wid * 64; ALAS float* li_l = ws; ALAS float* al_l = ws + 32;
  __syncthreads();
  float m_reg = -1e30f, l_reg = 0;
#pragma unroll
  for (int d = 0; d < 4; ++d) o[d] = f32x16{};
  constexpr int NQR = (MODE == 0 && PD == 2) ? 6 : (MODE == 0 ? 8 : NQ);
  bf16x8 qr[NQR];
  ALAS char* qpe_l = lds + L<MODE>::OFF_WS + 2048 + wid * 6144 + lane * 16;
  const bf16* Qw = Qb + (long)(wid * 32 + r32) * ldq + hi * 8;
#pragma unroll
  for (int d0 = 0; d0 < NQR; ++d0) qr[d0] = *reinterpret_cast<const bf16x8*>(Qw + d0 * 16);
  if constexpr (MODE == 0) {
    bf16x8 qp[4];
#pragma unroll
    for (int d0 = 0; d0 < 4; ++d0) qp[d0] = *reinterpret_cast<const bf16x8*>(Qw + (8 + d0) * 16);
#pragma unroll
    for (int d0 = 6; d0 < 8; ++d0) *(ALAS bf16x8*)(qpe_l + (d0 - 6) * 1024) = *reinterpret_cast<const bf16x8*>(Qw + d0 * 16);
    const f32x2* cp = cs + (long)(qpos0 + wid * 32 + r32) * 32 + hi * 8;
#pragma unroll
    for (int a = 0; a < 2; ++a) {
      unsigned w1[4], w2[4];
#pragma unroll
      for (int j = 0; j < 8; j += 2) {
        const f32x2 c0 = cp[16 * a + j], c1 = cp[16 * a + j + 1];
        const float x10 = bf2f(qp[a][j]), x20 = bf2f(qp[2 + a][j]), x11 = bf2f(qp[a][j + 1]), x21 = bf2f(qp[2 + a][j + 1]);
        w1[j >> 1] = cvtpk(x10 * c0.x - x20 * c0.y, x11 * c1.x - x21 * c1.y);
        w2[j >> 1] = cvtpk(x10 * c0.y + x20 * c0.x, x11 * c1.y + x21 * c1.x);
      }
      u32x4 v1 = {w1[0], w1[1], w1[2], w1[3]}, v2 = {w2[0], w2[1], w2[2], w2[3]};
      *(ALAS u32x4*)(qpe_l + (2 + a) * 1024) = v1; *(ALAS u32x4*)(qpe_l + (4 + a) * 1024) = v2;
    }
  }
  unsigned vsrc[2], kwsrc[2], knsrc;
#pragma unroll
  for (int i = 0; i < 2; ++i) { const int s = (wid + 8 * i) * 64 + lane;
    const int kk = (s >> 7) * 8 + ((s & 31) >> 2), c = ((s >> 5) & 3) * 32 + (s & 3) * 8, k = (kk & ~0xC) | ((kk & 4) << 1) | ((kk & 8) >> 1);
    vsrc[i] = (unsigned)(k * ldv + c);
    const int row = s >> 4, ch = (s & 15) ^ (row & 15); kwsrc[i] = (unsigned)(row * ldk + ch * 8); }
  { const int s = wid * 64 + lane, row = s >> 3, ch = (s & 7) ^ ((row >> 1) & 7); knsrc = (unsigned)(row * (MODE == 0 ? 64 : ldk) + ch * 8); }
  const bf16* Kn = MODE == 0 ? Kp : Kh; const int ldn = MODE == 0 ? 64 : ldk;
#define DMA16(src, dst) __builtin_amdgcn_global_load_lds((const unsigned*)(src), (ALAS unsigned*)(dst), 16, 0, 0)
#define DMA_V(t, b) do { const bf16* vb_ = Vh + (long)(t) * 64 * ldv; DMA16(vb_ + vsrc[0], V_lds + (b) * SHM_V + wid * 1024); DMA16(vb_ + vsrc[1], V_lds + (b) * SHM_V + (wid + 8) * 1024); } while (0)
#define DMA_K(t, b) do { if constexpr (MODE == 0) { const bf16* kb_ = Kh + (long)(t) * 64 * ldk; DMA16(kb_ + kwsrc[0], K_lds + (b) * SHM_K + wid * 1024); DMA16(kb_ + kwsrc[1], K_lds + (b) * SHM_K + (wid + 8) * 1024); } \
    DMA16(Kn + (long)(t) * 64 * ldn + knsrc, K_lds + (b) * SHM_K + SHM_KW + wid * 1024); } while (0)
#define STEP_END() do { asm volatile("s_waitcnt vmcnt(0)" ::: "memory"); __syncthreads(); } while (0)
#define QKT(P0, P1, b) do { P0 = f32x16{}; P1 = f32x16{}; const ALAS char* kb_ = K_lds + (b) * SHM_K; \
    if constexpr (MODE == 0) { _Pragma("unroll") for (int d0 = 0; d0 < 8; ++d0) { const int cb = (d0 * 16 + hi * 8) * 2; \
        const bf16x8 b0 = *reinterpret_cast<const ALAS bf16x8*>(kb_ + kw_addr(r32, cb)); const bf16x8 b1 = *reinterpret_cast<const ALAS bf16x8*>(kb_ + kw_addr(32 + r32, cb)); \
        bf16x8 qf_; if (d0 < NQR) qf_ = qr[d0 < NQR ? d0 : 0]; else qf_ = *reinterpret_cast<const ALAS bf16x8*>(qpe_l + (d0 - 6) * 1024); \
        P0 = __builtin_amdgcn_mfma_f32_32x32x16_bf16(b0, qf_, P0, 0, 0, 0); P1 = __builtin_amdgcn_mfma_f32_32x32x16_bf16(b1, qf_, P1, 0, 0, 0); } } \
    _Pragma("unroll") for (int d0 = 0; d0 < 4; ++d0) { const int cb = (d0 * 16 + hi * 8) * 2; \
        const bf16x8 b0 = *reinterpret_cast<const ALAS bf16x8*>(kb_ + SHM_KW + kn_addr(r32, cb)); const bf16x8 b1 = *reinterpret_cast<const ALAS bf16x8*>(kb_ + SHM_KW + kn_addr(32 + r32, cb)); \
        bf16x8 qf_; if constexpr (MODE == 0) qf_ = *reinterpret_cast<const ALAS bf16x8*>(qpe_l + (2 + d0) * 1024); else qf_ = qr[d0]; \
        P0 = __builtin_amdgcn_mfma_f32_32x32x16_bf16(b0, qf_, P0, 0, 0, 0); P1 = __builtin_amdgcn_mfma_f32_32x32x16_bf16(b1, qf_, P1, 0, 0, 0); } } while (0)
#define RESC(a) do { if (__any((a) < 1.f)) { if (hi == 0) al_l[r32] = (a); asm volatile("s_waitcnt lgkmcnt(0)" ::: "memory"); \
    _Pragma("unroll") for (int d = 0; d < 4; ++d) _Pragma("unroll") for (int r = 0; r < 16; ++r) o[d][r] *= al_l[crow(r, hi)]; } } while (0)
  const int vb0 = (int)(unsigned)(uintptr_t)V_lds + v_rd_base(lane);
  const ALAS float* lutp = (const ALAS float*)(lds + OFF_LUT) + (2047 - (qpos0 + wid * 32 + r32) + 4 * hi);
  f32x16 pA0, pA1, pB0, pB1; float mnA, mnB, alA, alB; bf16x8 pa0, pa1, pa2, pa3; const int NT = seq / 64;
  if constexpr (PD == 1) {
    DMA_K(0, 0); DMA_V(0, 0); STEP_END();
    for (int j = 0; j < NT; ++j) {
      const int b = j & 1;
      if (j + 1 < NT) { DMA_K(j + 1, b ^ 1); DMA_V(j + 1, b ^ 1); }
      QKT(pA0, pA1, b); partialSM<MODE == 1>(pA0, pA1, m_reg, mnA, alA, C, lutp + j * 64);
      RESC(alA);
      finishSM(pA0, pA1, alA, l_reg, pa0, pa1, pa2, pa3); SBAR();
      pv_d0(o, vb0 + b * SHM_V, pa0, pa1, pa2, pa3);
      STEP_END();
    }
  } else {
  DMA_K(0, 0); STEP_END();
  DMA_K(1, 1); DMA_V(0, 0);
  QKT(pA0, pA1, 0); partialSM<MODE == 1>(pA0, pA1, m_reg, mnA, alA, C, lutp);
  STEP_END();
  for (int j = 1; j + 1 < NT; j += 2) {
    DMA_K(j + 1, 0); DMA_V(j, 1);
    SBAR(); QKT(pB0, pB1, 1);
    finishSM(pA0, pA1, alA, l_reg, pa0, pa1, pa2, pa3); SBAR();
    pv_d0(o, vb0, pa0, pa1, pa2, pa3); partialSM<MODE == 1>(pB0, pB1, m_reg, mnB, alB, C, lutp + j * 64);
    RESC(alB);
    STEP_END();
    DMA_K(j + 2, 1); DMA_V(j + 1, 0);
    SBAR(); QKT(pA0, pA1, 0);
    finishSM(pB0, pB1, alB, l_reg, pa0, pa1, pa2, pa3); SBAR();
    pv_d0(o, vb0 + SHM_V, pa0, pa1, pa2, pa3); partialSM<MODE == 1>(pA0, pA1, m_reg, mnA, alA, C, lutp + (j + 1) * 64);
    RESC(alA);
    STEP_END();
  }
  DMA_V(NT - 1, 1);
  SBAR(); QKT(pB0, pB1, 1);
  finishSM(pA0, pA1, alA, l_reg, pa0, pa1, pa2, pa3); SBAR();
  pv_d0(o, vb0, pa0, pa1, pa2, pa3); partialSM<MODE == 1>(pB0, pB1, m_reg, mnB, alB, C, lutp + (NT - 1) * 64);
  RESC(alB);
  STEP_END();
  finishSM(pB0, pB1, alB, l_reg, pa0, pa1, pa2, pa3); SBAR();
  pv_d0(o, vb0 + SHM_V, pa0, pa1, pa2, pa3);
  }
  if (hi == 0) li_l[r32] = l_reg; asm volatile("s_waitcnt lgkmcnt(0)" ::: "memory");
#pragma unroll
  for (int r = 0; r < 16; ++r) { const float rl = __builtin_amdgcn_rcpf(li_l[crow(r, hi)]);
#pragma unroll
    for (int d = 0; d < 4; ++d) o[d][r] *= rl; }
#undef DMA16
#undef DMA_V
#undef DMA_K
#undef STEP_END
#undef QKT
#undef RESC
}
}
#define XB_TMO      128
#define XB_XCNT(j)  (256  + 64 * (j))
#define XB_XSUB(j)  (1280 + 64 * (j))
#define XB_XGEN(j)  (2304 + 64 * (j))
#define XB_TOP      3328
#define XB_TOPGEN   3392
#define XCD_BAR_WORDS 3456
#define XB_SPIN_CAP (1u << 18)
#define LAS __attribute__((address_space(3)))

__device__ __forceinline__ unsigned xb_ld(unsigned* p)              { return __hip_atomic_load(p, __ATOMIC_RELAXED, __HIP_MEMORY_SCOPE_AGENT); }
__device__ __forceinline__ unsigned xb_add(unsigned* p, unsigned v) { return __hip_atomic_fetch_add(p, v, __ATOMIC_RELAXED, __HIP_MEMORY_SCOPE_AGENT); }
__device__ __forceinline__ unsigned xb_xcc_id() { return (unsigned)__builtin_amdgcn_s_getreg((3 << 11) | 20) & 0xFu; }
#define XB_SPIN(cond, bar) do { unsigned _sp = 0; while (cond) { __builtin_amdgcn_s_sleep(1); \
    if ((++_sp & 255u) == 0u) { if (xb_ld(&(bar)[XB_TMO])) break; if (_sp > XB_SPIN_CAP) { atomicAdd(&(bar)[XB_TMO], 1u); break; } } } } while (0)

struct XcdBarrier {
    unsigned* bar; unsigned x;
    volatile LAS unsigned* st;
};

__device__ __forceinline__ XcdBarrier xcd_barrier_post(unsigned* bar, volatile LAS unsigned* st) {
    XcdBarrier b; b.bar = bar; b.x = xb_xcc_id(); b.st = st;
    if (threadIdx.x == 0) (void)xb_add(&bar[XB_XCNT(b.x)], 1u);
    return b;
}
__device__ __forceinline__ void xcd_barrier_complete(unsigned* bar, unsigned x, unsigned& nloc, unsigned& nx) {
    const unsigned G = gridDim.x * gridDim.y * gridDim.z;
    unsigned sum, cnt, mine, sp = 0u;
    for (;;) {
        sum = 0u; cnt = 0u; mine = 0u;
#pragma unroll
        for (unsigned j = 0; j < 16; ++j) { const unsigned c = xb_ld(&bar[XB_XCNT(j)]); sum += c; cnt += (c > 0u) ? 1u : 0u; mine = (j == x) ? c : mine; }
        if (sum == G) break;
        __builtin_amdgcn_s_sleep(1);
        if ((++sp & 255u) == 0u) { if (xb_ld(&bar[XB_TMO])) break; if (sp > XB_SPIN_CAP) { atomicAdd(&bar[XB_TMO], 1u); break; } }
    }
    nloc = mine > 0u ? mine : 1u; nx = cnt > 0u ? cnt : 1u;
}

__device__ __forceinline__ void xcd_barrier(const XcdBarrier& b) {
    asm volatile("s_waitcnt vmcnt(0)" ::: "memory");
    __syncthreads();
    if (threadIdx.x == 0) {
        unsigned* bar = b.bar;
        __builtin_amdgcn_s_waitcnt(0);
        unsigned nloc = b.st[0], nx = b.st[1];
        if (nloc == 0u) { xcd_barrier_complete(bar, b.x, nloc, nx); b.st[0] = nloc; b.st[1] = nx; }
        const unsigned old = xb_add(&bar[XB_XSUB(b.x)], 1u);
        const unsigned gen = old / nloc;
        if (old + 1u == (gen + 1u) * nloc) {
            __builtin_amdgcn_fence(__ATOMIC_RELEASE, "agent");
            asm volatile("s_waitcnt vmcnt(0)" ::: "memory");
            const unsigned og = xb_add(&bar[XB_TOP], 1u);
            const unsigned tg = og / nx;
            if (og + 1u == (tg + 1u) * nx) xb_add(&bar[XB_TOPGEN], 1u);
            else XB_SPIN(xb_ld(&bar[XB_TOPGEN]) == tg, bar);
            __builtin_amdgcn_fence(__ATOMIC_ACQUIRE, "agent");
            xb_add(&bar[XB_XGEN(b.x)], 1u);
            asm volatile("s_waitcnt vmcnt(0)" ::: "memory");
        } else {
            XB_SPIN(xb_ld(&bar[XB_XGEN(b.x)]) == gen, bar);
            __builtin_amdgcn_fence(__ATOMIC_ACQUIRE, "agent");
            asm volatile("s_waitcnt vmcnt(0)" ::: "memory");
        }
    }
    __syncthreads();
}


constexpr int NB = 32, SEQ = 2048, T = NB * SEQ, D = 1024, IN_COLS = 1984, PROJ_LD = 2048;
constexpr int NE = 32, TOPK = 4, HALF_T = T / 2, HALF_A = HALF_T * TOPK;
constexpr int ROWS_HALF = HALF_A + NE * 256, TILES_MAX = ROWS_HALF / 256;
constexpr float NORM_EPS = 1e-5f, LOG2E = 1.4426950408889634f;
constexpr int NWAVES = 8, NTHREADS = 512;

constexpr size_t KiB = 1024, MiB = 1u << 20;
constexpr size_t WS_CTL = 0, CTL_ZERO_BYTES = 64 * KiB;
constexpr size_t WS_ROPE = 1 * MiB;
constexpr size_t WS_BIAS = 1 * MiB + 512 * KiB;
constexpr size_t WS_LAM = 1 * MiB + 768 * KiB;
constexpr size_t WS_RINV = 2 * MiB;
constexpr size_t WS_EIDX = 3 * MiB, WS_GATE = 4 * MiB, WS_LRANK = 5 * MiB;
constexpr size_t WS_HIST = 6 * MiB;
constexpr size_t WS_ROWA = 7 * MiB, WS_ROWG = 9 * MiB;
constexpr size_t WS_TINFO = 11 * MiB;
constexpr size_t WS_WRH = 12 * MiB, WS_WRL = 12 * MiB + 64 * KiB;
constexpr size_t WS_WUQ = 13 * MiB, WS_WUKV = 13 * MiB + 512 * KiB;
constexpr size_t WS_WIN = 16 * MiB, WS_WO = 20 * MiB;
constexpr size_t WS_WD = 24 * MiB, WS_WGU = 88 * MiB;
constexpr size_t WS_XB = 216 * MiB;
constexpr size_t WS_PROJ = 344 * MiB, WS_QM = 600 * MiB, WS_KV = 696 * MiB, WS_MIXED = 824 * MiB, WS_CQN = 952 * MiB, WS_CKVN = 984 * MiB, WS_KPE = 1000 * MiB;
constexpr size_t WS_ACT = 344 * MiB, WS_Y4A = 616 * MiB, WS_Y4B = 88 * MiB;
constexpr size_t WS_END = 1008 * MiB;
static_assert(WS_ACT + (size_t)ROWS_HALF * 2048 <= WS_Y4A && WS_Y4A + (size_t)HALF_A * 2048 <= WS_END && WS_Y4B + (size_t)HALF_A * 2048 <= WS_PROJ, "ws map");

constexpr int SCRATCH_BYTES = 135168;
constexpr int MISC_OFF = SCRATCH_BYTES;
constexpr int LDS_BYTES = SCRATCH_BYTES + 1024;
static_assert(att::ATT_LDS <= SCRATCH_BYTES && pg8::STAGE_BYTES <= SCRATCH_BYTES, "LDS map");

#define GAS __attribute__((address_space(1)))
typedef unsigned short bf16;
typedef float f32x4 __attribute__((ext_vector_type(4)));
typedef float f32x2 __attribute__((ext_vector_type(2)));
typedef unsigned u32x4 __attribute__((ext_vector_type(4)));
typedef unsigned u32x2 __attribute__((ext_vector_type(2)));
typedef short bf16x8 __attribute__((ext_vector_type(8)));
typedef float f32x16 __attribute__((ext_vector_type(16)));
#define LDS_WAIT() asm volatile("s_waitcnt lgkmcnt(0)" ::: "memory")
#define VM_WAIT() asm volatile("s_waitcnt vmcnt(0)" ::: "memory")
__device__ __forceinline__ unsigned pk2(float lo, float hi) { return pg8::cvt_pk_bf16(lo, hi); }
__device__ __forceinline__ float bf2f(unsigned short v) { return __uint_as_float(((unsigned)v) << 16); }
__device__ __forceinline__ float wave_sum(float v) {
#pragma unroll
    for (int o = 1; o < 64; o <<= 1) v += __shfl_xor(v, o);
    return v;
}

struct Args {
    const float* in[22]; float* out; unsigned char* ws; int ph_lo, ph_hi;
};

template <class RowMap>
__device__ __forceinline__ void transpose_item(const float* W, int K, int N, bf16* WT, LAS float* scr, int item, int lane, const float* kscale, RowMap rm) {
    const int nblk = N / 32, kb = item / nblk, nb = item % nblk, k0 = 64 * kb, n0 = 32 * nb;
#pragma unroll 8
    for (int i = 0; i < 32; ++i) { const int kk = 2 * i + (lane >> 5); float v = W[(size_t)(k0 + kk) * N + n0 + (lane & 31)]; if (kscale) v *= kscale[k0 + kk]; scr[kk * 33 + (lane & 31)] = v; }
    LDS_WAIT(); asm volatile("" ::: "memory");
    const int c = lane & 7;
#pragma unroll
    for (int j = 0; j < 4; ++j) { const int n = (lane >> 3) + 8 * j; const LAS float* s = scr + (8 * c) * 33 + n;
        u32x4 o; o.x = pk2(s[0 * 33], s[1 * 33]); o.y = pk2(s[2 * 33], s[3 * 33]); o.z = pk2(s[4 * 33], s[5 * 33]); o.w = pk2(s[6 * 33], s[7 * 33]);
        *(u32x4*)(WT + (size_t)rm(n0 + n) * K + k0 + 8 * c) = o; }
    LDS_WAIT(); asm volatile("" ::: "memory");
}
struct RmId { __device__ __forceinline__ int operator()(int n) const { return n; } };
struct RmGu { __device__ __forceinline__ int operator()(int n) const { const int up = n >> 10, j = n & 1023; return 256 * (j >> 7) + 128 * up + (j & 127); } };

__device__ __forceinline__ void rms_row_to_bf16(const float* xrow, const float* g, bf16* orow, int lane) {
    const f32x4* xr = (const f32x4*)xrow + lane; const f32x4* gr = (const f32x4*)g + lane;
    f32x4 v[4]; float s = 0.f;
#pragma unroll
    for (int j = 0; j < 4; ++j) { v[j] = xr[64 * j]; s += (v[j].x * v[j].x + v[j].y * v[j].y) + (v[j].z * v[j].z + v[j].w * v[j].w); }
    const float r = 1.f / sqrtf(wave_sum(s) * (1.f / D) + NORM_EPS);
    u32x2* o8 = (u32x2*)orow + lane;
#pragma unroll
    for (int j = 0; j < 4; ++j) { const f32x4 gg = gr[64 * j]; u32x2 w; w.x = pk2(v[j].x * r * gg.x, v[j].y * r * gg.y); w.y = pk2(v[j].z * r * gg.z, v[j].w * r * gg.w); o8[64 * j] = w; }
}
__device__ __forceinline__ int t5_bucket(int rel) {
    const int n = rel < 0 ? -rel : rel; int b;
    if (n < 8) b = n; else { const int n2 = n * n; b = n2 >= 8192 ? 15 : n2 >= 4096 ? 14 : n2 >= 2048 ? 13 : n2 >= 1024 ? 12 : n2 >= 512 ? 11 : n2 >= 256 ? 10 : n2 >= 128 ? 9 : 8; }
    return (rel > 0 ? 16 : 0) + b;
}
__device__ __forceinline__ void p0_prologue(const Args& a, LAS unsigned char* lds, int vcu, int G, int wave, int lane) {
    unsigned char* ws = a.ws;
    LAS float* scr = (LAS float*)(lds + wave * 16384);
    const int gw = vcu * NWAVES + wave, NGW = G * NWAVES;
    const float* ffn_g = a.in[14];
    constexpr int I_IN = 16 * 62, I_UQ = 4 * 24, I_UKV = 2 * 32, I_O = 16 * 32, I_GU1 = 16 * 64, I_GU = NE * I_GU1, I_D1 = 16 * 32, I_D = NE * I_D1;
    constexpr int NITEMS = I_IN + I_UQ + I_UKV + I_O + I_GU + I_D;
    for (int it = gw; it < NITEMS; it += NGW) {
        int r = it;
        if (r < I_GU) { const int e = r / I_GU1; transpose_item(a.in[17] + (size_t)e * 1024 * 2048, 1024, 2048, (bf16*)(ws + WS_WGU) + (size_t)e * 2048 * 1024, scr, r % I_GU1, lane, ffn_g, RmGu{}); continue; } r -= I_GU;
        if (r < I_D) { const int e = r / I_D1; transpose_item(a.in[19] + (size_t)e * 1024 * 1024, 1024, 1024, (bf16*)(ws + WS_WD) + (size_t)e * 1024 * 1024, scr, r % I_D1, lane, nullptr, RmId{}); continue; } r -= I_D;
        if (r < I_IN) { transpose_item(a.in[3], 1024, IN_COLS, (bf16*)(ws + WS_WIN), scr, r, lane, nullptr, RmId{}); continue; } r -= I_IN;
        if (r < I_O) { transpose_item(a.in[13], 1024, 1024, (bf16*)(ws + WS_WO), scr, r, lane, nullptr, RmId{}); continue; } r -= I_O;
        if (r < I_UQ) { transpose_item(a.in[10], 256, 768, (bf16*)(ws + WS_WUQ), scr, r, lane, nullptr, RmId{}); continue; } r -= I_UQ;
        transpose_item(a.in[12], 128, 1024, (bf16*)(ws + WS_WUKV), scr, r, lane, nullptr, RmId{});
    }
    const int gt = gw * 64 + lane, NGT = NGW * 64;
    for (int i = gt; i < 64 * 1024 / 8; i += NGT) *((u32x4*)((bf16*)(ws + WS_WIN) + (size_t)IN_COLS * 1024) + i) = (u32x4){0u, 0u, 0u, 0u};
    for (int i = gt; i < 1024 * NE; i += NGT) { const int k = i >> 5, e = i & 31; const float w = a.in[15][i] * ffn_g[k];
        const unsigned h = pk2(w, 0.f) & 0xffffu; const float wl = w - bf2f((unsigned short)h);
        ((bf16*)(ws + WS_WRH))[e * 1024 + k] = (bf16)h; ((bf16*)(ws + WS_WRL))[e * 1024 + k] = (bf16)(pk2(wl, 0.f) & 0xffffu); }
    for (int i = gt; i < SEQ * 32; i += NGT) { const int pos = i >> 5, fi = i & 31;
        const float inv = (float)::exp2(-(double)fi * (13.287712379549449 / 32.0)); const float ang = (float)pos * inv;
        double tt = (double)ang * 0.15915494309189535; tt -= __builtin_rint(tt); const double rr = tt * 6.283185307179586, r2 = rr * rr;
        double cs_ = 1.0, sn = rr, term_c = 1.0, term_s = rr;
#pragma unroll
        for (int k = 1; k <= 13; ++k) { term_c *= -r2 / (double)((2 * k - 1) * (2 * k)); term_s *= -r2 / (double)((2 * k) * (2 * k + 1)); cs_ += term_c; sn += term_s; }
        ((f32x2*)(ws + WS_ROPE))[i] = (f32x2){(float)cs_, (float)sn}; }
    for (int i = gt; i < 8 * 4096; i += NGT) { const int m = i >> 12, d = i & 4095; ((float*)(ws + WS_BIAS))[i] = d < 4095 ? a.in[1][t5_bucket(d - 2047) * 8 + m] * LOG2E : 0.f; }
    if (gw == 0) { const float s1 = wave_sum(a.in[4][lane] * a.in[5][lane]), s2 = wave_sum(a.in[6][lane] * a.in[7][lane]);
        if (lane == 0) *(float*)(ws + WS_LAM) = __expf(s1) - __expf(s2) + 0.2f; }
    for (int m = gw; m < T; m += NGW) rms_row_to_bf16(a.in[0] + (size_t)m * D, a.in[2], (bf16*)(ws + WS_XB) + (size_t)m * D, lane);
}

__device__ __forceinline__ void p1b_latent(const Args& a, int vcu, int G, int wave, int lane) {
    unsigned char* ws = a.ws; const int gw = vcu * NWAVES + wave, NGW = G * NWAVES;
    const float* gq = a.in[9]; const float* gkv = a.in[11];
    for (int t = gw; t < T; t += NGW) {
        const bf16* pr = (const bf16*)(ws + WS_PROJ) + (size_t)t * PROJ_LD + 1536;
        bf16x8 v = (bf16x8){0, 0, 0, 0, 0, 0, 0, 0}; if (lane < 56) v = *(const bf16x8*)(pr + 8 * lane);
        float f[8], sq = 0.f;
#pragma unroll
        for (int j = 0; j < 8; ++j) { f[j] = bf2f((unsigned short)v[j]); sq += f[j] * f[j]; }
        const float sq_q = wave_sum(lane < 32 ? sq : 0.f), sq_kv = wave_sum((lane >= 32 && lane < 48) ? sq : 0.f);
        const float rq = 1.f / sqrtf(sq_q * (1.f / 256.f) + NORM_EPS), rkv = 1.f / sqrtf(sq_kv * (1.f / 128.f) + NORM_EPS);
        float part[8];
#pragma unroll
        for (int j = 0; j < 8; ++j) part[j] = __shfl_xor(f[j], 4);
        float o[8];
        if (lane < 32) {
#pragma unroll
            for (int j = 0; j < 8; ++j) o[j] = f[j] * rq * gq[8 * lane + j];
        } else if (lane < 48) {
#pragma unroll
            for (int j = 0; j < 8; ++j) o[j] = f[j] * rkv * gkv[8 * (lane - 32) + j];
        } else {
            const int aa = lane - 48; const f32x2* cp = (const f32x2*)(ws + WS_ROPE) + (size_t)(t & (SEQ - 1)) * 32 + 8 * (aa & 3);
#pragma unroll
            for (int j = 0; j < 8; ++j) { const f32x2 c = lane < 56 ? cp[j] : (f32x2){0.f, 0.f};
                o[j] = (aa < 4) ? (f[j] * c.x - part[j] * c.y) : (part[j] * c.y + f[j] * c.x); }
        }
        u32x4 w; w.x = pk2(o[0], o[1]); w.y = pk2(o[2], o[3]); w.z = pk2(o[4], o[5]); w.w = pk2(o[6], o[7]);
        if (lane < 32) *(u32x4*)((bf16*)(ws + WS_CQN) + (size_t)t * 256 + 8 * lane) = w;
        else if (lane < 48) *(u32x4*)((bf16*)(ws + WS_CKVN) + (size_t)t * 128 + 8 * (lane - 32)) = w;
        else if (lane < 56) *(u32x4*)((bf16*)(ws + WS_KPE) + (size_t)t * 64 + 8 * (lane - 48)) = w;
    }
}

__device__ __forceinline__ void p2_attention(const Args& a, LAS unsigned char* lds, int vcu, int G) {
    unsigned char* ws = a.ws;
    const int tid = threadIdx.x, wid = tid >> 6, lane = tid & 63, r32 = lane & 31, hi = lane >> 5;
    const bf16* proj = (const bf16*)(ws + WS_PROJ); bf16* mixed = (bf16*)(ws + WS_MIXED);
    const float lam = *(const float*)(ws + WS_LAM);
#ifndef ATT_SKIP_DIFF
    {
        const float C = 0.125f * LOG2E;
        float sg[4];
#pragma unroll
        for (int d0 = 0; d0 < 4; ++d0) sg[d0] = a.in[8][32 * d0 + r32] * 0.8f;
        LAS unsigned* stash = (LAS unsigned*)(lds + att::OFF_STASH) + (wid * 32) * 64 + lane;
        for (int it = 0;; ++it) {
            const int u = (it >> 1) * G + vcu, j = it & 1; if (u >= NB * 4 * 8) break;
            const int qb = u & 7, h = (u >> 3) & 3, b = u >> 5, q0 = qb * 256, mp = 2 * h + j;
            { const float* src = (const float*)(ws + WS_BIAS) + mp * 4096; LAS float* lut = (LAS float*)(lds + att::OFF_LUT);
#pragma unroll
              for (int i = 0; i < 8; ++i) lut[tid + 512 * i] = src[tid + 512 * i]; }
            const bf16* base = proj + (size_t)b * SEQ * PROJ_LD;
            f32x16 o[4];
            att::attn_unit<1, 2>(base + (size_t)q0 * PROJ_LD + 64 * mp, PROJ_LD, base + 512 + 64 * mp, PROJ_LD, nullptr, base + 1024 + 128 * h, PROJ_LD, SEQ,
                                 (LAS char*)lds, C, nullptr, q0, o);
            if (j == 0) {
#pragma unroll
                for (int d0 = 0; d0 < 4; ++d0)
#pragma unroll
                    for (int r = 0; r < 16; r += 2) stash[(d0 * 8 + (r >> 1)) * 64] = pk2(o[d0][r], o[d0][r + 1]);
            } else {
                bf16* orow = mixed + (size_t)(b * SEQ + q0 + wid * 32) * D + 128 * h + r32;
#pragma unroll
                for (int rp = 0; rp < 8; ++rp) {
                    float v[2][4], ss[2] = {0.f, 0.f};
#pragma unroll
                    for (int d0 = 0; d0 < 4; ++d0) { const unsigned w = stash[(d0 * 8 + rp) * 64];
                        v[0][d0] = bf2f((unsigned short)(w & 0xffffu)) - lam * o[d0][2 * rp]; v[1][d0] = bf2f((unsigned short)(w >> 16)) - lam * o[d0][2 * rp + 1];
                        ss[0] += v[0][d0] * v[0][d0]; ss[1] += v[1][d0] * v[1][d0]; }
#pragma unroll
                    for (int q = 0; q < 2; ++q) {
#pragma unroll
                        for (int sft = 1; sft < 32; sft <<= 1) ss[q] += __shfl_xor(ss[q], sft);
                        const float rn = 1.f / sqrtf(ss[q] * (1.f / 128.f) + NORM_EPS);
                        bf16* op = orow + (size_t)att::crow(2 * rp + q, hi) * D;
#pragma unroll
                        for (int d0 = 0; d0 < 4; ++d0) op[32 * d0] = (bf16)(pk2(v[q][d0] * rn * sg[d0], 0.f) & 0xffffu);
                    }
                }
            }
        }
    }
#endif
#ifndef ATT_SKIP_MLA
    {
        const float C = 0.07216878364870322f * LOG2E;
        for (int it = 0;; ++it) {
            const int u = it * G + vcu; if (u >= NB * 4 * 8) break;
            const int qb = u & 7, h = (u >> 3) & 3, b = u >> 5, q0 = qb * 256;
            const bf16* qm = (const bf16*)(ws + WS_QM) + (size_t)(b * SEQ + q0) * 768 + 192 * h;
            const bf16* kv = (const bf16*)(ws + WS_KV) + (size_t)b * SEQ * 1024 + 256 * h;
            const bf16* kpe = (const bf16*)(ws + WS_KPE) + (size_t)b * SEQ * 64;
            f32x16 o[4];
            att::attn_unit<0, 1>(qm, 768, kv, 1024, kpe, kv + 128, 1024, SEQ, (LAS char*)lds, C, (const att::f32x2*)(ws + WS_ROPE), q0, o);
            bf16* orow = mixed + (size_t)(b * SEQ + q0 + wid * 32) * D + 512 + 128 * h + r32;
#pragma unroll
            for (int r = 0; r < 16; ++r) { bf16* op = orow + (size_t)att::crow(r, hi) * D;
#pragma unroll
                for (int d0 = 0; d0 < 4; ++d0) op[32 * d0] = (bf16)(pk2(o[d0][r], 0.f) & 0xffffu); }
        }
    }
#endif
}

constexpr int WR_PITCH = 2064;
__device__ __forceinline__ void p3b_router(const Args& a, LAS unsigned char* lds, int G) {
    unsigned char* ws = a.ws;
    const int tid = threadIdx.x, wid = tid >> 6, lane = tid & 63, r32 = lane & 31, hi = lane >> 5;
    LAS unsigned char* wrh = lds; LAS unsigned char* wrl = lds + 32 * WR_PITCH; LAS unsigned* cnt = (LAS unsigned*)(lds + 64 * WR_PITCH);
    for (int i = tid; i < 2 * 32 * 128; i += NTHREADS) { const int tb = i >> 12, e = (i >> 7) & 31, c = i & 127;
        *(LAS u32x4*)(lds + (tb * 32 + e) * WR_PITCH + c * 16) = *((const u32x4*)(ws + (tb ? WS_WRL : WS_WRH)) + e * 128 + c); }
    const float* x1 = a.out; bf16* xb = (bf16*)(ws + WS_XB);
    for (int c = blockIdx.x; c < T / 256; c += G) {
        if (tid < 32) cnt[tid] = 0u;
        __syncthreads();
        const int t = c * 256 + wid * 32 + r32;
        const float* xr = x1 + (size_t)t * D + 64 * hi; bf16* xo = xb + (size_t)t * D + 64 * hi;
        f32x16 acc = f32x16{}; float ss = 0.f;
        for (int sg = 0; sg < 8; ++sg) {
            f32x4 v[16];
#pragma unroll
            for (int q = 0; q < 16; ++q) v[q] = *(const f32x4*)(xr + 128 * sg + 4 * q);
#pragma unroll
            for (int j = 0; j < 8; ++j) {
                const f32x4 x0 = v[2 * j], x1v = v[2 * j + 1];
                ss += (x0.x * x0.x + x0.y * x0.y) + (x0.z * x0.z + x0.w * x0.w) + (x1v.x * x1v.x + x1v.y * x1v.y) + (x1v.z * x1v.z + x1v.w * x1v.w);
                u32x4 hw; hw.x = pk2(x0.x, x0.y); hw.y = pk2(x0.z, x0.w); hw.z = pk2(x1v.x, x1v.y); hw.w = pk2(x1v.z, x1v.w);
                u32x4 lw;
                lw.x = pk2(x0.x - __uint_as_float(hw.x << 16), x0.y - __uint_as_float(hw.x & 0xffff0000u)); lw.y = pk2(x0.z - __uint_as_float(hw.y << 16), x0.w - __uint_as_float(hw.y & 0xffff0000u));
                lw.z = pk2(x1v.x - __uint_as_float(hw.z << 16), x1v.y - __uint_as_float(hw.z & 0xffff0000u)); lw.w = pk2(x1v.z - __uint_as_float(hw.w << 16), x1v.w - __uint_as_float(hw.w & 0xffff0000u));
                *(u32x4*)(xo + 128 * sg + 8 * j) = hw;
                const int kb = (128 * sg + 64 * hi + 8 * j) * 2;
                const bf16x8 wh = *(const LAS bf16x8*)(wrh + r32 * WR_PITCH + kb), wl = *(const LAS bf16x8*)(wrl + r32 * WR_PITCH + kb);
                const bf16x8 xh = __builtin_bit_cast(bf16x8, hw), xl = __builtin_bit_cast(bf16x8, lw);
                acc = __builtin_amdgcn_mfma_f32_32x32x16_bf16(wh, xh, acc, 0, 0, 0);
                acc = __builtin_amdgcn_mfma_f32_32x32x16_bf16(wh, xl, acc, 0, 0, 0);
                acc = __builtin_amdgcn_mfma_f32_32x32x16_bf16(wl, xh, acc, 0, 0, 0);
            }
        }
        ss += __shfl_xor(ss, 32);
        const float rinv = 1.f / sqrtf(ss * (1.f / D) + NORM_EPS);
        if (hi == 0) ((float*)(ws + WS_RINV))[t] = rinv;
        float lg[16];
#pragma unroll
        for (int r = 0; r < 16; ++r) lg[r] = acc[r] * rinv + a.in[16][att::crow(r, hi)];
        float tv[4]; int ti[4];
#pragma unroll
        for (int k = 0; k < 4; ++k) {
            float bv = lg[0]; int bi = att::crow(0, hi);
#pragma unroll
            for (int r = 1; r < 16; ++r) { const int e = att::crow(r, hi); if (lg[r] > bv) { bv = lg[r]; bi = e; } }
            const float ov = __shfl_xor(bv, 32); const int oi = __shfl_xor(bi, 32);
            const bool mine = (bv > ov) || (bv == ov && bi < oi);
            tv[k] = mine ? bv : ov; ti[k] = mine ? bi : oi;
#pragma unroll
            for (int r = 0; r < 16; ++r) if (att::crow(r, hi) == ti[k]) lg[r] = -3.0e38f;
        }
        const float e1 = __expf(tv[1] - tv[0]), e2 = __expf(tv[2] - tv[0]), e3 = __expf(tv[3] - tv[0]), rs = 1.f / (1.f + e1 + e2 + e3);
        if (hi == 0) {
            int lr[4];
#pragma unroll
            for (int k = 0; k < 4; ++k) lr[k] = (int)__hip_atomic_fetch_add(cnt + ti[k], 1u, __ATOMIC_RELAXED, __HIP_MEMORY_SCOPE_WORKGROUP);
            *((int4*)(ws + WS_EIDX) + t) = make_int4(ti[0], ti[1], ti[2], ti[3]);
            *((f32x4*)(ws + WS_GATE) + t) = (f32x4){rs, e1 * rs, e2 * rs, e3 * rs};
            *((int4*)(ws + WS_LRANK) + t) = make_int4(lr[0], lr[1], lr[2], lr[3]);
        }
        __syncthreads();
        if (tid < 32) ((int*)(ws + WS_HIST))[c * 32 + tid] = (int)cnt[tid];
        __syncthreads();
    }
}

__device__ __forceinline__ void p4_scatter(const Args& a, LAS unsigned char* lds, int G) {
    unsigned char* ws = a.ws; const int tid = threadIdx.x;
    LAS int* hist = (LAS int*)lds;
    LAS int* cntE = hist + 256 * 32;
    LAS int* pst = cntE + 64;
    for (int i = tid; i < 256 * 32; i += NTHREADS) hist[i] = ((const int*)(ws + WS_HIST))[i];
    __syncthreads();
    if (tid < 64) { const int hf = tid >> 5, e = tid & 31; int run = 0;
        for (int c = 0; c < 128; ++c) { const int v = hist[(hf * 128 + c) * 32 + e]; hist[(hf * 128 + c) * 32 + e] = run; run += v; }
        cntE[tid] = run; }
    __syncthreads();
    if (tid < 64) { const int hf = tid >> 5, e = tid & 31; int s = 0;
        for (int q = 0; q < e; ++q) s += (cntE[hf * 32 + q] + 255) & ~255;
        pst[tid] = s; }
    __syncthreads();
    int* rowa = (int*)(ws + WS_ROWA); float* rowg = (float*)(ws + WS_ROWG);
    for (int c = blockIdx.x; c < T / 256; c += G) { const int hf = c >> 7;
        for (int i = tid; i < 1024; i += NTHREADS) { const int asg = c * 1024 + i; const int e = ((const int*)(ws + WS_EIDX))[asg];
            const int p = pst[hf * 32 + e] + hist[c * 32 + e] + ((const int*)(ws + WS_LRANK))[asg];
            rowa[hf * ROWS_HALF + p] = asg; rowg[hf * ROWS_HALF + p] = ((const float*)(ws + WS_GATE))[asg]; } }
    if (blockIdx.x == 0 && tid < 64) { const int hf = tid >> 5, e = tid & 31; const int n = cntE[tid], st = pst[tid], pad = (n + 255) & ~255;
        for (int p = st + n; p < st + pad; ++p) { rowa[hf * ROWS_HALF + p] = -1; rowg[hf * ROWS_HALF + p] = 0.f; }
        int* tinfo = (int*)(ws + WS_TINFO);
        for (int tt = st >> 8; tt < (st + pad) >> 8; ++tt) tinfo[hf * 1024 + tt] = e;
        if (e == 31) tinfo[2048 + hf] = (st + pad) >> 8; }
}

struct MoeOrder {
    const int* tinfo; const int* rowa; int ntiles, nN, lgN, G, c;
    __device__ __forceinline__ bool next(int i, pg8::Unit& u) const {
        const int L = i * G + c; if (L >= ntiles * nN) return false;
        const int tile = L >> lgN, pn = L & (nN - 1); const int e = tinfo[tile]; u.pm = tile; u.pn = e * nN + pn; return true;
    }
    __device__ __forceinline__ int gather_row(const pg8::Unit& u, int i) const { const int as = rowa[u.pm * 256 + i]; return as < 0 ? 0 : (as >> 2); }
};
struct EpiSwiglu {
    static constexpr bool PERM = true;
    bf16* act; const float* rinv; const int* rowa; const float* bgu;
    __device__ __forceinline__ void operator()(const pg8::f32x4 (&acc)[2][2][4][2], const pg8::Unit& u, int wr, int wc, int fr, int fq) const {
        const int e = u.pn >> 3, pn = u.pn & 7, col0 = 128 * pn + 32 * wc + 8 * fq;
        const float* bp = bgu + (size_t)e * 2048 + col0;
        f32x4 bg[2], bu[2];
#pragma unroll
        for (int n = 0; n < 2; ++n) { bg[n] = *(const f32x4*)(bp + 4 * n); bu[n] = *(const f32x4*)(bp + 1024 + 4 * n); }
#pragma unroll
        for (int ai = 0; ai < 2; ++ai)
#pragma unroll
            for (int m = 0; m < 4; ++m) {
                const int p = u.pm * 256 + ai * 128 + wr * 64 + m * 16 + fr; const int as = rowa[p]; const float ri = rinv[as < 0 ? 0 : (as >> 2)];
                float o[8];
#pragma unroll
                for (int n = 0; n < 2; ++n)
#pragma unroll
                    for (int q = 0; q < 4; ++q) {
                        float g = fminf(acc[ai][0][m][n][q] * ri + bg[n][q], 7.f); const float up = fminf(fmaxf(acc[ai][1][m][n][q] * ri + bu[n][q], -7.f), 7.f);
                        const float sg = __builtin_amdgcn_rcpf(1.f + __builtin_amdgcn_exp2f(g * (-1.702f * LOG2E)));
                        o[4 * n + q] = (up + 1.f) * (g * sg); }
                u32x4 w; w.x = pk2(o[0], o[1]); w.y = pk2(o[2], o[3]); w.z = pk2(o[4], o[5]); w.w = pk2(o[6], o[7]);
                *(u32x4*)(act + (size_t)p * 1024 + col0) = w; }
    }
};
struct EpiDown {
    static constexpr bool PERM = true;
    bf16* y4; const int* rowa; const float* rowg; const float* bd; int slot0;
    __device__ __forceinline__ void operator()(const pg8::f32x4 (&acc)[2][2][4][2], const pg8::Unit& u, int wr, int wc, int fr, int fq) const {
        const int e = u.pn >> 2, pn = u.pn & 3, col0 = 256 * pn + 32 * wc + 8 * fq;
        const float* bp = bd + (size_t)e * 1024 + col0;
        f32x4 bv[2][2];
#pragma unroll
        for (int bj = 0; bj < 2; ++bj)
#pragma unroll
            for (int n = 0; n < 2; ++n) bv[bj][n] = *(const f32x4*)(bp + 128 * bj + 4 * n);
#pragma unroll
        for (int ai = 0; ai < 2; ++ai)
#pragma unroll
            for (int m = 0; m < 4; ++m) {
                const int p = u.pm * 256 + ai * 128 + wr * 64 + m * 16 + fr; const int as = rowa[p];
                if (as >= 0) { const float gt = rowg[p]; bf16* yr = y4 + (size_t)(as - slot0) * 1024 + col0;
#pragma unroll
                    for (int bj = 0; bj < 2; ++bj) { const f32x4 v0 = (acc[ai][bj][m][0] + bv[bj][0]) * gt, v1 = (acc[ai][bj][m][1] + bv[bj][1]) * gt;
                        u32x4 w; w.x = pk2(v0[0], v0[1]); w.y = pk2(v0[2], v0[3]); w.z = pk2(v1[0], v1[1]); w.w = pk2(v1[2], v1[3]);
                        *(u32x4*)(yr + 128 * bj) = w; } } }
    }
};

__device__ __forceinline__ void p7_final(const Args& a, int vcu, int G, int wave, int lane) {
    unsigned char* ws = a.ws; const int gw = vcu * NWAVES + wave, NGW = G * NWAVES;
    const f32x4* gr = (const f32x4*)a.in[21] + lane;
    for (int t = gw; t < T; t += NGW) {
        f32x4* xr = (f32x4*)(a.out + (size_t)t * D) + lane;
        const u32x2* yr = (const u32x2*)((t < HALF_T ? (const bf16*)(ws + WS_Y4A) + (size_t)t * 4 * D : (const bf16*)(ws + WS_Y4B) + (size_t)(t - HALF_T) * 4 * D)) + lane;
        f32x4 v[4]; float s = 0.f;
#pragma unroll
        for (int j = 0; j < 4; ++j) { v[j] = xr[64 * j];
#pragma unroll
            for (int k = 0; k < 4; ++k) { const u32x2 w = yr[k * 256 + 64 * j];
                v[j].x += __uint_as_float(w.x << 16); v[j].y += __uint_as_float(w.x & 0xffff0000u); v[j].z += __uint_as_float(w.y << 16); v[j].w += __uint_as_float(w.y & 0xffff0000u); }
            s += (v[j].x * v[j].x + v[j].y * v[j].y) + (v[j].z * v[j].z + v[j].w * v[j].w); }
        const float r = 1.f / sqrtf(wave_sum(s) * (1.f / D) + NORM_EPS);
#pragma unroll
        for (int j = 0; j < 4; ++j) { const f32x4 gg = gr[64 * j]; xr[64 * j] = (f32x4){v[j].x * r * gg.x, v[j].y * r * gg.y, v[j].z * r * gg.z, v[j].w * r * gg.w}; }
    }
}

constexpr int N_PHASES = 13;
__global__ void __launch_bounds__(NTHREADS, 2) fwd(Args args) {
    extern __shared__ __attribute__((aligned(16))) unsigned char lds_raw[];
    LAS unsigned char* lds = (LAS unsigned char*)lds_raw;
    volatile LAS unsigned* MISC = (volatile LAS unsigned*)(lds + MISC_OFF);
    const int tid = threadIdx.x, lane = tid & 63, wave = __builtin_amdgcn_readfirstlane(tid >> 6);
    const int G = gridDim.x; const int bx = blockIdx.x; const int vcu = (G % 8 == 0) ? (bx % 8) * (G / 8) + bx / 8 : bx;
    unsigned char* ws = args.ws;
    for (int u = tid; u < (LDS_BYTES - MISC_OFF) / 4; u += NTHREADS) MISC[u] = 0u;
    __syncthreads();
    const int lo = args.ph_lo, hi = args.ph_hi;
    const bool use_bar = (hi - lo) > 1;
    XcdBarrier bar; bar.bar = (unsigned*)(ws + WS_CTL); bar.x = 0; bar.st = nullptr;
    if (use_bar) bar = xcd_barrier_post((unsigned*)(ws + WS_CTL), MISC + 8);
#ifdef ONLY_PHASE
#define IN(k) ((k) == ONLY_PHASE)
#else
#define IN(k) (lo <= (k) && (k) < hi)
#endif
#define SEAM(k) do { if (IN(k) && IN((k) + 1)) xcd_barrier(bar); } while (0)

    if (IN(0)) { p0_prologue(args, lds, vcu, G, wave, lane); }
    SEAM(0);
    if (IN(1)) {
        pg8::Gemm g{(const bf16*)(ws + WS_XB), (const bf16*)(ws + WS_WIN), T, PROJ_LD, D}; pg8::StaticOrder S; S.init(T, PROJ_LD, G, bx);
        pg8::EpiBf16 E{(bf16*)(ws + WS_PROJ), PROJ_LD};
        pg8::gemm_phase<pg8::EpiBf16, pg8::StaticOrder, true, false>(lds, g, S, E);
    }
    SEAM(1);
    if (IN(2)) { p1b_latent(args, vcu, G, wave, lane); }
    SEAM(2);
    if (IN(3)) {
        { pg8::Gemm g{(const bf16*)(ws + WS_CQN), (const bf16*)(ws + WS_WUQ), T, 768, 256}; pg8::StaticOrder S; S.init(T, 768, G, bx);
          pg8::EpiBf16 E{(bf16*)(ws + WS_QM), 768}; pg8::gemm_phase<pg8::EpiBf16, pg8::StaticOrder, true, false>(lds, g, S, E); }
        { pg8::Gemm g{(const bf16*)(ws + WS_CKVN), (const bf16*)(ws + WS_WUKV), T, 1024, 128}; pg8::StaticOrder S; S.init(T, 1024, G, bx);
          pg8::EpiBf16 E{(bf16*)(ws + WS_KV), 1024}; pg8::gemm_phase<pg8::EpiBf16, pg8::StaticOrder, true, false>(lds, g, S, E); }
    }
    SEAM(3);
    if (IN(4)) { p2_attention(args, lds, vcu, G); }
    SEAM(4);
    if (IN(5)) {
        pg8::Gemm g{(const bf16*)(ws + WS_MIXED), (const bf16*)(ws + WS_WO), T, D, D}; pg8::StaticOrder S; S.init(T, D, G, bx);
        pg8::EpiResid E{args.in[0], args.out, D};
        pg8::gemm_phase<pg8::EpiResid, pg8::StaticOrder, true, false>(lds, g, S, E);
    }
    SEAM(5);
    if (IN(6)) { p3b_router(args, lds, G); }
    SEAM(6);
    if (IN(7)) { p4_scatter(args, lds, G); }
    SEAM(7);
#define MOE_HALF(PH, HF, Y4OFF) \
    if (IN(PH)) { \
        const int* tinfo = (const int*)(ws + WS_TINFO); MoeOrder S{tinfo + (HF) * 1024, (const int*)(ws + WS_ROWA) + (HF) * ROWS_HALF, tinfo[2048 + (HF)], 8, 3, G, bx}; \
        pg8::Gemm g{(const bf16*)(ws + WS_XB), (const bf16*)(ws + WS_WGU), 0, 2048, D}; \
        EpiSwiglu E{(bf16*)(ws + WS_ACT), (const float*)(ws + WS_RINV), (const int*)(ws + WS_ROWA) + (HF) * ROWS_HALF, args.in[18]}; \
        pg8::gemm_phase<EpiSwiglu, MoeOrder, true, true>(lds, g, S, E); \
    } \
    SEAM(PH); \
    if (IN((PH) + 1)) { \
        const int* tinfo = (const int*)(ws + WS_TINFO); MoeOrder S{tinfo + (HF) * 1024, (const int*)(ws + WS_ROWA) + (HF) * ROWS_HALF, tinfo[2048 + (HF)], 4, 2, G, bx}; \
        pg8::Gemm g{(const bf16*)(ws + WS_ACT), (const bf16*)(ws + WS_WD), 0, 1024, D}; \
        EpiDown E{(bf16*)(ws + (Y4OFF)), (const int*)(ws + WS_ROWA) + (HF) * ROWS_HALF, (const float*)(ws + WS_ROWG) + (HF) * ROWS_HALF, args.in[20], (HF) * HALF_A}; \
        pg8::gemm_phase<EpiDown, MoeOrder, true, false>(lds, g, S, E); \
    } \
    SEAM((PH) + 1);
    MOE_HALF(8, 0, WS_Y4A)
    MOE_HALF(10, 1, WS_Y4B)
    if (IN(12)) { p7_final(args, vcu, G, wave, lane); }
#undef IN
#undef SEAM
}

#ifndef MK_N_LAUNCHES
#define MK_N_LAUNCHES 1
#endif
extern "C" void kernel_launch(void* const* d_in, const int* in_sizes, int n_in, void* d_out, int out_size, void* d_ws, size_t ws_size, hipStream_t stream) {
    static int grid = 0;
    if (grid == 0) {
        if (n_in != 22 || in_sizes[0] != T * D || out_size != T * D || ws_size < WS_END) {
            fprintf(stderr, "kernel_launch: shape / workspace mismatch (n_in %d, in0 %d, out %d, ws %zu < %zu); nothing launched\n", n_in, n_in > 0 ? in_sizes[0] : -1, out_size, ws_size, (size_t)WS_END); grid = -1; return; }
        int dev = 0, cus = 0, per_cu = 0;
        if (hipGetDevice(&dev) != hipSuccess || hipDeviceGetAttribute(&cus, hipDeviceAttributeMultiprocessorCount, dev) != hipSuccess) { grid = -1; return; }
        if (hipFuncSetAttribute((const void*)fwd, hipFuncAttributeMaxDynamicSharedMemorySize, LDS_BYTES) != hipSuccess) { fprintf(stderr, "kernel_launch: hipFuncSetAttribute failed\n"); grid = -1; return; }
        if (hipOccupancyMaxActiveBlocksPerMultiprocessor(&per_cu, (const void*)fwd, NTHREADS, LDS_BYTES) != hipSuccess || per_cu < 1) { fprintf(stderr, "kernel_launch: occupancy query says %d\n", per_cu); }
        (void)hipGetLastError();
        grid = cus;
    }
    if (grid < 0) return;
    if (hipMemsetAsync((char*)d_ws + WS_CTL, 0, CTL_ZERO_BYTES, stream) != hipSuccess) return;
    Args a{};
    for (int i = 0; i < 22; ++i) a.in[i] = (const float*)d_in[i];
    a.out = (float*)d_out; a.ws = (unsigned char*)d_ws;
#if MK_N_LAUNCHES == 1
    a.ph_lo = 0; a.ph_hi = N_PHASES;
    hipLaunchKernelGGL(fwd, dim3(grid), dim3(NTHREADS), LDS_BYTES, stream, a);
#else
    for (int p = 0; p < N_PHASES; ++p) { a.ph_lo = p; a.ph_hi = p + 1; hipLaunchKernelGGL(fwd, dim3(grid), dim3(NTHREADS), LDS_BYTES, stream, a); }
#endif
}
```

```cpp
#include <hip/hip_runtime.h>
#include <cstdio>
#include <cstdint>

namespace pg8 {
#define PG8_LAS __attribute__((address_space(3)))
typedef unsigned short bf16_t;
typedef short bf16x8 __attribute__((ext_vector_type(8)));
typedef float f32x4 __attribute__((ext_vector_type(4)));
typedef unsigned u32x4 __attribute__((ext_vector_type(4)));
typedef unsigned u32x2 __attribute__((ext_vector_type(2)));
constexpr int BM = 256, BK = 64, HALF = 128, HTB = HALF * BK * 2  , STAGE_BYTES = 8 * HTB, NXCD = 8, WGM = 8;

__host__ __device__ __forceinline__ int lds_byte(int r, int c) { const int st = (r >> 4) * 2 + (c >> 5), rr = r & 15, cc = c & 31, ob = rr * 64 + cc * 2; return st * 1024 + (ob ^ (((ob >> 9) & 1) << 5)); }
__host__ __device__ __forceinline__ void stage_rc(int b, int& R, int& C) { const int st = b / 1024, sb = b % 1024, swz = sb ^ (((sb >> 9) & 1) << 5); R = (st >> 1) * 16 + swz / 64; C = (st & 1) * 32 + (swz % 64) / 2; }
__host__ __device__ __forceinline__ int perm32(int rho) { const int n = rho >> 4, i = rho & 15; return 8 * (i >> 2) + 4 * n + (i & 3); }

struct Unit { int pm, pn; };
struct Gemm { const bf16_t* A; const bf16_t* Bt; int M, N, K; };

struct StaticOrder {
    int nM, nN, nwg, G, c;
    __host__ __device__ void init(int M, int N, int G_, int c_) { nM = M / BM; nN = N / BM; nwg = nM * nN; G = G_; c = c_; }
    __host__ __device__ bool next(int i, Unit& u) const {
        const long L = (long)i * G + c; if (L >= nwg) return false;
        int wgid = (int)L; { const int q = nwg / NXCD, r = nwg % NXCD, xcd = wgid % NXCD, off = wgid / NXCD; wgid = (xcd < r ? xcd * (q + 1) : r * (q + 1) + (xcd - r) * q) + off; }
        const int nig = WGM * nN, gid = wgid / nig, fm = gid * WGM, gsz = (nM - fm) < WGM ? (nM - fm) : WGM;
        u.pm = fm + ((wgid % nig) % gsz); u.pn = (wgid % nig) / gsz; return true;
    }
    __device__ __forceinline__ int gather_row(const Unit&, int) const { return 0; }
};

__device__ __forceinline__ unsigned cvt_pk_bf16(float lo, float hi) { unsigned r; asm volatile("v_cvt_pk_bf16_f32 %0, %1, %2" : "=v"(r) : "v"(lo), "v"(hi)); return r; }

struct EpiBf16 {
    static constexpr bool PERM = true;
    bf16_t* O; int ldc;
    __device__ __forceinline__ void operator()(const f32x4 (&acc)[2][2][4][2], const Unit& u, int wr, int wc, int fr, int fq) const {
        const int row0 = u.pm * BM + wr * 64 + fr; const int col0 = u.pn * BM + wc * 32 + 8 * fq;
#pragma unroll
        for (int ai = 0; ai < 2; ++ai)
#pragma unroll
            for (int m = 0; m < 4; ++m) { bf16_t* rowp = O + (size_t)(row0 + ai * HALF + m * 16) * ldc + col0;
#pragma unroll
                for (int bj = 0; bj < 2; ++bj) { const f32x4 v0 = acc[ai][bj][m][0], v1 = acc[ai][bj][m][1];
                    u32x4 w; w.x = cvt_pk_bf16(v0[0], v0[1]); w.y = cvt_pk_bf16(v0[2], v0[3]); w.z = cvt_pk_bf16(v1[0], v1[1]); w.w = cvt_pk_bf16(v1[2], v1[3]);
                    *(u32x4*)(rowp + bj * HALF) = w; } }
    }
};
struct EpiResid {
    static constexpr bool PERM = false;
    const float* base; float* out; int ldc;
    __device__ __forceinline__ void operator()(const f32x4 (&acc)[2][2][4][2], const Unit& u, int wr, int wc, int fr, int fq) const {
        const int row0 = u.pm * BM + wr * 64 + fr; const int col0 = u.pn * BM + wc * 32 + 4 * fq;
#pragma unroll
        for (int ai = 0; ai < 2; ++ai)
#pragma unroll
            for (int m = 0; m < 4; ++m) { const size_t off = (size_t)(row0 + ai * HALF + m * 16) * ldc + col0;
#pragma unroll
                for (int bj = 0; bj < 2; ++bj)
#pragma unroll
                    for (int n = 0; n < 2; ++n) { const f32x4 bs = *(const f32x4*)(base + off + bj * HALF + n * 16); *(f32x4*)(out + off + bj * HALF + n * 16) = bs + acc[ai][bj][m][n]; } }
    }
};

template <class Epi, class Sched, bool ALIGN_EPI = false, bool GATHER = false>
__device__ __forceinline__ void gemm_phase(PG8_LAS unsigned char* lds, const Gemm g, const Sched& S, const Epi& E) {
    const int tid = threadIdx.x, wid = __builtin_amdgcn_readfirstlane(tid >> 6), lane = tid & 63, wr = wid >> 2, wc = wid & 3, fr = lane & 15, fq = lane >> 4;
    const int K = g.K, nt = K / BK;
    unsigned voffA[2], voffB[2]; int RA[2], CA[2];
#pragma unroll
    for (int i = 0; i < 2; ++i) { int R, C; stage_rc(tid * 16 + i * 8192, R, C); const int Rb = Epi::PERM ? ((R & ~31) + perm32(R & 31)) : R;
        voffA[i] = (unsigned)(R * K + C) * 2u; voffB[i] = (unsigned)(Rb * K + C) * 2u; RA[i] = R; CA[i] = C; }
    const size_t kstep = (size_t)(BK * 2);
    const size_t hstep = (size_t)HALF * K * 2;
    const size_t tstep = 2 * hstep;
    const unsigned ldsw = (unsigned)wid * 1024u;
    const int aoff = lds_byte(wr * 64 + fr, fq * 8), boff = lds_byte(wc * 32 + fr, fq * 8);
#define PG8_SA(b, h) (((b) * 2 + (h)) * HTB)
#define PG8_SB(b, h) ((4 + (b) * 2 + (h)) * HTB)
#define PG8_STAGE(bufoff, gbase, voff) do { _Pragma("unroll") for (int _i = 0; _i < 2; ++_i) \
        __builtin_amdgcn_global_load_lds((const unsigned*)((const char*)(gbase) + (voff)[_i]), (PG8_LAS unsigned*)(lds + (bufoff) + ldsw + _i * 8192), 16, 0, 0); } while (0)
#define PG8_STAGE_A(bufoff, h, base, O) do { if constexpr (GATHER) { PG8_STAGE(bufoff, base, O[h]); } else { PG8_STAGE(bufoff, (base) + (h) * hstep, voffA); } } while (0)
#define PG8_LDA(dst, b, h) do { _Pragma("unroll") for (int m = 0; m < 4; ++m) _Pragma("unroll") for (int k = 0; k < 2; ++k) dst[m][k] = *(const PG8_LAS bf16x8*)(lds + PG8_SA(b, h) + aoff + m * 2048 + k * 1024); } while (0)
#define PG8_LDB(dst, b, h) do { _Pragma("unroll") for (int n = 0; n < 2; ++n) _Pragma("unroll") for (int k = 0; k < 2; ++k) dst[n][k] = *(const PG8_LAS bf16x8*)(lds + PG8_SB(b, h) + boff + n * 2048 + k * 1024); } while (0)
#define PG8_MMA(ai, bj, At, Bt) do { __builtin_amdgcn_s_setprio(1); _Pragma("unroll") for (int m = 0; m < 4; ++m) _Pragma("unroll") for (int n = 0; n < 2; ++n) _Pragma("unroll") for (int k = 0; k < 2; ++k) \
        acc[ai][bj][m][n] = __builtin_amdgcn_mfma_f32_16x16x32_bf16(Bt[n][k], At[m][k], acc[ai][bj][m][n], 0, 0, 0); __builtin_amdgcn_s_setprio(0); } while (0)
#define PG8_WAIT_V(n) asm volatile("s_waitcnt vmcnt(" #n ")" ::: "memory")
#define PG8_WAIT_L(n) asm volatile("s_waitcnt lgkmcnt(" #n ")" ::: "memory")
#define PG8_BAR __builtin_amdgcn_s_barrier()
#define PG8_SCHED __builtin_amdgcn_sched_barrier(0)
    Unit cur, nxt; int ui = 0;
    if (!S.next(0, cur)) return;
    f32x4 acc[2][2][4][2];
#pragma unroll
    for (int a = 0; a < 2; ++a)
#pragma unroll
        for (int b = 0; b < 2; ++b)
#pragma unroll
            for (int m = 0; m < 4; ++m)
#pragma unroll
                for (int n = 0; n < 2; ++n) acc[a][b][m][n] = (f32x4){0.f, 0.f, 0.f, 0.f};
    bf16x8 At[4][2], B0[2][2], B1[2][2];
    unsigned gC[2][2], gN[2][2];
#pragma unroll
    for (int h = 0; h < 2; ++h)
#pragma unroll
        for (int i = 0; i < 2; ++i) { gC[h][i] = 0u; gN[h][i] = 0u; }
    if constexpr (GATHER) {
#pragma unroll
        for (int h = 0; h < 2; ++h)
#pragma unroll
            for (int i = 0; i < 2; ++i) gC[h][i] = (unsigned)S.gather_row(cur, h * HALF + RA[i]) * (unsigned)(K * 2) + (unsigned)(CA[i] * 2);
    }
    const char* cA = GATHER ? (const char*)g.A : (const char*)g.A + (size_t)cur.pm * tstep; const char* cB = (const char*)g.Bt + (size_t)cur.pn * tstep;
    PG8_STAGE(PG8_SB(0, 0), cB, voffB); PG8_STAGE(PG8_SB(0, 1), cB + hstep, voffB); PG8_STAGE_A(PG8_SA(0, 0), 0, cA, gC); PG8_STAGE_A(PG8_SA(0, 1), 1, cA, gC);
    if (wr == 1) PG8_BAR;
    PG8_WAIT_V(2); PG8_BAR;
    PG8_STAGE(PG8_SB(1, 0), cB + kstep, voffB); PG8_STAGE_A(PG8_SA(1, 0), 0, cA + kstep, gC); PG8_STAGE(PG8_SB(1, 1), cB + hstep + kstep, voffB);
    PG8_WAIT_V(6); PG8_BAR;
    for (;;) {
        const bool has_next = S.next(ui + 1, nxt);
        if constexpr (GATHER) {
            if (has_next) {
#pragma unroll
                for (int h = 0; h < 2; ++h)
#pragma unroll
                    for (int i = 0; i < 2; ++i) gN[h][i] = (unsigned)S.gather_row(nxt, h * HALF + RA[i]) * (unsigned)(K * 2) + (unsigned)(CA[i] * 2);
            } else {
#pragma unroll
                for (int h = 0; h < 2; ++h)
#pragma unroll
                    for (int i = 0; i < 2; ++i) gN[h][i] = gC[h][i];
            }
        }
        const char* nA = GATHER ? (const char*)g.A : (has_next ? (const char*)g.A + (size_t)nxt.pm * tstep : cA); const char* nB = has_next ? (const char*)g.Bt + (size_t)nxt.pn * tstep : cB;
        for (int t = 0; t < nt; t += 2) {
            const bool last = (t == nt - 2);
            const char* a1 = cA + (size_t)(t + 1) * kstep;
            const char* a2 = last ? nA : cA + (size_t)(t + 2) * kstep; const char* b2 = last ? nB : cB + (size_t)(t + 2) * kstep;
            const char* a3 = a2 + kstep; const char* b3 = b2 + kstep;
            unsigned g2[2][2];
#pragma unroll
            for (int h = 0; h < 2; ++h)
#pragma unroll
                for (int i = 0; i < 2; ++i) g2[h][i] = last ? gN[h][i] : gC[h][i];
            PG8_LDB(B0, 0, 0); PG8_LDB(B1, 0, 1); PG8_SCHED; PG8_LDA(At, 0, 0); PG8_STAGE_A(PG8_SA(1, 1), 1, a1, gC);
            PG8_WAIT_V(8); PG8_WAIT_L(0); PG8_BAR; PG8_MMA(0, 0, At, B0); PG8_MMA(0, 1, At, B1); PG8_BAR; PG8_SCHED;
            PG8_LDA(At, 0, 1); PG8_STAGE(PG8_SB(0, 0), b2, voffB); PG8_STAGE(PG8_SB(0, 1), b2 + hstep, voffB); PG8_STAGE_A(PG8_SA(0, 0), 0, a2, g2);
            PG8_WAIT_V(8); PG8_WAIT_L(0); PG8_BAR; PG8_MMA(1, 0, At, B0); PG8_MMA(1, 1, At, B1); PG8_BAR; PG8_SCHED;
            PG8_LDB(B0, 1, 0); PG8_LDB(B1, 1, 1); PG8_SCHED; PG8_LDA(At, 1, 0); PG8_STAGE_A(PG8_SA(0, 1), 1, a2, g2);
            PG8_WAIT_V(8); PG8_WAIT_L(0); PG8_BAR; PG8_MMA(0, 0, At, B0); PG8_MMA(0, 1, At, B1); PG8_BAR; PG8_SCHED;
            PG8_LDA(At, 1, 1); PG8_STAGE(PG8_SB(1, 0), b3, voffB); PG8_STAGE(PG8_SB(1, 1), b3 + hstep, voffB); PG8_STAGE_A(PG8_SA(1, 0), 0, a3, g2);
            PG8_WAIT_V(8); PG8_WAIT_L(0); PG8_BAR; PG8_MMA(1, 0, At, B0); PG8_MMA(1, 1, At, B1); PG8_BAR; PG8_SCHED;
        }
        if constexpr (ALIGN_EPI) { if (wr == 0) PG8_BAR; }
        E(acc, cur, wr, wc, fr, fq);
        if (!has_next) break;
#pragma unroll
        for (int a = 0; a < 2; ++a)
#pragma unroll
            for (int b = 0; b < 2; ++b)
#pragma unroll
                for (int m = 0; m < 4; ++m)
#pragma unroll
                    for (int n = 0; n < 2; ++n) acc[a][b][m][n] = (f32x4){0.f, 0.f, 0.f, 0.f};
        cur = nxt; cA = nA; cB = nB; ++ui;
#pragma unroll
        for (int h = 0; h < 2; ++h)
#pragma unroll
            for (int i = 0; i < 2; ++i) gC[h][i] = gN[h][i];
        if constexpr (ALIGN_EPI) { if (wr == 1) PG8_BAR; }
    }
    PG8_WAIT_V(0);
    if constexpr (!ALIGN_EPI) { if (wr == 0) PG8_BAR; }
    PG8_BAR;
#undef PG8_SA
#undef PG8_SB
#undef PG8_STAGE
#undef PG8_STAGE_A
#undef PG8_LDA
#undef PG8_LDB
#undef PG8_MMA
#undef PG8_WAIT_V
#undef PG8_WAIT_L
#undef PG8_BAR
#undef PG8_SCHED
}
}

namespace att {
#define ALAS __attribute__((address_space(3)))
using bf16 = unsigned short;
using bf16x8 = __attribute__((ext_vector_type(8))) short;
using s16x4  = __attribute__((ext_vector_type(4))) short;
using f32x16 = __attribute__((ext_vector_type(16))) float;
using f32x2  = __attribute__((ext_vector_type(2))) float;
using u32x4  = __attribute__((ext_vector_type(4))) unsigned;
#define SBAR() __builtin_amdgcn_sched_barrier(0)
constexpr int SHM_V = 64 * 128 * 2;
constexpr int OFF_V = 0, OFF_K = 2 * SHM_V;
template <int MODE> struct L { static constexpr int SHM_K = 64 * (MODE == 0 ? 384 : 128), OFF_WS = OFF_K + 2 * SHM_K; };
constexpr int OFF_LUT = L<1>::OFF_WS + 2048;
constexpr int OFF_STASH = OFF_LUT + 16384;
constexpr int ATT_LDS = OFF_STASH + 65536;
__device__ __forceinline__ int crow(int r, int hi) { return (r & 3) + 8 * (r >> 2) + 4 * hi; }
__device__ __forceinline__ unsigned cvtpk(float lo, float hi) { unsigned r; asm volatile("v_cvt_pk_bf16_f32 %0, %1, %2" : "=v"(r) : "v"(lo), "v"(hi)); return r; }
__device__ __forceinline__ float bf2f(short v) { return __uint_as_float(((unsigned)(unsigned short)v) << 16); }
template <int RB> __device__ __forceinline__ int kaddr(int row, int colB) { return row * RB + (colB ^ (((row >> 1) & 7) << 4)); }

template <bool BIAS>
__device__ __forceinline__ void partialSM(f32x16& p0, f32x16& p1, float& m_reg, float& mn, float& alpha, float C, const ALAS float* lut  ) {
  constexpr float THR2 = 8.f * 1.4426950408889634f;
  if constexpr (BIAS) {
#pragma unroll
    for (int r = 0; r < 16; ++r) { const int o = (r & 3) + 8 * (r >> 2); p0[r] = fmaf(p0[r], C, lut[o]); p1[r] = fmaf(p1[r], C, lut[32 + o]); }
  } else {
#pragma unroll
    for (int r = 0; r < 16; ++r) { p0[r] *= C; p1[r] *= C; }
  }
  float pmax = p0[0];
#pragma unroll
  for (int r = 1; r < 16; ++r) pmax = fmaxf(pmax, p0[r]);
#pragma unroll
  for (int r = 0; r < 16; ++r) pmax = fmaxf(pmax, p1[r]);
  { auto rr = __builtin_amdgcn_permlane32_swap(__float_as_uint(pmax), __float_as_uint(pmax), false, false);
    pmax = fmaxf(__uint_as_float(rr[0]), __uint_as_float(rr[1])); }
  if (__builtin_expect(__all(pmax - m_reg <= THR2), 1)) { mn = m_reg; alpha = 1.f; }
  else { mn = fmaxf(m_reg, pmax); alpha = __builtin_amdgcn_exp2f(m_reg - mn); m_reg = mn; }
#pragma unroll
  for (int r = 0; r < 16; ++r) p0[r] = __builtin_amdgcn_exp2f(p0[r] - mn);
#pragma unroll
  for (int r = 0; r < 16; ++r) p1[r] = p1[r] - mn;
}
__device__ __forceinline__ void finishSM(f32x16& p0, f32x16& p1, float alpha, float& l_reg, bf16x8& pa0, bf16x8& pa1, bf16x8& pa2, bf16x8& pa3) {
#pragma unroll
  for (int r = 0; r < 16; ++r) p1[r] = __builtin_amdgcn_exp2f(p1[r]);
  float ps = 0;
#pragma unroll
  for (int r = 0; r < 16; ++r) ps += p0[r];
#pragma unroll
  for (int r = 0; r < 16; ++r) ps += p1[r];
  { auto rr = __builtin_amdgcn_permlane32_swap(__float_as_uint(ps), __float_as_uint(ps), false, false);
    ps = __uint_as_float(rr[0]) + __uint_as_float(rr[1]); }
  l_reg = l_reg * alpha + ps;
#define PK4(P, BASE, OUT) do { unsigned a0 = cvtpk(P[BASE + 0], P[BASE + 1]), a1 = cvtpk(P[BASE + 2], P[BASE + 3]);   \
    unsigned b0 = cvtpk(P[BASE + 4], P[BASE + 5]), b1 = cvtpk(P[BASE + 6], P[BASE + 7]);                              \
    auto r0 = __builtin_amdgcn_permlane32_swap(a0, b0, false, false); auto r1 = __builtin_amdgcn_permlane32_swap(a1, b1, false, false); \
    u32x4 w = {r0[0], r1[0], r0[1], r1[1]}; OUT = __builtin_bit_cast(bf16x8, w); } while (0)
  PK4(p0, 0, pa0); PK4(p0, 8, pa1); PK4(p1, 0, pa2); PK4(p1, 8, pa3);
#undef PK4
}
template <int NQ, int RB>
__device__ __forceinline__ void qkt(f32x16& p0, f32x16& p1, const ALAS char* Ks, const bf16x8* qr, int r32, int hi) {
  p0 = f32x16{}; p1 = f32x16{};
#pragma unroll
  for (int d0 = 0; d0 < NQ; ++d0) { const int cb = (d0 * 16 + hi * 8) * 2;
    const bf16x8 b0 = *reinterpret_cast<const ALAS bf16x8*>(Ks + kaddr<RB>(r32, cb));
    const bf16x8 b1 = *reinterpret_cast<const ALAS bf16x8*>(Ks + kaddr<RB>(32 + r32, cb));
    p0 = __builtin_amdgcn_mfma_f32_32x32x16_bf16(b0, qr[d0], p0, 0, 0, 0);
    p1 = __builtin_amdgcn_mfma_f32_32x32x16_bf16(b1, qr[d0], p1, 0, 0, 0); }
}
__device__ __forceinline__ int v_st(int k, int c) { const int kk = (k & ~0xC) | ((k & 4) << 1) | ((k & 8) >> 1); return ((kk >> 3) * 4 + (c >> 5)) * 512 + ((kk & 7) * 32 + (c & 31)) * 2; }
__device__ __forceinline__ int v_rd_base(int lane) { return ((lane & 3) << 3) | (((lane >> 2) & 3) << 6) | (((lane >> 4) & 1) << 5) | (((lane >> 5) & 1) << 8); }
constexpr int v_rd_off(int d0, int ks, int half) { return d0 * 512 + ks * 4096 + half * 2048; }
template <int OFF> __device__ __forceinline__ s16x4 tr_read(int vb) {
  s16x4 r; asm volatile("ds_read_b64_tr_b16 %0, %1 offset:%2" : "=&v"(r) : "v"(vb), "i"(OFF) : "memory"); return r;
}
template <int D0> __device__ __forceinline__ void pv_one(f32x16& od, int vb, bf16x8 pa0, bf16x8 pa1, bf16x8 pa2, bf16x8 pa3) {
  const s16x4 l0 = tr_read<v_rd_off(D0, 0, 0)>(vb), h0 = tr_read<v_rd_off(D0, 0, 1)>(vb), l1 = tr_read<v_rd_off(D0, 1, 0)>(vb), h1 = tr_read<v_rd_off(D0, 1, 1)>(vb);
  const s16x4 l2 = tr_read<v_rd_off(D0, 2, 0)>(vb), h2 = tr_read<v_rd_off(D0, 2, 1)>(vb), l3 = tr_read<v_rd_off(D0, 3, 0)>(vb), h3 = tr_read<v_rd_off(D0, 3, 1)>(vb);
  asm volatile("s_waitcnt lgkmcnt(0)" ::: "memory"); SBAR();
#define PK(L, H) (bf16x8){L[0], L[1], L[2], L[3], H[0], H[1], H[2], H[3]}
  od = __builtin_amdgcn_mfma_f32_32x32x16_bf16(pa0, PK(l0, h0), od, 0, 0, 0);
  od = __builtin_amdgcn_mfma_f32_32x32x16_bf16(pa1, PK(l1, h1), od, 0, 0, 0);
  od = __builtin_amdgcn_mfma_f32_32x32x16_bf16(pa2, PK(l2, h2), od, 0, 0, 0);
  od = __builtin_amdgcn_mfma_f32_32x32x16_bf16(pa3, PK(l3, h3), od, 0, 0, 0);
#undef PK
}
__device__ __forceinline__ void pv_d0(f32x16* o, int vb, bf16x8 pa0, bf16x8 pa1, bf16x8 pa2, bf16x8 pa3) {
  pv_one<0>(o[0], vb, pa0, pa1, pa2, pa3); pv_one<1>(o[1], vb, pa0, pa1, pa2, pa3); pv_one<2>(o[2], vb, pa0, pa1, pa2, pa3); pv_one<3>(o[3], vb, pa0, pa1, pa2, pa3);
}

__device__ __forceinline__ int kw_addr(int row, int colB) { return row * 256 + (colB ^ ((row & 15) << 4)); }
__device__ __forceinline__ int kn_addr(int row, int colB) { return row * 128 + (colB ^ (((row >> 1) & 7) << 4)); }
template <int MODE, int PD>
__device__ __forceinline__ void attn_unit(const bf16* __restrict__ Qb, int ldq, const bf16* __restrict__ Kh, int ldk, const bf16* __restrict__ Kp, const bf16* __restrict__ Vh, int ldv,
                                          int seq, ALAS char* lds, float C, const f32x2* __restrict__ cs, int qpos0, f32x16 (&o)[4]) {
  constexpr int DQK = MODE == 0 ? 192 : 64, NQ = DQK / 16;
  constexpr int SHM_KW = MODE == 0 ? 64 * 256 : 0, SHM_KN = 64 * 128, SHM_K = SHM_KW + SHM_KN;
  static_assert(2 * SHM_K == 2 * L<MODE>::SHM_K, "K buffers");
  const int tid = threadIdx.x, wid = __builtin_amdgcn_readfirstlane(tid >> 6), lane = tid & 63, r32 = lane & 31, hi = lane >> 5;
  ALAS char* V_lds = lds + OFF_V; ALAS char* K_lds = lds + OFF_K;
  ALAS float* ws = (ALAS float*)(lds + L<MODE>::OFF_WS) + wid * 64; ALAS float* li_l = ws; ALAS float* al_l = ws + 32;
  __syncthreads();
  float m_reg = -1e30f, l_reg = 0;
#pragma unroll
  for (int d = 0; d < 4; ++d) o[d] = f32x16{};
  constexpr int NQR = (MODE == 0 && PD == 2) ? 6 : (MODE == 0 ? 8 : NQ);
  bf16x8 qr[NQR];
  ALAS char* qpe_l = lds + L<MODE>::OFF_WS + 2048 + wid * 6144 + lane * 16;
  const bf16* Qw = Qb + (long)(wid * 32 + r32) * ldq + hi * 8;
#pragma unroll
  for (int d0 = 0; d0 < NQR; ++d0) qr[d0] = *reinterpret_cast<const bf16x8*>(Qw + d0 * 16);
  if constexpr (MODE == 0) {
    bf16x8 qp[4];
#pragma unroll
    for (int d0 = 0; d0 < 4; ++d0) qp[d0] = *reinterpret_cast<const bf16x8*>(Qw + (8 + d0) * 16);
#pragma unroll
    for (int d0 = 6; d0 < 8; ++d0) *(ALAS bf16x8*)(qpe_l + (d0 - 6) * 1024) = *reinterpret_cast<const bf16x8*>(Qw + d0 * 16);
    const f32x2* cp = cs + (long)(qpos0 + wid * 32 + r32) * 32 + hi * 8;
#pragma unroll
    for (int a = 0; a < 2; ++a) {
      unsigned w1[4], w2[4];
#pragma unroll
      for (int j = 0; j < 8; j += 2) {
        const f32x2 c0 = cp[16 * a + j], c1 = cp[16 * a + j + 1];
        const float x10 = bf2f(qp[a][j]), x20 = bf2f(qp[2 + a][j]), x11 = bf2f(qp[a][j + 1]), x21 = bf2f(qp[2 + a][j + 1]);
        w1[j >> 1] = cvtpk(x10 * c0.x - x20 * c0.y, x11 * c1.x - x21 * c1.y);
        w2[j >> 1] = cvtpk(x10 * c0.y + x20 * c0.x, x11 * c1.y + x21 * c1.x);
      }
      u32x4 v1 = {w1[0], w1[1], w1[2], w1[3]}, v2 = {w2[0], w2[1], w2[2], w2[3]};
      *(ALAS u32x4*)(qpe_l + (2 + a) * 1024) = v1; *(ALAS u32x4*)(qpe_l + (4 + a) * 1024) = v2;
    }
  }
  unsigned vsrc[2], kwsrc[2], knsrc;
#pragma unroll
  for (int i = 0; i < 2; ++i) { const int s = (wid + 8 * i) * 64 + lane;
    const int kk = (s >> 7) * 8 + ((s & 31) >> 2), c = ((s >> 5) & 3) * 32 + (s & 3) * 8, k = (kk & ~0xC) | ((kk & 4) << 1) | ((kk & 8) >> 1);
    vsrc[i] = (unsigned)(k * ldv + c);
    const int row = s >> 4, ch = (s & 15) ^ (row & 15); kwsrc[i] = (unsigned)(row * ldk + ch * 8); }
  { const int s = wid * 64 + lane, row = s >> 3, ch = (s & 7) ^ ((row >> 1) & 7); knsrc = (unsigned)(row * (MODE == 0 ? 64 : ldk) + ch * 8); }
  const bf16* Kn = MODE == 0 ? Kp : Kh; const int ldn = MODE == 0 ? 64 : ldk;
#define DMA16(src, dst) __builtin_amdgcn_global_load_lds((const unsigned*)(src), (ALAS unsigned*)(dst), 16, 0, 0)
#define DMA_V(t, b) do { const bf16* vb_ = Vh + (long)(t) * 64 * ldv; DMA16(vb_ + vsrc[0], V_lds + (b) * SHM_V + wid * 1024); DMA16(vb_ + vsrc[1], V_lds + (b) * SHM_V + (wid + 8) * 1024); } while (0)
#define DMA_K(t, b) do { if constexpr (MODE == 0) { const bf16* kb_ = Kh + (long)(t) * 64 * ldk; DMA16(kb_ + kwsrc[0], K_lds + (b) * SHM_K + wid * 1024); DMA16(kb_ + kwsrc[1], K_lds + (b) * SHM_K + (wid + 8) * 1024); } \
    DMA16(Kn + (long)(t) * 64 * ldn + knsrc, K_lds + (b) * SHM_K + SHM_KW + wid * 1024); } while (0)
#define STEP_END() do { asm volatile("s_waitcnt vmcnt(0)" ::: "memory"); __syncthreads(); } while (0)
#define QKT(P0, P1, b) do { P0 = f32x16{}; P1 = f32x16{}; const ALAS char* kb_ = K_lds + (b) * SHM_K; \
    if constexpr (MODE == 0) { _Pragma("unroll") for (int d0 = 0; d0 < 8; ++d0) { const int cb = (d0 * 16 + hi * 8) * 2; \
        const bf16x8 b0 = *reinterpret_cast<const ALAS bf16x8*>(kb_ + kw_addr(r32, cb)); const bf16x8 b1 = *reinterpret_cast<const ALAS bf16x8*>(kb_ + kw_addr(32 + r32, cb)); \
        bf16x8 qf_; if (d0 < NQR) qf_ = qr[d0 < NQR ? d0 : 0]; else qf_ = *reinterpret_cast<const ALAS bf16x8*>(qpe_l + (d0 - 6) * 1024); \
        P0 = __builtin_amdgcn_mfma_f32_32x32x16_bf16(b0, qf_, P0, 0, 0, 0); P1 = __builtin_amdgcn_mfma_f32_32x32x16_bf16(b1, qf_, P1, 0, 0, 0); } } \
    _Pragma("unroll") for (int d0 = 0; d0 < 4; ++d0) { const int cb = (d0 * 16 + hi * 8) * 2; \
        const bf16x8 b0 = *reinterpret_cast<const ALAS bf16x8*>(kb_ + SHM_KW + kn_addr(r32, cb)); const bf16x8 b1 = *reinterpret_cast<const ALAS bf16x8*>(kb_ + SHM_KW + kn_addr(32 + r32, cb)); \
        bf16x8 qf_; if constexpr (MODE == 0) qf_ = *reinterpret_cast<const ALAS bf16x8*>(qpe_l + (2 + d0) * 1024); else qf_ = qr[d0]; \
        P0 = __builtin_amdgcn_mfma_f32_32x32x16_bf16(b0, qf_, P0, 0, 0, 0); P1 = __builtin_amdgcn_mfma_f32_32x32x16_bf16(b1, qf_, P1, 0, 0, 0); } } while (0)
#define RESC(a) do { if (__any((a) < 1.f)) { if (hi == 0) al_l[r32] = (a); asm volatile("s_waitcnt lgkmcnt(0)" ::: "memory"); \
    _Pragma("unroll") for (int d = 0; d < 4; ++d) _Pragma("unroll") for (int r = 0; r < 16; ++r) o[d][r] *= al_l[crow(r, hi)]; } } while (0)
  const int vb0 = (int)(unsigned)(uintptr_t)V_lds + v_rd_base(lane);
  const ALAS float* lutp = (const ALAS float*)(lds + OFF_LUT) + (2047 - (qpos0 + wid * 32 + r32) + 4 * hi);
  f32x16 pA0, pA1, pB0, pB1; float mnA, mnB, alA, alB; bf16x8 pa0, pa1, pa2, pa3; const int NT = seq / 64;
  if constexpr (PD == 1) {
    DMA_K(0, 0); DMA_V(0, 0); STEP_END();
    for (int j = 0; j < NT; ++j) {
      const int b = j & 1;
      if (j + 1 < NT) { DMA_K(j + 1, b ^ 1); DMA_V(j + 1, b ^ 1); }
      QKT(pA0, pA1, b); partialSM<MODE == 1>(pA0, pA1, m_reg, mnA, alA, C, lutp + j * 64);
      RESC(alA);
      finishSM(pA0, pA1, alA, l_reg, pa0, pa1, pa2, pa3); SBAR();
      pv_d0(o, vb0 + b * SHM_V, pa0, pa1, pa2, pa3);
      STEP_END();
    }
  } else {
  DMA_K(0, 0); STEP_END();
  DMA_K(1, 1); DMA_V(0, 0);
  QKT(pA0, pA1, 0); partialSM<MODE == 1>(pA0, pA1, m_reg, mnA, alA, C, lutp);
  STEP_END();
  for (int j = 1; j + 1 < NT; j += 2) {
    DMA_K(j + 1, 0); DMA_V(j, 1);
    SBAR(); QKT(pB0, pB1, 1);
    finishSM(pA0, pA1, alA, l_reg, pa0, pa1, pa2, pa3); SBAR();
    pv_d0(o, vb0, pa0, pa1, pa2, pa3); partialSM<MODE == 1>(pB0, pB1, m_reg, mnB, alB, C, lutp + j * 64);
    RESC(alB);
    STEP_END();
    DMA_K(j + 2, 1); DMA_V(j + 1, 0);
    SBAR(); QKT(pA0, pA1, 0);
    finishSM(pB0, pB1, alB, l_reg, pa0, pa1, pa2, pa3); SBAR();
    pv_d0(o, vb0 + SHM_V, pa0, pa1, pa2, pa3); partialSM<MODE == 1>(pA0, pA1, m_reg, mnA, alA, C, lutp + (j + 1) * 64);
    RESC(alA);
    STEP_END();
  }
  DMA_V(NT - 1, 1);
  SBAR(); QKT(pB0, pB1, 1);
  finishSM(pA0, pA1, alA, l_reg, pa0, pa1, pa2, pa3); SBAR();
  pv_d0(o, vb0, pa0, pa1, pa2, pa3); partialSM<MODE == 1>(pB0, pB1, m_reg, mnB, alB, C, lutp + (NT - 1) * 64);
  RESC(alB);
  STEP_END();
  finishSM(pB0, pB1, alB, l_reg, pa0, pa1, pa2, pa3); SBAR();
  pv_d0(o, vb0 + SHM_V, pa0, pa1, pa2, pa3);
  }
  if (hi == 0) li_l[r32] = l_reg; asm volatile("s_waitcnt lgkmcnt(0)" ::: "memory");
#pragma unroll
  for (int r = 0; r < 16; ++r) { const float rl = __builtin_amdgcn_rcpf(li_l[crow(r, hi)]);
#pragma unroll
    for (int d = 0; d < 4; ++d) o[d][r] *= rl; }
#undef DMA16
#undef DMA_V
#undef DMA_K
#undef STEP_END
#undef QKT
#undef RESC
}
}
#define XB_TMO      128
#define XB_XCNT(j)  (256  + 64 * (j))
#define XB_XSUB(j)  (1280 + 64 * (j))
#define XB_XGEN(j)  (2304 + 64 * (j))
#define XB_TOP      3328
#define XB_TOPGEN   3392
#define XCD_BAR_WORDS 3456
#define XB_SPIN_CAP (1u << 18)
#define LAS __attribute__((address_space(3)))

__device__ __forceinline__ unsigned xb_ld(unsigned* p)              { return __hip_atomic_load(p, __ATOMIC_RELAXED, __HIP_MEMORY_SCOPE_AGENT); }
__device__ __forceinline__ unsigned xb_add(unsigned* p, unsigned v) { return __hip_atomic_fetch_add(p, v, __ATOMIC_RELAXED, __HIP_MEMORY_SCOPE_AGENT); }
__device__ __forceinline__ unsigned xb_xcc_id() { return (unsigned)__builtin_amdgcn_s_getreg((3 << 11) | 20) & 0xFu; }
#define XB_SPIN(cond, bar) do { unsigned _sp = 0; while (cond) { __builtin_amdgcn_s_sleep(1); \
    if ((++_sp & 255u) == 0u) { if (xb_ld(&(bar)[XB_TMO])) break; if (_sp > XB_SPIN_CAP) { atomicAdd(&(bar)[XB_TMO], 1u); break; } } } } while (0)

struct XcdBarrier {
    unsigned* bar; unsigned x;
    volatile LAS unsigned* st;
};

__device__ __forceinline__ XcdBarrier xcd_barrier_post(unsigned* bar, volatile LAS unsigned* st) {
    XcdBarrier b; b.bar = bar; b.x = xb_xcc_id(); b.st = st;
    if (threadIdx.x == 0) (void)xb_add(&bar[XB_XCNT(b.x)], 1u);
    return b;
}
__device__ __forceinline__ void xcd_barrier_complete(unsigned* bar, unsigned x, unsigned& nloc, unsigned& nx) {
    const unsigned G = gridDim.x * gridDim.y * gridDim.z;
    unsigned sum, cnt, mine, sp = 0u;
    for (;;) {
        sum = 0u; cnt = 0u; mine = 0u;
#pragma unroll
        for (unsigned j = 0; j < 16; ++j) { const unsigned c = xb_ld(&bar[XB_XCNT(j)]); sum += c; cnt += (c > 0u) ? 1u : 0u; mine = (j == x) ? c : mine; }
        if (sum == G) break;
        __builtin_amdgcn_s_sleep(1);
        if ((++sp & 255u) == 0u) { if (xb_ld(&bar[XB_TMO])) break; if (sp > XB_SPIN_CAP) { atomicAdd(&bar[XB_TMO], 1u); break; } }
    }
    nloc = mine > 0u ? mine : 1u; nx = cnt > 0u ? cnt : 1u;
}

__device__ __forceinline__ void xcd_barrier(const XcdBarrier& b) {
    asm volatile("s_waitcnt vmcnt(0)" ::: "memory");
    __syncthreads();
    if (threadIdx.x == 0) {
        unsigned* bar = b.bar;
        __builtin_amdgcn_s_waitcnt(0);
        unsigned nloc = b.st[0], nx = b.st[1];
        if (nloc == 0u) { xcd_barrier_complete(bar, b.x, nloc, nx); b.st[0] = nloc; b.st[1] = nx; }
        const unsigned old = xb_add(&bar[XB_XSUB(b.x)], 1u);
        const unsigned gen = old / nloc;
        if (old + 1u == (gen + 1u) * nloc) {
            __builtin_amdgcn_fence(__ATOMIC_RELEASE, "agent");
            asm volatile("s_waitcnt vmcnt(0)" ::: "memory");
            const unsigned og = xb_add(&bar[XB_TOP], 1u);
            const unsigned tg = og / nx;
            if (og + 1u == (tg + 1u) * nx) xb_add(&bar[XB_TOPGEN], 1u);
            else XB_SPIN(xb_ld(&bar[XB_TOPGEN]) == tg, bar);
            __builtin_amdgcn_fence(__ATOMIC_ACQUIRE, "agent");
            xb_add(&bar[XB_XGEN(b.x)], 1u);
            asm volatile("s_waitcnt vmcnt(0)" ::: "memory");
        } else {
            XB_SPIN(xb_ld(&bar[XB_XGEN(b.x)]) == gen, bar);
            __builtin_amdgcn_fence(__ATOMIC_ACQUIRE, "agent");
            asm volatile("s_waitcnt vmcnt(0)" ::: "memory");
        }
    }
    __syncthreads();
}


constexpr int NB = 32, SEQ = 2048, T = NB * SEQ, D = 1024, IN_COLS = 1984, PROJ_LD = 2048;
constexpr int NE = 32, TOPK = 4, HALF_T = T / 2, HALF_A = HALF_T * TOPK;
constexpr int ROWS_HALF = HALF_A + NE * 256, TILES_MAX = ROWS_HALF / 256;
constexpr float NORM_EPS = 1e-5f, LOG2E = 1.4426950408889634f;
constexpr int NWAVES = 8, NTHREADS = 512;

constexpr size_t KiB = 1024, MiB = 1u << 20;
constexpr size_t WS_CTL = 0, CTL_ZERO_BYTES = 64 * KiB;
constexpr size_t WS_ROPE = 1 * MiB;
constexpr size_t WS_BIAS = 1 * MiB + 512 * KiB;
constexpr size_t WS_LAM = 1 * MiB + 768 * KiB;
constexpr size_t WS_RINV = 2 * MiB;
constexpr size_t WS_EIDX = 3 * MiB, WS_GATE = 4 * MiB, WS_LRANK = 5 * MiB;
constexpr size_t WS_HIST = 6 * MiB;
constexpr size_t WS_ROWA = 7 * MiB, WS_ROWG = 9 * MiB;
constexpr size_t WS_TINFO = 11 * MiB;
constexpr size_t WS_WRH = 12 * MiB, WS_WRL = 12 * MiB + 64 * KiB;
constexpr size_t WS_WUQ = 13 * MiB, WS_WUKV = 13 * MiB + 512 * KiB;
constexpr size_t WS_WIN = 16 * MiB, WS_WO = 20 * MiB;
constexpr size_t WS_WD = 24 * MiB, WS_WGU = 88 * MiB;
constexpr size_t WS_XB = 216 * MiB;
constexpr size_t WS_PROJ = 344 * MiB, WS_QM = 600 * MiB, WS_KV = 696 * MiB, WS_MIXED = 824 * MiB, WS_CQN = 952 * MiB, WS_CKVN = 984 * MiB, WS_KPE = 1000 * MiB;
constexpr size_t WS_ACT = 344 * MiB, WS_Y4A = 616 * MiB, WS_Y4B = 88 * MiB;
constexpr size_t WS_END = 1008 * MiB;
static_assert(WS_ACT + (size_t)ROWS_HALF * 2048 <= WS_Y4A && WS_Y4A + (size_t)HALF_A * 2048 <= WS_END && WS_Y4B + (size_t)HALF_A * 2048 <= WS_PROJ, "ws map");

constexpr int SCRATCH_BYTES = 135168;
constexpr int MISC_OFF = SCRATCH_BYTES;
constexpr int LDS_BYTES = SCRATCH_BYTES + 1024;
static_assert(att::ATT_LDS <= SCRATCH_BYTES && pg8::STAGE_BYTES <= SCRATCH_BYTES, "LDS map");

#define GAS __attribute__((address_space(1)))
typedef unsigned short bf16;
typedef float f32x4 __attribute__((ext_vector_type(4)));
typedef float f32x2 __attribute__((ext_vector_type(2)));
typedef unsigned u32x4 __attribute__((ext_vector_type(4)));
typedef unsigned u32x2 __attribute__((ext_vector_type(2)));
typedef short bf16x8 __attribute__((ext_vector_type(8)));
typedef float f32x16 __attribute__((ext_vector_type(16)));
#define LDS_WAIT() asm volatile("s_waitcnt lgkmcnt(0)" ::: "memory")
#define VM_WAIT() asm volatile("s_waitcnt vmcnt(0)" ::: "memory")
__device__ __forceinline__ unsigned pk2(float lo, float hi) { return pg8::cvt_pk_bf16(lo, hi); }
__device__ __forceinline__ float bf2f(unsigned short v) { return __uint_as_float(((unsigned)v) << 16); }
__device__ __forceinline__ float wave_sum(float v) {
#pragma unroll
    for (int o = 1; o < 64; o <<= 1) v += __shfl_xor(v, o);
    return v;
}

struct Args {
    const float* in[22]; float* out; unsigned char* ws; int ph_lo, ph_hi;
};

template <class RowMap>
__device__ __forceinline__ void transpose_item(const float* W, int K, int N, bf16* WT, LAS float* scr, int item, int lane, const float* kscale, RowMap rm) {
    const int nblk = N / 32, kb = item / nblk, nb = item % nblk, k0 = 64 * kb, n0 = 32 * nb;
    float v[32];
#pragma unroll
    for (int i = 0; i < 32; ++i) v[i] = W[(size_t)(k0 + 2 * i + (lane >> 5)) * N + n0 + (lane & 31)];
    if (kscale) {
#pragma unroll
        for (int i = 0; i < 32; ++i) v[i] *= kscale[k0 + 2 * i + (lane >> 5)];
    }
#pragma unroll
    for (int i = 0; i < 32; ++i) scr[(2 * i + (lane >> 5)) * 33 + (lane & 31)] = v[i];
    LDS_WAIT(); asm volatile("" ::: "memory");
    const int c = lane & 7;
#pragma unroll
    for (int j = 0; j < 4; ++j) { const int n = (lane >> 3) + 8 * j; const LAS float* s = scr + (8 * c) * 33 + n;
        u32x4 o; o.x = pk2(s[0 * 33], s[1 * 33]); o.y = pk2(s[2 * 33], s[3 * 33]); o.z = pk2(s[4 * 33], s[5 * 33]); o.w = pk2(s[6 * 33], s[7 * 33]);
        *(u32x4*)(WT + (size_t)rm(n0 + n) * K + k0 + 8 * c) = o; }
    LDS_WAIT(); asm volatile("" ::: "memory");
}
struct RmId { __device__ __forceinline__ int operator()(int n) const { return n; } };
struct RmGu { __device__ __forceinline__ int operator()(int n) const { const int up = n >> 10, j = n & 1023; return 256 * (j >> 7) + 128 * up + (j & 127); } };

__device__ __forceinline__ void rms_row_to_bf16(const float* xrow, const float* g, bf16* orow, int lane) {
    const f32x4* xr = (const f32x4*)xrow + lane; const f32x4* gr = (const f32x4*)g + lane;
    f32x4 v[4]; float s = 0.f;
#pragma unroll
    for (int j = 0; j < 4; ++j) { v[j] = xr[64 * j]; s += (v[j].x * v[j].x + v[j].y * v[j].y) + (v[j].z * v[j].z + v[j].w * v[j].w); }
    const float r = 1.f / sqrtf(wave_sum(s) * (1.f / D) + NORM_EPS);
    u32x2* o8 = (u32x2*)orow + lane;
#pragma unroll
    for (int j = 0; j < 4; ++j) { const f32x4 gg = gr[64 * j]; u32x2 w; w.x = pk2(v[j].x * r * gg.x, v[j].y * r * gg.y); w.y = pk2(v[j].z * r * gg.z, v[j].w * r * gg.w); o8[64 * j] = w; }
}
__device__ __forceinline__ int t5_bucket(int rel) {
    const int n = rel < 0 ? -rel : rel; int b;
    if (n < 8) b = n; else { const int n2 = n * n; b = n2 >= 8192 ? 15 : n2 >= 4096 ? 14 : n2 >= 2048 ? 13 : n2 >= 1024 ? 12 : n2 >= 512 ? 11 : n2 >= 256 ? 10 : n2 >= 128 ? 9 : 8; }
    return (rel > 0 ? 16 : 0) + b;
}
__device__ __forceinline__ void p0_prologue(const Args& a, LAS unsigned char* lds, int vcu, int G, int wave, int lane) {
    unsigned char* ws = a.ws;
    LAS float* scr = (LAS float*)(lds + wave * 16384);
    const int gw = vcu * NWAVES + wave, NGW = G * NWAVES;
    const float* ffn_g = a.in[14];
    constexpr int I_IN = 16 * 62, I_UQ = 4 * 24, I_UKV = 2 * 32, I_O = 16 * 32, I_GU1 = 16 * 64, I_GU = NE * I_GU1, I_D1 = 16 * 32, I_D = NE * I_D1;
    constexpr int NITEMS = I_IN + I_UQ + I_UKV + I_O + I_GU + I_D;
    for (int it = gw; it < NITEMS; it += NGW) {
        int r = it;
        if (r < I_GU) { const int e = r / I_GU1; transpose_item(a.in[17] + (size_t)e * 1024 * 2048, 1024, 2048, (bf16*)(ws + WS_WGU) + (size_t)e * 2048 * 1024, scr, r % I_GU1, lane, ffn_g, RmGu{}); continue; } r -= I_GU;
        if (r < I_D) { const int e = r / I_D1; transpose_item(a.in[19] + (size_t)e * 1024 * 1024, 1024, 1024, (bf16*)(ws + WS_WD) + (size_t)e * 1024 * 1024, scr, r % I_D1, lane, nullptr, RmId{}); continue; } r -= I_D;
        if (r < I_IN) { transpose_item(a.in[3], 1024, IN_COLS, (bf16*)(ws + WS_WIN), scr, r, lane, nullptr, RmId{}); continue; } r -= I_IN;
        if (r < I_O) { transpose_item(a.in[13], 1024, 1024, (bf16*)(ws + WS_WO), scr, r, lane, nullptr, RmId{}); continue; } r -= I_O;
        if (r < I_UQ) { transpose_item(a.in[10], 256, 768, (bf16*)(ws + WS_WUQ), scr, r, lane, nullptr, RmId{}); continue; } r -= I_UQ;
        transpose_item(a.in[12], 128, 1024, (bf16*)(ws + WS_WUKV), scr, r, lane, nullptr, RmId{});
    }
    const int gt = gw * 64 + lane, NGT = NGW * 64;
    for (int i = gt; i < 64 * 1024 / 8; i += NGT) *((u32x4*)((bf16*)(ws + WS_WIN) + (size_t)IN_COLS * 1024) + i) = (u32x4){0u, 0u, 0u, 0u};
    for (int i = gt; i < 1024 * NE; i += NGT) { const int k = i >> 5, e = i & 31; const float w = a.in[15][i] * ffn_g[k];
        const unsigned h = pk2(w, 0.f) & 0xffffu; const float wl = w - bf2f((unsigned short)h);
        ((bf16*)(ws + WS_WRH))[e * 1024 + k] = (bf16)h; ((bf16*)(ws + WS_WRL))[e * 1024 + k] = (bf16)(pk2(wl, 0.f) & 0xffffu); }
    for (int i = gt; i < SEQ * 32; i += NGT) { const int pos = i >> 5, fi = i & 31;
        const float inv = (float)::exp2(-(double)fi * (13.287712379549449 / 32.0)); const float ang = (float)pos * inv;
        double tt = (double)ang * 0.15915494309189535; tt -= __builtin_rint(tt); const double rr = tt * 6.283185307179586, r2 = rr * rr;
        double cs_ = 1.0, sn = rr, term_c = 1.0, term_s = rr;
#pragma unroll
        for (int k = 1; k <= 13; ++k) { term_c *= -r2 / (double)((2 * k - 1) * (2 * k)); term_s *= -r2 / (double)((2 * k) * (2 * k + 1)); cs_ += term_c; sn += term_s; }
        ((f32x2*)(ws + WS_ROPE))[i] = (f32x2){(float)cs_, (float)sn}; }
    for (int i = gt; i < 8 * 4096; i += NGT) { const int m = i >> 12, d = i & 4095; ((float*)(ws + WS_BIAS))[i] = d < 4095 ? a.in[1][t5_bucket(d - 2047) * 8 + m] * LOG2E : 0.f; }
    if (gw == 0) { const float s1 = wave_sum(a.in[4][lane] * a.in[5][lane]), s2 = wave_sum(a.in[6][lane] * a.in[7][lane]);
        if (lane == 0) *(float*)(ws + WS_LAM) = __expf(s1) - __expf(s2) + 0.2f; }
    for (int m = gw; m < T; m += 2 * NGW) {
        const int m2 = m + NGW < T ? m + NGW : m;
        const f32x4* xr0 = (const f32x4*)(a.in[0] + (size_t)m * D) + lane; const f32x4* xr1 = (const f32x4*)(a.in[0] + (size_t)m2 * D) + lane; const f32x4* gr = (const f32x4*)a.in[2] + lane;
        f32x4 v0[4], v1[4]; float s0 = 0.f, s1 = 0.f;
#pragma unroll
        for (int j = 0; j < 4; ++j) { v0[j] = xr0[64 * j]; v1[j] = xr1[64 * j]; }
#pragma unroll
        for (int j = 0; j < 4; ++j) { s0 += (v0[j].x * v0[j].x + v0[j].y * v0[j].y) + (v0[j].z * v0[j].z + v0[j].w * v0[j].w); s1 += (v1[j].x * v1[j].x + v1[j].y * v1[j].y) + (v1[j].z * v1[j].z + v1[j].w * v1[j].w); }
        const float r0 = 1.f / sqrtf(wave_sum(s0) * (1.f / D) + NORM_EPS), r1 = 1.f / sqrtf(wave_sum(s1) * (1.f / D) + NORM_EPS);
        u32x2* o0 = (u32x2*)((bf16*)(ws + WS_XB) + (size_t)m * D) + lane; u32x2* o1 = (u32x2*)((bf16*)(ws + WS_XB) + (size_t)m2 * D) + lane;
#pragma unroll
        for (int j = 0; j < 4; ++j) { const f32x4 gg = gr[64 * j]; u32x2 w;
            w.x = pk2(v0[j].x * r0 * gg.x, v0[j].y * r0 * gg.y); w.y = pk2(v0[j].z * r0 * gg.z, v0[j].w * r0 * gg.w); o0[64 * j] = w;
            w.x = pk2(v1[j].x * r1 * gg.x, v1[j].y * r1 * gg.y); w.y = pk2(v1[j].z * r1 * gg.z, v1[j].w * r1 * gg.w); o1[64 * j] = w; }
    }
}

__device__ __forceinline__ void p1b_latent(const Args& a, int vcu, int G, int wave, int lane) {
    unsigned char* ws = a.ws; const int gw = vcu * NWAVES + wave, NGW = G * NWAVES;
    const float* gq = a.in[9]; const float* gkv = a.in[11];
    float gl[8];
#pragma unroll
    for (int j = 0; j < 8; ++j) gl[j] = lane < 32 ? gq[8 * lane + j] : (lane < 48 ? gkv[8 * (lane - 32) + j] : 1.f);
    constexpr int R = 4;
    for (int t0 = gw; t0 < T; t0 += R * NGW) {
        bf16x8 v[R];
#pragma unroll
        for (int q = 0; q < R; ++q) { const int t = t0 + q * NGW; v[q] = (bf16x8){0, 0, 0, 0, 0, 0, 0, 0};
            if (lane < 56 && t < T) v[q] = *(const bf16x8*)((const bf16*)(ws + WS_PROJ) + (size_t)t * PROJ_LD + 1536 + 8 * lane); }
#pragma unroll
        for (int q = 0; q < R; ++q) { const int t = t0 + q * NGW; if (t >= T) break;
            float f[8], sq = 0.f;
#pragma unroll
            for (int j = 0; j < 8; ++j) { f[j] = bf2f((unsigned short)v[q][j]); sq += f[j] * f[j]; }
            const float sq_q = wave_sum(lane < 32 ? sq : 0.f), sq_kv = wave_sum((lane >= 32 && lane < 48) ? sq : 0.f);
            const float rq = 1.f / sqrtf(sq_q * (1.f / 256.f) + NORM_EPS), rkv = 1.f / sqrtf(sq_kv * (1.f / 128.f) + NORM_EPS);
            float part[8];
#pragma unroll
            for (int j = 0; j < 8; ++j) part[j] = __shfl_xor(f[j], 4);
            float o[8];
            if (lane < 48) { const float rr = lane < 32 ? rq : rkv;
#pragma unroll
                for (int j = 0; j < 8; ++j) o[j] = f[j] * rr * gl[j];
            } else {
                const int aa = lane - 48; const f32x2* cp = (const f32x2*)(ws + WS_ROPE) + (size_t)(t & (SEQ - 1)) * 32 + 8 * (aa & 3);
#pragma unroll
                for (int j = 0; j < 8; ++j) { const f32x2 c = lane < 56 ? cp[j] : (f32x2){0.f, 0.f};
                    o[j] = (aa < 4) ? (f[j] * c.x - part[j] * c.y) : (part[j] * c.y + f[j] * c.x); }
            }
            u32x4 w; w.x = pk2(o[0], o[1]); w.y = pk2(o[2], o[3]); w.z = pk2(o[4], o[5]); w.w = pk2(o[6], o[7]);
            if (lane < 32) *(u32x4*)((bf16*)(ws + WS_CQN) + (size_t)t * 256 + 8 * lane) = w;
            else if (lane < 48) *(u32x4*)((bf16*)(ws + WS_CKVN) + (size_t)t * 128 + 8 * (lane - 32)) = w;
            else if (lane < 56) *(u32x4*)((bf16*)(ws + WS_KPE) + (size_t)t * 64 + 8 * (lane - 48)) = w;
        }
    }
}

template <int WHICH  >
__device__ __forceinline__ void p2_attention(const Args& a, LAS unsigned char* lds, int vcu, int G) {
    unsigned char* ws = a.ws;
    const int tid = threadIdx.x, wid = tid >> 6, lane = tid & 63, r32 = lane & 31, hi = lane >> 5;
    const bf16* proj = (const bf16*)(ws + WS_PROJ); bf16* mixed = (bf16*)(ws + WS_MIXED);
    const float lam = *(const float*)(ws + WS_LAM);
    if constexpr (WHICH & 1) {
        const float C = 0.125f * LOG2E;
        float sg[4];
#pragma unroll
        for (int d0 = 0; d0 < 4; ++d0) sg[d0] = a.in[8][32 * d0 + r32] * 0.8f;
        LAS unsigned* stash = (LAS unsigned*)(lds + att::OFF_STASH) + (wid * 32) * 64 + lane;
        for (int it = 0;; ++it) {
            const int u = (it >> 1) * G + vcu, j = it & 1; if (u >= NB * 4 * 8) break;
            const int qb = u & 7, h = (u >> 3) & 3, b = u >> 5, q0 = qb * 256, mp = 2 * h + j;
            { const float* src = (const float*)(ws + WS_BIAS) + mp * 4096; LAS float* lut = (LAS float*)(lds + att::OFF_LUT);
#pragma unroll
              for (int i = 0; i < 8; ++i) lut[tid + 512 * i] = src[tid + 512 * i]; }
            const bf16* base = proj + (size_t)b * SEQ * PROJ_LD;
            f32x16 o[4];
            att::attn_unit<1, 2>(base + (size_t)q0 * PROJ_LD + 64 * mp, PROJ_LD, base + 512 + 64 * mp, PROJ_LD, nullptr, base + 1024 + 128 * h, PROJ_LD, SEQ,
                                 (LAS char*)lds, C, nullptr, q0, o);
            if (j == 0) {
#pragma unroll
                for (int d0 = 0; d0 < 4; ++d0)
#pragma unroll
                    for (int r = 0; r < 16; r += 2) stash[(d0 * 8 + (r >> 1)) * 64] = pk2(o[d0][r], o[d0][r + 1]);
            } else {
                bf16* orow = mixed + (size_t)(b * SEQ + q0 + wid * 32) * D + 128 * h + r32;
#pragma unroll
                for (int rp = 0; rp < 8; ++rp) {
                    float v[2][4], ss[2] = {0.f, 0.f};
#pragma unroll
                    for (int d0 = 0; d0 < 4; ++d0) { const unsigned w = stash[(d0 * 8 + rp) * 64];
                        v[0][d0] = bf2f((unsigned short)(w & 0xffffu)) - lam * o[d0][2 * rp]; v[1][d0] = bf2f((unsigned short)(w >> 16)) - lam * o[d0][2 * rp + 1];
                        ss[0] += v[0][d0] * v[0][d0]; ss[1] += v[1][d0] * v[1][d0]; }
#pragma unroll
                    for (int q = 0; q < 2; ++q) {
#pragma unroll
                        for (int sft = 1; sft < 32; sft <<= 1) ss[q] += __shfl_xor(ss[q], sft);
                        const float rn = 1.f / sqrtf(ss[q] * (1.f / 128.f) + NORM_EPS);
                        bf16* op = orow + (size_t)att::crow(2 * rp + q, hi) * D;
#pragma unroll
                        for (int d0 = 0; d0 < 4; ++d0) op[32 * d0] = (bf16)(pk2(v[q][d0] * rn * sg[d0], 0.f) & 0xffffu);
                    }
                }
            }
        }
    }
    if constexpr (WHICH & 2) {
        const float C = 0.07216878364870322f * LOG2E;
        for (int it = 0;; ++it) {
            const int u = it * G + vcu; if (u >= NB * 4 * 8) break;
            const int qb = u & 7, h = (u >> 3) & 3, b = u >> 5, q0 = qb * 256;
            const bf16* qm = (const bf16*)(ws + WS_QM) + (size_t)(b * SEQ + q0) * 768 + 192 * h;
            const bf16* kv = (const bf16*)(ws + WS_KV) + (size_t)b * SEQ * 1024 + 256 * h;
            const bf16* kpe = (const bf16*)(ws + WS_KPE) + (size_t)b * SEQ * 64;
            f32x16 o[4];
            att::attn_unit<0, 1>(qm, 768, kv, 1024, kpe, kv + 128, 1024, SEQ, (LAS char*)lds, C, (const att::f32x2*)(ws + WS_ROPE), q0, o);
            bf16* orow = mixed + (size_t)(b * SEQ + q0 + wid * 32) * D + 512 + 128 * h + r32;
#pragma unroll
            for (int r = 0; r < 16; ++r) { bf16* op = orow + (size_t)att::crow(r, hi) * D;
#pragma unroll
                for (int d0 = 0; d0 < 4; ++d0) op[32 * d0] = (bf16)(pk2(o[d0][r], 0.f) & 0xffffu); }
        }
    }
}

constexpr int WR_PITCH = 2064;
__device__ __forceinline__ void p3b_router(const Args& a, LAS unsigned char* lds, int G) {
    unsigned char* ws = a.ws;
    const int tid = threadIdx.x, wid = tid >> 6, lane = tid & 63, r32 = lane & 31, hi = lane >> 5;
    LAS unsigned char* wrh = lds; LAS unsigned char* wrl = lds + 32 * WR_PITCH; LAS unsigned* cnt = (LAS unsigned*)(lds + 64 * WR_PITCH);
    for (int i = tid; i < 2 * 32 * 128; i += NTHREADS) { const int tb = i >> 12, e = (i >> 7) & 31, c = i & 127;
        *(LAS u32x4*)(lds + (tb * 32 + e) * WR_PITCH + c * 16) = *((const u32x4*)(ws + (tb ? WS_WRL : WS_WRH)) + e * 128 + c); }
    const float* x1 = a.out; bf16* xb = (bf16*)(ws + WS_XB);
    for (int c = blockIdx.x; c < T / 256; c += G) {
        if (tid < 32) cnt[tid] = 0u;
        __syncthreads();
        const int t = c * 256 + wid * 32 + r32;
        const float* xr = x1 + (size_t)t * D + 64 * hi; bf16* xo = xb + (size_t)t * D + 64 * hi;
        f32x16 acc = f32x16{}; float ss = 0.f;
        for (int sg = 0; sg < 8; ++sg) {
            f32x4 v[16];
#pragma unroll
            for (int q = 0; q < 16; ++q) v[q] = *(const f32x4*)(xr + 128 * sg + 4 * q);
#pragma unroll
            for (int j = 0; j < 8; ++j) {
                const f32x4 x0 = v[2 * j], x1v = v[2 * j + 1];
                ss += (x0.x * x0.x + x0.y * x0.y) + (x0.z * x0.z + x0.w * x0.w) + (x1v.x * x1v.x + x1v.y * x1v.y) + (x1v.z * x1v.z + x1v.w * x1v.w);
                u32x4 hw; hw.x = pk2(x0.x, x0.y); hw.y = pk2(x0.z, x0.w); hw.z = pk2(x1v.x, x1v.y); hw.w = pk2(x1v.z, x1v.w);
                u32x4 lw;
                lw.x = pk2(x0.x - __uint_as_float(hw.x << 16), x0.y - __uint_as_float(hw.x & 0xffff0000u)); lw.y = pk2(x0.z - __uint_as_float(hw.y << 16), x0.w - __uint_as_float(hw.y & 0xffff0000u));
                lw.z = pk2(x1v.x - __uint_as_float(hw.z << 16), x1v.y - __uint_as_float(hw.z & 0xffff0000u)); lw.w = pk2(x1v.z - __uint_as_float(hw.w << 16), x1v.w - __uint_as_float(hw.w & 0xffff0000u));
                *(u32x4*)(xo + 128 * sg + 8 * j) = hw;
                const int kb = (128 * sg + 64 * hi + 8 * j) * 2;
                const bf16x8 wh = *(const LAS bf16x8*)(wrh + r32 * WR_PITCH + kb), wl = *(const LAS bf16x8*)(wrl + r32 * WR_PITCH + kb);
                const bf16x8 xh = __builtin_bit_cast(bf16x8, hw), xl = __builtin_bit_cast(bf16x8, lw);
                acc = __builtin_amdgcn_mfma_f32_32x32x16_bf16(wh, xh, acc, 0, 0, 0);
                acc = __builtin_amdgcn_mfma_f32_32x32x16_bf16(wh, xl, acc, 0, 0, 0);
                acc = __builtin_amdgcn_mfma_f32_32x32x16_bf16(wl, xh, acc, 0, 0, 0);
            }
        }
        ss += __shfl_xor(ss, 32);
        const float rinv = 1.f / sqrtf(ss * (1.f / D) + NORM_EPS);
        if (hi == 0) ((float*)(ws + WS_RINV))[t] = rinv;
        float lg[16];
#pragma unroll
        for (int r = 0; r < 16; ++r) lg[r] = acc[r] * rinv + a.in[16][att::crow(r, hi)];
        float tv[4]; int ti[4];
#pragma unroll
        for (int k = 0; k < 4; ++k) {
            float bv = lg[0]; int bi = att::crow(0, hi);
#pragma unroll
            for (int r = 1; r < 16; ++r) { const int e = att::crow(r, hi); if (lg[r] > bv) { bv = lg[r]; bi = e; } }
            const float ov = __shfl_xor(bv, 32); const int oi = __shfl_xor(bi, 32);
            const bool mine = (bv > ov) || (bv == ov && bi < oi);
            tv[k] = mine ? bv : ov; ti[k] = mine ? bi : oi;
#pragma unroll
            for (int r = 0; r < 16; ++r) if (att::crow(r, hi) == ti[k]) lg[r] = -3.0e38f;
        }
        const float e1 = __expf(tv[1] - tv[0]), e2 = __expf(tv[2] - tv[0]), e3 = __expf(tv[3] - tv[0]), rs = 1.f / (1.f + e1 + e2 + e3);
        if (hi == 0) {
            int lr[4];
#pragma unroll
            for (int k = 0; k < 4; ++k) lr[k] = (int)__hip_atomic_fetch_add(cnt + ti[k], 1u, __ATOMIC_RELAXED, __HIP_MEMORY_SCOPE_WORKGROUP);
            *((int4*)(ws + WS_EIDX) + t) = make_int4(ti[0], ti[1], ti[2], ti[3]);
            *((f32x4*)(ws + WS_GATE) + t) = (f32x4){rs, e1 * rs, e2 * rs, e3 * rs};
            *((int4*)(ws + WS_LRANK) + t) = make_int4(lr[0], lr[1], lr[2], lr[3]);
        }
        __syncthreads();
        if (tid < 32) ((int*)(ws + WS_HIST))[c * 32 + tid] = (int)cnt[tid];
        __syncthreads();
    }
}

__device__ __forceinline__ void p4_scatter(const Args& a, LAS unsigned char* lds, int G) {
    unsigned char* ws = a.ws; const int tid = threadIdx.x;
    LAS int* hist = (LAS int*)lds;
    LAS int* cntE = hist + 256 * 32;
    LAS int* pst = cntE + 64;
    for (int i = tid; i < 256 * 32; i += NTHREADS) hist[i] = ((const int*)(ws + WS_HIST))[i];
    __syncthreads();
    if (tid < 64) { const int hf = tid >> 5, e = tid & 31; int run = 0;
        for (int c = 0; c < 128; ++c) { const int v = hist[(hf * 128 + c) * 32 + e]; hist[(hf * 128 + c) * 32 + e] = run; run += v; }
        cntE[tid] = run; }
    __syncthreads();
    if (tid < 64) { const int hf = tid >> 5, e = tid & 31; int s = 0;
        for (int q = 0; q < e; ++q) s += (cntE[hf * 32 + q] + 255) & ~255;
        pst[tid] = s; }
    __syncthreads();
    int* rowa = (int*)(ws + WS_ROWA); float* rowg = (float*)(ws + WS_ROWG);
    for (int c = blockIdx.x; c < T / 256; c += G) { const int hf = c >> 7;
        for (int i = tid; i < 1024; i += NTHREADS) { const int asg = c * 1024 + i; const int e = ((const int*)(ws + WS_EIDX))[asg];
            const int p = pst[hf * 32 + e] + hist[c * 32 + e] + ((const int*)(ws + WS_LRANK))[asg];
            rowa[hf * ROWS_HALF + p] = asg; rowg[hf * ROWS_HALF + p] = ((const float*)(ws + WS_GATE))[asg]; } }
    if (blockIdx.x == 0 && tid < 64) { const int hf = tid >> 5, e = tid & 31; const int n = cntE[tid], st = pst[tid], pad = (n + 255) & ~255;
        for (int p = st + n; p < st + pad; ++p) { rowa[hf * ROWS_HALF + p] = -1; rowg[hf * ROWS_HALF + p] = 0.f; }
        int* tinfo = (int*)(ws + WS_TINFO);
        for (int tt = st >> 8; tt < (st + pad) >> 8; ++tt) tinfo[hf * 1024 + tt] = e;
        if (e == 31) tinfo[2048 + hf] = (st + pad) >> 8; }
}

struct MoeOrder {
    const int* tinfo; const int* rowa; int ntiles, nN, lgN, G, c;
    __device__ __forceinline__ bool next(int i, pg8::Unit& u) const {
        const int L = i * G + c; if (L >= ntiles * nN) return false;
        const int tile = L >> lgN, pn = L & (nN - 1); const int e = tinfo[tile]; u.pm = tile; u.pn = e * nN + pn; return true;
    }
    __device__ __forceinline__ int gather_row(const pg8::Unit& u, int i) const { const int as = rowa[u.pm * 256 + i]; return as < 0 ? 0 : (as >> 2); }
};
struct EpiSwiglu {
    static constexpr bool PERM = true;
    bf16* act; const float* rinv; const int* rowa; const float* bgu;
    __device__ __forceinline__ void operator()(const pg8::f32x4 (&acc)[2][2][4][2], const pg8::Unit& u, int wr, int wc, int fr, int fq) const {
        const int e = u.pn >> 3, pn = u.pn & 7, col0 = 128 * pn + 32 * wc + 8 * fq;
        const float* bp = bgu + (size_t)e * 2048 + col0;
        f32x4 bg[2], bu[2];
#pragma unroll
        for (int n = 0; n < 2; ++n) { bg[n] = *(const f32x4*)(bp + 4 * n); bu[n] = *(const f32x4*)(bp + 1024 + 4 * n); }
#pragma unroll
        for (int ai = 0; ai < 2; ++ai)
#pragma unroll
            for (int m = 0; m < 4; ++m) {
                const int p = u.pm * 256 + ai * 128 + wr * 64 + m * 16 + fr; const int as = rowa[p]; const float ri = rinv[as < 0 ? 0 : (as >> 2)];
                float o[8];
#pragma unroll
                for (int n = 0; n < 2; ++n)
#pragma unroll
                    for (int q = 0; q < 4; ++q) {
                        float g = fminf(acc[ai][0][m][n][q] * ri + bg[n][q], 7.f); const float up = fminf(fmaxf(acc[ai][1][m][n][q] * ri + bu[n][q], -7.f), 7.f);
                        const float sg = __builtin_amdgcn_rcpf(1.f + __builtin_amdgcn_exp2f(g * (-1.702f * LOG2E)));
                        o[4 * n + q] = (up + 1.f) * (g * sg); }
                u32x4 w; w.x = pk2(o[0], o[1]); w.y = pk2(o[2], o[3]); w.z = pk2(o[4], o[5]); w.w = pk2(o[6], o[7]);
                *(u32x4*)(act + (size_t)p * 1024 + col0) = w; }
    }
};
struct EpiDown {
    static constexpr bool PERM = true;
    bf16* y4; const int* rowa; const float* rowg; const float* bd; int slot0;
    __device__ __forceinline__ void operator()(const pg8::f32x4 (&acc)[2][2][4][2], const pg8::Unit& u, int wr, int wc, int fr, int fq) const {
        const int e = u.pn >> 2, pn = u.pn & 3, col0 = 256 * pn + 32 * wc + 8 * fq;
        const float* bp = bd + (size_t)e * 1024 + col0;
        f32x4 bv[2][2];
#pragma unroll
        for (int bj = 0; bj < 2; ++bj)
#pragma unroll
            for (int n = 0; n < 2; ++n) bv[bj][n] = *(const f32x4*)(bp + 128 * bj + 4 * n);
#pragma unroll
        for (int ai = 0; ai < 2; ++ai)
#pragma unroll
            for (int m = 0; m < 4; ++m) {
                const int p = u.pm * 256 + ai * 128 + wr * 64 + m * 16 + fr; const int as = rowa[p];
                if (as >= 0) { const float gt = rowg[p]; bf16* yr = y4 + (size_t)(as - slot0) * 1024 + col0;
#pragma unroll
                    for (int bj = 0; bj < 2; ++bj) { const f32x4 v0 = (acc[ai][bj][m][0] + bv[bj][0]) * gt, v1 = (acc[ai][bj][m][1] + bv[bj][1]) * gt;
                        u32x4 w; w.x = pk2(v0[0], v0[1]); w.y = pk2(v0[2], v0[3]); w.z = pk2(v1[0], v1[1]); w.w = pk2(v1[2], v1[3]);
                        *(u32x4*)(yr + 128 * bj) = w; } } }
    }
};

__device__ __forceinline__ void p7_final(const Args& a, int vcu, int G, int wave, int lane) {
    unsigned char* ws = a.ws; const int gw = vcu * NWAVES + wave, NGW = G * NWAVES;
    const f32x4* gr = (const f32x4*)a.in[21] + lane;
    for (int t = gw; t < T; t += NGW) {
        f32x4* xr = (f32x4*)(a.out + (size_t)t * D) + lane;
        const u32x2* yr = (const u32x2*)((t < HALF_T ? (const bf16*)(ws + WS_Y4A) + (size_t)t * 4 * D : (const bf16*)(ws + WS_Y4B) + (size_t)(t - HALF_T) * 4 * D)) + lane;
        f32x4 v[4]; float s = 0.f;
#pragma unroll
        for (int j = 0; j < 4; ++j) { v[j] = xr[64 * j];
#pragma unroll
            for (int k = 0; k < 4; ++k) { const u32x2 w = yr[k * 256 + 64 * j];
                v[j].x += __uint_as_float(w.x << 16); v[j].y += __uint_as_float(w.x & 0xffff0000u); v[j].z += __uint_as_float(w.y << 16); v[j].w += __uint_as_float(w.y & 0xffff0000u); }
            s += (v[j].x * v[j].x + v[j].y * v[j].y) + (v[j].z * v[j].z + v[j].w * v[j].w); }
        const float r = 1.f / sqrtf(wave_sum(s) * (1.f / D) + NORM_EPS);
#pragma unroll
        for (int j = 0; j < 4; ++j) { const f32x4 gg = gr[64 * j]; xr[64 * j] = (f32x4){v[j].x * r * gg.x, v[j].y * r * gg.y, v[j].z * r * gg.z, v[j].w * r * gg.w}; }
    }
}

constexpr int N_PHASES = 13;
__global__ void __launch_bounds__(NTHREADS, 2) fwd(Args args) {
    extern __shared__ __attribute__((aligned(16))) unsigned char lds_raw[];
    LAS unsigned char* lds = (LAS unsigned char*)lds_raw;
    volatile LAS unsigned* MISC = (volatile LAS unsigned*)(lds + MISC_OFF);
    const int tid = threadIdx.x, lane = tid & 63, wave = __builtin_amdgcn_readfirstlane(tid >> 6);
    const int G = gridDim.x; const int bx = blockIdx.x; const int vcu = (G % 8 == 0) ? (bx % 8) * (G / 8) + bx / 8 : bx;
    unsigned char* ws = args.ws;
    for (int u = tid; u < (LDS_BYTES - MISC_OFF) / 4; u += NTHREADS) MISC[u] = 0u;
    __syncthreads();
    const int lo = args.ph_lo, hi = args.ph_hi;
    const bool use_bar = (hi - lo) > 1;
    XcdBarrier bar; bar.bar = (unsigned*)(ws + WS_CTL); bar.x = 0; bar.st = nullptr;
    if (use_bar) bar = xcd_barrier_post((unsigned*)(ws + WS_CTL), MISC + 8);
#ifdef ONLY_PHASE
#define IN(k) ((k) == ONLY_PHASE)
#else
#define IN(k) (lo <= (k) && (k) < hi)
#endif
#define SEAM(k) do { if (IN(k) && IN((k) + 1)) xcd_barrier(bar); } while (0)

    if (IN(0)) { p0_prologue(args, lds, vcu, G, wave, lane); }
    SEAM(0);
    if (IN(1)) {
        pg8::Gemm g{(const bf16*)(ws + WS_XB), (const bf16*)(ws + WS_WIN), T, PROJ_LD, D}; pg8::StaticOrder S; S.init(T, PROJ_LD, G, bx);
        pg8::EpiBf16 E{(bf16*)(ws + WS_PROJ), PROJ_LD};
        pg8::gemm_phase<pg8::EpiBf16, pg8::StaticOrder, true, false>(lds, g, S, E);
    }
    SEAM(1);
    if (IN(2)) { p1b_latent(args, vcu, G, wave, lane); }
    SEAM(2);
    if (IN(3)) {
        { pg8::Gemm g{(const bf16*)(ws + WS_CQN), (const bf16*)(ws + WS_WUQ), T, 768, 256}; pg8::StaticOrder S; S.init(T, 768, G, bx);
          pg8::EpiBf16 E{(bf16*)(ws + WS_QM), 768}; pg8::gemm_phase<pg8::EpiBf16, pg8::StaticOrder, true, false>(lds, g, S, E); }
        { pg8::Gemm g{(const bf16*)(ws + WS_CKVN), (const bf16*)(ws + WS_WUKV), T, 1024, 128}; pg8::StaticOrder S; S.init(T, 1024, G, bx);
          pg8::EpiBf16 E{(bf16*)(ws + WS_KV), 1024}; pg8::gemm_phase<pg8::EpiBf16, pg8::StaticOrder, true, false>(lds, g, S, E); }
    }
    SEAM(3);
    if (IN(4)) { p2_attention<3>(args, lds, vcu, G); }
    SEAM(4);
    if (IN(5)) {
        pg8::Gemm g{(const bf16*)(ws + WS_MIXED), (const bf16*)(ws + WS_WO), T, D, D}; pg8::StaticOrder S; S.init(T, D, G, bx);
        pg8::EpiResid E{args.in[0], args.out, D};
        pg8::gemm_phase<pg8::EpiResid, pg8::StaticOrder, true, false>(lds, g, S, E);
    }
    SEAM(5);
    if (IN(6)) { p3b_router(args, lds, G); }
    SEAM(6);
    if (IN(7)) { p4_scatter(args, lds, G); }
    SEAM(7);
#define MOE_HALF(PH, HF, Y4OFF) \
    if (IN(PH)) { \
        const int* tinfo = (const int*)(ws + WS_TINFO); MoeOrder S{tinfo + (HF) * 1024, (const int*)(ws + WS_ROWA) + (HF) * ROWS_HALF, tinfo[2048 + (HF)], 8, 3, G, bx}; \
        pg8::Gemm g{(const bf16*)(ws + WS_XB), (const bf16*)(ws + WS_WGU), 0, 2048, D}; \
        EpiSwiglu E{(bf16*)(ws + WS_ACT), (const float*)(ws + WS_RINV), (const int*)(ws + WS_ROWA) + (HF) * ROWS_HALF, args.in[18]}; \
        pg8::gemm_phase<EpiSwiglu, MoeOrder, true, true>(lds, g, S, E); \
    } \
    SEAM(PH); \
    if (IN((PH) + 1)) { \
        const int* tinfo = (const int*)(ws + WS_TINFO); MoeOrder S{tinfo + (HF) * 1024, (const int*)(ws + WS_ROWA) + (HF) * ROWS_HALF, tinfo[2048 + (HF)], 4, 2, G, bx}; \
        pg8::Gemm g{(const bf16*)(ws + WS_ACT), (const bf16*)(ws + WS_WD), 0, 1024, D}; \
        EpiDown E{(bf16*)(ws + (Y4OFF)), (const int*)(ws + WS_ROWA) + (HF) * ROWS_HALF, (const float*)(ws + WS_ROWG) + (HF) * ROWS_HALF, args.in[20], (HF) * HALF_A}; \
        pg8::gemm_phase<EpiDown, MoeOrder, true, false>(lds, g, S, E); \
    } \
    SEAM((PH) + 1);
    MOE_HALF(8, 0, WS_Y4A)
    MOE_HALF(10, 1, WS_Y4B)
    if (IN(12)) { p7_final(args, vcu, G, wave, lane); }
#ifdef PROBE_EXTRA
    if (IN(13)) { p2_attention<1>(args, lds, vcu, G); }
    if (IN(14)) { p2_attention<2>(args, lds, vcu, G); }
#endif
#undef IN
#undef SEAM
}

#ifndef MK_N_LAUNCHES
#define MK_N_LAUNCHES 1
#endif
extern "C" void kernel_launch(void* const* d_in, const int* in_sizes, int n_in, void* d_out, int out_size, void* d_ws, size_t ws_size, hipStream_t stream) {
    static int grid = 0;
    if (grid == 0) {
        if (n_in != 22 || in_sizes[0] != T * D || out_size != T * D || ws_size < WS_END) {
            fprintf(stderr, "kernel_launch: shape / workspace mismatch (n_in %d, in0 %d, out %d, ws %zu < %zu); nothing launched\n", n_in, n_in > 0 ? in_sizes[0] : -1, out_size, ws_size, (size_t)WS_END); grid = -1; return; }
        int dev = 0, cus = 0, per_cu = 0;
        if (hipGetDevice(&dev) != hipSuccess || hipDeviceGetAttribute(&cus, hipDeviceAttributeMultiprocessorCount, dev) != hipSuccess) { grid = -1; return; }
        if (hipFuncSetAttribute((const void*)fwd, hipFuncAttributeMaxDynamicSharedMemorySize, LDS_BYTES) != hipSuccess) { fprintf(stderr, "kernel_launch: hipFuncSetAttribute failed\n"); grid = -1; return; }
        if (hipOccupancyMaxActiveBlocksPerMultiprocessor(&per_cu, (const void*)fwd, NTHREADS, LDS_BYTES) != hipSuccess || per_cu < 1) { fprintf(stderr, "kernel_launch: occupancy query says %d\n", per_cu); }
        (void)hipGetLastError();
        grid = cus;
    }
    if (grid < 0) return;
    if (hipMemsetAsync((char*)d_ws + WS_CTL, 0, CTL_ZERO_BYTES, stream) != hipSuccess) return;
    Args a{};
    for (int i = 0; i < 22; ++i) a.in[i] = (const float*)d_in[i];
    a.out = (float*)d_out; a.ws = (unsigned char*)d_ws;
#if MK_N_LAUNCHES == 1
    a.ph_lo = 0; a.ph_hi = N_PHASES;
    hipLaunchKernelGGL(fwd, dim3(grid), dim3(NTHREADS), LDS_BYTES, stream, a);
#else
#ifndef PROBE_MASK
#define PROBE_MASK 0
#endif
    for (int p = 0; p < N_PHASES; ++p) { a.ph_lo = p; a.ph_hi = p + 1; hipLaunchKernelGGL(fwd, dim3(grid), dim3(NTHREADS), LDS_BYTES, stream, a);
        if ((PROBE_MASK >> p) & 1) hipLaunchKernelGGL(fwd, dim3(grid), dim3(NTHREADS), LDS_BYTES, stream, a);
#ifdef PROBE_EXTRA
        if (p == 4) { a.ph_lo = PROBE_EXTRA; a.ph_hi = PROBE_EXTRA + 1; hipLaunchKernelGGL(fwd, dim3(grid), dim3(NTHREADS), LDS_BYTES, stream, a); }
#endif
    }
#endif
}
```

```cpp
#include <hip/hip_runtime.h>
#include <cstdio>
#include <cstdint>

namespace pg8 {
#define PG8_LAS __attribute__((address_space(3)))
typedef unsigned short bf16_t;
typedef short bf16x8 __attribute__((ext_vector_type(8)));
typedef float f32x4 __attribute__((ext_vector_type(4)));
typedef unsigned u32x4 __attribute__((ext_vector_type(4)));
typedef unsigned u32x2 __attribute__((ext_vector_type(2)));
constexpr int BM = 256, BK = 64, HALF = 128, HTB = HALF * BK * 2  , STAGE_BYTES = 8 * HTB, NXCD = 8, WGM = 8;

__host__ __device__ __forceinline__ int lds_byte(int r, int c) { const int st = (r >> 4) * 2 + (c >> 5), rr = r & 15, cc = c & 31, ob = rr * 64 + cc * 2; return st * 1024 + (ob ^ (((ob >> 9) & 1) << 5)); }
__host__ __device__ __forceinline__ void stage_rc(int b, int& R, int& C) { const int st = b / 1024, sb = b % 1024, swz = sb ^ (((sb >> 9) & 1) << 5); R = (st >> 1) * 16 + swz / 64; C = (st & 1) * 32 + (swz % 64) / 2; }
__host__ __device__ __forceinline__ int perm32(int rho) { const int n = rho >> 4, i = rho & 15; return 8 * (i >> 2) + 4 * n + (i & 3); }

struct Unit { int pm, pn; };
struct Gemm { const bf16_t* A; const bf16_t* Bt; int M, N, K; };

struct StaticOrder {
    int nM, nN, nwg, G, c;
    __host__ __device__ void init(int M, int N, int G_, int c_) { nM = M / BM; nN = N / BM; nwg = nM * nN; G = G_; c = c_; }
    __host__ __device__ bool next(int i, Unit& u) const {
        const long L = (long)i * G + c; if (L >= nwg) return false;
        int wgid = (int)L; { const int q = nwg / NXCD, r = nwg % NXCD, xcd = wgid % NXCD, off = wgid / NXCD; wgid = (xcd < r ? xcd * (q + 1) : r * (q + 1) + (xcd - r) * q) + off; }
        const int nig = WGM * nN, gid = wgid / nig, fm = gid * WGM, gsz = (nM - fm) < WGM ? (nM - fm) : WGM;
        u.pm = fm + ((wgid % nig) % gsz); u.pn = (wgid % nig) / gsz; return true;
    }
    __device__ __forceinline__ int gather_row(const Unit&, int) const { return 0; }
};

__device__ __forceinline__ unsigned cvt_pk_bf16(float lo, float hi) { unsigned r; asm volatile("v_cvt_pk_bf16_f32 %0, %1, %2" : "=v"(r) : "v"(lo), "v"(hi)); return r; }

struct EpiBf16 {
    static constexpr bool PERM = true;
    bf16_t* O; int ldc;
    __device__ __forceinline__ void operator()(const f32x4 (&acc)[2][2][4][2], const Unit& u, int wr, int wc, int fr, int fq) const {
        const int row0 = u.pm * BM + wr * 64 + fr; const int col0 = u.pn * BM + wc * 32 + 8 * fq;
#pragma unroll
        for (int ai = 0; ai < 2; ++ai)
#pragma unroll
            for (int m = 0; m < 4; ++m) { bf16_t* rowp = O + (size_t)(row0 + ai * HALF + m * 16) * ldc + col0;
#pragma unroll
                for (int bj = 0; bj < 2; ++bj) { const f32x4 v0 = acc[ai][bj][m][0], v1 = acc[ai][bj][m][1];
                    u32x4 w; w.x = cvt_pk_bf16(v0[0], v0[1]); w.y = cvt_pk_bf16(v0[2], v0[3]); w.z = cvt_pk_bf16(v1[0], v1[1]); w.w = cvt_pk_bf16(v1[2], v1[3]);
                    *(u32x4*)(rowp + bj * HALF) = w; } }
    }
};
struct EpiResid {
    static constexpr bool PERM = false;
    const float* base; float* out; int ldc;
    __device__ __forceinline__ void operator()(const f32x4 (&acc)[2][2][4][2], const Unit& u, int wr, int wc, int fr, int fq) const {
        const int row0 = u.pm * BM + wr * 64 + fr; const int col0 = u.pn * BM + wc * 32 + 4 * fq;
#pragma unroll
        for (int ai = 0; ai < 2; ++ai)
#pragma unroll
            for (int m = 0; m < 4; ++m) { const size_t off = (size_t)(row0 + ai * HALF + m * 16) * ldc + col0;
#pragma unroll
                for (int bj = 0; bj < 2; ++bj)
#pragma unroll
                    for (int n = 0; n < 2; ++n) { const f32x4 bs = *(const f32x4*)(base + off + bj * HALF + n * 16); *(f32x4*)(out + off + bj * HALF + n * 16) = bs + acc[ai][bj][m][n]; } }
    }
};

template <class Epi, class Sched, bool ALIGN_EPI = false, bool GATHER = false>
__device__ __forceinline__ void gemm_phase(PG8_LAS unsigned char* lds, const Gemm g, const Sched& S, const Epi& E) {
    const int tid = threadIdx.x, wid = __builtin_amdgcn_readfirstlane(tid >> 6), lane = tid & 63, wr = wid >> 2, wc = wid & 3, fr = lane & 15, fq = lane >> 4;
    const int K = g.K, nt = K / BK;
    unsigned voffA[2], voffB[2]; int RA[2], CA[2];
#pragma unroll
    for (int i = 0; i < 2; ++i) { int R, C; stage_rc(tid * 16 + i * 8192, R, C); const int Rb = Epi::PERM ? ((R & ~31) + perm32(R & 31)) : R;
        voffA[i] = (unsigned)(R * K + C) * 2u; voffB[i] = (unsigned)(Rb * K + C) * 2u; RA[i] = R; CA[i] = C; }
    const size_t kstep = (size_t)(BK * 2);
    const size_t hstep = (size_t)HALF * K * 2;
    const size_t tstep = 2 * hstep;
    const unsigned ldsw = (unsigned)wid * 1024u;
    const int aoff = lds_byte(wr * 64 + fr, fq * 8), boff = lds_byte(wc * 32 + fr, fq * 8);
#define PG8_SA(b, h) (((b) * 2 + (h)) * HTB)
#define PG8_SB(b, h) ((4 + (b) * 2 + (h)) * HTB)
#define PG8_STAGE(bufoff, gbase, voff) do { _Pragma("unroll") for (int _i = 0; _i < 2; ++_i) \
        __builtin_amdgcn_global_load_lds((const unsigned*)((const char*)(gbase) + (voff)[_i]), (PG8_LAS unsigned*)(lds + (bufoff) + ldsw + _i * 8192), 16, 0, 0); } while (0)
#define PG8_STAGE_A(bufoff, h, base, O) do { if constexpr (GATHER) { PG8_STAGE(bufoff, base, O[h]); } else { PG8_STAGE(bufoff, (base) + (h) * hstep, voffA); } } while (0)
#define PG8_LDA(dst, b, h) do { _Pragma("unroll") for (int m = 0; m < 4; ++m) _Pragma("unroll") for (int k = 0; k < 2; ++k) dst[m][k] = *(const PG8_LAS bf16x8*)(lds + PG8_SA(b, h) + aoff + m * 2048 + k * 1024); } while (0)
#define PG8_LDB(dst, b, h) do { _Pragma("unroll") for (int n = 0; n < 2; ++n) _Pragma("unroll") for (int k = 0; k < 2; ++k) dst[n][k] = *(const PG8_LAS bf16x8*)(lds + PG8_SB(b, h) + boff + n * 2048 + k * 1024); } while (0)
#define PG8_MMA(ai, bj, At, Bt) do { __builtin_amdgcn_s_setprio(1); _Pragma("unroll") for (int m = 0; m < 4; ++m) _Pragma("unroll") for (int n = 0; n < 2; ++n) _Pragma("unroll") for (int k = 0; k < 2; ++k) \
        acc[ai][bj][m][n] = __builtin_amdgcn_mfma_f32_16x16x32_bf16(Bt[n][k], At[m][k], acc[ai][bj][m][n], 0, 0, 0); __builtin_amdgcn_s_setprio(0); } while (0)
#define PG8_WAIT_V(n) asm volatile("s_waitcnt vmcnt(" #n ")" ::: "memory")
#define PG8_WAIT_L(n) asm volatile("s_waitcnt lgkmcnt(" #n ")" ::: "memory")
#define PG8_BAR __builtin_amdgcn_s_barrier()
#define PG8_SCHED __builtin_amdgcn_sched_barrier(0)
    Unit cur, nxt; int ui = 0;
    if (!S.next(0, cur)) return;
    f32x4 acc[2][2][4][2];
#pragma unroll
    for (int a = 0; a < 2; ++a)
#pragma unroll
        for (int b = 0; b < 2; ++b)
#pragma unroll
            for (int m = 0; m < 4; ++m)
#pragma unroll
                for (int n = 0; n < 2; ++n) acc[a][b][m][n] = (f32x4){0.f, 0.f, 0.f, 0.f};
    bf16x8 At[4][2], B0[2][2], B1[2][2];
    unsigned gC[2][2], gN[2][2];
#pragma unroll
    for (int h = 0; h < 2; ++h)
#pragma unroll
        for (int i = 0; i < 2; ++i) { gC[h][i] = 0u; gN[h][i] = 0u; }
    if constexpr (GATHER) {
#pragma unroll
        for (int h = 0; h < 2; ++h)
#pragma unroll
            for (int i = 0; i < 2; ++i) gC[h][i] = (unsigned)S.gather_row(cur, h * HALF + RA[i]) * (unsigned)(K * 2) + (unsigned)(CA[i] * 2);
    }
    const char* cA = GATHER ? (const char*)g.A : (const char*)g.A + (size_t)cur.pm * tstep; const char* cB = (const char*)g.Bt + (size_t)cur.pn * tstep;
    PG8_STAGE(PG8_SB(0, 0), cB, voffB); PG8_STAGE(PG8_SB(0, 1), cB + hstep, voffB); PG8_STAGE_A(PG8_SA(0, 0), 0, cA, gC); PG8_STAGE_A(PG8_SA(0, 1), 1, cA, gC);
    if (wr == 1) PG8_BAR;
    PG8_WAIT_V(2); PG8_BAR;
    PG8_STAGE(PG8_SB(1, 0), cB + kstep, voffB); PG8_STAGE_A(PG8_SA(1, 0), 0, cA + kstep, gC); PG8_STAGE(PG8_SB(1, 1), cB + hstep + kstep, voffB);
    PG8_WAIT_V(6); PG8_BAR;
    for (;;) {
        const bool has_next = S.next(ui + 1, nxt);
        if constexpr (GATHER) {
            if (has_next) {
#pragma unroll
                for (int h = 0; h < 2; ++h)
#pragma unroll
                    for (int i = 0; i < 2; ++i) gN[h][i] = (unsigned)S.gather_row(nxt, h * HALF + RA[i]) * (unsigned)(K * 2) + (unsigned)(CA[i] * 2);
            } else {
#pragma unroll
                for (int h = 0; h < 2; ++h)
#pragma unroll
                    for (int i = 0; i < 2; ++i) gN[h][i] = gC[h][i];
            }
        }
        const char* nA = GATHER ? (const char*)g.A : (has_next ? (const char*)g.A + (size_t)nxt.pm * tstep : cA); const char* nB = has_next ? (const char*)g.Bt + (size_t)nxt.pn * tstep : cB;
        for (int t = 0; t < nt; t += 2) {
            const bool last = (t == nt - 2);
            const char* a1 = cA + (size_t)(t + 1) * kstep;
            const char* a2 = last ? nA : cA + (size_t)(t + 2) * kstep; const char* b2 = last ? nB : cB + (size_t)(t + 2) * kstep;
            const char* a3 = a2 + kstep; const char* b3 = b2 + kstep;
            unsigned g2[2][2];
#pragma unroll
            for (int h = 0; h < 2; ++h)
#pragma unroll
                for (int i = 0; i < 2; ++i) g2[h][i] = last ? gN[h][i] : gC[h][i];
            PG8_LDB(B0, 0, 0); PG8_LDB(B1, 0, 1); PG8_SCHED; PG8_LDA(At, 0, 0); PG8_STAGE_A(PG8_SA(1, 1), 1, a1, gC);
            PG8_WAIT_V(8); PG8_WAIT_L(0); PG8_BAR; PG8_MMA(0, 0, At, B0); PG8_MMA(0, 1, At, B1); PG8_BAR; PG8_SCHED;
            PG8_LDA(At, 0, 1); PG8_STAGE(PG8_SB(0, 0), b2, voffB); PG8_STAGE(PG8_SB(0, 1), b2 + hstep, voffB); PG8_STAGE_A(PG8_SA(0, 0), 0, a2, g2);
            PG8_WAIT_V(8); PG8_WAIT_L(0); PG8_BAR; PG8_MMA(1, 0, At, B0); PG8_MMA(1, 1, At, B1); PG8_BAR; PG8_SCHED;
            PG8_LDB(B0, 1, 0); PG8_LDB(B1, 1, 1); PG8_SCHED; PG8_LDA(At, 1, 0); PG8_STAGE_A(PG8_SA(0, 1), 1, a2, g2);
            PG8_WAIT_V(8); PG8_WAIT_L(0); PG8_BAR; PG8_MMA(0, 0, At, B0); PG8_MMA(0, 1, At, B1); PG8_BAR; PG8_SCHED;
            PG8_LDA(At, 1, 1); PG8_STAGE(PG8_SB(1, 0), b3, voffB); PG8_STAGE(PG8_SB(1, 1), b3 + hstep, voffB); PG8_STAGE_A(PG8_SA(1, 0), 0, a3, g2);
            PG8_WAIT_V(8); PG8_WAIT_L(0); PG8_BAR; PG8_MMA(1, 0, At, B0); PG8_MMA(1, 1, At, B1); PG8_BAR; PG8_SCHED;
        }
        if constexpr (ALIGN_EPI) { if (wr == 0) PG8_BAR; }
        E(acc, cur, wr, wc, fr, fq);
        if (!has_next) break;
#pragma unroll
        for (int a = 0; a < 2; ++a)
#pragma unroll
            for (int b = 0; b < 2; ++b)
#pragma unroll
                for (int m = 0; m < 4; ++m)
#pragma unroll
                    for (int n = 0; n < 2; ++n) acc[a][b][m][n] = (f32x4){0.f, 0.f, 0.f, 0.f};
        cur = nxt; cA = nA; cB = nB; ++ui;
#pragma unroll
        for (int h = 0; h < 2; ++h)
#pragma unroll
            for (int i = 0; i < 2; ++i) gC[h][i] = gN[h][i];
        if constexpr (ALIGN_EPI) { if (wr == 1) PG8_BAR; }
    }
    PG8_WAIT_V(0);
    if constexpr (!ALIGN_EPI) { if (wr == 0) PG8_BAR; }
    PG8_BAR;
#undef PG8_SA
#undef PG8_SB
#undef PG8_STAGE
#undef PG8_STAGE_A
#undef PG8_LDA
#undef PG8_LDB
#undef PG8_MMA
#undef PG8_WAIT_V
#undef PG8_WAIT_L
#undef PG8_BAR
#undef PG8_SCHED
}
}

namespace att {
#define ALAS __attribute__((address_space(3)))
using bf16 = unsigned short;
using bf16x8 = __attribute__((ext_vector_type(8))) short;
using s16x4  = __attribute__((ext_vector_type(4))) short;
using f32x16 = __attribute__((ext_vector_type(16))) float;
using f32x2  = __attribute__((ext_vector_type(2))) float;
using u32x4  = __attribute__((ext_vector_type(4))) unsigned;
#define SBAR() __builtin_amdgcn_sched_barrier(0)
constexpr int SHM_V = 64 * 128 * 2;
constexpr int OFF_V = 0;
template <int MODE> struct L { static constexpr int NVB = MODE == 0 ? 3 : 2, SHM_K = 64 * (MODE == 0 ? 384 : 128), OFF_K = NVB * SHM_V, OFF_WS = OFF_K + 2 * SHM_K; };
constexpr int OFF_LUT = L<1>::OFF_WS + 2048;
constexpr int OFF_STASH = OFF_LUT + 16384;
constexpr int OFF_QPE = L<0>::OFF_WS + 2048;
constexpr int ATT_LDS = (OFF_STASH + 65536) > (OFF_QPE + 32768) ? (OFF_STASH + 65536) : (OFF_QPE + 32768);
__device__ __forceinline__ int crow(int r, int hi) { return (r & 3) + 8 * (r >> 2) + 4 * hi; }
__device__ __forceinline__ unsigned cvtpk(float lo, float hi) { unsigned r; asm volatile("v_cvt_pk_bf16_f32 %0, %1, %2" : "=v"(r) : "v"(lo), "v"(hi)); return r; }
__device__ __forceinline__ float bf2f(short v) { return __uint_as_float(((unsigned)(unsigned short)v) << 16); }
template <int RB> __device__ __forceinline__ int kaddr(int row, int colB) { return row * RB + (colB ^ (((row >> 1) & 7) << 4)); }

template <bool NEAR>
__device__ __forceinline__ void partialSM(f32x16& p0, f32x16& p1, float& m_reg, float& mn, float& alpha, float C, const ALAS float* lut, float cfar) {
  constexpr float THR2 = 8.f * 1.4426950408889634f;
  if constexpr (NEAR) {
#pragma unroll
    for (int r = 0; r < 16; ++r) { const int o = (r & 3) + 8 * (r >> 2); p0[r] = fmaf(p0[r], C, lut[o]); p1[r] = fmaf(p1[r], C, lut[32 + o]); }
  }
  float pmax = p0[0];
#pragma unroll
  for (int r = 1; r < 16; ++r) pmax = fmaxf(pmax, p0[r]);
#pragma unroll
  for (int r = 0; r < 16; ++r) pmax = fmaxf(pmax, p1[r]);
  { auto rr = __builtin_amdgcn_permlane32_swap(__float_as_uint(pmax), __float_as_uint(pmax), false, false);
    pmax = fmaxf(__uint_as_float(rr[0]), __uint_as_float(rr[1])); }
  if constexpr (!NEAR) pmax = fmaf(pmax, C, cfar);
  if (__builtin_expect(__all(pmax - m_reg <= THR2), 1)) { mn = m_reg; alpha = 1.f; }
  else { mn = fmaxf(m_reg, pmax); alpha = __builtin_amdgcn_exp2f(m_reg - mn); m_reg = mn; }
  if constexpr (NEAR) {
#pragma unroll
    for (int r = 0; r < 16; ++r) p0[r] = __builtin_amdgcn_exp2f(p0[r] - mn);
#pragma unroll
    for (int r = 0; r < 16; ++r) p1[r] = p1[r] - mn;
  } else {
    const float cm = cfar - mn;
#pragma unroll
    for (int r = 0; r < 16; ++r) p0[r] = __builtin_amdgcn_exp2f(fmaf(p0[r], C, cm));
#pragma unroll
    for (int r = 0; r < 16; ++r) p1[r] = fmaf(p1[r], C, cm);
  }
}
__device__ __forceinline__ void finishSM(f32x16& p0, f32x16& p1, float alpha, float& l_reg, bf16x8& pa0, bf16x8& pa1, bf16x8& pa2, bf16x8& pa3) {
#pragma unroll
  for (int r = 0; r < 16; ++r) p1[r] = __builtin_amdgcn_exp2f(p1[r]);
  float ps = 0;
#pragma unroll
  for (int r = 0; r < 16; ++r) ps += p0[r];
#pragma unroll
  for (int r = 0; r < 16; ++r) ps += p1[r];
  { auto rr = __builtin_amdgcn_permlane32_swap(__float_as_uint(ps), __float_as_uint(ps), false, false);
    ps = __uint_as_float(rr[0]) + __uint_as_float(rr[1]); }
  l_reg = l_reg * alpha + ps;
#define PK4(P, BASE, OUT) do { unsigned a0 = cvtpk(P[BASE + 0], P[BASE + 1]), a1 = cvtpk(P[BASE + 2], P[BASE + 3]);   \
    unsigned b0 = cvtpk(P[BASE + 4], P[BASE + 5]), b1 = cvtpk(P[BASE + 6], P[BASE + 7]);                              \
    auto r0 = __builtin_amdgcn_permlane32_swap(a0, b0, false, false); auto r1 = __builtin_amdgcn_permlane32_swap(a1, b1, false, false); \
    u32x4 w = {r0[0], r1[0], r0[1], r1[1]}; OUT = __builtin_bit_cast(bf16x8, w); } while (0)
  PK4(p0, 0, pa0); PK4(p0, 8, pa1); PK4(p1, 0, pa2); PK4(p1, 8, pa3);
#undef PK4
}
template <int NQ, int RB>
__device__ __forceinline__ void qkt(f32x16& p0, f32x16& p1, const ALAS char* Ks, const bf16x8* qr, int r32, int hi) {
  p0 = f32x16{}; p1 = f32x16{};
#pragma unroll
  for (int d0 = 0; d0 < NQ; ++d0) { const int cb = (d0 * 16 + hi * 8) * 2;
    const bf16x8 b0 = *reinterpret_cast<const ALAS bf16x8*>(Ks + kaddr<RB>(r32, cb));
    const bf16x8 b1 = *reinterpret_cast<const ALAS bf16x8*>(Ks + kaddr<RB>(32 + r32, cb));
    p0 = __builtin_amdgcn_mfma_f32_32x32x16_bf16(b0, qr[d0], p0, 0, 0, 0);
    p1 = __builtin_amdgcn_mfma_f32_32x32x16_bf16(b1, qr[d0], p1, 0, 0, 0); }
}
__device__ __forceinline__ int v_st(int k, int c) { const int kk = (k & ~0xC) | ((k & 4) << 1) | ((k & 8) >> 1); return ((kk >> 3) * 4 + (c >> 5)) * 512 + ((kk & 7) * 32 + (c & 31)) * 2; }
__device__ __forceinline__ int v_rd_base(int lane) { return ((lane & 3) << 3) | (((lane >> 2) & 3) << 6) | (((lane >> 4) & 1) << 5) | (((lane >> 5) & 1) << 8); }
constexpr int v_rd_off(int d0, int ks, int half) { return d0 * 512 + ks * 4096 + half * 2048; }
template <int OFF> __device__ __forceinline__ s16x4 tr_read(int vb) {
  s16x4 r; asm volatile("ds_read_b64_tr_b16 %0, %1 offset:%2" : "=&v"(r) : "v"(vb), "i"(OFF) : "memory"); return r;
}
template <int D0> __device__ __forceinline__ void pv_one(f32x16& od, int vb, bf16x8 pa0, bf16x8 pa1, bf16x8 pa2, bf16x8 pa3) {
  const s16x4 l0 = tr_read<v_rd_off(D0, 0, 0)>(vb), h0 = tr_read<v_rd_off(D0, 0, 1)>(vb), l1 = tr_read<v_rd_off(D0, 1, 0)>(vb), h1 = tr_read<v_rd_off(D0, 1, 1)>(vb);
  const s16x4 l2 = tr_read<v_rd_off(D0, 2, 0)>(vb), h2 = tr_read<v_rd_off(D0, 2, 1)>(vb), l3 = tr_read<v_rd_off(D0, 3, 0)>(vb), h3 = tr_read<v_rd_off(D0, 3, 1)>(vb);
  asm volatile("s_waitcnt lgkmcnt(0)" ::: "memory"); SBAR();
#define PK(L, H) (bf16x8){L[0], L[1], L[2], L[3], H[0], H[1], H[2], H[3]}
  od = __builtin_amdgcn_mfma_f32_32x32x16_bf16(pa0, PK(l0, h0), od, 0, 0, 0);
  od = __builtin_amdgcn_mfma_f32_32x32x16_bf16(pa1, PK(l1, h1), od, 0, 0, 0);
  od = __builtin_amdgcn_mfma_f32_32x32x16_bf16(pa2, PK(l2, h2), od, 0, 0, 0);
  od = __builtin_amdgcn_mfma_f32_32x32x16_bf16(pa3, PK(l3, h3), od, 0, 0, 0);
#undef PK
}
__device__ __forceinline__ void pv_d0(f32x16* o, int vb, bf16x8 pa0, bf16x8 pa1, bf16x8 pa2, bf16x8 pa3) {
  pv_one<0>(o[0], vb, pa0, pa1, pa2, pa3); pv_one<1>(o[1], vb, pa0, pa1, pa2, pa3); pv_one<2>(o[2], vb, pa0, pa1, pa2, pa3); pv_one<3>(o[3], vb, pa0, pa1, pa2, pa3);
}

__device__ __forceinline__ int kw_addr(int row, int colB) { return row * 256 + (colB ^ ((row & 15) << 4)); }
__device__ __forceinline__ int kn_addr(int row, int colB) { return row * 128 + (colB ^ (((row >> 1) & 7) << 4)); }
template <int MODE>
__device__ __forceinline__ void attn_unit(const bf16* __restrict__ Qb, int ldq, const bf16* __restrict__ Kh, int ldk, const bf16* __restrict__ Kp, const bf16* __restrict__ Vh, int ldv,
                                          int seq, ALAS char* lds, float C, const f32x2* __restrict__ cs, int qpos0, f32x16 (&o)[4]) {
  constexpr int SHM_KW = MODE == 0 ? 64 * 256 : 0, SHM_KN = 64 * 128, SHM_K = SHM_KW + SHM_KN;
  static_assert(SHM_K == L<MODE>::SHM_K, "K buffers");
  const int tid = threadIdx.x, wid = __builtin_amdgcn_readfirstlane(tid >> 6), lane = tid & 63, r32 = lane & 31, hi = lane >> 5;
  const bool late = wid >= 4;
  ALAS char* V_lds = lds + OFF_V; ALAS char* K_lds = lds + L<MODE>::OFF_K;
  ALAS float* ws = (ALAS float*)(lds + L<MODE>::OFF_WS) + wid * 64; ALAS float* li_l = ws; ALAS float* al_l = ws + 32;
  __syncthreads();
  float m_reg = -1e30f, l_reg = 0;
#pragma unroll
  for (int d = 0; d < 4; ++d) o[d] = f32x16{};
  constexpr int NQR = MODE == 0 ? 8 : 4;
  bf16x8 qr[NQR];
  ALAS char* qpe_l = lds + OFF_QPE + wid * 4096 + lane * 16;
  const bf16* Qw = Qb + (long)(wid * 32 + r32) * ldq + hi * 8;
#pragma unroll
  for (int d0 = 0; d0 < NQR; ++d0) qr[d0] = *reinterpret_cast<const bf16x8*>(Qw + d0 * 16);
  if constexpr (MODE == 0) {
    bf16x8 qp[4];
#pragma unroll
    for (int d0 = 0; d0 < 4; ++d0) qp[d0] = *reinterpret_cast<const bf16x8*>(Qw + (8 + d0) * 16);
    const f32x2* cp = cs + (long)(qpos0 + wid * 32 + r32) * 32 + hi * 8;
#pragma unroll
    for (int a = 0; a < 2; ++a) {
      unsigned w1[4], w2[4];
#pragma unroll
      for (int j = 0; j < 8; j += 2) {
        const f32x2 c0 = cp[16 * a + j], c1 = cp[16 * a + j + 1];
        const float x10 = bf2f(qp[a][j]), x20 = bf2f(qp[2 + a][j]), x11 = bf2f(qp[a][j + 1]), x21 = bf2f(qp[2 + a][j + 1]);
        w1[j >> 1] = cvtpk(x10 * c0.x - x20 * c0.y, x11 * c1.x - x21 * c1.y);
        w2[j >> 1] = cvtpk(x10 * c0.y + x20 * c0.x, x11 * c1.y + x21 * c1.x);
      }
      u32x4 v1 = {w1[0], w1[1], w1[2], w1[3]}, v2 = {w2[0], w2[1], w2[2], w2[3]};
      *(ALAS u32x4*)(qpe_l + a * 1024) = v1; *(ALAS u32x4*)(qpe_l + (2 + a) * 1024) = v2;
    }
  }
  unsigned vsrc[2], kwsrc[2], knsrc;
#pragma unroll
  for (int i = 0; i < 2; ++i) { const int s = (wid + 8 * i) * 64 + lane;
    const int kk = (s >> 7) * 8 + ((s & 31) >> 2), c = ((s >> 5) & 3) * 32 + (s & 3) * 8, k = (kk & ~0xC) | ((kk & 4) << 1) | ((kk & 8) >> 1);
    vsrc[i] = (unsigned)(k * ldv + c);
    const int row = s >> 4, ch = (s & 15) ^ (row & 15); kwsrc[i] = (unsigned)(row * ldk + ch * 8); }
  { const int s = wid * 64 + lane, row = s >> 3, ch = (s & 7) ^ ((row >> 1) & 7); knsrc = (unsigned)(row * (MODE == 0 ? 64 : ldk) + ch * 8); }
  const bf16* Kn = MODE == 0 ? Kp : Kh; const int ldn = MODE == 0 ? 64 : ldk;
#define DMA16(src, dst) __builtin_amdgcn_global_load_lds((const unsigned*)(src), (ALAS unsigned*)(dst), 16, 0, 0)
#define DMA_V(t, b) do { const bf16* vb_ = Vh + (long)(t) * 64 * ldv; DMA16(vb_ + vsrc[0], V_lds + (b) * SHM_V + wid * 1024); DMA16(vb_ + vsrc[1], V_lds + (b) * SHM_V + (wid + 8) * 1024); } while (0)
#define DMA_K(t, b) do { if constexpr (MODE == 0) { const bf16* kb_ = Kh + (long)(t) * 64 * ldk; DMA16(kb_ + kwsrc[0], K_lds + (b) * SHM_K + wid * 1024); DMA16(kb_ + kwsrc[1], K_lds + (b) * SHM_K + (wid + 8) * 1024); } \
    DMA16(Kn + (long)(t) * 64 * ldn + knsrc, K_lds + (b) * SHM_K + SHM_KW + wid * 1024); } while (0)
#define STEP_END() do { asm volatile("s_waitcnt vmcnt(0)" ::: "memory"); __syncthreads(); } while (0)
#define QKT(P0, P1, b) do { P0 = f32x16{}; P1 = f32x16{}; const ALAS char* kb_ = K_lds + (b) * SHM_K; \
    if constexpr (MODE == 0) { _Pragma("unroll") for (int d0 = 0; d0 < 8; ++d0) { const int cb = (d0 * 16 + hi * 8) * 2; \
        const bf16x8 b0 = *reinterpret_cast<const ALAS bf16x8*>(kb_ + kw_addr(r32, cb)); const bf16x8 b1 = *reinterpret_cast<const ALAS bf16x8*>(kb_ + kw_addr(32 + r32, cb)); \
        P0 = __builtin_amdgcn_mfma_f32_32x32x16_bf16(b0, qr[d0], P0, 0, 0, 0); P1 = __builtin_amdgcn_mfma_f32_32x32x16_bf16(b1, qr[d0], P1, 0, 0, 0); } } \
    _Pragma("unroll") for (int d0 = 0; d0 < 4; ++d0) { const int cb = (d0 * 16 + hi * 8) * 2; \
        const bf16x8 b0 = *reinterpret_cast<const ALAS bf16x8*>(kb_ + SHM_KW + kn_addr(r32, cb)); const bf16x8 b1 = *reinterpret_cast<const ALAS bf16x8*>(kb_ + SHM_KW + kn_addr(32 + r32, cb)); \
        bf16x8 qf_; if constexpr (MODE == 0) qf_ = *reinterpret_cast<const ALAS bf16x8*>(qpe_l + d0 * 1024); else qf_ = qr[d0]; \
        P0 = __builtin_amdgcn_mfma_f32_32x32x16_bf16(b0, qf_, P0, 0, 0, 0); P1 = __builtin_amdgcn_mfma_f32_32x32x16_bf16(b1, qf_, P1, 0, 0, 0); } } while (0)
#define RESC(a) do { if (__any((a) < 1.f)) { if (hi == 0) al_l[r32] = (a); asm volatile("s_waitcnt lgkmcnt(0)" ::: "memory"); \
    _Pragma("unroll") for (int d = 0; d < 4; ++d) _Pragma("unroll") for (int r = 0; r < 16; ++r) o[d][r] *= al_l[crow(r, hi)]; } } while (0)
  const int vb0 = (int)(unsigned)(uintptr_t)V_lds + v_rd_base(lane);
  const int qw = qpos0 + wid * 32;
  const ALAS float* lutb = (const ALAS float*)(lds + OFF_LUT);
  const ALAS float* lutp = lutb + (2047 - (qw + r32) + 4 * hi);
  float cpos = 0.f, cneg = 0.f;
#define PSM(P0, P1, MN, AL, TILE) do { if constexpr (MODE == 0) partialSM<false>(P0, P1, m_reg, MN, AL, C, lutp, 0.f); else { const int k0_ = (TILE) * 64; \
    if ((k0_ >= qw + 122) || (k0_ + 154 <= qw)) partialSM<false>(P0, P1, m_reg, MN, AL, C, lutp, k0_ > qw ? cpos : cneg); else partialSM<true>(P0, P1, m_reg, MN, AL, C, lutp + k0_, 0.f); } } while (0)
  f32x16 pA0, pA1; float mnA, alA; bf16x8 pa0, pa1, pa2, pa3; const int NT = seq / 64;
  if constexpr (MODE == 0) {
    DMA_K(0, 0); DMA_V(0, 0); STEP_END();
    int vbj = 0, vbp = 0;
    for (int j = 0; j < NT; ++j) {
      const int kb = j & 1, vbn = vbj == 2 ? 0 : vbj + 1;
      if (j + 1 < NT) { DMA_K(j + 1, kb ^ 1); DMA_V(j + 1, vbn); }
      if (late && j > 0) pv_d0(o, vb0 + vbp * SHM_V, pa0, pa1, pa2, pa3);
      SBAR();
      QKT(pA0, pA1, kb); PSM(pA0, pA1, mnA, alA, j);
      RESC(alA);
      finishSM(pA0, pA1, alA, l_reg, pa0, pa1, pa2, pa3); SBAR();
      if (!late) pv_d0(o, vb0 + vbj * SHM_V, pa0, pa1, pa2, pa3);
      STEP_END();
      vbp = vbj; vbj = vbn;
    }
    if (late) pv_d0(o, vb0 + vbp * SHM_V, pa0, pa1, pa2, pa3);
  } else {
    f32x16 pB0, pB1; float mnB, alB;
    DMA_K(0, 0); STEP_END();
    cpos = lutb[2047 + 128]; cneg = lutb[2047 - 128];
#define DIFF_LOOP(LATE) do { \
      \
    DMA_K(1, 1); DMA_V(0, 0); \
    QKT(pA0, pA1, 0); \
    if (!(LATE)) { PSM(pA0, pA1, mnA, alA, 0); } \
    STEP_END(); \
    for (int j = 1; j + 1 < NT; j += 2) { \
        \
      DMA_K(j + 1, 0); DMA_V(j, 1); \
      if (LATE) { PSM(pA0, pA1, mnA, alA, j - 1); RESC(alA); } \
      SBAR(); QKT(pB0, pB1, 1); \
      finishSM(pA0, pA1, alA, l_reg, pa0, pa1, pa2, pa3); SBAR(); \
      pv_d0(o, vb0, pa0, pa1, pa2, pa3); \
      if (!(LATE)) { PSM(pB0, pB1, mnB, alB, j); RESC(alB); } \
      STEP_END(); \
        \
      DMA_K(j + 2, 1); DMA_V(j + 1, 0); \
      if (LATE) { PSM(pB0, pB1, mnB, alB, j); RESC(alB); } \
      SBAR(); QKT(pA0, pA1, 0); \
      finishSM(pB0, pB1, alB, l_reg, pa0, pa1, pa2, pa3); SBAR(); \
      pv_d0(o, vb0 + SHM_V, pa0, pa1, pa2, pa3); \
      if (!(LATE)) { PSM(pA0, pA1, mnA, alA, j + 1); RESC(alA); } \
      STEP_END(); \
    } \
      \
    DMA_V(NT - 1, 1); \
    if (LATE) { PSM(pA0, pA1, mnA, alA, NT - 2); RESC(alA); } \
    SBAR(); QKT(pB0, pB1, 1); \
    finishSM(pA0, pA1, alA, l_reg, pa0, pa1, pa2, pa3); SBAR(); \
    pv_d0(o, vb0, pa0, pa1, pa2, pa3); \
    PSM(pB0, pB1, mnB, alB, NT - 1); RESC(alB); \
    STEP_END(); \
    finishSM(pB0, pB1, alB, l_reg, pa0, pa1, pa2, pa3); SBAR(); \
    pv_d0(o, vb0 + SHM_V, pa0, pa1, pa2, pa3); } while (0)
    if (late) DIFF_LOOP(true); else DIFF_LOOP(false);
#undef DIFF_LOOP
  }
  if (hi == 0) li_l[r32] = l_reg; asm volatile("s_waitcnt lgkmcnt(0)" ::: "memory");
#pragma unroll
  for (int r = 0; r < 16; ++r) { const float rl = __builtin_amdgcn_rcpf(li_l[crow(r, hi)]);
#pragma unroll
    for (int d = 0; d < 4; ++d) o[d][r] *= rl; }
#undef DMA16
#undef DMA_V
#undef DMA_K
#undef STEP_END
#undef QKT
#undef RESC
#undef PSM
}
}
#define XB_TMO      128
#define XB_XCNT(j)  (256  + 64 * (j))
#define XB_XSUB(j)  (1280 + 64 * (j))
#define XB_XGEN(j)  (2304 + 64 * (j))
#define XB_TOP      3328
#define XB_TOPGEN   3392
#define XCD_BAR_WORDS 3456
#define XB_SPIN_CAP (1u << 18)
#define LAS __attribute__((address_space(3)))

__device__ __forceinline__ unsigned xb_ld(unsigned* p)              { return __hip_atomic_load(p, __ATOMIC_RELAXED, __HIP_MEMORY_SCOPE_AGENT); }
__device__ __forceinline__ unsigned xb_add(unsigned* p, unsigned v) { return __hip_atomic_fetch_add(p, v, __ATOMIC_RELAXED, __HIP_MEMORY_SCOPE_AGENT); }
__device__ __forceinline__ unsigned xb_xcc_id() { return (unsigned)__builtin_amdgcn_s_getreg((3 << 11) | 20) & 0xFu; }
#define XB_SPIN(cond, bar) do { unsigned _sp = 0; while (cond) { __builtin_amdgcn_s_sleep(1); \
    if ((++_sp & 255u) == 0u) { if (xb_ld(&(bar)[XB_TMO])) break; if (_sp > XB_SPIN_CAP) { atomicAdd(&(bar)[XB_TMO], 1u); break; } } } } while (0)

struct XcdBarrier {
    unsigned* bar; unsigned x;
    volatile LAS unsigned* st;
};

__device__ __forceinline__ XcdBarrier xcd_barrier_post(unsigned* bar, volatile LAS unsigned* st) {
    XcdBarrier b; b.bar = bar; b.x = xb_xcc_id(); b.st = st;
    if (threadIdx.x == 0) (void)xb_add(&bar[XB_XCNT(b.x)], 1u);
    return b;
}
__device__ __forceinline__ void xcd_barrier_complete(unsigned* bar, unsigned x, unsigned& nloc, unsigned& nx) {
    const unsigned G = gridDim.x * gridDim.y * gridDim.z;
    unsigned sum, cnt, mine, sp = 0u;
    for (;;) {
        sum = 0u; cnt = 0u; mine = 0u;
#pragma unroll
        for (unsigned j = 0; j < 16; ++j) { const unsigned c = xb_ld(&bar[XB_XCNT(j)]); sum += c; cnt += (c > 0u) ? 1u : 0u; mine = (j == x) ? c : mine; }
        if (sum == G) break;
        __builtin_amdgcn_s_sleep(1);
        if ((++sp & 255u) == 0u) { if (xb_ld(&bar[XB_TMO])) break; if (sp > XB_SPIN_CAP) { atomicAdd(&bar[XB_TMO], 1u); break; } }
    }
    nloc = mine > 0u ? mine : 1u; nx = cnt > 0u ? cnt : 1u;
}

__device__ __forceinline__ void xcd_barrier(const XcdBarrier& b) {
    asm volatile("s_waitcnt vmcnt(0)" ::: "memory");
    __syncthreads();
    if (threadIdx.x == 0) {
        unsigned* bar = b.bar;
        __builtin_amdgcn_s_waitcnt(0);
        unsigned nloc = b.st[0], nx = b.st[1];
        if (nloc == 0u) { xcd_barrier_complete(bar, b.x, nloc, nx); b.st[0] = nloc; b.st[1] = nx; }
        const unsigned old = xb_add(&bar[XB_XSUB(b.x)], 1u);
        const unsigned gen = old / nloc;
        if (old + 1u == (gen + 1u) * nloc) {
            __builtin_amdgcn_fence(__ATOMIC_RELEASE, "agent");
            asm volatile("s_waitcnt vmcnt(0)" ::: "memory");
            const unsigned og = xb_add(&bar[XB_TOP], 1u);
            const unsigned tg = og / nx;
            if (og + 1u == (tg + 1u) * nx) xb_add(&bar[XB_TOPGEN], 1u);
            else XB_SPIN(xb_ld(&bar[XB_TOPGEN]) == tg, bar);
            __builtin_amdgcn_fence(__ATOMIC_ACQUIRE, "agent");
            xb_add(&bar[XB_XGEN(b.x)], 1u);
            asm volatile("s_waitcnt vmcnt(0)" ::: "memory");
        } else {
            XB_SPIN(xb_ld(&bar[XB_XGEN(b.x)]) == gen, bar);
            __builtin_amdgcn_fence(__ATOMIC_ACQUIRE, "agent");
            asm volatile("s_waitcnt vmcnt(0)" ::: "memory");
        }
    }
    __syncthreads();
}


constexpr int NB = 32, SEQ = 2048, T = NB * SEQ, D = 1024, IN_COLS = 1984, PROJ_LD = 2048;
constexpr int NE = 32, TOPK = 4, HALF_T = T / 2, HALF_A = HALF_T * TOPK;
constexpr int ROWS_HALF = HALF_A + NE * 256, TILES_MAX = ROWS_HALF / 256;
constexpr float NORM_EPS = 1e-5f, LOG2E = 1.4426950408889634f;
constexpr int NWAVES = 8, NTHREADS = 512;

constexpr size_t KiB = 1024, MiB = 1u << 20;
constexpr size_t WS_CTL = 0, CTL_ZERO_BYTES = 64 * KiB;
constexpr size_t WS_ROPE = 1 * MiB;
constexpr size_t WS_BIAS = 1 * MiB + 512 * KiB;
constexpr size_t WS_LAM = 1 * MiB + 768 * KiB;
constexpr size_t WS_RINV = 2 * MiB;
constexpr size_t WS_EIDX = 3 * MiB, WS_GATE = 4 * MiB, WS_LRANK = 5 * MiB;
constexpr size_t WS_HIST = 6 * MiB;
constexpr size_t WS_ROWA = 7 * MiB, WS_ROWG = 9 * MiB;
constexpr size_t WS_TINFO = 11 * MiB;
constexpr size_t WS_WRH = 12 * MiB, WS_WRL = 12 * MiB + 64 * KiB;
constexpr size_t WS_WUQ = 13 * MiB, WS_WUKV = 13 * MiB + 512 * KiB;
constexpr size_t WS_WIN = 16 * MiB, WS_WO = 20 * MiB;
constexpr size_t WS_WD = 24 * MiB, WS_WGU = 88 * MiB;
constexpr size_t WS_XB = 216 * MiB;
constexpr size_t WS_PROJ = 344 * MiB, WS_QM = 600 * MiB, WS_KV = 696 * MiB, WS_MIXED = 824 * MiB, WS_CQN = 952 * MiB, WS_CKVN = 984 * MiB, WS_KPE = 1000 * MiB;
constexpr size_t WS_ACT = 344 * MiB, WS_Y4A = 616 * MiB, WS_Y4B = 88 * MiB;
constexpr size_t WS_END = 1008 * MiB;
static_assert(WS_ACT + (size_t)ROWS_HALF * 2048 <= WS_Y4A && WS_Y4A + (size_t)HALF_A * 2048 <= WS_END && WS_Y4B + (size_t)HALF_A * 2048 <= WS_PROJ, "ws map");

constexpr int SCRATCH_BYTES = 135168;
constexpr int MISC_OFF = SCRATCH_BYTES;
constexpr int LDS_BYTES = SCRATCH_BYTES + 1024;
static_assert(att::ATT_LDS <= SCRATCH_BYTES && pg8::STAGE_BYTES <= SCRATCH_BYTES, "LDS map");

#define GAS __attribute__((address_space(1)))
typedef unsigned short bf16;
typedef float f32x4 __attribute__((ext_vector_type(4)));
typedef float f32x2 __attribute__((ext_vector_type(2)));
typedef unsigned u32x4 __attribute__((ext_vector_type(4)));
typedef unsigned u32x2 __attribute__((ext_vector_type(2)));
typedef short bf16x8 __attribute__((ext_vector_type(8)));
typedef float f32x16 __attribute__((ext_vector_type(16)));
#define LDS_WAIT() asm volatile("s_waitcnt lgkmcnt(0)" ::: "memory")
#define VM_WAIT() asm volatile("s_waitcnt vmcnt(0)" ::: "memory")
__device__ __forceinline__ unsigned pk2(float lo, float hi) { return pg8::cvt_pk_bf16(lo, hi); }
__device__ __forceinline__ float bf2f(unsigned short v) { return __uint_as_float(((unsigned)v) << 16); }
__device__ __forceinline__ float wave_sum(float v) {
#pragma unroll
    for (int o = 1; o < 64; o <<= 1) v += __shfl_xor(v, o);
    return v;
}

struct Args {
    const float* in[22]; float* out; unsigned char* ws; int ph_lo, ph_hi;
};

template <class RowMap>
__device__ __forceinline__ void transpose_item(const float* W, int K, int N, bf16* WT, LAS float* scr, int item, int lane, const float* kscale, RowMap rm) {
    const int nblk = N / 32, kb = item / nblk, nb = item % nblk, k0 = 64 * kb, n0 = 32 * nb;
    float v[32];
#pragma unroll
    for (int i = 0; i < 32; ++i) v[i] = W[(size_t)(k0 + 2 * i + (lane >> 5)) * N + n0 + (lane & 31)];
    if (kscale) {
#pragma unroll
        for (int i = 0; i < 32; ++i) v[i] *= kscale[k0 + 2 * i + (lane >> 5)];
    }
#pragma unroll
    for (int i = 0; i < 32; ++i) scr[(2 * i + (lane >> 5)) * 33 + (lane & 31)] = v[i];
    LDS_WAIT(); asm volatile("" ::: "memory");
    const int c = lane & 7;
#pragma unroll
    for (int j = 0; j < 4; ++j) { const int n = (lane >> 3) + 8 * j; const LAS float* s = scr + (8 * c) * 33 + n;
        u32x4 o; o.x = pk2(s[0 * 33], s[1 * 33]); o.y = pk2(s[2 * 33], s[3 * 33]); o.z = pk2(s[4 * 33], s[5 * 33]); o.w = pk2(s[6 * 33], s[7 * 33]);
        *(u32x4*)(WT + (size_t)rm(n0 + n) * K + k0 + 8 * c) = o; }
    LDS_WAIT(); asm volatile("" ::: "memory");
}
struct RmId { __device__ __forceinline__ int operator()(int n) const { return n; } };
struct RmGu { __device__ __forceinline__ int operator()(int n) const { const int up = n >> 10, j = n & 1023; return 256 * (j >> 7) + 128 * up + (j & 127); } };

__device__ __forceinline__ void rms_row_to_bf16(const float* xrow, const float* g, bf16* orow, int lane) {
    const f32x4* xr = (const f32x4*)xrow + lane; const f32x4* gr = (const f32x4*)g + lane;
    f32x4 v[4]; float s = 0.f;
#pragma unroll
    for (int j = 0; j < 4; ++j) { v[j] = xr[64 * j]; s += (v[j].x * v[j].x + v[j].y * v[j].y) + (v[j].z * v[j].z + v[j].w * v[j].w); }
    const float r = 1.f / sqrtf(wave_sum(s) * (1.f / D) + NORM_EPS);
    u32x2* o8 = (u32x2*)orow + lane;
#pragma unroll
    for (int j = 0; j < 4; ++j) { const f32x4 gg = gr[64 * j]; u32x2 w; w.x = pk2(v[j].x * r * gg.x, v[j].y * r * gg.y); w.y = pk2(v[j].z * r * gg.z, v[j].w * r * gg.w); o8[64 * j] = w; }
}
__device__ __forceinline__ int t5_bucket(int rel) {
    const int n = rel < 0 ? -rel : rel; int b;
    if (n < 8) b = n; else { const int n2 = n * n; b = n2 >= 8192 ? 15 : n2 >= 4096 ? 14 : n2 >= 2048 ? 13 : n2 >= 1024 ? 12 : n2 >= 512 ? 11 : n2 >= 256 ? 10 : n2 >= 128 ? 9 : 8; }
    return (rel > 0 ? 16 : 0) + b;
}
__device__ __forceinline__ void p0_prologue(const Args& a, LAS unsigned char* lds, int vcu, int G, int wave, int lane) {
    unsigned char* ws = a.ws;
    LAS float* scr = (LAS float*)(lds + wave * 16384);
    const int gw = vcu * NWAVES + wave, NGW = G * NWAVES;
    const float* ffn_g = a.in[14];
    constexpr int I_IN = 16 * 62, I_UQ = 4 * 24, I_UKV = 2 * 32, I_O = 16 * 32, I_GU1 = 16 * 64, I_GU = NE * I_GU1, I_D1 = 16 * 32, I_D = NE * I_D1;
    constexpr int NITEMS = I_IN + I_UQ + I_UKV + I_O + I_GU + I_D;
    for (int it = gw; it < NITEMS; it += NGW) {
        int r = it;
        if (r < I_GU) { const int e = r / I_GU1; transpose_item(a.in[17] + (size_t)e * 1024 * 2048, 1024, 2048, (bf16*)(ws + WS_WGU) + (size_t)e * 2048 * 1024, scr, r % I_GU1, lane, ffn_g, RmGu{}); continue; } r -= I_GU;
        if (r < I_D) { const int e = r / I_D1; transpose_item(a.in[19] + (size_t)e * 1024 * 1024, 1024, 1024, (bf16*)(ws + WS_WD) + (size_t)e * 1024 * 1024, scr, r % I_D1, lane, nullptr, RmId{}); continue; } r -= I_D;
        if (r < I_IN) { transpose_item(a.in[3], 1024, IN_COLS, (bf16*)(ws + WS_WIN), scr, r, lane, nullptr, RmId{}); continue; } r -= I_IN;
        if (r < I_O) { transpose_item(a.in[13], 1024, 1024, (bf16*)(ws + WS_WO), scr, r, lane, nullptr, RmId{}); continue; } r -= I_O;
        if (r < I_UQ) { transpose_item(a.in[10], 256, 768, (bf16*)(ws + WS_WUQ), scr, r, lane, nullptr, RmId{}); continue; } r -= I_UQ;
        transpose_item(a.in[12], 128, 1024, (bf16*)(ws + WS_WUKV), scr, r, lane, nullptr, RmId{});
    }
    const int gt = gw * 64 + lane, NGT = NGW * 64;
    for (int i = gt; i < 64 * 1024 / 8; i += NGT) *((u32x4*)((bf16*)(ws + WS_WIN) + (size_t)IN_COLS * 1024) + i) = (u32x4){0u, 0u, 0u, 0u};
    for (int i = gt; i < 1024 * NE; i += NGT) { const int k = i >> 5, e = i & 31; const float w = a.in[15][i] * ffn_g[k];
        const unsigned h = pk2(w, 0.f) & 0xffffu; const float wl = w - bf2f((unsigned short)h);
        ((bf16*)(ws + WS_WRH))[e * 1024 + k] = (bf16)h; ((bf16*)(ws + WS_WRL))[e * 1024 + k] = (bf16)(pk2(wl, 0.f) & 0xffffu); }
    for (int i = gt; i < SEQ * 32; i += NGT) { const int pos = i >> 5, fi = i & 31;
        const float inv = (float)::exp2(-(double)fi * (13.287712379549449 / 32.0)); const float ang = (float)pos * inv;
        double tt = (double)ang * 0.15915494309189535; tt -= __builtin_rint(tt); const double rr = tt * 6.283185307179586, r2 = rr * rr;
        double cs_ = 1.0, sn = rr, term_c = 1.0, term_s = rr;
#pragma unroll
        for (int k = 1; k <= 13; ++k) { term_c *= -r2 / (double)((2 * k - 1) * (2 * k)); term_s *= -r2 / (double)((2 * k) * (2 * k + 1)); cs_ += term_c; sn += term_s; }
        ((f32x2*)(ws + WS_ROPE))[i] = (f32x2){(float)cs_, (float)sn}; }
    for (int i = gt; i < 8 * 4096; i += NGT) { const int m = i >> 12, d = i & 4095; ((float*)(ws + WS_BIAS))[i] = d < 4095 ? a.in[1][t5_bucket(d - 2047) * 8 + m] * LOG2E : 0.f; }
    if (gw == 0) { const float s1 = wave_sum(a.in[4][lane] * a.in[5][lane]), s2 = wave_sum(a.in[6][lane] * a.in[7][lane]);
        if (lane == 0) *(float*)(ws + WS_LAM) = __expf(s1) - __expf(s2) + 0.2f; }
    for (int m = gw; m < T; m += 2 * NGW) {
        const int m2 = m + NGW < T ? m + NGW : m;
        const f32x4* xr0 = (const f32x4*)(a.in[0] + (size_t)m * D) + lane; const f32x4* xr1 = (const f32x4*)(a.in[0] + (size_t)m2 * D) + lane; const f32x4* gr = (const f32x4*)a.in[2] + lane;
        f32x4 v0[4], v1[4]; float s0 = 0.f, s1 = 0.f;
#pragma unroll
        for (int j = 0; j < 4; ++j) { v0[j] = xr0[64 * j]; v1[j] = xr1[64 * j]; }
#pragma unroll
        for (int j = 0; j < 4; ++j) { s0 += (v0[j].x * v0[j].x + v0[j].y * v0[j].y) + (v0[j].z * v0[j].z + v0[j].w * v0[j].w); s1 += (v1[j].x * v1[j].x + v1[j].y * v1[j].y) + (v1[j].z * v1[j].z + v1[j].w * v1[j].w); }
        const float r0 = 1.f / sqrtf(wave_sum(s0) * (1.f / D) + NORM_EPS), r1 = 1.f / sqrtf(wave_sum(s1) * (1.f / D) + NORM_EPS);
        u32x2* o0 = (u32x2*)((bf16*)(ws + WS_XB) + (size_t)m * D) + lane; u32x2* o1 = (u32x2*)((bf16*)(ws + WS_XB) + (size_t)m2 * D) + lane;
#pragma unroll
        for (int j = 0; j < 4; ++j) { const f32x4 gg = gr[64 * j]; u32x2 w;
            w.x = pk2(v0[j].x * r0 * gg.x, v0[j].y * r0 * gg.y); w.y = pk2(v0[j].z * r0 * gg.z, v0[j].w * r0 * gg.w); o0[64 * j] = w;
            w.x = pk2(v1[j].x * r1 * gg.x, v1[j].y * r1 * gg.y); w.y = pk2(v1[j].z * r1 * gg.z, v1[j].w * r1 * gg.w); o1[64 * j] = w; }
    }
}

__device__ __forceinline__ void p1b_latent(const Args& a, int vcu, int G, int wave, int lane) {
    unsigned char* ws = a.ws; const int gw = vcu * NWAVES + wave, NGW = G * NWAVES;
    const float* gq = a.in[9]; const float* gkv = a.in[11];
    float gl[8];
#pragma unroll
    for (int j = 0; j < 8; ++j) gl[j] = lane < 32 ? gq[8 * lane + j] : (lane < 48 ? gkv[8 * (lane - 32) + j] : 1.f);
    constexpr int R = 4;
    for (int t0 = gw; t0 < T; t0 += R * NGW) {
        bf16x8 v[R];
#pragma unroll
        for (int q = 0; q < R; ++q) { const int t = t0 + q * NGW; v[q] = (bf16x8){0, 0, 0, 0, 0, 0, 0, 0};
            if (lane < 56 && t < T) v[q] = *(const bf16x8*)((const bf16*)(ws + WS_PROJ) + (size_t)t * PROJ_LD + 1536 + 8 * lane); }
#pragma unroll
        for (int q = 0; q < R; ++q) { const int t = t0 + q * NGW; if (t >= T) break;
            float f[8], sq = 0.f;
#pragma unroll
            for (int j = 0; j < 8; ++j) { f[j] = bf2f((unsigned short)v[q][j]); sq += f[j] * f[j]; }
            const float sq_q = wave_sum(lane < 32 ? sq : 0.f), sq_kv = wave_sum((lane >= 32 && lane < 48) ? sq : 0.f);
            const float rq = 1.f / sqrtf(sq_q * (1.f / 256.f) + NORM_EPS), rkv = 1.f / sqrtf(sq_kv * (1.f / 128.f) + NORM_EPS);
            float part[8];
#pragma unroll
            for (int j = 0; j < 8; ++j) part[j] = __shfl_xor(f[j], 4);
            float o[8];
            if (lane < 48) { const float rr = lane < 32 ? rq : rkv;
#pragma unroll
                for (int j = 0; j < 8; ++j) o[j] = f[j] * rr * gl[j];
            } else {
                const int aa = lane - 48; const f32x2* cp = (const f32x2*)(ws + WS_ROPE) + (size_t)(t & (SEQ - 1)) * 32 + 8 * (aa & 3);
#pragma unroll
                for (int j = 0; j < 8; ++j) { const f32x2 c = lane < 56 ? cp[j] : (f32x2){0.f, 0.f};
                    o[j] = (aa < 4) ? (f[j] * c.x - part[j] * c.y) : (part[j] * c.y + f[j] * c.x); }
            }
            u32x4 w; w.x = pk2(o[0], o[1]); w.y = pk2(o[2], o[3]); w.z = pk2(o[4], o[5]); w.w = pk2(o[6], o[7]);
            if (lane < 32) *(u32x4*)((bf16*)(ws + WS_CQN) + (size_t)t * 256 + 8 * lane) = w;
            else if (lane < 48) *(u32x4*)((bf16*)(ws + WS_CKVN) + (size_t)t * 128 + 8 * (lane - 32)) = w;
            else if (lane < 56) *(u32x4*)((bf16*)(ws + WS_KPE) + (size_t)t * 64 + 8 * (lane - 48)) = w;
        }
    }
}

template <int WHICH  >
__device__ __forceinline__ void p2_attention(const Args& a, LAS unsigned char* lds, int vcu, int G) {
    unsigned char* ws = a.ws;
    const int tid = threadIdx.x, wid = tid >> 6, lane = tid & 63, r32 = lane & 31, hi = lane >> 5;
    const bf16* proj = (const bf16*)(ws + WS_PROJ); bf16* mixed = (bf16*)(ws + WS_MIXED);
    const float lam = *(const float*)(ws + WS_LAM);
    if constexpr (WHICH & 1) {
        const float C = 0.125f * LOG2E;
        float sg[4];
#pragma unroll
        for (int d0 = 0; d0 < 4; ++d0) sg[d0] = a.in[8][32 * d0 + r32] * 0.8f;
        LAS unsigned* stash = (LAS unsigned*)(lds + att::OFF_STASH) + (wid * 32) * 64 + lane;
        for (int it = 0;; ++it) {
            const int u = (it >> 1) * G + vcu, j = it & 1; if (u >= NB * 4 * 8) break;
            const int qb = u & 7, h = (u >> 3) & 3, b = u >> 5, q0 = qb * 256, mp = 2 * h + j;
            { const float* src = (const float*)(ws + WS_BIAS) + mp * 4096; LAS float* lut = (LAS float*)(lds + att::OFF_LUT);
#pragma unroll
              for (int i = 0; i < 8; ++i) lut[tid + 512 * i] = src[tid + 512 * i]; }
            const bf16* base = proj + (size_t)b * SEQ * PROJ_LD;
            f32x16 o[4];
            att::attn_unit<1>(base + (size_t)q0 * PROJ_LD + 64 * mp, PROJ_LD, base + 512 + 64 * mp, PROJ_LD, nullptr, base + 1024 + 128 * h, PROJ_LD, SEQ,
                                 (LAS char*)lds, C, nullptr, q0, o);
            if (j == 0) {
#pragma unroll
                for (int d0 = 0; d0 < 4; ++d0)
#pragma unroll
                    for (int r = 0; r < 16; r += 2) stash[(d0 * 8 + (r >> 1)) * 64] = pk2(o[d0][r], o[d0][r + 1]);
            } else {
                bf16* orow = mixed + (size_t)(b * SEQ + q0 + wid * 32) * D + 128 * h + r32;
#pragma unroll
                for (int rp = 0; rp < 8; ++rp) {
                    float v[2][4], ss[2] = {0.f, 0.f};
#pragma unroll
                    for (int d0 = 0; d0 < 4; ++d0) { const unsigned w = stash[(d0 * 8 + rp) * 64];
                        v[0][d0] = bf2f((unsigned short)(w & 0xffffu)) - lam * o[d0][2 * rp]; v[1][d0] = bf2f((unsigned short)(w >> 16)) - lam * o[d0][2 * rp + 1];
                        ss[0] += v[0][d0] * v[0][d0]; ss[1] += v[1][d0] * v[1][d0]; }
#pragma unroll
                    for (int q = 0; q < 2; ++q) {
#pragma unroll
                        for (int sft = 1; sft < 32; sft <<= 1) ss[q] += __shfl_xor(ss[q], sft);
                        const float rn = 1.f / sqrtf(ss[q] * (1.f / 128.f) + NORM_EPS);
                        bf16* op = orow + (size_t)att::crow(2 * rp + q, hi) * D;
#pragma unroll
                        for (int d0 = 0; d0 < 4; ++d0) op[32 * d0] = (bf16)(pk2(v[q][d0] * rn * sg[d0], 0.f) & 0xffffu);
                    }
                }
            }
        }
    }
    if constexpr (WHICH & 2) {
        const float C = 0.07216878364870322f * LOG2E;
        for (int it = 0;; ++it) {
            const int u = it * G + vcu; if (u >= NB * 4 * 8) break;
            const int qb = u & 7, h = (u >> 3) & 3, b = u >> 5, q0 = qb * 256;
            const bf16* qm = (const bf16*)(ws + WS_QM) + (size_t)(b * SEQ + q0) * 768 + 192 * h;
            const bf16* kv = (const bf16*)(ws + WS_KV) + (size_t)b * SEQ * 1024 + 256 * h;
            const bf16* kpe = (const bf16*)(ws + WS_KPE) + (size_t)b * SEQ * 64;
            f32x16 o[4];
            att::attn_unit<0>(qm, 768, kv, 1024, kpe, kv + 128, 1024, SEQ, (LAS char*)lds, C, (const att::f32x2*)(ws + WS_ROPE), q0, o);
            bf16* orow = mixed + (size_t)(b * SEQ + q0 + wid * 32) * D + 512 + 128 * h + r32;
#pragma unroll
            for (int r = 0; r < 16; ++r) { bf16* op = orow + (size_t)att::crow(r, hi) * D;
#pragma unroll
                for (int d0 = 0; d0 < 4; ++d0) op[32 * d0] = (bf16)(pk2(o[d0][r], 0.f) & 0xffffu); }
        }
    }
}

constexpr int WR_PITCH = 2064;
__device__ __forceinline__ void p3b_router(const Args& a, LAS unsigned char* lds, int G) {
    unsigned char* ws = a.ws;
    const int tid = threadIdx.x, wid = tid >> 6, lane = tid & 63, r32 = lane & 31, hi = lane >> 5;
    LAS unsigned char* wrh = lds; LAS unsigned char* wrl = lds + 32 * WR_PITCH; LAS unsigned* cnt = (LAS unsigned*)(lds + 64 * WR_PITCH);
    for (int i = tid; i < 2 * 32 * 128; i += NTHREADS) { const int tb = i >> 12, e = (i >> 7) & 31, c = i & 127;
        *(LAS u32x4*)(lds + (tb * 32 + e) * WR_PITCH + c * 16) = *((const u32x4*)(ws + (tb ? WS_WRL : WS_WRH)) + e * 128 + c); }
    const float* x1 = a.out; bf16* xb = (bf16*)(ws + WS_XB);
    for (int c = blockIdx.x; c < T / 256; c += G) {
        if (tid < 32) cnt[tid] = 0u;
        __syncthreads();
        const int t = c * 256 + wid * 32 + r32;
        const float* xr = x1 + (size_t)t * D + 64 * hi; bf16* xo = xb + (size_t)t * D + 64 * hi;
        f32x16 acc = f32x16{}; float ss = 0.f;
        for (int sg = 0; sg < 8; ++sg) {
            f32x4 v[16];
#pragma unroll
            for (int q = 0; q < 16; ++q) v[q] = *(const f32x4*)(xr + 128 * sg + 4 * q);
#pragma unroll
            for (int j = 0; j < 8; ++j) {
                const f32x4 x0 = v[2 * j], x1v = v[2 * j + 1];
                ss += (x0.x * x0.x + x0.y * x0.y) + (x0.z * x0.z + x0.w * x0.w) + (x1v.x * x1v.x + x1v.y * x1v.y) + (x1v.z * x1v.z + x1v.w * x1v.w);
                u32x4 hw; hw.x = pk2(x0.x, x0.y); hw.y = pk2(x0.z, x0.w); hw.z = pk2(x1v.x, x1v.y); hw.w = pk2(x1v.z, x1v.w);
                u32x4 lw;
                lw.x = pk2(x0.x - __uint_as_float(hw.x << 16), x0.y - __uint_as_float(hw.x & 0xffff0000u)); lw.y = pk2(x0.z - __uint_as_float(hw.y << 16), x0.w - __uint_as_float(hw.y & 0xffff0000u));
                lw.z = pk2(x1v.x - __uint_as_float(hw.z << 16), x1v.y - __uint_as_float(hw.z & 0xffff0000u)); lw.w = pk2(x1v.z - __uint_as_float(hw.w << 16), x1v.w - __uint_as_float(hw.w & 0xffff0000u));
                *(u32x4*)(xo + 128 * sg + 8 * j) = hw;
                const int kb = (128 * sg + 64 * hi + 8 * j) * 2;
                const bf16x8 wh = *(const LAS bf16x8*)(wrh + r32 * WR_PITCH + kb), wl = *(const LAS bf16x8*)(wrl + r32 * WR_PITCH + kb);
                const bf16x8 xh = __builtin_bit_cast(bf16x8, hw), xl = __builtin_bit_cast(bf16x8, lw);
                acc = __builtin_amdgcn_mfma_f32_32x32x16_bf16(wh, xh, acc, 0, 0, 0);
                acc = __builtin_amdgcn_mfma_f32_32x32x16_bf16(wh, xl, acc, 0, 0, 0);
                acc = __builtin_amdgcn_mfma_f32_32x32x16_bf16(wl, xh, acc, 0, 0, 0);
            }
        }
        ss += __shfl_xor(ss, 32);
        const float rinv = 1.f / sqrtf(ss * (1.f / D) + NORM_EPS);
        if (hi == 0) ((float*)(ws + WS_RINV))[t] = rinv;
        float lg[16];
#pragma unroll
        for (int r = 0; r < 16; ++r) lg[r] = acc[r] * rinv + a.in[16][att::crow(r, hi)];
        float tv[4]; int ti[4];
#pragma unroll
        for (int k = 0; k < 4; ++k) {
            float bv = lg[0]; int bi = att::crow(0, hi);
#pragma unroll
            for (int r = 1; r < 16; ++r) { const int e = att::crow(r, hi); if (lg[r] > bv) { bv = lg[r]; bi = e; } }
            const float ov = __shfl_xor(bv, 32); const int oi = __shfl_xor(bi, 32);
            const bool mine = (bv > ov) || (bv == ov && bi < oi);
            tv[k] = mine ? bv : ov; ti[k] = mine ? bi : oi;
#pragma unroll
            for (int r = 0; r < 16; ++r) if (att::crow(r, hi) == ti[k]) lg[r] = -3.0e38f;
        }
        const float e1 = __expf(tv[1] - tv[0]), e2 = __expf(tv[2] - tv[0]), e3 = __expf(tv[3] - tv[0]), rs = 1.f / (1.f + e1 + e2 + e3);
        if (hi == 0) {
            int lr[4];
#pragma unroll
            for (int k = 0; k < 4; ++k) lr[k] = (int)__hip_atomic_fetch_add(cnt + ti[k], 1u, __ATOMIC_RELAXED, __HIP_MEMORY_SCOPE_WORKGROUP);
            *((int4*)(ws + WS_EIDX) + t) = make_int4(ti[0], ti[1], ti[2], ti[3]);
            *((f32x4*)(ws + WS_GATE) + t) = (f32x4){rs, e1 * rs, e2 * rs, e3 * rs};
            *((int4*)(ws + WS_LRANK) + t) = make_int4(lr[0], lr[1], lr[2], lr[3]);
        }
        __syncthreads();
        if (tid < 32) ((int*)(ws + WS_HIST))[c * 32 + tid] = (int)cnt[tid];
        __syncthreads();
    }
}

__device__ __forceinline__ void p4_scatter(const Args& a, LAS unsigned char* lds, int G) {
    unsigned char* ws = a.ws; const int tid = threadIdx.x;
    LAS int* hist = (LAS int*)lds;
    LAS int* cntE = hist + 256 * 32;
    LAS int* pst = cntE + 64;
    for (int i = tid; i < 256 * 32; i += NTHREADS) hist[i] = ((const int*)(ws + WS_HIST))[i];
    __syncthreads();
    if (tid < 64) { const int hf = tid >> 5, e = tid & 31; int run = 0;
        for (int c = 0; c < 128; ++c) { const int v = hist[(hf * 128 + c) * 32 + e]; hist[(hf * 128 + c) * 32 + e] = run; run += v; }
        cntE[tid] = run; }
    __syncthreads();
    if (tid < 64) { const int hf = tid >> 5, e = tid & 31; int s = 0;
        for (int q = 0; q < e; ++q) s += (cntE[hf * 32 + q] + 255) & ~255;
        pst[tid] = s; }
    __syncthreads();
    int* rowa = (int*)(ws + WS_ROWA); float* rowg = (float*)(ws + WS_ROWG);
    for (int c = blockIdx.x; c < T / 256; c += G) { const int hf = c >> 7;
        for (int i = tid; i < 1024; i += NTHREADS) { const int asg = c * 1024 + i; const int e = ((const int*)(ws + WS_EIDX))[asg];
            const int p = pst[hf * 32 + e] + hist[c * 32 + e] + ((const int*)(ws + WS_LRANK))[asg];
            rowa[hf * ROWS_HALF + p] = asg; rowg[hf * ROWS_HALF + p] = ((const float*)(ws + WS_GATE))[asg]; } }
    if (blockIdx.x == 0 && tid < 64) { const int hf = tid >> 5, e = tid & 31; const int n = cntE[tid], st = pst[tid], pad = (n + 255) & ~255;
        for (int p = st + n; p < st + pad; ++p) { rowa[hf * ROWS_HALF + p] = -1; rowg[hf * ROWS_HALF + p] = 0.f; }
        int* tinfo = (int*)(ws + WS_TINFO);
        for (int tt = st >> 8; tt < (st + pad) >> 8; ++tt) tinfo[hf * 1024 + tt] = e;
        if (e == 31) tinfo[2048 + hf] = (st + pad) >> 8; }
}

struct MoeOrder {
    const int* tinfo; const int* rowa; int ntiles, nN, lgN, G, c;
    __device__ __forceinline__ bool next(int i, pg8::Unit& u) const {
        const int L = i * G + c; if (L >= ntiles * nN) return false;
        const int tile = L >> lgN, pn = L & (nN - 1); const int e = tinfo[tile]; u.pm = tile; u.pn = e * nN + pn; return true;
    }
    __device__ __forceinline__ int gather_row(const pg8::Unit& u, int i) const { const int as = rowa[u.pm * 256 + i]; return as < 0 ? 0 : (as >> 2); }
};
struct EpiSwiglu {
    static constexpr bool PERM = true;
    bf16* act; const float* rinv; const int* rowa; const float* bgu;
    __device__ __forceinline__ void operator()(const pg8::f32x4 (&acc)[2][2][4][2], const pg8::Unit& u, int wr, int wc, int fr, int fq) const {
        const int e = u.pn >> 3, pn = u.pn & 7, col0 = 128 * pn + 32 * wc + 8 * fq;
        const float* bp = bgu + (size_t)e * 2048 + col0;
        f32x4 bg[2], bu[2];
#pragma unroll
        for (int n = 0; n < 2; ++n) { bg[n] = *(const f32x4*)(bp + 4 * n); bu[n] = *(const f32x4*)(bp + 1024 + 4 * n); }
#pragma unroll
        for (int ai = 0; ai < 2; ++ai)
#pragma unroll
            for (int m = 0; m < 4; ++m) {
                const int p = u.pm * 256 + ai * 128 + wr * 64 + m * 16 + fr; const int as = rowa[p]; const float ri = rinv[as < 0 ? 0 : (as >> 2)];
                float o[8];
#pragma unroll
                for (int n = 0; n < 2; ++n)
#pragma unroll
                    for (int q = 0; q < 4; ++q) {
                        float g = fminf(acc[ai][0][m][n][q] * ri + bg[n][q], 7.f); const float up = fminf(fmaxf(acc[ai][1][m][n][q] * ri + bu[n][q], -7.f), 7.f);
                        const float sg = __builtin_amdgcn_rcpf(1.f + __builtin_amdgcn_exp2f(g * (-1.702f * LOG2E)));
                        o[4 * n + q] = (up + 1.f) * (g * sg); }
                u32x4 w; w.x = pk2(o[0], o[1]); w.y = pk2(o[2], o[3]); w.z = pk2(o[4], o[5]); w.w = pk2(o[6], o[7]);
                *(u32x4*)(act + (size_t)p * 1024 + col0) = w; }
    }
};
struct EpiDown {
    static constexpr bool PERM = true;
    bf16* y4; const int* rowa; const float* rowg; const float* bd; int slot0;
    __device__ __forceinline__ void operator()(const pg8::f32x4 (&acc)[2][2][4][2], const pg8::Unit& u, int wr, int wc, int fr, int fq) const {
        const int e = u.pn >> 2, pn = u.pn & 3, col0 = 256 * pn + 32 * wc + 8 * fq;
        const float* bp = bd + (size_t)e * 1024 + col0;
        f32x4 bv[2][2];
#pragma unroll
        for (int bj = 0; bj < 2; ++bj)
#pragma unroll
            for (int n = 0; n < 2; ++n) bv[bj][n] = *(const f32x4*)(bp + 128 * bj + 4 * n);
#pragma unroll
        for (int ai = 0; ai < 2; ++ai)
#pragma unroll
            for (int m = 0; m < 4; ++m) {
                const int p = u.pm * 256 + ai * 128 + wr * 64 + m * 16 + fr; const int as = rowa[p];
                if (as >= 0) { const float gt = rowg[p]; bf16* yr = y4 + (size_t)(as - slot0) * 1024 + col0;
#pragma unroll
                    for (int bj = 0; bj < 2; ++bj) { const f32x4 v0 = (acc[ai][bj][m][0] + bv[bj][0]) * gt, v1 = (acc[ai][bj][m][1] + bv[bj][1]) * gt;
                        u32x4 w; w.x = pk2(v0[0], v0[1]); w.y = pk2(v0[2], v0[3]); w.z = pk2(v1[0], v1[1]); w.w = pk2(v1[2], v1[3]);
                        *(u32x4*)(yr + 128 * bj) = w; } } }
    }
};

__device__ __forceinline__ void p7_final(const Args& a, int vcu, int G, int wave, int lane) {
    unsigned char* ws = a.ws; const int gw = vcu * NWAVES + wave, NGW = G * NWAVES;
    const f32x4* gr = (const f32x4*)a.in[21] + lane;
    for (int t = gw; t < T; t += NGW) {
        f32x4* xr = (f32x4*)(a.out + (size_t)t * D) + lane;
        const u32x2* yr = (const u32x2*)((t < HALF_T ? (const bf16*)(ws + WS_Y4A) + (size_t)t * 4 * D : (const bf16*)(ws + WS_Y4B) + (size_t)(t - HALF_T) * 4 * D)) + lane;
        f32x4 v[4]; float s = 0.f;
#pragma unroll
        for (int j = 0; j < 4; ++j) { v[j] = xr[64 * j];
#pragma unroll
            for (int k = 0; k < 4; ++k) { const u32x2 w = yr[k * 256 + 64 * j];
                v[j].x += __uint_as_float(w.x << 16); v[j].y += __uint_as_float(w.x & 0xffff0000u); v[j].z += __uint_as_float(w.y << 16); v[j].w += __uint_as_float(w.y & 0xffff0000u); }
            s += (v[j].x * v[j].x + v[j].y * v[j].y) + (v[j].z * v[j].z + v[j].w * v[j].w); }
        const float r = 1.f / sqrtf(wave_sum(s) * (1.f / D) + NORM_EPS);
#pragma unroll
        for (int j = 0; j < 4; ++j) { const f32x4 gg = gr[64 * j]; xr[64 * j] = (f32x4){v[j].x * r * gg.x, v[j].y * r * gg.y, v[j].z * r * gg.z, v[j].w * r * gg.w}; }
    }
}

constexpr int N_PHASES = 13;
__global__ void __launch_bounds__(NTHREADS, 2) fwd(Args args) {
    extern __shared__ __attribute__((aligned(16))) unsigned char lds_raw[];
    LAS unsigned char* lds = (LAS unsigned char*)lds_raw;
    volatile LAS unsigned* MISC = (volatile LAS unsigned*)(lds + MISC_OFF);
    const int tid = threadIdx.x, lane = tid & 63, wave = __builtin_amdgcn_readfirstlane(tid >> 6);
    const int G = gridDim.x; const int bx = blockIdx.x; const int vcu = (G % 8 == 0) ? (bx % 8) * (G / 8) + bx / 8 : bx;
    unsigned char* ws = args.ws;
    for (int u = tid; u < (LDS_BYTES - MISC_OFF) / 4; u += NTHREADS) MISC[u] = 0u;
    __syncthreads();
    const int lo = args.ph_lo, hi = args.ph_hi;
    const bool use_bar = (hi - lo) > 1;
    XcdBarrier bar; bar.bar = (unsigned*)(ws + WS_CTL); bar.x = 0; bar.st = nullptr;
    if (use_bar) bar = xcd_barrier_post((unsigned*)(ws + WS_CTL), MISC + 8);
#ifdef ONLY_PHASE
#define IN(k) ((k) == ONLY_PHASE)
#else
#define IN(k) (lo <= (k) && (k) < hi)
#endif
#define SEAM(k) do { if (IN(k) && IN((k) + 1)) xcd_barrier(bar); } while (0)

    if (IN(0)) { p0_prologue(args, lds, vcu, G, wave, lane); }
    SEAM(0);
    if (IN(1)) {
        pg8::Gemm g{(const bf16*)(ws + WS_XB), (const bf16*)(ws + WS_WIN), T, PROJ_LD, D}; pg8::StaticOrder S; S.init(T, PROJ_LD, G, bx);
        pg8::EpiBf16 E{(bf16*)(ws + WS_PROJ), PROJ_LD};
        pg8::gemm_phase<pg8::EpiBf16, pg8::StaticOrder, true, false>(lds, g, S, E);
    }
    SEAM(1);
    if (IN(2)) { p1b_latent(args, vcu, G, wave, lane); }
    SEAM(2);
    if (IN(3)) {
        { pg8::Gemm g{(const bf16*)(ws + WS_CQN), (const bf16*)(ws + WS_WUQ), T, 768, 256}; pg8::StaticOrder S; S.init(T, 768, G, bx);
          pg8::EpiBf16 E{(bf16*)(ws + WS_QM), 768}; pg8::gemm_phase<pg8::EpiBf16, pg8::StaticOrder, true, false>(lds, g, S, E); }
        { pg8::Gemm g{(const bf16*)(ws + WS_CKVN), (const bf16*)(ws + WS_WUKV), T, 1024, 128}; pg8::StaticOrder S; S.init(T, 1024, G, bx);
          pg8::EpiBf16 E{(bf16*)(ws + WS_KV), 1024}; pg8::gemm_phase<pg8::EpiBf16, pg8::StaticOrder, true, false>(lds, g, S, E); }
    }
    SEAM(3);
    if (IN(4)) { p2_attention<3>(args, lds, vcu, G); }
    SEAM(4);
    if (IN(5)) {
        pg8::Gemm g{(const bf16*)(ws + WS_MIXED), (const bf16*)(ws + WS_WO), T, D, D}; pg8::StaticOrder S; S.init(T, D, G, bx);
        pg8::EpiResid E{args.in[0], args.out, D};
        pg8::gemm_phase<pg8::EpiResid, pg8::StaticOrder, true, false>(lds, g, S, E);
    }
    SEAM(5);
    if (IN(6)) { p3b_router(args, lds, G); }
    SEAM(6);
    if (IN(7)) { p4_scatter(args, lds, G); }
    SEAM(7);
#define MOE_HALF(PH, HF, Y4OFF) \
    if (IN(PH)) { \
        const int* tinfo = (const int*)(ws + WS_TINFO); MoeOrder S{tinfo + (HF) * 1024, (const int*)(ws + WS_ROWA) + (HF) * ROWS_HALF, tinfo[2048 + (HF)], 8, 3, G, bx}; \
        pg8::Gemm g{(const bf16*)(ws + WS_XB), (const bf16*)(ws + WS_WGU), 0, 2048, D}; \
        EpiSwiglu E{(bf16*)(ws + WS_ACT), (const float*)(ws + WS_RINV), (const int*)(ws + WS_ROWA) + (HF) * ROWS_HALF, args.in[18]}; \
        pg8::gemm_phase<EpiSwiglu, MoeOrder, true, true>(lds, g, S, E); \
    } \
    SEAM(PH); \
    if (IN((PH) + 1)) { \
        const int* tinfo = (const int*)(ws + WS_TINFO); MoeOrder S{tinfo + (HF) * 1024, (const int*)(ws + WS_ROWA) + (HF) * ROWS_HALF, tinfo[2048 + (HF)], 4, 2, G, bx}; \
        pg8::Gemm g{(const bf16*)(ws + WS_ACT), (const bf16*)(ws + WS_WD), 0, 1024, D}; \
        EpiDown E{(bf16*)(ws + (Y4OFF)), (const int*)(ws + WS_ROWA) + (HF) * ROWS_HALF, (const float*)(ws + WS_ROWG) + (HF) * ROWS_HALF, args.in[20], (HF) * HALF_A}; \
        pg8::gemm_phase<EpiDown, MoeOrder, true, false>(lds, g, S, E); \
    } \
    SEAM((PH) + 1);
    MOE_HALF(8, 0, WS_Y4A)
    MOE_HALF(10, 1, WS_Y4B)
    if (IN(12)) { p7_final(args, vcu, G, wave, lane); }
#ifdef PROBE_EXTRA
    if (IN(13)) { p2_attention<1>(args, lds, vcu, G); }
    if (IN(14)) { p2_attention<2>(args, lds, vcu, G); }
#endif
#undef IN
#undef SEAM
}

#ifndef MK_N_LAUNCHES
#define MK_N_LAUNCHES 1
#endif
extern "C" void kernel_launch(void* const* d_in, const int* in_sizes, int n_in, void* d_out, int out_size, void* d_ws, size_t ws_size, hipStream_t stream) {
    static int grid = 0;
    if (grid == 0) {
        if (n_in != 22 || in_sizes[0] != T * D || out_size != T * D || ws_size < WS_END) {
            fprintf(stderr, "kernel_launch: shape / workspace mismatch (n_in %d, in0 %d, out %d, ws %zu < %zu); nothing launched\n", n_in, n_in > 0 ? in_sizes[0] : -1, out_size, ws_size, (size_t)WS_END); grid = -1; return; }
        int dev = 0, cus = 0, per_cu = 0;
        if (hipGetDevice(&dev) != hipSuccess || hipDeviceGetAttribute(&cus, hipDeviceAttributeMultiprocessorCount, dev) != hipSuccess) { grid = -1; return; }
        if (hipFuncSetAttribute((const void*)fwd, hipFuncAttributeMaxDynamicSharedMemorySize, LDS_BYTES) != hipSuccess) { fprintf(stderr, "kernel_launch: hipFuncSetAttribute failed\n"); grid = -1; return; }
        if (hipOccupancyMaxActiveBlocksPerMultiprocessor(&per_cu, (const void*)fwd, NTHREADS, LDS_BYTES) != hipSuccess || per_cu < 1) { fprintf(stderr, "kernel_launch: occupancy query says %d\n", per_cu); }
        (void)hipGetLastError();
        grid = cus;
    }
    if (grid < 0) return;
    if (hipMemsetAsync((char*)d_ws + WS_CTL, 0, CTL_ZERO_BYTES, stream) != hipSuccess) return;
    Args a{};
    for (int i = 0; i < 22; ++i) a.in[i] = (const float*)d_in[i];
    a.out = (float*)d_out; a.ws = (unsigned char*)d_ws;
#if MK_N_LAUNCHES == 1
    a.ph_lo = 0; a.ph_hi = N_PHASES;
    hipLaunchKernelGGL(fwd, dim3(grid), dim3(NTHREADS), LDS_BYTES, stream, a);
#else
#ifndef PROBE_MASK
#define PROBE_MASK 0
#endif
    for (int p = 0; p < N_PHASES; ++p) { a.ph_lo = p; a.ph_hi = p + 1; hipLaunchKernelGGL(fwd, dim3(grid), dim3(NTHREADS), LDS_BYTES, stream, a);
        if ((PROBE_MASK >> p) & 1) hipLaunchKernelGGL(fwd, dim3(grid), dim3(NTHREADS), LDS_BYTES, stream, a);
#ifdef PROBE_EXTRA
        if (p == 4) { a.ph_lo = PROBE_EXTRA; a.ph_hi = PROBE_EXTRA + 1; hipLaunchKernelGGL(fwd, dim3(grid), dim3(NTHREADS), LDS_BYTES, stream, a); }
#endif
    }
#endif
}
```

```cpp
#include <hip/hip_runtime.h>
#include <cstdio>
#include <cstdint>

__device__ __forceinline__ int hw_lane() { int l; asm volatile("v_mbcnt_lo_u32_b32 %0, -1, 0\n\tv_mbcnt_hi_u32_b32 %0, -1, %0" : "=v"(l)); return l; }
namespace pg8 {
#define PG8_LAS __attribute__((address_space(3)))
typedef unsigned short bf16_t;
typedef short bf16x8 __attribute__((ext_vector_type(8)));
typedef float f32x4 __attribute__((ext_vector_type(4)));
typedef unsigned u32x4 __attribute__((ext_vector_type(4)));
typedef unsigned u32x2 __attribute__((ext_vector_type(2)));
typedef int v8i __attribute__((ext_vector_type(8)));
typedef short bf16x16 __attribute__((ext_vector_type(16)));
constexpr int BM = 256, BK = 64, HALF = 128, HTB = HALF * BK * 2  , STAGE_BYTES = 8 * HTB, NXCD = 8, WGM = 8;

__host__ __device__ __forceinline__ int lds_byte(int r, int c) { const int st = (r >> 4) * 2 + (c >> 5), rr = r & 15, cc = c & 31, ob = rr * 64 + cc * 2; return st * 1024 + (ob ^ (((ob >> 9) & 1) << 5)); }
__host__ __device__ __forceinline__ void stage_rc(int b, int& R, int& C) { const int st = b / 1024, sb = b % 1024, swz = sb ^ (((sb >> 9) & 1) << 5); R = (st >> 1) * 16 + swz / 64; C = (st & 1) * 32 + (swz % 64) / 2; }
__host__ __device__ __forceinline__ int perm32(int rho) { const int n = rho >> 4, i = rho & 15; return 8 * (i >> 2) + 4 * n + (i & 3); }

struct Unit { int pm, pn; };
struct Gemm { const bf16_t* A; const bf16_t* Bt; int M, N, K; };

struct StaticOrder {
    int nM, nN, nwg, G, c;
    __host__ __device__ void init(int M, int N, int G_, int c_) { nM = M / BM; nN = N / BM; nwg = nM * nN; G = G_; c = c_; }
    __host__ __device__ bool next(int i, Unit& u) const {
        const long L = (long)i * G + c; if (L >= nwg) return false;
        int wgid = (int)L; { const int q = nwg / NXCD, r = nwg % NXCD, xcd = wgid % NXCD, off = wgid / NXCD; wgid = (xcd < r ? xcd * (q + 1) : r * (q + 1) + (xcd - r) * q) + off; }
        const int nig = WGM * nN, gid = wgid / nig, fm = gid * WGM, gsz = (nM - fm) < WGM ? (nM - fm) : WGM;
        u.pm = fm + ((wgid % nig) % gsz); u.pn = (wgid % nig) / gsz; return true;
    }
    __device__ __forceinline__ int gather_row(const Unit&, int) const { return 0; }
};

__device__ __forceinline__ unsigned cvt_pk_bf16(float lo, float hi) { unsigned r; asm volatile("v_cvt_pk_bf16_f32 %0, %1, %2" : "=v"(r) : "v"(lo), "v"(hi)); return r; }

struct EpiBf16 {
    static constexpr bool PERM = true;
    bf16_t* O; int ldc;
    __device__ __forceinline__ void operator()(const f32x4 (&acc)[2][2][4][2], const Unit& u, int wr, int wc, int fr, int fq) const {
        const int row0 = u.pm * BM + wr * 64 + fr; const int col0 = u.pn * BM + wc * 32 + 8 * fq;
#pragma unroll
        for (int ai = 0; ai < 2; ++ai)
#pragma unroll
            for (int m = 0; m < 4; ++m) { bf16_t* rowp = O + (size_t)(row0 + ai * HALF + m * 16) * ldc + col0;
#pragma unroll
                for (int bj = 0; bj < 2; ++bj) { const f32x4 v0 = acc[ai][bj][m][0], v1 = acc[ai][bj][m][1];
                    u32x4 w; w.x = cvt_pk_bf16(v0[0], v0[1]); w.y = cvt_pk_bf16(v0[2], v0[3]); w.z = cvt_pk_bf16(v1[0], v1[1]); w.w = cvt_pk_bf16(v1[2], v1[3]);
                    *(u32x4*)(rowp + bj * HALF) = w; } }
    }
};
struct EpiResid {
    static constexpr bool PERM = false;
    const float* base; float* out; int ldc;
    __device__ __forceinline__ void operator()(const f32x4 (&acc)[2][2][4][2], const Unit& u, int wr, int wc, int fr, int fq) const {
        const int row0 = u.pm * BM + wr * 64 + fr; const int col0 = u.pn * BM + wc * 32 + 4 * fq;
#pragma unroll
        for (int ai = 0; ai < 2; ++ai)
#pragma unroll
            for (int m = 0; m < 4; ++m) { const size_t off = (size_t)(row0 + ai * HALF + m * 16) * ldc + col0;
#pragma unroll
                for (int bj = 0; bj < 2; ++bj)
#pragma unroll
                    for (int n = 0; n < 2; ++n) { const f32x4 bs = *(const f32x4*)(base + off + bj * HALF + n * 16); *(f32x4*)(out + off + bj * HALF + n * 16) = bs + acc[ai][bj][m][n]; } }
    }
};

template <class Epi, class Sched, bool ALIGN_EPI = false, bool GATHER = false, bool F8 = false>
__device__ __forceinline__ void gemm_phase(PG8_LAS unsigned char* lds, const Gemm g, const Sched& S, const Epi& E, int wave) {
    const int wid = wave, lane = hw_lane(), tid = wid * 64 + lane, wr = wid >> 2, wc = wid & 3, fr = lane & 15, fq = lane >> 4;
    const int K = g.K, nt = K / BK;
    unsigned voffA[2], voffB[2]; int RA[2], CA[2];
#pragma unroll
    for (int i = 0; i < 2; ++i) { int R, C; stage_rc(tid * 16 + i * 8192, R, C); const int Rb = Epi::PERM ? ((R & ~31) + perm32(R & 31)) : R;
        voffA[i] = (unsigned)(R * K + C) * 2u; voffB[i] = (unsigned)(Rb * K + C) * 2u; RA[i] = R; CA[i] = C; }
    const size_t kstep = (size_t)(BK * 2);
    const size_t hstep = (size_t)HALF * K * 2;
    const size_t tstep = 2 * hstep;
    const unsigned ldsw = (unsigned)wid * 1024u, ldsu = (unsigned)(uintptr_t)lds;
    const int aoff = lds_byte(wr * 64 + fr, fq * (F8 ? 16 : 8)), boff = lds_byte(wc * 32 + fr, fq * (F8 ? 16 : 8));
    PG8_LAS unsigned char* ldsA = lds + aoff; PG8_LAS unsigned char* ldsB = lds + 4 * HTB + boff;
    if constexpr (F8) { asm volatile("" : "+v"(ldsA)); asm volatile("" : "+v"(ldsB)); }
#define PG8_SA(b, h) (((b) * 2 + (h)) * HTB)
#define PG8_SB(b, h) ((4 + (b) * 2 + (h)) * HTB)
#define PG8_SBR(b, h) (((b) * 2 + (h)) * HTB)
#define PG8_DMA1(ldsaddr, gbase, vo) asm volatile("s_mov_b32 m0, %0\n\ts_nop 0\n\tglobal_load_lds_dwordx4 %1, %2" :: "s"(ldsaddr), "v"(vo), "s"(gbase) : "memory", "m0")
#define PG8_STAGE(bufoff, gbase, voff) do { PG8_DMA1(ldsu + (unsigned)(bufoff) + ldsw, (const char*)(gbase), (voff)[0]); PG8_DMA1(ldsu + (unsigned)(bufoff) + ldsw + 8192u, (const char*)(gbase), (voff)[1]); } while (0)
#define PG8_STAGE_A(bufoff, h, base, O) do { if constexpr (GATHER) { PG8_STAGE(bufoff, base, O[h]); } else { PG8_STAGE(bufoff, (base) + (h) * hstep, voffA); } } while (0)
#define PG8_CAT8(lo, hi) ((v8i){(int)lo.x, (int)lo.y, (int)lo.z, (int)lo.w, (int)hi.x, (int)hi.y, (int)hi.z, (int)hi.w})
#define PG8_LDA(dst, b, h) do { if constexpr (F8) { _Pragma("unroll") for (int m = 0; m < 4; ++m) { const u32x4 lo_ = *(const PG8_LAS u32x4*)(ldsA + PG8_SA(b, h) + m * 2048), hi_ = *(const PG8_LAS u32x4*)(ldsA + PG8_SA(b, h) + m * 2048 + 16); dst##8[m] = PG8_CAT8(lo_, hi_); } } \
    else { _Pragma("unroll") for (int m = 0; m < 4; ++m) _Pragma("unroll") for (int k = 0; k < 2; ++k) dst[m][k] = *(const PG8_LAS bf16x8*)(lds + PG8_SA(b, h) + aoff + m * 2048 + k * 1024); } } while (0)
#define PG8_LDB(dst, b, h) do { if constexpr (F8) { _Pragma("unroll") for (int n = 0; n < 2; ++n) { const u32x4 lo_ = *(const PG8_LAS u32x4*)(ldsB + PG8_SBR(b, h) + n * 2048), hi_ = *(const PG8_LAS u32x4*)(ldsB + PG8_SBR(b, h) + n * 2048 + 16); dst##8[n] = PG8_CAT8(lo_, hi_); } } \
    else { _Pragma("unroll") for (int n = 0; n < 2; ++n) _Pragma("unroll") for (int k = 0; k < 2; ++k) dst[n][k] = *(const PG8_LAS bf16x8*)(lds + PG8_SB(b, h) + boff + n * 2048 + k * 1024); } } while (0)
#define PG8_MMA(ai, bj, At, Bt) do { __builtin_amdgcn_s_setprio(1); if constexpr (F8) { _Pragma("unroll") for (int m = 0; m < 4; ++m) _Pragma("unroll") for (int n = 0; n < 2; ++n) \
            acc[ai][bj][m][n] = __builtin_amdgcn_mfma_scale_f32_16x16x128_f8f6f4(Bt##8[n], At##8[m], acc[ai][bj][m][n], 0, 0, 0, 0x7f7f7f7f, 0, 0x7f7f7f7f); } \
    else { _Pragma("unroll") for (int m = 0; m < 4; ++m) _Pragma("unroll") for (int n = 0; n < 2; ++n) _Pragma("unroll") for (int k = 0; k < 2; ++k) \
        acc[ai][bj][m][n] = __builtin_amdgcn_mfma_f32_16x16x32_bf16(Bt[n][k], At[m][k], acc[ai][bj][m][n], 0, 0, 0); } __builtin_amdgcn_s_setprio(0); } while (0)
#define PG8_WAIT_V(n) asm volatile("s_waitcnt vmcnt(" #n ")" ::: "memory")
#define PG8_WAIT_L(n) asm volatile("s_waitcnt lgkmcnt(" #n ")" ::: "memory")
#define PG8_BAR __builtin_amdgcn_s_barrier()
#define PG8_SCHED __builtin_amdgcn_sched_barrier(0)
    Unit cur, nxt; int ui = 0;
    if (!S.next(0, cur)) return;
    f32x4 acc[2][2][4][2];
#pragma unroll
    for (int a = 0; a < 2; ++a)
#pragma unroll
        for (int b = 0; b < 2; ++b)
#pragma unroll
            for (int m = 0; m < 4; ++m)
#pragma unroll
                for (int n = 0; n < 2; ++n) acc[a][b][m][n] = (f32x4){0.f, 0.f, 0.f, 0.f};
    bf16x8 At[4][2], B0[2][2], B1[2][2]; v8i At8[4], B08[2], B18[2];
    unsigned gC[2][2], gN[2][2];
#pragma unroll
    for (int h = 0; h < 2; ++h)
#pragma unroll
        for (int i = 0; i < 2; ++i) { gC[h][i] = 0u; gN[h][i] = 0u; }
    if constexpr (GATHER) {
#pragma unroll
        for (int h = 0; h < 2; ++h)
#pragma unroll
            for (int i = 0; i < 2; ++i) gC[h][i] = (unsigned)S.gather_row(cur, h * HALF + RA[i]) * (unsigned)(K * 2) + (unsigned)(CA[i] * 2);
    }
    const char* cA = GATHER ? (const char*)g.A : (const char*)g.A + (size_t)cur.pm * tstep; const char* cB = (const char*)g.Bt + (size_t)cur.pn * tstep;
    PG8_STAGE(PG8_SB(0, 0), cB, voffB); PG8_STAGE(PG8_SB(0, 1), cB + hstep, voffB); PG8_STAGE_A(PG8_SA(0, 0), 0, cA, gC); PG8_STAGE_A(PG8_SA(0, 1), 1, cA, gC);
    if (wr == 1) PG8_BAR;
    PG8_WAIT_V(2); PG8_BAR;
    PG8_STAGE(PG8_SB(1, 0), cB + kstep, voffB); PG8_STAGE_A(PG8_SA(1, 0), 0, cA + kstep, gC); PG8_STAGE(PG8_SB(1, 1), cB + hstep + kstep, voffB);
    PG8_WAIT_V(6); PG8_BAR;
    for (;;) {
        const bool has_next = S.next(ui + 1, nxt);
        if constexpr (GATHER) {
            if (has_next) {
#pragma unroll
                for (int h = 0; h < 2; ++h)
#pragma unroll
                    for (int i = 0; i < 2; ++i) gN[h][i] = (unsigned)S.gather_row(nxt, h * HALF + RA[i]) * (unsigned)(K * 2) + (unsigned)(CA[i] * 2);
            } else {
#pragma unroll
                for (int h = 0; h < 2; ++h)
#pragma unroll
                    for (int i = 0; i < 2; ++i) gN[h][i] = gC[h][i];
            }
        }
        const char* nA = GATHER ? (const char*)g.A : (has_next ? (const char*)g.A + (size_t)nxt.pm * tstep : cA); const char* nB = has_next ? (const char*)g.Bt + (size_t)nxt.pn * tstep : cB;
#pragma unroll 1
        for (int t = 0; t < nt; t += 2) {
            const bool last = (t == nt - 2);
            const char* a1 = cA + (size_t)(t + 1) * kstep;
            const char* a2 = last ? nA : cA + (size_t)(t + 2) * kstep; const char* b2 = last ? nB : cB + (size_t)(t + 2) * kstep;
            const char* a3 = a2 + kstep; const char* b3 = b2 + kstep;
            PG8_LDB(B0, 0, 0); PG8_LDB(B1, 0, 1); PG8_SCHED; PG8_LDA(At, 0, 0); PG8_STAGE_A(PG8_SA(1, 1), 1, a1, gC);
            if constexpr (GATHER) { if (last) { _Pragma("unroll") for (int h = 0; h < 2; ++h) _Pragma("unroll") for (int i = 0; i < 2; ++i) gC[h][i] = gN[h][i]; } }
            PG8_WAIT_V(8); PG8_WAIT_L(0); PG8_BAR; PG8_MMA(0, 0, At, B0); PG8_MMA(0, 1, At, B1); PG8_BAR; PG8_SCHED;
            PG8_LDA(At, 0, 1); PG8_STAGE(PG8_SB(0, 0), b2, voffB); PG8_STAGE(PG8_SB(0, 1), b2 + hstep, voffB); PG8_STAGE_A(PG8_SA(0, 0), 0, a2, gC);
            PG8_WAIT_V(8); PG8_WAIT_L(0); PG8_BAR; PG8_MMA(1, 0, At, B0); PG8_MMA(1, 1, At, B1); PG8_BAR; PG8_SCHED;
            PG8_LDB(B0, 1, 0); PG8_LDB(B1, 1, 1); PG8_SCHED; PG8_LDA(At, 1, 0); PG8_STAGE_A(PG8_SA(0, 1), 1, a2, gC);
            PG8_WAIT_V(8); PG8_WAIT_L(0); PG8_BAR; PG8_MMA(0, 0, At, B0); PG8_MMA(0, 1, At, B1); PG8_BAR; PG8_SCHED;
            PG8_LDA(At, 1, 1); PG8_STAGE(PG8_SB(1, 0), b3, voffB); PG8_STAGE(PG8_SB(1, 1), b3 + hstep, voffB); PG8_STAGE_A(PG8_SA(1, 0), 0, a3, gC);
            PG8_WAIT_V(8); PG8_WAIT_L(0); PG8_BAR; PG8_MMA(1, 0, At, B0); PG8_MMA(1, 1, At, B1); PG8_BAR; PG8_SCHED;
        }
        if constexpr (ALIGN_EPI) { if (wr == 0) PG8_BAR; }
        E(acc, cur, wr, wc, fr, fq);
        if (!has_next) break;
#pragma unroll
        for (int a = 0; a < 2; ++a)
#pragma unroll
            for (int b = 0; b < 2; ++b)
#pragma unroll
                for (int m = 0; m < 4; ++m)
#pragma unroll
                    for (int n = 0; n < 2; ++n) acc[a][b][m][n] = (f32x4){0.f, 0.f, 0.f, 0.f};
        cur = nxt; cA = nA; cB = nB; ++ui;
#pragma unroll
        for (int h = 0; h < 2; ++h)
#pragma unroll
            for (int i = 0; i < 2; ++i) gC[h][i] = gN[h][i];
        if constexpr (ALIGN_EPI) { if (wr == 1) PG8_BAR; }
    }
    PG8_WAIT_V(0);
    if constexpr (!ALIGN_EPI) { if (wr == 0) PG8_BAR; }
    PG8_BAR;
#undef PG8_SA
#undef PG8_SB
#undef PG8_SBR
#undef PG8_STAGE
#undef PG8_DMA1
#undef PG8_STAGE_A
#undef PG8_LDA
#undef PG8_CAT8
#undef PG8_LDB
#undef PG8_MMA
#undef PG8_WAIT_V
#undef PG8_WAIT_L
#undef PG8_BAR
#undef PG8_SCHED
}
}

namespace att {
#define ALAS __attribute__((address_space(3)))
using bf16 = unsigned short;
using bf16x8 = __attribute__((ext_vector_type(8))) short;
using s16x4  = __attribute__((ext_vector_type(4))) short;
using f32x16 = __attribute__((ext_vector_type(16))) float;
using f32x2  = __attribute__((ext_vector_type(2))) float;
using u32x4  = __attribute__((ext_vector_type(4))) unsigned;
#define SBAR() __builtin_amdgcn_sched_barrier(0)
constexpr int SHM_V = 64 * 128 * 2;
constexpr int OFF_V = 0;
template <int MODE> struct L { static constexpr int NVB = MODE == 0 ? 3 : 2, SHM_K = 64 * (MODE == 0 ? 384 : 128), OFF_K = NVB * SHM_V, OFF_WS = OFF_K + 2 * SHM_K; };
constexpr int OFF_LUT = L<1>::OFF_WS + 2048;
constexpr int OFF_STASH = OFF_LUT + 16384;
constexpr int OFF_QPE = L<0>::OFF_WS + 2048;
constexpr int ATT_LDS = (OFF_STASH + 65536) > (OFF_QPE + 40960) ? (OFF_STASH + 65536) : (OFF_QPE + 40960);
__device__ __forceinline__ int crow(int r, int hi) { return (r & 3) + 8 * (r >> 2) + 4 * hi; }
__device__ __forceinline__ unsigned cvtpk(float lo, float hi) { unsigned r; asm volatile("v_cvt_pk_bf16_f32 %0, %1, %2" : "=v"(r) : "v"(lo), "v"(hi)); return r; }
__device__ __forceinline__ float bf2f(short v) { return __uint_as_float(((unsigned)(unsigned short)v) << 16); }
template <int RB> __device__ __forceinline__ int kaddr(int row, int colB) { return row * RB + (colB ^ (((row >> 1) & 7) << 4)); }

template <bool NEAR>
__device__ __forceinline__ void partialSM(f32x16& p0, f32x16& p1, float& m_reg, float& mn, float& alpha, float C, const ALAS float* lut, float cfar) {
  constexpr float THR2 = 8.f * 1.4426950408889634f;
  if constexpr (NEAR) {
#pragma unroll
    for (int r = 0; r < 16; ++r) { const int o = (r & 3) + 8 * (r >> 2); p0[r] = fmaf(p0[r], C, lut[o]); p1[r] = fmaf(p1[r], C, lut[32 + o]); }
  }
  float pmax = p0[0];
#pragma unroll
  for (int r = 1; r < 16; ++r) pmax = fmaxf(pmax, p0[r]);
#pragma unroll
  for (int r = 0; r < 16; ++r) pmax = fmaxf(pmax, p1[r]);
  { auto rr = __builtin_amdgcn_permlane32_swap(__float_as_uint(pmax), __float_as_uint(pmax), false, false);
    pmax = fmaxf(__uint_as_float(rr[0]), __uint_as_float(rr[1])); }
  if constexpr (!NEAR) pmax = fmaf(pmax, C, cfar);
  if (__builtin_expect(__all(pmax - m_reg <= THR2), 1)) { mn = m_reg; alpha = 1.f; }
  else { mn = fmaxf(m_reg, pmax); alpha = __builtin_amdgcn_exp2f(m_reg - mn); m_reg = mn; }
  if constexpr (NEAR) {
#pragma unroll
    for (int r = 0; r < 16; ++r) p0[r] = __builtin_amdgcn_exp2f(p0[r] - mn);
#pragma unroll
    for (int r = 0; r < 16; ++r) p1[r] = p1[r] - mn;
  } else {
    const float cm = cfar - mn;
#pragma unroll
    for (int r = 0; r < 16; ++r) p0[r] = __builtin_amdgcn_exp2f(fmaf(p0[r], C, cm));
#pragma unroll
    for (int r = 0; r < 16; ++r) p1[r] = fmaf(p1[r], C, cm);
  }
}
__device__ __forceinline__ void finishSM(f32x16& p0, f32x16& p1, float alpha, float& l_reg, bf16x8& pa0, bf16x8& pa1, bf16x8& pa2, bf16x8& pa3) {
#pragma unroll
  for (int r = 0; r < 16; ++r) p1[r] = __builtin_amdgcn_exp2f(p1[r]);
  float ps = 0;
#pragma unroll
  for (int r = 0; r < 16; ++r) ps += p0[r];
#pragma unroll
  for (int r = 0; r < 16; ++r) ps += p1[r];
  { auto rr = __builtin_amdgcn_permlane32_swap(__float_as_uint(ps), __float_as_uint(ps), false, false);
    ps = __uint_as_float(rr[0]) + __uint_as_float(rr[1]); }
  l_reg = l_reg * alpha + ps;
#define PK4(P, BASE, OUT) do { unsigned a0 = cvtpk(P[BASE + 0], P[BASE + 1]), a1 = cvtpk(P[BASE + 2], P[BASE + 3]);   \
    unsigned b0 = cvtpk(P[BASE + 4], P[BASE + 5]), b1 = cvtpk(P[BASE + 6], P[BASE + 7]);                              \
    auto r0 = __builtin_amdgcn_permlane32_swap(a0, b0, false, false); auto r1 = __builtin_amdgcn_permlane32_swap(a1, b1, false, false); \
    u32x4 w = {r0[0], r1[0], r0[1], r1[1]}; OUT = __builtin_bit_cast(bf16x8, w); } while (0)
  PK4(p0, 0, pa0); PK4(p0, 8, pa1); PK4(p1, 0, pa2); PK4(p1, 8, pa3);
#undef PK4
}
template <int NQ, int RB>
__device__ __forceinline__ void qkt(f32x16& p0, f32x16& p1, const ALAS char* Ks, const bf16x8* qr, int r32, int hi) {
  p0 = f32x16{}; p1 = f32x16{};
#pragma unroll
  for (int d0 = 0; d0 < NQ; ++d0) { const int cb = (d0 * 16 + hi * 8) * 2;
    const bf16x8 b0 = *reinterpret_cast<const ALAS bf16x8*>(Ks + kaddr<RB>(r32, cb));
    const bf16x8 b1 = *reinterpret_cast<const ALAS bf16x8*>(Ks + kaddr<RB>(32 + r32, cb));
    p0 = __builtin_amdgcn_mfma_f32_32x32x16_bf16(b0, qr[d0], p0, 0, 0, 0);
    p1 = __builtin_amdgcn_mfma_f32_32x32x16_bf16(b1, qr[d0], p1, 0, 0, 0); }
}
__device__ __forceinline__ int v_st(int k, int c) { const int kk = (k & ~0xC) | ((k & 4) << 1) | ((k & 8) >> 1); return ((kk >> 3) * 4 + (c >> 5)) * 512 + ((kk & 7) * 32 + (c & 31)) * 2; }
__device__ __forceinline__ int v_rd_base(int lane) { return ((lane & 3) << 3) | (((lane >> 2) & 3) << 6) | (((lane >> 4) & 1) << 5) | (((lane >> 5) & 1) << 8); }
constexpr int v_rd_off(int d0, int ks, int half) { return d0 * 512 + ks * 4096 + half * 2048; }
template <int OFF> __device__ __forceinline__ s16x4 tr_read(int vb) {
  s16x4 r; asm volatile("ds_read_b64_tr_b16 %0, %1 offset:%2" : "=&v"(r) : "v"(vb), "i"(OFF) : "memory"); return r;
}
template <int D0> __device__ __forceinline__ void pv_one(f32x16& od, int vb, bf16x8 pa0, bf16x8 pa1, bf16x8 pa2, bf16x8 pa3) {
  const s16x4 l0 = tr_read<v_rd_off(D0, 0, 0)>(vb), h0 = tr_read<v_rd_off(D0, 0, 1)>(vb), l1 = tr_read<v_rd_off(D0, 1, 0)>(vb), h1 = tr_read<v_rd_off(D0, 1, 1)>(vb);
  const s16x4 l2 = tr_read<v_rd_off(D0, 2, 0)>(vb), h2 = tr_read<v_rd_off(D0, 2, 1)>(vb), l3 = tr_read<v_rd_off(D0, 3, 0)>(vb), h3 = tr_read<v_rd_off(D0, 3, 1)>(vb);
  asm volatile("s_waitcnt lgkmcnt(0)" ::: "memory"); SBAR();
#define PK(L, H) (bf16x8){L[0], L[1], L[2], L[3], H[0], H[1], H[2], H[3]}
  od = __builtin_amdgcn_mfma_f32_32x32x16_bf16(pa0, PK(l0, h0), od, 0, 0, 0);
  od = __builtin_amdgcn_mfma_f32_32x32x16_bf16(pa1, PK(l1, h1), od, 0, 0, 0);
  od = __builtin_amdgcn_mfma_f32_32x32x16_bf16(pa2, PK(l2, h2), od, 0, 0, 0);
  od = __builtin_amdgcn_mfma_f32_32x32x16_bf16(pa3, PK(l3, h3), od, 0, 0, 0);
#undef PK
}
__device__ __forceinline__ void pv_d0(f32x16* o, int vb, bf16x8 pa0, bf16x8 pa1, bf16x8 pa2, bf16x8 pa3) {
  pv_one<0>(o[0], vb, pa0, pa1, pa2, pa3); pv_one<1>(o[1], vb, pa0, pa1, pa2, pa3); pv_one<2>(o[2], vb, pa0, pa1, pa2, pa3); pv_one<3>(o[3], vb, pa0, pa1, pa2, pa3);
}

__device__ __forceinline__ int kw_addr(int row, int colB) { return row * 256 + (colB ^ ((row & 15) << 4)); }
__device__ __forceinline__ int kn_addr(int row, int colB) { return row * 128 + (colB ^ (((row >> 1) & 7) << 4)); }
template <int MODE>
__device__ __forceinline__ void attn_unit(const bf16* __restrict__ Qb, int ldq, const bf16* __restrict__ Kh, int ldk, const bf16* __restrict__ Kp, const bf16* __restrict__ Vh, int ldv,
                                          int seq, ALAS char* lds, float C, const f32x2* __restrict__ cs, int qpos0, f32x16 (&o)[4], int wave, int lane_in) {
  constexpr int SHM_KW = MODE == 0 ? 64 * 256 : 0, SHM_KN = 64 * 128, SHM_K = SHM_KW + SHM_KN;
  static_assert(SHM_K == L<MODE>::SHM_K, "K buffers");
  const int tid = threadIdx.x, wid = __builtin_amdgcn_readfirstlane(tid >> 6), lane = tid & 63, r32 = lane & 31, hi = lane >> 5;
  const bool late = wid >= 4;
  ALAS char* V_lds = lds + OFF_V; ALAS char* K_lds = lds + L<MODE>::OFF_K;
  ALAS float* ws = (ALAS float*)(lds + L<MODE>::OFF_WS) + wid * 64; ALAS float* li_l = ws; ALAS float* al_l = ws + 32;
  __syncthreads();
  float m_reg = -1e30f, l_reg = 0;
#pragma unroll
  for (int d = 0; d < 4; ++d) o[d] = f32x16{};
  constexpr int NQR = MODE == 0 ? 7 : 4;
  bf16x8 qr[NQR];
  ALAS char* qpe_l = lds + OFF_QPE + wid * 5120 + lane * 16;
  const bf16* Qw = Qb + (long)(wid * 32 + r32) * ldq + hi * 8;
#pragma unroll
  for (int d0 = 0; d0 < NQR; ++d0) qr[d0] = *reinterpret_cast<const bf16x8*>(Qw + d0 * 16);
  if constexpr (MODE == 0) {
    bf16x8 qp[4];
#pragma unroll
    for (int d0 = 0; d0 < 4; ++d0) qp[d0] = *reinterpret_cast<const bf16x8*>(Qw + (8 + d0) * 16);
    *(ALAS bf16x8*)(qpe_l + 4 * 1024) = *reinterpret_cast<const bf16x8*>(Qw + 7 * 16);
    const f32x2* cp = cs + (long)(qpos0 + wid * 32 + r32) * 32 + hi * 8;
#pragma unroll
    for (int a = 0; a < 2; ++a) {
      unsigned w1[4], w2[4];
#pragma unroll
      for (int j = 0; j < 8; j += 2) {
        const f32x2 c0 = cp[16 * a + j], c1 = cp[16 * a + j + 1];
        const float x10 = bf2f(qp[a][j]), x20 = bf2f(qp[2 + a][j]), x11 = bf2f(qp[a][j + 1]), x21 = bf2f(qp[2 + a][j + 1]);
        w1[j >> 1] = cvtpk(x10 * c0.x - x20 * c0.y, x11 * c1.x - x21 * c1.y);
        w2[j >> 1] = cvtpk(x10 * c0.y + x20 * c0.x, x11 * c1.y + x21 * c1.x);
      }
      u32x4 v1 = {w1[0], w1[1], w1[2], w1[3]}, v2 = {w2[0], w2[1], w2[2], w2[3]};
      *(ALAS u32x4*)(qpe_l + a * 1024) = v1; *(ALAS u32x4*)(qpe_l + (2 + a) * 1024) = v2;
    }
  }
  unsigned vsrc[2], kwsrc[2], knsrc;
#pragma unroll
  for (int i = 0; i < 2; ++i) { const int s = (wid + 8 * i) * 64 + lane;
    const int kk = (s >> 7) * 8 + ((s & 31) >> 2), c = ((s >> 5) & 3) * 32 + (s & 3) * 8, k = (kk & ~0xC) | ((kk & 4) << 1) | ((kk & 8) >> 1);
    vsrc[i] = (unsigned)(k * ldv + c);
    const int row = s >> 4, ch = (s & 15) ^ (row & 15); kwsrc[i] = (unsigned)(row * ldk + ch * 8); }
  { const int s = wid * 64 + lane, row = s >> 3, ch = (s & 7) ^ ((row >> 1) & 7); knsrc = (unsigned)(row * (MODE == 0 ? 64 : ldk) + ch * 8); }
  const bf16* Kn = MODE == 0 ? Kp : Kh; const int ldn = MODE == 0 ? 64 : ldk;
#define DMA16(src, dst) __builtin_amdgcn_global_load_lds((const unsigned*)(src), (ALAS unsigned*)(dst), 16, 0, 0)
#define DMA_V(t, b) do { const bf16* vb_ = Vh + (long)(t) * 64 * ldv; DMA16(vb_ + vsrc[0], V_lds + (b) * SHM_V + wid * 1024); DMA16(vb_ + vsrc[1], V_lds + (b) * SHM_V + (wid + 8) * 1024); } while (0)
#define DMA_K(t, b) do { if constexpr (MODE == 0) { const bf16* kb_ = Kh + (long)(t) * 64 * ldk; DMA16(kb_ + kwsrc[0], K_lds + (b) * SHM_K + wid * 1024); DMA16(kb_ + kwsrc[1], K_lds + (b) * SHM_K + (wid + 8) * 1024); } \
    DMA16(Kn + (long)(t) * 64 * ldn + knsrc, K_lds + (b) * SHM_K + SHM_KW + wid * 1024); } while (0)
#define STEP_END() do { asm volatile("s_waitcnt vmcnt(0)" ::: "memory"); __syncthreads(); } while (0)
#define QKT(P0, P1, b) do { P0 = f32x16{}; P1 = f32x16{}; const ALAS char* kb_ = K_lds + (b) * SHM_K; \
    if constexpr (MODE == 0) { _Pragma("unroll") for (int d0 = 0; d0 < 8; ++d0) { const int cb = (d0 * 16 + hi * 8) * 2; \
        const bf16x8 b0 = *reinterpret_cast<const ALAS bf16x8*>(kb_ + kw_addr(r32, cb)); const bf16x8 b1 = *reinterpret_cast<const ALAS bf16x8*>(kb_ + kw_addr(32 + r32, cb)); \
        bf16x8 qn_; if (d0 < NQR) qn_ = qr[d0 < NQR ? d0 : 0]; else qn_ = *reinterpret_cast<const ALAS bf16x8*>(qpe_l + 4 * 1024); \
        P0 = __builtin_amdgcn_mfma_f32_32x32x16_bf16(b0, qn_, P0, 0, 0, 0); P1 = __builtin_amdgcn_mfma_f32_32x32x16_bf16(b1, qn_, P1, 0, 0, 0); } } \
    _Pragma("unroll") for (int d0 = 0; d0 < 4; ++d0) { const int cb = (d0 * 16 + hi * 8) * 2; \
        const bf16x8 b0 = *reinterpret_cast<const ALAS bf16x8*>(kb_ + SHM_KW + kn_addr(r32, cb)); const bf16x8 b1 = *reinterpret_cast<const ALAS bf16x8*>(kb_ + SHM_KW + kn_addr(32 + r32, cb)); \
        bf16x8 qf_; if constexpr (MODE == 0) qf_ = *reinterpret_cast<const ALAS bf16x8*>(qpe_l + d0 * 1024); else qf_ = qr[d0]; \
        P0 = __builtin_amdgcn_mfma_f32_32x32x16_bf16(b0, qf_, P0, 0, 0, 0); P1 = __builtin_amdgcn_mfma_f32_32x32x16_bf16(b1, qf_, P1, 0, 0, 0); } } while (0)
#define RESC(a) do { if (__any((a) < 1.f)) { if (hi == 0) al_l[r32] = (a); asm volatile("s_waitcnt lgkmcnt(0)" ::: "memory"); \
    _Pragma("unroll") for (int d = 0; d < 4; ++d) _Pragma("unroll") for (int r = 0; r < 16; ++r) o[d][r] *= al_l[crow(r, hi)]; } } while (0)
  const int vb0 = (int)(unsigned)(uintptr_t)V_lds + v_rd_base(lane);
  const int qw = qpos0 + wid * 32;
  const ALAS float* lutb = (const ALAS float*)(lds + OFF_LUT);
  const ALAS float* lutp = lutb + (2047 - (qw + r32) + 4 * hi);
  float cpos = 0.f, cneg = 0.f;
#define PSM(P0, P1, MN, AL, TILE) do { if constexpr (MODE == 0) partialSM<false>(P0, P1, m_reg, MN, AL, C, lutp, 0.f); else { const int k0_ = (TILE) * 64; \
    if ((k0_ >= qw + 122) || (k0_ + 154 <= qw)) partialSM<false>(P0, P1, m_reg, MN, AL, C, lutp, k0_ > qw ? cpos : cneg); else partialSM<true>(P0, P1, m_reg, MN, AL, C, lutp + k0_, 0.f); } } while (0)
  f32x16 pA0, pA1; float mnA, alA; bf16x8 pa0, pa1, pa2, pa3; const int NT = seq / 64;
  if constexpr (MODE == 0) {
    DMA_K(0, 0); DMA_V(0, 0); STEP_END();
    int vbj = 0, vbp = 0;
    for (int j = 0; j < NT; ++j) {
      const int kb = j & 1, vbn = vbj == 2 ? 0 : vbj + 1;
      if (j + 1 < NT) { DMA_K(j + 1, kb ^ 1); DMA_V(j + 1, vbn); }
      if (late && j > 0) pv_d0(o, vb0 + vbp * SHM_V, pa0, pa1, pa2, pa3);
      SBAR();
      QKT(pA0, pA1, kb); PSM(pA0, pA1, mnA, alA, j);
      RESC(alA);
      finishSM(pA0, pA1, alA, l_reg, pa0, pa1, pa2, pa3); SBAR();
      if (!late) pv_d0(o, vb0 + vbj * SHM_V, pa0, pa1, pa2, pa3);
      STEP_END();
      vbp = vbj; vbj = vbn;
    }
    if (late) pv_d0(o, vb0 + vbp * SHM_V, pa0, pa1, pa2, pa3);
  } else {
    f32x16 pB0, pB1; float mnB, alB;
    DMA_K(0, 0); STEP_END();
    cpos = lutb[2047 + 128]; cneg = lutb[2047 - 128];
#define DIFF_LOOP(LATE) do { \
      \
    DMA_K(1, 1); DMA_V(0, 0); \
    QKT(pA0, pA1, 0); \
    if (!(LATE)) { PSM(pA0, pA1, mnA, alA, 0); } \
    STEP_END(); \
    for (int j = 1; j + 1 < NT; j += 2) { \
        \
      DMA_K(j + 1, 0); DMA_V(j, 1); \
      if (LATE) { PSM(pA0, pA1, mnA, alA, j - 1); RESC(alA); } \
      SBAR(); QKT(pB0, pB1, 1); \
      finishSM(pA0, pA1, alA, l_reg, pa0, pa1, pa2, pa3); SBAR(); \
      pv_d0(o, vb0, pa0, pa1, pa2, pa3); \
      if (!(LATE)) { PSM(pB0, pB1, mnB, alB, j); RESC(alB); } \
      STEP_END(); \
        \
      DMA_K(j + 2, 1); DMA_V(j + 1, 0); \
      if (LATE) { PSM(pB0, pB1, mnB, alB, j); RESC(alB); } \
      SBAR(); QKT(pA0, pA1, 0); \
      finishSM(pB0, pB1, alB, l_reg, pa0, pa1, pa2, pa3); SBAR(); \
      pv_d0(o, vb0 + SHM_V, pa0, pa1, pa2, pa3); \
      if (!(LATE)) { PSM(pA0, pA1, mnA, alA, j + 1); RESC(alA); } \
      STEP_END(); \
    } \
      \
    DMA_V(NT - 1, 1); \
    if (LATE) { PSM(pA0, pA1, mnA, alA, NT - 2); RESC(alA); } \
    SBAR(); QKT(pB0, pB1, 1); \
    finishSM(pA0, pA1, alA, l_reg, pa0, pa1, pa2, pa3); SBAR(); \
    pv_d0(o, vb0, pa0, pa1, pa2, pa3); \
    PSM(pB0, pB1, mnB, alB, NT - 1); RESC(alB); \
    STEP_END(); \
    finishSM(pB0, pB1, alB, l_reg, pa0, pa1, pa2, pa3); SBAR(); \
    pv_d0(o, vb0 + SHM_V, pa0, pa1, pa2, pa3); } while (0)
    if (late) DIFF_LOOP(true); else DIFF_LOOP(false);
#undef DIFF_LOOP
  }
  if (hi == 0) li_l[r32] = l_reg; asm volatile("s_waitcnt lgkmcnt(0)" ::: "memory");
#pragma unroll
  for (int r = 0; r < 16; ++r) { const float rl = __builtin_amdgcn_rcpf(li_l[crow(r, hi)]);
#pragma unroll
    for (int d = 0; d < 4; ++d) o[d][r] *= rl; }
#undef DMA16
#undef DMA_V
#undef DMA_K
#undef STEP_END
#undef QKT
#undef RESC
#undef PSM
}
}
#define XB_TMO      128
#define XB_XCNT(j)  (256  + 64 * (j))
#define XB_XSUB(j)  (1280 + 64 * (j))
#define XB_XGEN(j)  (2304 + 64 * (j))
#define XB_TOP      3328
#define XB_TOPGEN   3392
#define XCD_BAR_WORDS 3456
#define XB_SPIN_CAP (1u << 18)
#define LAS __attribute__((address_space(3)))

__device__ __forceinline__ unsigned xb_ld(unsigned* p)              { return __hip_atomic_load(p, __ATOMIC_RELAXED, __HIP_MEMORY_SCOPE_AGENT); }
__device__ __forceinline__ unsigned xb_add(unsigned* p, unsigned v) { return __hip_atomic_fetch_add(p, v, __ATOMIC_RELAXED, __HIP_MEMORY_SCOPE_AGENT); }
__device__ __forceinline__ unsigned xb_xcc_id() { return (unsigned)__builtin_amdgcn_s_getreg((3 << 11) | 20) & 0xFu; }
#define XB_SPIN(cond, bar) do { unsigned _sp = 0; while (cond) { __builtin_amdgcn_s_sleep(1); \
    if ((++_sp & 255u) == 0u) { if (xb_ld(&(bar)[XB_TMO])) break; if (_sp > XB_SPIN_CAP) { atomicAdd(&(bar)[XB_TMO], 1u); break; } } } } while (0)

struct XcdBarrier {
    unsigned* bar; unsigned x, w;
    volatile LAS unsigned* st;
};

__device__ __forceinline__ XcdBarrier xcd_barrier_post(unsigned* bar, volatile LAS unsigned* st, unsigned wave) {
    XcdBarrier b; b.bar = bar; b.x = xb_xcc_id(); b.st = st; b.w = wave;
    if (wave == 0 && hw_lane() == 0) (void)xb_add(&bar[XB_XCNT(b.x)], 1u);
    return b;
}
__device__ __forceinline__ void xcd_barrier_complete(unsigned* bar, unsigned x, unsigned& nloc, unsigned& nx) {
    const unsigned G = gridDim.x * gridDim.y * gridDim.z;
    unsigned sum, cnt, mine, sp = 0u;
    for (;;) {
        sum = 0u; cnt = 0u; mine = 0u;
#pragma unroll
        for (unsigned j = 0; j < 16; ++j) { const unsigned c = xb_ld(&bar[XB_XCNT(j)]); sum += c; cnt += (c > 0u) ? 1u : 0u; mine = (j == x) ? c : mine; }
        if (sum == G) break;
        __builtin_amdgcn_s_sleep(1);
        if ((++sp & 255u) == 0u) { if (xb_ld(&bar[XB_TMO])) break; if (sp > XB_SPIN_CAP) { atomicAdd(&bar[XB_TMO], 1u); break; } }
    }
    nloc = mine > 0u ? mine : 1u; nx = cnt > 0u ? cnt : 1u;
}

__device__ __forceinline__ void xcd_barrier(const XcdBarrier& b) {
    asm volatile("s_waitcnt vmcnt(0)" ::: "memory");
    __syncthreads();
    if (b.w == 0 && hw_lane() == 0) {
        unsigned* bar = b.bar;
        __builtin_amdgcn_s_waitcnt(0);
        unsigned nloc = b.st[0], nx = b.st[1];
        if (nloc == 0u) { xcd_barrier_complete(bar, b.x, nloc, nx); b.st[0] = nloc; b.st[1] = nx; }
        const unsigned old = xb_add(&bar[XB_XSUB(b.x)], 1u);
        const unsigned gen = old / nloc;
        if (old + 1u == (gen + 1u) * nloc) {
            __builtin_amdgcn_fence(__ATOMIC_RELEASE, "agent");
            asm volatile("s_waitcnt vmcnt(0)" ::: "memory");
            const unsigned og = xb_add(&bar[XB_TOP], 1u);
            const unsigned tg = og / nx;
            if (og + 1u == (tg + 1u) * nx) xb_add(&bar[XB_TOPGEN], 1u);
            else XB_SPIN(xb_ld(&bar[XB_TOPGEN]) == tg, bar);
            __builtin_amdgcn_fence(__ATOMIC_ACQUIRE, "agent");
            xb_add(&bar[XB_XGEN(b.x)], 1u);
            asm volatile("s_waitcnt vmcnt(0)" ::: "memory");
        } else {
            XB_SPIN(xb_ld(&bar[XB_XGEN(b.x)]) == gen, bar);
            __builtin_amdgcn_fence(__ATOMIC_ACQUIRE, "agent");
            asm volatile("s_waitcnt vmcnt(0)" ::: "memory");
        }
    }
    __syncthreads();
}


constexpr int NB = 32, SEQ = 2048, T = NB * SEQ, D = 1024, IN_COLS = 1984, PROJ_LD = 2048;
constexpr int NE = 32, TOPK = 4, NA = T * TOPK, HALF_T = T / 2, HALF_A = NA / 2;
constexpr int ROWS_ALL = NA + NE * 256, TILES_MAX = ROWS_ALL / 256;
constexpr float NORM_EPS = 1e-5f, LOG2E = 1.4426950408889634f;
constexpr float SC_W = 64.f, SC_X = 4.f, SC_A = 4.f;
constexpr int NWAVES = 8, NTHREADS = 512;

constexpr size_t KiB = 1024, MiB = 1u << 20;
constexpr size_t WS_CTL = 0, CTL_ZERO_BYTES = 64 * KiB;
constexpr size_t WS_ROPE = 1 * MiB;
constexpr size_t WS_BIAS = 1 * MiB + 512 * KiB;
constexpr size_t WS_LAM = 1 * MiB + 768 * KiB;
constexpr size_t WS_RINV = 2 * MiB;
constexpr size_t WS_EIDX = 3 * MiB, WS_GATE = 4 * MiB, WS_LRANK = 5 * MiB;
constexpr size_t WS_HIST = 6 * MiB;
constexpr size_t WS_ROWA = 7 * MiB, WS_ROWG = 9 * MiB;
constexpr size_t WS_TINFO = 11 * MiB;
constexpr size_t WS_WRH = 12 * MiB, WS_WRL = 12 * MiB + 64 * KiB;
constexpr size_t WS_WUQ = 13 * MiB, WS_WUKV = 13 * MiB + 512 * KiB;
constexpr size_t WS_WIN = 16 * MiB, WS_WO = 20 * MiB;
constexpr size_t WS_WD8 = 24 * MiB, WS_WGU8 = 56 * MiB;
constexpr size_t WS_XB = 120 * MiB;
constexpr size_t WS_XB8 = 248 * MiB;
constexpr size_t WS_PROJ = 312 * MiB, WS_QM = 568 * MiB, WS_KV = 664 * MiB, WS_MIXED = 792 * MiB, WS_CQN = 920 * MiB, WS_CKVN = 952 * MiB, WS_KPE = 968 * MiB;
constexpr size_t WS_ACT8 = 312 * MiB, WS_Y4A = 576 * MiB, WS_Y4B = 56 * MiB;
constexpr size_t WS_END = 976 * MiB;
static_assert(WS_ACT8 + (size_t)ROWS_ALL * 1024 <= WS_Y4A && WS_Y4A + (size_t)HALF_A * 2048 <= WS_CQN && WS_Y4B + (size_t)HALF_A * 2048 <= WS_PROJ && WS_ROWA + (size_t)ROWS_ALL * 4 <= WS_ROWG && WS_ROWG + (size_t)ROWS_ALL * 4 <= WS_TINFO, "ws map");

constexpr int SCRATCH_BYTES = 141312;
constexpr int MISC_OFF = SCRATCH_BYTES;
constexpr int LDS_BYTES = SCRATCH_BYTES + 1024;
static_assert(att::ATT_LDS <= SCRATCH_BYTES && pg8::STAGE_BYTES <= SCRATCH_BYTES, "LDS map");

#define GAS __attribute__((address_space(1)))
typedef unsigned short bf16;
typedef float f32x4 __attribute__((ext_vector_type(4)));
typedef float f32x2 __attribute__((ext_vector_type(2)));
typedef unsigned u32x4 __attribute__((ext_vector_type(4)));
typedef unsigned u32x2 __attribute__((ext_vector_type(2)));
typedef short bf16x8 __attribute__((ext_vector_type(8)));
typedef float f32x16 __attribute__((ext_vector_type(16)));
#define LDS_WAIT() asm volatile("s_waitcnt lgkmcnt(0)" ::: "memory")
#define VM_WAIT() asm volatile("s_waitcnt vmcnt(0)" ::: "memory")
__device__ __forceinline__ unsigned pk2(float lo, float hi) { return pg8::cvt_pk_bf16(lo, hi); }
__device__ __forceinline__ unsigned cvt8(float a, float b, float c, float d) { int w = 0; w = __builtin_amdgcn_cvt_pk_fp8_f32(a, b, w, false); w = __builtin_amdgcn_cvt_pk_fp8_f32(c, d, w, true); return (unsigned)w; }
__device__ __forceinline__ float bf2f(unsigned short v) { return __uint_as_float(((unsigned)v) << 16); }
__device__ __forceinline__ float wave_sum(float v) {
#pragma unroll
    for (int o = 1; o < 64; o <<= 1) v += __shfl_xor(v, o);
    return v;
}

struct Args {
    const float* in[22]; float* out; unsigned char* ws; int ph_lo, ph_hi;
};

template <bool F8OUT, class RowMap>
__device__ __forceinline__ void transpose_item(const float* W, int K, int N, void* WTv, LAS float* scr, int item, int lane, const float* kscale, RowMap rm) {
    const int nblk = N / 32, kb = item / nblk, nb = item % nblk, k0 = 64 * kb, n0 = 32 * nb;
    float v[32];
#pragma unroll
    for (int i = 0; i < 32; ++i) v[i] = W[(size_t)(k0 + 2 * i + (lane >> 5)) * N + n0 + (lane & 31)];
    if (kscale) {
#pragma unroll
        for (int i = 0; i < 32; ++i) v[i] *= kscale[k0 + 2 * i + (lane >> 5)];
    }
    if constexpr (F8OUT) {
#pragma unroll
        for (int i = 0; i < 32; ++i) v[i] *= SC_W;
    }
#pragma unroll
    for (int i = 0; i < 32; ++i) scr[(2 * i + (lane >> 5)) * 33 + (lane & 31)] = v[i];
    LDS_WAIT(); asm volatile("" ::: "memory");
    const int c = lane & 7;
#pragma unroll
    for (int j = 0; j < 4; ++j) { const int n = (lane >> 3) + 8 * j; const LAS float* s = scr + (8 * c) * 33 + n;
        if constexpr (F8OUT) { u32x2 o; o.x = cvt8(s[0 * 33], s[1 * 33], s[2 * 33], s[3 * 33]); o.y = cvt8(s[4 * 33], s[5 * 33], s[6 * 33], s[7 * 33]);
            *(u32x2*)((unsigned char*)WTv + (size_t)rm(n0 + n) * K + k0 + 8 * c) = o; }
        else { u32x4 o; o.x = pk2(s[0 * 33], s[1 * 33]); o.y = pk2(s[2 * 33], s[3 * 33]); o.z = pk2(s[4 * 33], s[5 * 33]); o.w = pk2(s[6 * 33], s[7 * 33]);
            *(u32x4*)((bf16*)WTv + (size_t)rm(n0 + n) * K + k0 + 8 * c) = o; } }
    LDS_WAIT(); asm volatile("" ::: "memory");
}
struct RmId { __device__ __forceinline__ int operator()(int n) const { return n; } };
struct RmGu { __device__ __forceinline__ int operator()(int n) const { const int up = n >> 10, j = n & 1023; return 256 * (j >> 7) + 128 * up + (j & 127); } };

__device__ __forceinline__ void rms_row_to_bf16(const float* xrow, const float* g, bf16* orow, int lane) {
    const f32x4* xr = (const f32x4*)xrow + lane; const f32x4* gr = (const f32x4*)g + lane;
    f32x4 v[4]; float s = 0.f;
#pragma unroll
    for (int j = 0; j < 4; ++j) { v[j] = xr[64 * j]; s += (v[j].x * v[j].x + v[j].y * v[j].y) + (v[j].z * v[j].z + v[j].w * v[j].w); }
    const float r = 1.f / sqrtf(wave_sum(s) * (1.f / D) + NORM_EPS);
    u32x2* o8 = (u32x2*)orow + lane;
#pragma unroll
    for (int j = 0; j < 4; ++j) { const f32x4 gg = gr[64 * j]; u32x2 w; w.x = pk2(v[j].x * r * gg.x, v[j].y * r * gg.y); w.y = pk2(v[j].z * r * gg.z, v[j].w * r * gg.w); o8[64 * j] = w; }
}
__device__ __forceinline__ int t5_bucket(int rel) {
    const int n = rel < 0 ? -rel : rel; int b;
    if (n < 8) b = n; else { const int n2 = n * n; b = n2 >= 8192 ? 15 : n2 >= 4096 ? 14 : n2 >= 2048 ? 13 : n2 >= 1024 ? 12 : n2 >= 512 ? 11 : n2 >= 256 ? 10 : n2 >= 128 ? 9 : 8; }
    return (rel > 0 ? 16 : 0) + b;
}
__device__ __forceinline__ void p0_prologue(const Args& a, LAS unsigned char* lds, int vcu, int G, int wave, int lane) {
    unsigned char* ws = a.ws;
    LAS float* scr = (LAS float*)(lds + wave * 16384);
    const int gw = vcu * NWAVES + wave, NGW = G * NWAVES;
    const float* ffn_g = a.in[14];
    constexpr int I_IN = 16 * 62, I_UQ = 4 * 24, I_UKV = 2 * 32, I_O = 16 * 32, I_GU1 = 16 * 64, I_GU = NE * I_GU1, I_D1 = 16 * 32, I_D = NE * I_D1;
    constexpr int NITEMS = I_IN + I_UQ + I_UKV + I_O + I_GU + I_D;
    for (int it = gw; it < NITEMS; it += NGW) {
        int r = it;
        if (r < I_GU) { const int e = r / I_GU1; transpose_item<true>(a.in[17] + (size_t)e * 1024 * 2048, 1024, 2048, ws + WS_WGU8 + (size_t)e * 2048 * 1024, scr, r % I_GU1, lane, ffn_g, RmGu{}); continue; } r -= I_GU;
        if (r < I_D) { const int e = r / I_D1; transpose_item<true>(a.in[19] + (size_t)e * 1024 * 1024, 1024, 1024, ws + WS_WD8 + (size_t)e * 1024 * 1024, scr, r % I_D1, lane, nullptr, RmId{}); continue; } r -= I_D;
        if (r < I_IN) { transpose_item<false>(a.in[3], 1024, IN_COLS, (bf16*)(ws + WS_WIN), scr, r, lane, nullptr, RmId{}); continue; } r -= I_IN;
        if (r < I_O) { transpose_item<false>(a.in[13], 1024, 1024, (bf16*)(ws + WS_WO), scr, r, lane, nullptr, RmId{}); continue; } r -= I_O;
        if (r < I_UQ) { transpose_item<false>(a.in[10], 256, 768, (bf16*)(ws + WS_WUQ), scr, r, lane, nullptr, RmId{}); continue; } r -= I_UQ;
        transpose_item<false>(a.in[12], 128, 1024, (bf16*)(ws + WS_WUKV), scr, r, lane, nullptr, RmId{});
    }
    const int gt = gw * 64 + lane, NGT = NGW * 64;
    for (int i = gt; i < 64 * 1024 / 8; i += NGT) *((u32x4*)((bf16*)(ws + WS_WIN) + (size_t)IN_COLS * 1024) + i) = (u32x4){0u, 0u, 0u, 0u};
    for (int i = gt; i < 1024 * NE; i += NGT) { const int k = i >> 5, e = i & 31; const float w = a.in[15][i] * ffn_g[k];
        const unsigned h = pk2(w, 0.f) & 0xffffu; const float wl = w - bf2f((unsigned short)h);
        ((bf16*)(ws + WS_WRH))[e * 1024 + k] = (bf16)h; ((bf16*)(ws + WS_WRL))[e * 1024 + k] = (bf16)(pk2(wl, 0.f) & 0xffffu); }
    for (int i = gt; i < SEQ * 32; i += NGT) { const int pos = i >> 5, fi = i & 31;
        const float inv = (float)::exp2(-(double)fi * (13.287712379549449 / 32.0)); const float ang = (float)pos * inv;
        double tt = (double)ang * 0.15915494309189535; tt -= __builtin_rint(tt); const double rr = tt * 6.283185307179586, r2 = rr * rr;
        double cs_ = 1.0, sn = rr, term_c = 1.0, term_s = rr;
#pragma unroll
        for (int k = 1; k <= 13; ++k) { term_c *= -r2 / (double)((2 * k - 1) * (2 * k)); term_s *= -r2 / (double)((2 * k) * (2 * k + 1)); cs_ += term_c; sn += term_s; }
        ((f32x2*)(ws + WS_ROPE))[i] = (f32x2){(float)cs_, (float)sn}; }
    for (int i = gt; i < 8 * 4096; i += NGT) { const int m = i >> 12, d = i & 4095; ((float*)(ws + WS_BIAS))[i] = d < 4095 ? a.in[1][t5_bucket(d - 2047) * 8 + m] * LOG2E : 0.f; }
    if (gw == 0) { const float s1 = wave_sum(a.in[4][lane] * a.in[5][lane]), s2 = wave_sum(a.in[6][lane] * a.in[7][lane]);
        if (lane == 0) *(float*)(ws + WS_LAM) = __expf(s1) - __expf(s2) + 0.2f; }
    for (int m = gw; m < T; m += 2 * NGW) {
        const int m2 = m + NGW < T ? m + NGW : m;
        const f32x4* xr0 = (const f32x4*)(a.in[0] + (size_t)m * D) + lane; const f32x4* xr1 = (const f32x4*)(a.in[0] + (size_t)m2 * D) + lane; const f32x4* gr = (const f32x4*)a.in[2] + lane;
        f32x4 v0[4], v1[4]; float s0 = 0.f, s1 = 0.f;
#pragma unroll
        for (int j = 0; j < 4; ++j) { v0[j] = xr0[64 * j]; v1[j] = xr1[64 * j]; }
#pragma unroll
        for (int j = 0; j < 4; ++j) { s0 += (v0[j].x * v0[j].x + v0[j].y * v0[j].y) + (v0[j].z * v0[j].z + v0[j].w * v0[j].w); s1 += (v1[j].x * v1[j].x + v1[j].y * v1[j].y) + (v1[j].z * v1[j].z + v1[j].w * v1[j].w); }
        const float r0 = 1.f / sqrtf(wave_sum(s0) * (1.f / D) + NORM_EPS), r1 = 1.f / sqrtf(wave_sum(s1) * (1.f / D) + NORM_EPS);
        u32x2* o0 = (u32x2*)((bf16*)(ws + WS_XB) + (size_t)m * D) + lane; u32x2* o1 = (u32x2*)((bf16*)(ws + WS_XB) + (size_t)m2 * D) + lane;
#pragma unroll
        for (int j = 0; j < 4; ++j) { const f32x4 gg = gr[64 * j]; u32x2 w;
            w.x = pk2(v0[j].x * r0 * gg.x, v0[j].y * r0 * gg.y); w.y = pk2(v0[j].z * r0 * gg.z, v0[j].w * r0 * gg.w); o0[64 * j] = w;
            w.x = pk2(v1[j].x * r1 * gg.x, v1[j].y * r1 * gg.y); w.y = pk2(v1[j].z * r1 * gg.z, v1[j].w * r1 * gg.w); o1[64 * j] = w; }
    }
}

__device__ __forceinline__ void p1b_latent(const Args& a, int vcu, int G, int wave, int lane) {
    unsigned char* ws = a.ws; const int gw = vcu * NWAVES + wave, NGW = G * NWAVES;
    const float* gq = a.in[9]; const float* gkv = a.in[11];
    float gl[8];
#pragma unroll
    for (int j = 0; j < 8; ++j) gl[j] = lane < 32 ? gq[8 * lane + j] : (lane < 48 ? gkv[8 * (lane - 32) + j] : 1.f);
    constexpr int R = 4;
    for (int t0 = gw; t0 < T; t0 += R * NGW) {
        bf16x8 v[R];
#pragma unroll
        for (int q = 0; q < R; ++q) { const int t = t0 + q * NGW; v[q] = (bf16x8){0, 0, 0, 0, 0, 0, 0, 0};
            if (lane < 56 && t < T) v[q] = *(const bf16x8*)((const bf16*)(ws + WS_PROJ) + (size_t)t * PROJ_LD + 1536 + 8 * lane); }
#pragma unroll
        for (int q = 0; q < R; ++q) { const int t = t0 + q * NGW; if (t >= T) break;
            float f[8], sq = 0.f;
#pragma unroll
            for (int j = 0; j < 8; ++j) { f[j] = bf2f((unsigned short)v[q][j]); sq += f[j] * f[j]; }
            const float sq_q = wave_sum(lane < 32 ? sq : 0.f), sq_kv = wave_sum((lane >= 32 && lane < 48) ? sq : 0.f);
            const float rq = 1.f / sqrtf(sq_q * (1.f / 256.f) + NORM_EPS), rkv = 1.f / sqrtf(sq_kv * (1.f / 128.f) + NORM_EPS);
            float part[8];
#pragma unroll
            for (int j = 0; j < 8; ++j) part[j] = __shfl_xor(f[j], 4);
            float o[8];
            if (lane < 48) { const float rr = lane < 32 ? rq : rkv;
#pragma unroll
                for (int j = 0; j < 8; ++j) o[j] = f[j] * rr * gl[j];
            } else {
                const int aa = lane - 48; const f32x2* cp = (const f32x2*)(ws + WS_ROPE) + (size_t)(t & (SEQ - 1)) * 32 + 8 * (aa & 3);
#pragma unroll
                for (int j = 0; j < 8; ++j) { const f32x2 c = lane < 56 ? cp[j] : (f32x2){0.f, 0.f};
                    o[j] = (aa < 4) ? (f[j] * c.x - part[j] * c.y) : (part[j] * c.y + f[j] * c.x); }
            }
            u32x4 w; w.x = pk2(o[0], o[1]); w.y = pk2(o[2], o[3]); w.z = pk2(o[4], o[5]); w.w = pk2(o[6], o[7]);
            if (lane < 32) *(u32x4*)((bf16*)(ws + WS_CQN) + (size_t)t * 256 + 8 * lane) = w;
            else if (lane < 48) *(u32x4*)((bf16*)(ws + WS_CKVN) + (size_t)t * 128 + 8 * (lane - 32)) = w;
            else if (lane < 56) *(u32x4*)((bf16*)(ws + WS_KPE) + (size_t)t * 64 + 8 * (lane - 48)) = w;
        }
    }
}

template <int WHICH  >
__device__ __forceinline__ void p2_attention(const Args& a, LAS unsigned char* lds, int vcu, int G, int wave) {
    unsigned char* ws = a.ws;
    const int tid = threadIdx.x, wid = tid >> 6, lane = tid & 63, r32 = lane & 31, hi = lane >> 5;
    const bf16* proj = (const bf16*)(ws + WS_PROJ); bf16* mixed = (bf16*)(ws + WS_MIXED);
    const float lam = *(const float*)(ws + WS_LAM);
    if constexpr (WHICH & 1) {
        const float C = 0.125f * LOG2E;
        float sg[4];
#pragma unroll
        for (int d0 = 0; d0 < 4; ++d0) sg[d0] = a.in[8][32 * d0 + r32] * 0.8f;
        LAS unsigned* stash = (LAS unsigned*)(lds + att::OFF_STASH) + (wid * 32) * 64 + lane;
        for (int it = 0;; ++it) {
            const int u = (it >> 1) * G + vcu, j = it & 1; if (u >= NB * 4 * 8) break;
            const int qb = u & 7, h = (u >> 3) & 3, b = u >> 5, q0 = qb * 256, mp = 2 * h + j;
            { const float* src = (const float*)(ws + WS_BIAS) + mp * 4096; LAS float* lut = (LAS float*)(lds + att::OFF_LUT);
#pragma unroll
              for (int i = 0; i < 8; ++i) lut[tid + 512 * i] = src[tid + 512 * i]; }
            const bf16* base = proj + (size_t)b * SEQ * PROJ_LD;
            f32x16 o[4];
            att::attn_unit<1>(base + (size_t)q0 * PROJ_LD + 64 * mp, PROJ_LD, base + 512 + 64 * mp, PROJ_LD, nullptr, base + 1024 + 128 * h, PROJ_LD, SEQ,
                                 (LAS char*)lds, C, nullptr, q0, o, wave, lane);
            if (j == 0) {
#pragma unroll
                for (int d0 = 0; d0 < 4; ++d0)
#pragma unroll
                    for (int r = 0; r < 16; r += 2) stash[(d0 * 8 + (r >> 1)) * 64] = pk2(o[d0][r], o[d0][r + 1]);
            } else {
                bf16* orow = mixed + (size_t)(b * SEQ + q0 + wid * 32) * D + 128 * h + r32;
#pragma unroll
                for (int rp = 0; rp < 8; ++rp) {
                    float v[2][4], ss[2] = {0.f, 0.f};
#pragma unroll
                    for (int d0 = 0; d0 < 4; ++d0) { const unsigned w = stash[(d0 * 8 + rp) * 64];
                        v[0][d0] = bf2f((unsigned short)(w & 0xffffu)) - lam * o[d0][2 * rp]; v[1][d0] = bf2f((unsigned short)(w >> 16)) - lam * o[d0][2 * rp + 1];
                        ss[0] += v[0][d0] * v[0][d0]; ss[1] += v[1][d0] * v[1][d0]; }
#pragma unroll
                    for (int q = 0; q < 2; ++q) {
#pragma unroll
                        for (int sft = 1; sft < 32; sft <<= 1) ss[q] += __shfl_xor(ss[q], sft);
                        const float rn = 1.f / sqrtf(ss[q] * (1.f / 128.f) + NORM_EPS);
                        bf16* op = orow + (size_t)att::crow(2 * rp + q, hi) * D;
#pragma unroll
                        for (int d0 = 0; d0 < 4; ++d0) op[32 * d0] = (bf16)(pk2(v[q][d0] * rn * sg[d0], 0.f) & 0xffffu);
                    }
                }
            }
        }
    }
    if constexpr (WHICH & 2) {
        const float C = 0.07216878364870322f * LOG2E;
        for (int it = 0;; ++it) {
            const int u = it * G + vcu; if (u >= NB * 4 * 8) break;
            const int qb = u & 7, h = (u >> 3) & 3, b = u >> 5, q0 = qb * 256;
            const bf16* qm = (const bf16*)(ws + WS_QM) + (size_t)(b * SEQ + q0) * 768 + 192 * h;
            const bf16* kv = (const bf16*)(ws + WS_KV) + (size_t)b * SEQ * 1024 + 256 * h;
            const bf16* kpe = (const bf16*)(ws + WS_KPE) + (size_t)b * SEQ * 64;
            f32x16 o[4];
            att::attn_unit<0>(qm, 768, kv, 1024, kpe, kv + 128, 1024, SEQ, (LAS char*)lds, C, (const att::f32x2*)(ws + WS_ROPE), q0, o, wave, lane);
            bf16* orow = mixed + (size_t)(b * SEQ + q0 + wid * 32) * D + 512 + 128 * h + r32;
#pragma unroll
            for (int r = 0; r < 16; ++r) { bf16* op = orow + (size_t)att::crow(r, hi) * D;
#pragma unroll
                for (int d0 = 0; d0 < 4; ++d0) op[32 * d0] = (bf16)(pk2(o[d0][r], 0.f) & 0xffffu); }
        }
    }
}

constexpr int WR_PITCH = 2064;
__device__ __forceinline__ void p3b_router(const Args& a, LAS unsigned char* lds, int G, int wave) {
    unsigned char* ws = a.ws;
    const int wid = wave, lane = hw_lane(), tid = wid * 64 + lane, r32 = lane & 31, hi = lane >> 5;
    LAS unsigned char* wrh = lds; LAS unsigned char* wrl = lds + 32 * WR_PITCH; LAS unsigned* cnt = (LAS unsigned*)(lds + 64 * WR_PITCH);
    for (int i = tid; i < 2 * 32 * 128; i += NTHREADS) { const int tb = i >> 12, e = (i >> 7) & 31, c = i & 127;
        *(LAS u32x4*)(lds + (tb * 32 + e) * WR_PITCH + c * 16) = *((const u32x4*)(ws + (tb ? WS_WRL : WS_WRH)) + e * 128 + c); }
    const float* x1 = a.out; unsigned char* xb = ws + WS_XB8;
    for (int c = blockIdx.x; c < T / 256; c += G) {
        if (tid < 32) cnt[tid] = 0u;
        __syncthreads();
        const int t = c * 256 + wid * 32 + r32;
        const float* xr = x1 + (size_t)t * D + 64 * hi; unsigned char* xo = xb + (size_t)t * D + 64 * hi;
        f32x16 acc = f32x16{}; float ss = 0.f;
        for (int sg = 0; sg < 8; ++sg) {
            f32x4 v[16];
#pragma unroll
            for (int q = 0; q < 16; ++q) v[q] = *(const f32x4*)(xr + 128 * sg + 4 * q);
#pragma unroll
            for (int j = 0; j < 8; ++j) {
                const f32x4 x0 = v[2 * j], x1v = v[2 * j + 1];
                ss += (x0.x * x0.x + x0.y * x0.y) + (x0.z * x0.z + x0.w * x0.w) + (x1v.x * x1v.x + x1v.y * x1v.y) + (x1v.z * x1v.z + x1v.w * x1v.w);
                u32x4 hw; hw.x = pk2(x0.x, x0.y); hw.y = pk2(x0.z, x0.w); hw.z = pk2(x1v.x, x1v.y); hw.w = pk2(x1v.z, x1v.w);
                u32x4 lw;
                lw.x = pk2(x0.x - __uint_as_float(hw.x << 16), x0.y - __uint_as_float(hw.x & 0xffff0000u)); lw.y = pk2(x0.z - __uint_as_float(hw.y << 16), x0.w - __uint_as_float(hw.y & 0xffff0000u));
                lw.z = pk2(x1v.x - __uint_as_float(hw.z << 16), x1v.y - __uint_as_float(hw.z & 0xffff0000u)); lw.w = pk2(x1v.z - __uint_as_float(hw.w << 16), x1v.w - __uint_as_float(hw.w & 0xffff0000u));
                { u32x2 w8; w8.x = cvt8(x0.x * SC_X, x0.y * SC_X, x0.z * SC_X, x0.w * SC_X); w8.y = cvt8(x1v.x * SC_X, x1v.y * SC_X, x1v.z * SC_X, x1v.w * SC_X); *(u32x2*)(xo + 128 * sg + 8 * j) = w8; }
                const int kb = (128 * sg + 64 * hi + 8 * j) * 2;
                const bf16x8 wh = *(const LAS bf16x8*)(wrh + r32 * WR_PITCH + kb), wl = *(const LAS bf16x8*)(wrl + r32 * WR_PITCH + kb);
                const bf16x8 xh = __builtin_bit_cast(bf16x8, hw), xl = __builtin_bit_cast(bf16x8, lw);
                acc = __builtin_amdgcn_mfma_f32_32x32x16_bf16(wh, xh, acc, 0, 0, 0);
                acc = __builtin_amdgcn_mfma_f32_32x32x16_bf16(wh, xl, acc, 0, 0, 0);
                acc = __builtin_amdgcn_mfma_f32_32x32x16_bf16(wl, xh, acc, 0, 0, 0);
            }
        }
        ss += __shfl_xor(ss, 32);
        const float rinv = 1.f / sqrtf(ss * (1.f / D) + NORM_EPS);
        if (hi == 0) ((float*)(ws + WS_RINV))[t] = rinv;
        float lg[16];
#pragma unroll
        for (int r = 0; r < 16; ++r) lg[r] = acc[r] * rinv + a.in[16][att::crow(r, hi)];
        float tv[4]; int ti[4];
#pragma unroll
        for (int k = 0; k < 4; ++k) {
            float bv = lg[0]; int bi = att::crow(0, hi);
#pragma unroll
            for (int r = 1; r < 16; ++r) { const int e = att::crow(r, hi); if (lg[r] > bv) { bv = lg[r]; bi = e; } }
            const float ov = __shfl_xor(bv, 32); const int oi = __shfl_xor(bi, 32);
            const bool mine = (bv > ov) || (bv == ov && bi < oi);
            tv[k] = mine ? bv : ov; ti[k] = mine ? bi : oi;
#pragma unroll
            for (int r = 0; r < 16; ++r) if (att::crow(r, hi) == ti[k]) lg[r] = -3.0e38f;
        }
        const float e1 = __expf(tv[1] - tv[0]), e2 = __expf(tv[2] - tv[0]), e3 = __expf(tv[3] - tv[0]), rs = 1.f / (1.f + e1 + e2 + e3);
        if (hi == 0) {
            int lr[4];
#pragma unroll
            for (int k = 0; k < 4; ++k) lr[k] = (int)__hip_atomic_fetch_add(cnt + ti[k], 1u, __ATOMIC_RELAXED, __HIP_MEMORY_SCOPE_WORKGROUP);
            *((int4*)(ws + WS_EIDX) + t) = make_int4(ti[0], ti[1], ti[2], ti[3]);
            *((f32x4*)(ws + WS_GATE) + t) = (f32x4){rs, e1 * rs, e2 * rs, e3 * rs};
            *((int4*)(ws + WS_LRANK) + t) = make_int4(lr[0], lr[1], lr[2], lr[3]);
        }
        __syncthreads();
        if (tid < 32) ((int*)(ws + WS_HIST))[c * 32 + tid] = (int)cnt[tid];
        __syncthreads();
    }
}

__device__ __forceinline__ void p4_scatter(const Args& a, LAS unsigned char* lds, int G, int wave) {
    unsigned char* ws = a.ws; const int tid = wave * 64 + hw_lane();
    LAS int* hist = (LAS int*)lds;
    LAS int* cntE = hist + 256 * 32;
    LAS int* pst = cntE + 32;
    for (int i = tid; i < 256 * 32; i += NTHREADS) hist[i] = ((const int*)(ws + WS_HIST))[i];
    __syncthreads();
    if (tid < 32) { int run = 0;
        for (int c = 0; c < 256; ++c) { const int v = hist[c * 32 + tid]; hist[c * 32 + tid] = run; run += v; }
        cntE[tid] = run; }
    __syncthreads();
    if (tid < 32) { int s = 0;
        for (int q = 0; q < tid; ++q) s += (cntE[q] + 255) & ~255;
        pst[tid] = s; }
    __syncthreads();
    int* rowa = (int*)(ws + WS_ROWA); float* rowg = (float*)(ws + WS_ROWG);
    for (int c = blockIdx.x; c < T / 256; c += G) {
        for (int i = tid; i < 1024; i += NTHREADS) { const int asg = c * 1024 + i; const int e = ((const int*)(ws + WS_EIDX))[asg];
            const int p = pst[e] + hist[c * 32 + e] + ((const int*)(ws + WS_LRANK))[asg];
            rowa[p] = asg; rowg[p] = ((const float*)(ws + WS_GATE))[asg]; } }
    if (blockIdx.x == 0 && tid < 32) { const int e = tid; const int n = cntE[e], st = pst[e], pad = (n + 255) & ~255;
        for (int p = st + n; p < st + pad; ++p) { rowa[p] = -1; rowg[p] = 0.f; }
        int* tinfo = (int*)(ws + WS_TINFO);
        for (int tt = st >> 8; tt < (st + pad) >> 8; ++tt) tinfo[tt] = e;
        if (e == 31) tinfo[2048] = (st + pad) >> 8; }
}

struct MoeOrder {
    const int* tinfo; const int* rowa; int ntiles, nN, lgN, G, c;
    __device__ __forceinline__ bool next(int i, pg8::Unit& u) const {
        const int L = i * G + c; if (L >= ntiles * nN) return false;
        const int tile = L >> lgN, pn = L & (nN - 1); const int e = tinfo[tile]; u.pm = tile; u.pn = e * nN + pn; return true;
    }
    __device__ __forceinline__ int gather_row(const pg8::Unit& u, int i) const { const int as = rowa[u.pm * 256 + i]; return as < 0 ? 0 : (as >> 2); }
};
struct EpiSwiglu {
    static constexpr bool PERM = true;
    unsigned char* act; const float* rinv; const int* rowa; const float* bgu;
    __device__ __forceinline__ void operator()(const pg8::f32x4 (&acc)[2][2][4][2], const pg8::Unit& u, int wr, int wc, int fr, int fq) const {
        const int e = u.pn >> 3, pn = u.pn & 7, col0 = 128 * pn + 32 * wc + 8 * fq;
        const float* bp = bgu + (size_t)e * 2048 + col0;
        f32x4 bg[2], bu[2];
#pragma unroll
        for (int n = 0; n < 2; ++n) { bg[n] = *(const f32x4*)(bp + 4 * n); bu[n] = *(const f32x4*)(bp + 1024 + 4 * n); }
#pragma unroll
        for (int ai = 0; ai < 2; ++ai)
#pragma unroll
            for (int m = 0; m < 4; ++m) {
                const int p = u.pm * 256 + ai * 128 + wr * 64 + m * 16 + fr; const int as = rowa[p]; const float ri = rinv[as < 0 ? 0 : (as >> 2)] * (1.f / (SC_W * SC_X));
                float o[8];
#pragma unroll
                for (int n = 0; n < 2; ++n)
#pragma unroll
                    for (int q = 0; q < 4; ++q) {
                        float g = fminf(acc[ai][0][m][n][q] * ri + bg[n][q], 7.f); const float up = fminf(fmaxf(acc[ai][1][m][n][q] * ri + bu[n][q], -7.f), 7.f);
                        const float sg = __builtin_amdgcn_rcpf(1.f + __builtin_amdgcn_exp2f(g * (-1.702f * LOG2E)));
                        o[4 * n + q] = (up + 1.f) * (g * sg) * SC_A; }
                u32x2 w; w.x = cvt8(o[0], o[1], o[2], o[3]); w.y = cvt8(o[4], o[5], o[6], o[7]);
                *(u32x2*)(act + (size_t)p * 1024 + col0) = w; }
    }
};
struct EpiDown {
    static constexpr bool PERM = true;
    bf16* y4a; bf16* y4b; const int* rowa; const float* rowg; const float* bd;
    __device__ __forceinline__ void operator()(const pg8::f32x4 (&acc)[2][2][4][2], const pg8::Unit& u, int wr, int wc, int fr, int fq) const {
        const int e = u.pn >> 2, pn = u.pn & 3, col0 = 256 * pn + 32 * wc + 8 * fq;
        const float* bp = bd + (size_t)e * 1024 + col0;
        f32x4 bv[2][2];
#pragma unroll
        for (int bj = 0; bj < 2; ++bj)
#pragma unroll
            for (int n = 0; n < 2; ++n) bv[bj][n] = *(const f32x4*)(bp + 128 * bj + 4 * n);
#pragma unroll
        for (int ai = 0; ai < 2; ++ai)
#pragma unroll
            for (int m = 0; m < 4; ++m) {
                const int p = u.pm * 256 + ai * 128 + wr * 64 + m * 16 + fr; const int as = rowa[p];
                if (as >= 0) { const float gt = rowg[p]; bf16* yr = (as < HALF_A ? y4a + (size_t)as * 1024 : y4b + (size_t)(as - HALF_A) * 1024) + col0;
#pragma unroll
                    for (int bj = 0; bj < 2; ++bj) { const f32x4 v0 = (acc[ai][bj][m][0] * (1.f / (SC_W * SC_A)) + bv[bj][0]) * gt, v1 = (acc[ai][bj][m][1] * (1.f / (SC_W * SC_A)) + bv[bj][1]) * gt;
                        u32x4 w; w.x = pk2(v0[0], v0[1]); w.y = pk2(v0[2], v0[3]); w.z = pk2(v1[0], v1[1]); w.w = pk2(v1[2], v1[3]);
                        *(u32x4*)(yr + 128 * bj) = w; } } }
    }
};

__device__ __forceinline__ void p7_final(const Args& a, int vcu, int G, int wave, int lane) {
    unsigned char* ws = a.ws; const int gw = vcu * NWAVES + wave, NGW = G * NWAVES;
    const f32x4* gr = (const f32x4*)a.in[21] + lane;
    for (int t = gw; t < T; t += NGW) {
        f32x4* xr = (f32x4*)(a.out + (size_t)t * D) + lane;
        const u32x2* yr = (const u32x2*)((t < HALF_T ? (const bf16*)(ws + WS_Y4A) + (size_t)t * 4 * D : (const bf16*)(ws + WS_Y4B) + (size_t)(t - HALF_T) * 4 * D)) + lane;
        f32x4 v[4]; float s = 0.f;
#pragma unroll
        for (int j = 0; j < 4; ++j) { v[j] = xr[64 * j];
#pragma unroll
            for (int k = 0; k < 4; ++k) { const u32x2 w = yr[k * 256 + 64 * j];
                v[j].x += __uint_as_float(w.x << 16); v[j].y += __uint_as_float(w.x & 0xffff0000u); v[j].z += __uint_as_float(w.y << 16); v[j].w += __uint_as_float(w.y & 0xffff0000u); }
            s += (v[j].x * v[j].x + v[j].y * v[j].y) + (v[j].z * v[j].z + v[j].w * v[j].w); }
        const float r = 1.f / sqrtf(wave_sum(s) * (1.f / D) + NORM_EPS);
#pragma unroll
        for (int j = 0; j < 4; ++j) { const f32x4 gg = gr[64 * j]; xr[64 * j] = (f32x4){v[j].x * r * gg.x, v[j].y * r * gg.y, v[j].z * r * gg.z, v[j].w * r * gg.w}; }
    }
}

constexpr int N_PHASES = 11;
__global__ void __launch_bounds__(NTHREADS, 2) fwd(Args args) {
    extern __shared__ __attribute__((aligned(16))) unsigned char lds_raw[];
    LAS unsigned char* lds = (LAS unsigned char*)lds_raw;
    volatile LAS unsigned* MISC = (volatile LAS unsigned*)(lds + MISC_OFF);
    const int wave = __builtin_amdgcn_readfirstlane((int)threadIdx.x >> 6);
    const int G = gridDim.x; const int bx = blockIdx.x; const int vcu = (G % 8 == 0) ? (bx % 8) * (G / 8) + bx / 8 : bx;
    unsigned char* ws = args.ws;
    for (int u = wave * 64 + hw_lane(); u < (LDS_BYTES - MISC_OFF) / 4; u += NTHREADS) MISC[u] = 0u;
    __syncthreads();
    const int lo = args.ph_lo, hi = args.ph_hi;
    const bool use_bar = (hi - lo) > 1;
    XcdBarrier bar; bar.bar = (unsigned*)(ws + WS_CTL); bar.x = 0; bar.st = nullptr;
    if (use_bar) bar = xcd_barrier_post((unsigned*)(ws + WS_CTL), MISC + 8, (unsigned)wave);
#ifdef ONLY_PHASE
#define IN(k) ((k) == ONLY_PHASE)
#else
#define IN(k) (lo <= (k) && (k) < hi)
#endif
#define SEAM(k) do { if (IN(k) && IN((k) + 1)) xcd_barrier(bar); } while (0)

    if (IN(0)) { p0_prologue(args, lds, vcu, G, wave, hw_lane()); }
    SEAM(0);
    if (IN(1)) {
        pg8::Gemm g{(const bf16*)(ws + WS_XB), (const bf16*)(ws + WS_WIN), T, PROJ_LD, D}; pg8::StaticOrder S; S.init(T, PROJ_LD, G, bx);
        pg8::EpiBf16 E{(bf16*)(ws + WS_PROJ), PROJ_LD};
        pg8::gemm_phase<pg8::EpiBf16, pg8::StaticOrder, true, false>(lds, g, S, E, wave);
    }
    SEAM(1);
    if (IN(2)) { p1b_latent(args, vcu, G, wave, hw_lane()); }
    SEAM(2);
    if (IN(3)) {
        { pg8::Gemm g{(const bf16*)(ws + WS_CQN), (const bf16*)(ws + WS_WUQ), T, 768, 256}; pg8::StaticOrder S; S.init(T, 768, G, bx);
          pg8::EpiBf16 E{(bf16*)(ws + WS_QM), 768}; pg8::gemm_phase<pg8::EpiBf16, pg8::StaticOrder, true, false>(lds, g, S, E, wave); }
        { pg8::Gemm g{(const bf16*)(ws + WS_CKVN), (const bf16*)(ws + WS_WUKV), T, 1024, 128}; pg8::StaticOrder S; S.init(T, 1024, G, bx);
          pg8::EpiBf16 E{(bf16*)(ws + WS_KV), 1024}; pg8::gemm_phase<pg8::EpiBf16, pg8::StaticOrder, true, false>(lds, g, S, E, wave); }
    }
    SEAM(3);
    if (IN(4)) { p2_attention<3>(args, lds, vcu, G, wave); }
    SEAM(4);
    if (IN(5)) {
        pg8::Gemm g{(const bf16*)(ws + WS_MIXED), (const bf16*)(ws + WS_WO), T, D, D}; pg8::StaticOrder S; S.init(T, D, G, bx);
        pg8::EpiResid E{args.in[0], args.out, D};
        pg8::gemm_phase<pg8::EpiResid, pg8::StaticOrder, true, false>(lds, g, S, E, wave);
    }
    SEAM(5);
    if (IN(6)) { p3b_router(args, lds, G, wave); }
    SEAM(6);
    if (IN(7)) { p4_scatter(args, lds, G, wave); }
    SEAM(7);
    if (IN(8)) {
        const int* tinfo = (const int*)(ws + WS_TINFO); MoeOrder S{tinfo, (const int*)(ws + WS_ROWA), tinfo[2048], 8, 3, G, bx};
        pg8::Gemm g{(const bf16*)(ws + WS_XB8), (const bf16*)(ws + WS_WGU8), 0, 2048, D / 2};
        EpiSwiglu E{ws + WS_ACT8, (const float*)(ws + WS_RINV), (const int*)(ws + WS_ROWA), args.in[18]};
        pg8::gemm_phase<EpiSwiglu, MoeOrder, true, true, true>(lds, g, S, E, wave);
    }
    SEAM(8);
    if (IN(9)) {
        const int* tinfo = (const int*)(ws + WS_TINFO); MoeOrder S{tinfo, (const int*)(ws + WS_ROWA), tinfo[2048], 4, 2, G, bx};
        pg8::Gemm g{(const bf16*)(ws + WS_ACT8), (const bf16*)(ws + WS_WD8), 0, 1024, D / 2};
        EpiDown E{(bf16*)(ws + WS_Y4A), (bf16*)(ws + WS_Y4B), (const int*)(ws + WS_ROWA), (const float*)(ws + WS_ROWG), args.in[20]};
        pg8::gemm_phase<EpiDown, MoeOrder, true, false, true>(lds, g, S, E, wave);
    }
    SEAM(9);
    if (IN(10)) { p7_final(args, vcu, G, wave, hw_lane()); }
#ifdef PROBE_EXTRA
    if (IN(11)) { p2_attention<1>(args, lds, vcu, G, wave); }
    if (IN(12)) { p2_attention<2>(args, lds, vcu, G, wave); }
#endif
#undef IN
#undef SEAM
}

#ifndef MK_N_LAUNCHES
#define MK_N_LAUNCHES 1
#endif
extern "C" void kernel_launch(void* const* d_in, const int* in_sizes, int n_in, void* d_out, int out_size, void* d_ws, size_t ws_size, hipStream_t stream) {
    static int grid = 0;
    if (grid == 0) {
        if (n_in != 22 || in_sizes[0] != T * D || out_size != T * D || ws_size < WS_END) {
            fprintf(stderr, "kernel_launch: shape / workspace mismatch (n_in %d, in0 %d, out %d, ws %zu < %zu); nothing launched\n", n_in, n_in > 0 ? in_sizes[0] : -1, out_size, ws_size, (size_t)WS_END); grid = -1; return; }
        int dev = 0, cus = 0, per_cu = 0;
        if (hipGetDevice(&dev) != hipSuccess || hipDeviceGetAttribute(&cus, hipDeviceAttributeMultiprocessorCount, dev) != hipSuccess) { grid = -1; return; }
        if (hipFuncSetAttribute((const void*)fwd, hipFuncAttributeMaxDynamicSharedMemorySize, LDS_BYTES) != hipSuccess) { fprintf(stderr, "kernel_launch: hipFuncSetAttribute failed\n"); grid = -1; return; }
        if (hipOccupancyMaxActiveBlocksPerMultiprocessor(&per_cu, (const void*)fwd, NTHREADS, LDS_BYTES) != hipSuccess || per_cu < 1) { fprintf(stderr, "kernel_launch: occupancy query says %d\n", per_cu); }
        (void)hipGetLastError();
        grid = cus;
    }
    if (grid < 0) return;
    if (hipMemsetAsync((char*)d_ws + WS_CTL, 0, CTL_ZERO_BYTES, stream) != hipSuccess) return;
    Args a{};
    for (int i = 0; i < 22; ++i) a.in[i] = (const float*)d_in[i];
    a.out = (float*)d_out; a.ws = (unsigned char*)d_ws;
#if MK_N_LAUNCHES == 1
    a.ph_lo = 0; a.ph_hi = N_PHASES;
    hipLaunchKernelGGL(fwd, dim3(grid), dim3(NTHREADS), LDS_BYTES, stream, a);
#else
#ifndef PROBE_MASK
#define PROBE_MASK 0
#endif
    for (int p = 0; p < N_PHASES; ++p) { a.ph_lo = p; a.ph_hi = p + 1; hipLaunchKernelGGL(fwd, dim3(grid), dim3(NTHREADS), LDS_BYTES, stream, a);
        if ((PROBE_MASK >> p) & 1) hipLaunchKernelGGL(fwd, dim3(grid), dim3(NTHREADS), LDS_BYTES, stream, a);
#ifdef PROBE_EXTRA
        if (p == 4) { a.ph_lo = PROBE_EXTRA; a.ph_hi = PROBE_EXTRA + 1; hipLaunchKernelGGL(fwd, dim3(grid), dim3(NTHREADS), LDS_BYTES, stream, a); }
#endif
    }
#endif
}
```

```cpp
#include <hip/hip_runtime.h>
#include <cstdio>
#include <cstdint>

__device__ __forceinline__ int hw_lane() { int l; asm volatile("v_mbcnt_lo_u32_b32 %0, -1, 0\n\tv_mbcnt_hi_u32_b32 %0, -1, %0" : "=v"(l)); return l; }
namespace pg8 {
#define PG8_LAS __attribute__((address_space(3)))
typedef unsigned short bf16_t;
typedef short bf16x8 __attribute__((ext_vector_type(8)));
typedef float f32x4 __attribute__((ext_vector_type(4)));
typedef unsigned u32x4 __attribute__((ext_vector_type(4)));
typedef unsigned u32x2 __attribute__((ext_vector_type(2)));
typedef int v8i __attribute__((ext_vector_type(8)));
typedef short bf16x16 __attribute__((ext_vector_type(16)));
constexpr int BM = 256, BK = 64, HALF = 128, HTB = HALF * BK * 2  , STAGE_BYTES = 8 * HTB, NXCD = 8, WGM = 8;

__host__ __device__ __forceinline__ int lds_byte(int r, int c) { const int st = (r >> 4) * 2 + (c >> 5), rr = r & 15, cc = c & 31, ob = rr * 64 + cc * 2; return st * 1024 + (ob ^ (((ob >> 9) & 1) << 5)); }
__host__ __device__ __forceinline__ void stage_rc(int b, int& R, int& C) { const int st = b / 1024, sb = b % 1024, swz = sb ^ (((sb >> 9) & 1) << 5); R = (st >> 1) * 16 + swz / 64; C = (st & 1) * 32 + (swz % 64) / 2; }
__host__ __device__ __forceinline__ int perm32(int rho) { const int n = rho >> 4, i = rho & 15; return 8 * (i >> 2) + 4 * n + (i & 3); }

struct Unit { int pm, pn; };
struct Gemm { const bf16_t* A; const bf16_t* Bt; int M, N, K; };

struct StaticOrder {
    int nM, nN, nwg, G, c;
    __host__ __device__ void init(int M, int N, int G_, int c_) { nM = M / BM; nN = N / BM; nwg = nM * nN; G = G_; c = c_; }
    __host__ __device__ bool next(int i, Unit& u) const {
        const long L = (long)i * G + c; if (L >= nwg) return false;
        int wgid = (int)L; { const int q = nwg / NXCD, r = nwg % NXCD, xcd = wgid % NXCD, off = wgid / NXCD; wgid = (xcd < r ? xcd * (q + 1) : r * (q + 1) + (xcd - r) * q) + off; }
        const int nig = WGM * nN, gid = wgid / nig, fm = gid * WGM, gsz = (nM - fm) < WGM ? (nM - fm) : WGM;
        u.pm = fm + ((wgid % nig) % gsz); u.pn = (wgid % nig) / gsz; return true;
    }
    __device__ __forceinline__ int gather_row(const Unit&, int) const { return 0; }
};

__device__ __forceinline__ unsigned cvt_pk_bf16(float lo, float hi) { unsigned r; asm volatile("v_cvt_pk_bf16_f32 %0, %1, %2" : "=v"(r) : "v"(lo), "v"(hi)); return r; }

struct EpiBf16 {
    static constexpr bool PERM = true;
    bf16_t* O; int ldc;
    __device__ __forceinline__ void operator()(const f32x4 (&acc)[2][2][4][2], const Unit& u, int wr, int wc, int fr, int fq) const {
        const int row0 = u.pm * BM + wr * 64 + fr; const int col0 = u.pn * BM + wc * 32 + 8 * fq;
#pragma unroll
        for (int ai = 0; ai < 2; ++ai)
#pragma unroll
            for (int m = 0; m < 4; ++m) { bf16_t* rowp = O + (size_t)(row0 + ai * HALF + m * 16) * ldc + col0;
#pragma unroll
                for (int bj = 0; bj < 2; ++bj) { const f32x4 v0 = acc[ai][bj][m][0], v1 = acc[ai][bj][m][1];
                    u32x4 w; w.x = cvt_pk_bf16(v0[0], v0[1]); w.y = cvt_pk_bf16(v0[2], v0[3]); w.z = cvt_pk_bf16(v1[0], v1[1]); w.w = cvt_pk_bf16(v1[2], v1[3]);
                    *(u32x4*)(rowp + bj * HALF) = w; } }
    }
};
struct EpiResid {
    static constexpr bool PERM = true;
    const float* base; bf16_t* out; int ldc;
    __device__ __forceinline__ void operator()(const f32x4 (&acc)[2][2][4][2], const Unit& u, int wr, int wc, int fr, int fq) const {
        const int row0 = u.pm * BM + wr * 64 + fr; const int col0 = u.pn * BM + wc * 32 + 8 * fq;
#pragma unroll
        for (int ai = 0; ai < 2; ++ai)
#pragma unroll
            for (int m = 0; m < 4; ++m) { const size_t off = (size_t)(row0 + ai * HALF + m * 16) * ldc + col0;
#pragma unroll
                for (int bj = 0; bj < 2; ++bj) { const f32x4 v0 = *(const f32x4*)(base + off + bj * HALF) + acc[ai][bj][m][0], v1 = *(const f32x4*)(base + off + bj * HALF + 4) + acc[ai][bj][m][1];
                    u32x4 w; w.x = cvt_pk_bf16(v0[0], v0[1]); w.y = cvt_pk_bf16(v0[2], v0[3]); w.z = cvt_pk_bf16(v1[0], v1[1]); w.w = cvt_pk_bf16(v1[2], v1[3]);
                    *(u32x4*)(out + off + bj * HALF) = w; } }
    }
};

template <class Epi, class Sched, bool ALIGN_EPI = false, bool GATHER = false, bool F8 = false>
__device__ __forceinline__ void gemm_phase(PG8_LAS unsigned char* lds, const Gemm g, const Sched& S, const Epi& E, int wave) {
    const int wid = wave, lane = hw_lane(), tid = wid * 64 + lane, wr = wid >> 2, wc = wid & 3, fr = lane & 15, fq = lane >> 4;
    const int K = g.K, nt = K / BK;
    unsigned voffA[2], voffB[2]; int RA[2], CA[2];
#pragma unroll
    for (int i = 0; i < 2; ++i) { int R, C; stage_rc(tid * 16 + i * 8192, R, C); const int Rb = Epi::PERM ? ((R & ~31) + perm32(R & 31)) : R;
        voffA[i] = (unsigned)(R * K + C) * 2u; voffB[i] = (unsigned)(Rb * K + C) * 2u; RA[i] = R; CA[i] = C; }
    const size_t kstep = (size_t)(BK * 2);
    const size_t hstep = (size_t)HALF * K * 2;
    const size_t tstep = 2 * hstep;
    const unsigned ldsw = (unsigned)wid * 1024u, ldsu = (unsigned)(uintptr_t)lds;
    const int aoff = lds_byte(wr * 64 + fr, fq * (F8 ? 16 : 8)), boff = lds_byte(wc * 32 + fr, fq * (F8 ? 16 : 8));
    PG8_LAS unsigned char* ldsA = lds + aoff; PG8_LAS unsigned char* ldsB = lds + 4 * HTB + boff;
    if constexpr (F8) { asm volatile("" : "+v"(ldsA)); asm volatile("" : "+v"(ldsB)); }
#define PG8_SA(b, h) (((b) * 2 + (h)) * HTB)
#define PG8_SB(b, h) ((4 + (b) * 2 + (h)) * HTB)
#define PG8_SBR(b, h) (((b) * 2 + (h)) * HTB)
#define PG8_DMA1(ldsaddr, gbase, vo) asm volatile("s_mov_b32 m0, %0\n\ts_nop 0\n\tglobal_load_lds_dwordx4 %1, %2" :: "s"(ldsaddr), "v"(vo), "s"(gbase) : "memory", "m0")
#define PG8_STAGE(bufoff, gbase, voff) do { PG8_DMA1(ldsu + (unsigned)(bufoff) + ldsw, (const char*)(gbase), (voff)[0]); PG8_DMA1(ldsu + (unsigned)(bufoff) + ldsw + 8192u, (const char*)(gbase), (voff)[1]); } while (0)
#define PG8_STAGE_A(bufoff, h, base, O) do { if constexpr (GATHER) { PG8_STAGE(bufoff, base, O[h]); } else { PG8_STAGE(bufoff, (base) + (h) * hstep, voffA); } } while (0)
#define PG8_CAT8(lo, hi) ((v8i){(int)lo.x, (int)lo.y, (int)lo.z, (int)lo.w, (int)hi.x, (int)hi.y, (int)hi.z, (int)hi.w})
#define PG8_LDA(dst, b, h) do { if constexpr (F8) { _Pragma("unroll") for (int m = 0; m < 4; ++m) { const u32x4 lo_ = *(const PG8_LAS u32x4*)(ldsA + PG8_SA(b, h) + m * 2048), hi_ = *(const PG8_LAS u32x4*)(ldsA + PG8_SA(b, h) + m * 2048 + 16); dst##8[m] = PG8_CAT8(lo_, hi_); } } \
    else { _Pragma("unroll") for (int m = 0; m < 4; ++m) _Pragma("unroll") for (int k = 0; k < 2; ++k) dst[m][k] = *(const PG8_LAS bf16x8*)(lds + PG8_SA(b, h) + aoff + m * 2048 + k * 1024); } } while (0)
#define PG8_LDB(dst, b, h) do { if constexpr (F8) { _Pragma("unroll") for (int n = 0; n < 2; ++n) { const u32x4 lo_ = *(const PG8_LAS u32x4*)(ldsB + PG8_SBR(b, h) + n * 2048), hi_ = *(const PG8_LAS u32x4*)(ldsB + PG8_SBR(b, h) + n * 2048 + 16); dst##8[n] = PG8_CAT8(lo_, hi_); } } \
    else { _Pragma("unroll") for (int n = 0; n < 2; ++n) _Pragma("unroll") for (int k = 0; k < 2; ++k) dst[n][k] = *(const PG8_LAS bf16x8*)(lds + PG8_SB(b, h) + boff + n * 2048 + k * 1024); } } while (0)
#define PG8_MMA(ai, bj, At, Bt) do { __builtin_amdgcn_s_setprio(1); if constexpr (F8) { _Pragma("unroll") for (int m = 0; m < 4; ++m) _Pragma("unroll") for (int n = 0; n < 2; ++n) \
            acc[ai][bj][m][n] = __builtin_amdgcn_mfma_scale_f32_16x16x128_f8f6f4(Bt##8[n], At##8[m], acc[ai][bj][m][n], 0, 0, 0, 0x7f7f7f7f, 0, 0x7f7f7f7f); } \
    else { _Pragma("unroll") for (int m = 0; m < 4; ++m) _Pragma("unroll") for (int n = 0; n < 2; ++n) _Pragma("unroll") for (int k = 0; k < 2; ++k) \
        acc[ai][bj][m][n] = __builtin_amdgcn_mfma_f32_16x16x32_bf16(Bt[n][k], At[m][k], acc[ai][bj][m][n], 0, 0, 0); } __builtin_amdgcn_s_setprio(0); } while (0)
#define PG8_WAIT_V(n) asm volatile("s_waitcnt vmcnt(" #n ")" ::: "memory")
#define PG8_WAIT_L(n) asm volatile("s_waitcnt lgkmcnt(" #n ")" ::: "memory")
#define PG8_BAR __builtin_amdgcn_s_barrier()
#define PG8_SCHED __builtin_amdgcn_sched_barrier(0)
    Unit cur, nxt; int ui = 0;
    if (!S.next(0, cur)) return;
    f32x4 acc[2][2][4][2];
#pragma unroll
    for (int a = 0; a < 2; ++a)
#pragma unroll
        for (int b = 0; b < 2; ++b)
#pragma unroll
            for (int m = 0; m < 4; ++m)
#pragma unroll
                for (int n = 0; n < 2; ++n) acc[a][b][m][n] = (f32x4){0.f, 0.f, 0.f, 0.f};
    bf16x8 At[4][2], B0[2][2], B1[2][2]; v8i At8[4], B08[2], B18[2];
    unsigned gC[2][2], gN[2][2];
#pragma unroll
    for (int h = 0; h < 2; ++h)
#pragma unroll
        for (int i = 0; i < 2; ++i) { gC[h][i] = 0u; gN[h][i] = 0u; }
    if constexpr (GATHER) {
#pragma unroll
        for (int h = 0; h < 2; ++h)
#pragma unroll
            for (int i = 0; i < 2; ++i) gC[h][i] = (unsigned)S.gather_row(cur, h * HALF + RA[i]) * (unsigned)(K * 2) + (unsigned)(CA[i] * 2);
    }
    const char* cA = GATHER ? (const char*)g.A : (const char*)g.A + (size_t)cur.pm * tstep; const char* cB = (const char*)g.Bt + (size_t)cur.pn * tstep;
    PG8_STAGE(PG8_SB(0, 0), cB, voffB); PG8_STAGE(PG8_SB(0, 1), cB + hstep, voffB); PG8_STAGE_A(PG8_SA(0, 0), 0, cA, gC); PG8_STAGE_A(PG8_SA(0, 1), 1, cA, gC);
    if (wr == 1) PG8_BAR;
    PG8_WAIT_V(2); PG8_BAR;
    PG8_STAGE(PG8_SB(1, 0), cB + kstep, voffB); PG8_STAGE_A(PG8_SA(1, 0), 0, cA + kstep, gC); PG8_STAGE(PG8_SB(1, 1), cB + hstep + kstep, voffB);
    PG8_WAIT_V(6); PG8_BAR;
    for (;;) {
        const bool has_next = S.next(ui + 1, nxt);
        if constexpr (GATHER) {
            if (has_next) {
#pragma unroll
                for (int h = 0; h < 2; ++h)
#pragma unroll
                    for (int i = 0; i < 2; ++i) gN[h][i] = (unsigned)S.gather_row(nxt, h * HALF + RA[i]) * (unsigned)(K * 2) + (unsigned)(CA[i] * 2);
            } else {
#pragma unroll
                for (int h = 0; h < 2; ++h)
#pragma unroll
                    for (int i = 0; i < 2; ++i) gN[h][i] = gC[h][i];
            }
        }
        const char* nA = GATHER ? (const char*)g.A : (has_next ? (const char*)g.A + (size_t)nxt.pm * tstep : cA); const char* nB = has_next ? (const char*)g.Bt + (size_t)nxt.pn * tstep : cB;
#pragma unroll 1
        for (int t = 0; t < nt; t += 2) {
            const bool last = (t == nt - 2);
            const char* a1 = cA + (size_t)(t + 1) * kstep;
            const char* a2 = last ? nA : cA + (size_t)(t + 2) * kstep; const char* b2 = last ? nB : cB + (size_t)(t + 2) * kstep;
            const char* a3 = a2 + kstep; const char* b3 = b2 + kstep;
            PG8_LDB(B0, 0, 0); PG8_LDB(B1, 0, 1); PG8_SCHED; PG8_LDA(At, 0, 0); PG8_STAGE_A(PG8_SA(1, 1), 1, a1, gC);
            if constexpr (GATHER) { if (last) { _Pragma("unroll") for (int h = 0; h < 2; ++h) _Pragma("unroll") for (int i = 0; i < 2; ++i) gC[h][i] = gN[h][i]; } }
            PG8_WAIT_V(8); PG8_WAIT_L(0); PG8_BAR; PG8_MMA(0, 0, At, B0); PG8_MMA(0, 1, At, B1); PG8_BAR; PG8_SCHED;
            PG8_LDA(At, 0, 1); PG8_STAGE(PG8_SB(0, 0), b2, voffB); PG8_STAGE(PG8_SB(0, 1), b2 + hstep, voffB); PG8_STAGE_A(PG8_SA(0, 0), 0, a2, gC);
            PG8_WAIT_V(8); PG8_WAIT_L(0); PG8_BAR; PG8_MMA(1, 0, At, B0); PG8_MMA(1, 1, At, B1); PG8_BAR; PG8_SCHED;
            PG8_LDB(B0, 1, 0); PG8_LDB(B1, 1, 1); PG8_SCHED; PG8_LDA(At, 1, 0); PG8_STAGE_A(PG8_SA(0, 1), 1, a2, gC);
            PG8_WAIT_V(8); PG8_WAIT_L(0); PG8_BAR; PG8_MMA(0, 0, At, B0); PG8_MMA(0, 1, At, B1); PG8_BAR; PG8_SCHED;
            PG8_LDA(At, 1, 1); PG8_STAGE(PG8_SB(1, 0), b3, voffB); PG8_STAGE(PG8_SB(1, 1), b3 + hstep, voffB); PG8_STAGE_A(PG8_SA(1, 0), 0, a3, gC);
            PG8_WAIT_V(8); PG8_WAIT_L(0); PG8_BAR; PG8_MMA(1, 0, At, B0); PG8_MMA(1, 1, At, B1); PG8_BAR; PG8_SCHED;
        }
        if constexpr (ALIGN_EPI) { if (wr == 0) PG8_BAR; }
        E(acc, cur, wr, wc, fr, fq);
        if (!has_next) break;
#pragma unroll
        for (int a = 0; a < 2; ++a)
#pragma unroll
            for (int b = 0; b < 2; ++b)
#pragma unroll
                for (int m = 0; m < 4; ++m)
#pragma unroll
                    for (int n = 0; n < 2; ++n) acc[a][b][m][n] = (f32x4){0.f, 0.f, 0.f, 0.f};
        cur = nxt; cA = nA; cB = nB; ++ui;
#pragma unroll
        for (int h = 0; h < 2; ++h)
#pragma unroll
            for (int i = 0; i < 2; ++i) gC[h][i] = gN[h][i];
        if constexpr (ALIGN_EPI) { if (wr == 1) PG8_BAR; }
    }
    PG8_WAIT_V(0);
    if constexpr (!ALIGN_EPI) { if (wr == 0) PG8_BAR; }
    PG8_BAR;
#undef PG8_SA
#undef PG8_SB
#undef PG8_SBR
#undef PG8_STAGE
#undef PG8_DMA1
#undef PG8_STAGE_A
#undef PG8_LDA
#undef PG8_CAT8
#undef PG8_LDB
#undef PG8_MMA
#undef PG8_WAIT_V
#undef PG8_WAIT_L
#undef PG8_BAR
#undef PG8_SCHED
}
}

namespace att {
#define ALAS __attribute__((address_space(3)))
using bf16 = unsigned short;
using bf16x8 = __attribute__((ext_vector_type(8))) short;
using s16x4  = __attribute__((ext_vector_type(4))) short;
using f32x16 = __attribute__((ext_vector_type(16))) float;
using f32x2  = __attribute__((ext_vector_type(2))) float;
using u32x4  = __attribute__((ext_vector_type(4))) unsigned;
#define SBAR() __builtin_amdgcn_sched_barrier(0)
constexpr int SHM_V = 64 * 128 * 2;
constexpr int OFF_V = 0;
template <int MODE> struct L { static constexpr int NVB = MODE == 0 ? 3 : 2, SHM_K = 64 * (MODE == 0 ? 384 : 128), OFF_K = NVB * SHM_V, OFF_WS = OFF_K + 2 * SHM_K; };
constexpr int OFF_LUT = L<1>::OFF_WS + 2048;
constexpr int OFF_STASH = OFF_LUT + 16384;
constexpr int OFF_QPE = L<0>::OFF_WS + 2048;
constexpr int ATT_LDS = (OFF_STASH + 65536) > (OFF_QPE + 40960) ? (OFF_STASH + 65536) : (OFF_QPE + 40960);
__device__ __forceinline__ int crow(int r, int hi) { return (r & 3) + 8 * (r >> 2) + 4 * hi; }
__device__ __forceinline__ unsigned cvtpk(float lo, float hi) { unsigned r; asm volatile("v_cvt_pk_bf16_f32 %0, %1, %2" : "=v"(r) : "v"(lo), "v"(hi)); return r; }
__device__ __forceinline__ float bf2f(short v) { return __uint_as_float(((unsigned)(unsigned short)v) << 16); }
template <int RB> __device__ __forceinline__ int kaddr(int row, int colB) { return row * RB + (colB ^ (((row >> 1) & 7) << 4)); }

template <bool NEAR>
__device__ __forceinline__ void partialSM(f32x16& p0, f32x16& p1, float& m_reg, float& mn, float& alpha, float C, const ALAS float* lut, float cfar) {
  constexpr float THR2 = 8.f * 1.4426950408889634f;
  if constexpr (NEAR) {
#pragma unroll
    for (int r = 0; r < 16; ++r) { const int o = (r & 3) + 8 * (r >> 2); p0[r] = fmaf(p0[r], C, lut[o]); p1[r] = fmaf(p1[r], C, lut[32 + o]); }
  }
  float pmax = p0[0];
#pragma unroll
  for (int r = 1; r < 16; ++r) pmax = fmaxf(pmax, p0[r]);
#pragma unroll
  for (int r = 0; r < 16; ++r) pmax = fmaxf(pmax, p1[r]);
  { auto rr = __builtin_amdgcn_permlane32_swap(__float_as_uint(pmax), __float_as_uint(pmax), false, false);
    pmax = fmaxf(__uint_as_float(rr[0]), __uint_as_float(rr[1])); }
  if constexpr (!NEAR) pmax = fmaf(pmax, C, cfar);
  if (__builtin_expect(__all(pmax - m_reg <= THR2), 1)) { mn = m_reg; alpha = 1.f; }
  else { mn = fmaxf(m_reg, pmax); alpha = __builtin_amdgcn_exp2f(m_reg - mn); m_reg = mn; }
  if constexpr (NEAR) {
#pragma unroll
    for (int r = 0; r < 16; ++r) p0[r] = __builtin_amdgcn_exp2f(p0[r] - mn);
#pragma unroll
    for (int r = 0; r < 16; ++r) p1[r] = p1[r] - mn;
  } else {
    const float cm = cfar - mn;
#pragma unroll
    for (int r = 0; r < 16; ++r) p0[r] = __builtin_amdgcn_exp2f(fmaf(p0[r], C, cm));
#pragma unroll
    for (int r = 0; r < 16; ++r) p1[r] = fmaf(p1[r], C, cm);
  }
}
__device__ __forceinline__ void finishSM(f32x16& p0, f32x16& p1, float alpha, float& l_reg, bf16x8& pa0, bf16x8& pa1, bf16x8& pa2, bf16x8& pa3) {
#pragma unroll
  for (int r = 0; r < 16; ++r) p1[r] = __builtin_amdgcn_exp2f(p1[r]);
  float ps = 0;
#pragma unroll
  for (int r = 0; r < 16; ++r) ps += p0[r];
#pragma unroll
  for (int r = 0; r < 16; ++r) ps += p1[r];
  { auto rr = __builtin_amdgcn_permlane32_swap(__float_as_uint(ps), __float_as_uint(ps), false, false);
    ps = __uint_as_float(rr[0]) + __uint_as_float(rr[1]); }
  l_reg = l_reg * alpha + ps;
#define PK4(P, BASE, OUT) do { unsigned a0 = cvtpk(P[BASE + 0], P[BASE + 1]), a1 = cvtpk(P[BASE + 2], P[BASE + 3]);   \
    unsigned b0 = cvtpk(P[BASE + 4], P[BASE + 5]), b1 = cvtpk(P[BASE + 6], P[BASE + 7]);                              \
    auto r0 = __builtin_amdgcn_permlane32_swap(a0, b0, false, false); auto r1 = __builtin_amdgcn_permlane32_swap(a1, b1, false, false); \
    u32x4 w = {r0[0], r1[0], r0[1], r1[1]}; OUT = __builtin_bit_cast(bf16x8, w); } while (0)
  PK4(p0, 0, pa0); PK4(p0, 8, pa1); PK4(p1, 0, pa2); PK4(p1, 8, pa3);
#undef PK4
}
template <int NQ, int RB>
__device__ __forceinline__ void qkt(f32x16& p0, f32x16& p1, const ALAS char* Ks, const bf16x8* qr, int r32, int hi) {
  p0 = f32x16{}; p1 = f32x16{};
#pragma unroll
  for (int d0 = 0; d0 < NQ; ++d0) { const int cb = (d0 * 16 + hi * 8) * 2;
    const bf16x8 b0 = *reinterpret_cast<const ALAS bf16x8*>(Ks + kaddr<RB>(r32, cb));
    const bf16x8 b1 = *reinterpret_cast<const ALAS bf16x8*>(Ks + kaddr<RB>(32 + r32, cb));
    p0 = __builtin_amdgcn_mfma_f32_32x32x16_bf16(b0, qr[d0], p0, 0, 0, 0);
    p1 = __builtin_amdgcn_mfma_f32_32x32x16_bf16(b1, qr[d0], p1, 0, 0, 0); }
}
__device__ __forceinline__ int v_st(int k, int c) { const int kk = (k & ~0xC) | ((k & 4) << 1) | ((k & 8) >> 1); return ((kk >> 3) * 4 + (c >> 5)) * 512 + ((kk & 7) * 32 + (c & 31)) * 2; }
__device__ __forceinline__ int v_rd_base(int lane) { return ((lane & 3) << 3) | (((lane >> 2) & 3) << 6) | (((lane >> 4) & 1) << 5) | (((lane >> 5) & 1) << 8); }
constexpr int v_rd_off(int d0, int ks, int half) { return d0 * 512 + ks * 4096 + half * 2048; }
template <int OFF> __device__ __forceinline__ s16x4 tr_read(int vb) {
  s16x4 r; asm volatile("ds_read_b64_tr_b16 %0, %1 offset:%2" : "=&v"(r) : "v"(vb), "i"(OFF) : "memory"); return r;
}
template <int D0> __device__ __forceinline__ void pv_one(f32x16& od, int vb, bf16x8 pa0, bf16x8 pa1, bf16x8 pa2, bf16x8 pa3) {
  const s16x4 l0 = tr_read<v_rd_off(D0, 0, 0)>(vb), h0 = tr_read<v_rd_off(D0, 0, 1)>(vb), l1 = tr_read<v_rd_off(D0, 1, 0)>(vb), h1 = tr_read<v_rd_off(D0, 1, 1)>(vb);
  const s16x4 l2 = tr_read<v_rd_off(D0, 2, 0)>(vb), h2 = tr_read<v_rd_off(D0, 2, 1)>(vb), l3 = tr_read<v_rd_off(D0, 3, 0)>(vb), h3 = tr_read<v_rd_off(D0, 3, 1)>(vb);
  asm volatile("s_waitcnt lgkmcnt(0)" ::: "memory"); SBAR();
#define PK(L, H) (bf16x8){L[0], L[1], L[2], L[3], H[0], H[1], H[2], H[3]}
  od = __builtin_amdgcn_mfma_f32_32x32x16_bf16(pa0, PK(l0, h0), od, 0, 0, 0);
  od = __builtin_amdgcn_mfma_f32_32x32x16_bf16(pa1, PK(l1, h1), od, 0, 0, 0);
  od = __builtin_amdgcn_mfma_f32_32x32x16_bf16(pa2, PK(l2, h2), od, 0, 0, 0);
  od = __builtin_amdgcn_mfma_f32_32x32x16_bf16(pa3, PK(l3, h3), od, 0, 0, 0);
#undef PK
}
__device__ __forceinline__ void pv_d0(f32x16* o, int vb, bf16x8 pa0, bf16x8 pa1, bf16x8 pa2, bf16x8 pa3) {
  pv_one<0>(o[0], vb, pa0, pa1, pa2, pa3); pv_one<1>(o[1], vb, pa0, pa1, pa2, pa3); pv_one<2>(o[2], vb, pa0, pa1, pa2, pa3); pv_one<3>(o[3], vb, pa0, pa1, pa2, pa3);
}

__device__ __forceinline__ int kw_addr(int row, int colB) { return row * 256 + (colB ^ ((row & 15) << 4)); }
__device__ __forceinline__ int kn_addr(int row, int colB) { return row * 128 + (colB ^ (((row >> 1) & 7) << 4)); }
template <int MODE>
__device__ __forceinline__ void attn_unit(const bf16* __restrict__ Qb, int ldq, const bf16* __restrict__ Kh, int ldk, const bf16* __restrict__ Kp, const bf16* __restrict__ Vh, int ldv,
                                          int seq, ALAS char* lds, float C, const f32x2* __restrict__ cs, int qpos0, f32x16 (&o)[4], int wave, int lane_in) {
  constexpr int SHM_KW = MODE == 0 ? 64 * 256 : 0, SHM_KN = 64 * 128, SHM_K = SHM_KW + SHM_KN;
  static_assert(SHM_K == L<MODE>::SHM_K, "K buffers");
  const int tid = threadIdx.x, wid = __builtin_amdgcn_readfirstlane(tid >> 6), lane = tid & 63, r32 = lane & 31, hi = lane >> 5;
  const bool late = wid >= 4;
  ALAS char* V_lds = lds + OFF_V; ALAS char* K_lds = lds + L<MODE>::OFF_K;
  ALAS float* ws = (ALAS float*)(lds + L<MODE>::OFF_WS) + wid * 64; ALAS float* li_l = ws; ALAS float* al_l = ws + 32;
  __syncthreads();
  float m_reg = -1e30f, l_reg = 0;
#pragma unroll
  for (int d = 0; d < 4; ++d) o[d] = f32x16{};
  constexpr int NQR = MODE == 0 ? 7 : 4;
  bf16x8 qr[NQR];
  ALAS char* qpe_l = lds + OFF_QPE + wid * 5120 + lane * 16;
  const bf16* Qw = Qb + (long)(wid * 32 + r32) * ldq + hi * 8;
#pragma unroll
  for (int d0 = 0; d0 < NQR; ++d0) qr[d0] = *reinterpret_cast<const bf16x8*>(Qw + d0 * 16);
  if constexpr (MODE == 0) {
    bf16x8 qp[4];
#pragma unroll
    for (int d0 = 0; d0 < 4; ++d0) qp[d0] = *reinterpret_cast<const bf16x8*>(Qw + (8 + d0) * 16);
    *(ALAS bf16x8*)(qpe_l + 4 * 1024) = *reinterpret_cast<const bf16x8*>(Qw + 7 * 16);
    const f32x2* cp = cs + (long)(qpos0 + wid * 32 + r32) * 32 + hi * 8;
#pragma unroll
    for (int a = 0; a < 2; ++a) {
      unsigned w1[4], w2[4];
#pragma unroll
      for (int j = 0; j < 8; j += 2) {
        const f32x2 c0 = cp[16 * a + j], c1 = cp[16 * a + j + 1];
        const float x10 = bf2f(qp[a][j]), x20 = bf2f(qp[2 + a][j]), x11 = bf2f(qp[a][j + 1]), x21 = bf2f(qp[2 + a][j + 1]);
        w1[j >> 1] = cvtpk(x10 * c0.x - x20 * c0.y, x11 * c1.x - x21 * c1.y);
        w2[j >> 1] = cvtpk(x10 * c0.y + x20 * c0.x, x11 * c1.y + x21 * c1.x);
      }
      u32x4 v1 = {w1[0], w1[1], w1[2], w1[3]}, v2 = {w2[0], w2[1], w2[2], w2[3]};
      *(ALAS u32x4*)(qpe_l + a * 1024) = v1; *(ALAS u32x4*)(qpe_l + (2 + a) * 1024) = v2;
    }
  }
  unsigned vsrc[2], kwsrc[2], knsrc;
#pragma unroll
  for (int i = 0; i < 2; ++i) { const int s = (wid + 8 * i) * 64 + lane;
    const int kk = (s >> 7) * 8 + ((s & 31) >> 2), c = ((s >> 5) & 3) * 32 + (s & 3) * 8, k = (kk & ~0xC) | ((kk & 4) << 1) | ((kk & 8) >> 1);
    vsrc[i] = (unsigned)(k * ldv + c);
    const int row = s >> 4, ch = (s & 15) ^ (row & 15); kwsrc[i] = (unsigned)(row * ldk + ch * 8); }
  { const int s = wid * 64 + lane, row = s >> 3, ch = (s & 7) ^ ((row >> 1) & 7); knsrc = (unsigned)(row * (MODE == 0 ? 64 : ldk) + ch * 8); }
  const bf16* Kn = MODE == 0 ? Kp : Kh; const int ldn = MODE == 0 ? 64 : ldk;
#define DMA16(src, dst) __builtin_amdgcn_global_load_lds((const unsigned*)(src), (ALAS unsigned*)(dst), 16, 0, 0)
#define DMA_V(t, b) do { const bf16* vb_ = Vh + (long)(t) * 64 * ldv; DMA16(vb_ + vsrc[0], V_lds + (b) * SHM_V + wid * 1024); DMA16(vb_ + vsrc[1], V_lds + (b) * SHM_V + (wid + 8) * 1024); } while (0)
#define DMA_K(t, b) do { if constexpr (MODE == 0) { const bf16* kb_ = Kh + (long)(t) * 64 * ldk; DMA16(kb_ + kwsrc[0], K_lds + (b) * SHM_K + wid * 1024); DMA16(kb_ + kwsrc[1], K_lds + (b) * SHM_K + (wid + 8) * 1024); } \
    DMA16(Kn + (long)(t) * 64 * ldn + knsrc, K_lds + (b) * SHM_K + SHM_KW + wid * 1024); } while (0)
#define STEP_END() do { asm volatile("s_waitcnt vmcnt(0)" ::: "memory"); __syncthreads(); } while (0)
#define QKT(P0, P1, b) do { P0 = f32x16{}; P1 = f32x16{}; const ALAS char* kb_ = K_lds + (b) * SHM_K; \
    if constexpr (MODE == 0) { _Pragma("unroll") for (int d0 = 0; d0 < 8; ++d0) { const int cb = (d0 * 16 + hi * 8) * 2; \
        const bf16x8 b0 = *reinterpret_cast<const ALAS bf16x8*>(kb_ + kw_addr(r32, cb)); const bf16x8 b1 = *reinterpret_cast<const ALAS bf16x8*>(kb_ + kw_addr(32 + r32, cb)); \
        bf16x8 qn_; if (d0 < NQR) qn_ = qr[d0 < NQR ? d0 : 0]; else qn_ = *reinterpret_cast<const ALAS bf16x8*>(qpe_l + 4 * 1024); \
        P0 = __builtin_amdgcn_mfma_f32_32x32x16_bf16(b0, qn_, P0, 0, 0, 0); P1 = __builtin_amdgcn_mfma_f32_32x32x16_bf16(b1, qn_, P1, 0, 0, 0); } } \
    _Pragma("unroll") for (int d0 = 0; d0 < 4; ++d0) { const int cb = (d0 * 16 + hi * 8) * 2; \
        const bf16x8 b0 = *reinterpret_cast<const ALAS bf16x8*>(kb_ + SHM_KW + kn_addr(r32, cb)); const bf16x8 b1 = *reinterpret_cast<const ALAS bf16x8*>(kb_ + SHM_KW + kn_addr(32 + r32, cb)); \
        bf16x8 qf_; if constexpr (MODE == 0) qf_ = *reinterpret_cast<const ALAS bf16x8*>(qpe_l + d0 * 1024); else qf_ = qr[d0]; \
        P0 = __builtin_amdgcn_mfma_f32_32x32x16_bf16(b0, qf_, P0, 0, 0, 0); P1 = __builtin_amdgcn_mfma_f32_32x32x16_bf16(b1, qf_, P1, 0, 0, 0); } } while (0)
#define RESC(a) do { if (__any((a) < 1.f)) { if (hi == 0) al_l[r32] = (a); asm volatile("s_waitcnt lgkmcnt(0)" ::: "memory"); \
    _Pragma("unroll") for (int d = 0; d < 4; ++d) _Pragma("unroll") for (int r = 0; r < 16; ++r) o[d][r] *= al_l[crow(r, hi)]; } } while (0)
  const int vb0 = (int)(unsigned)(uintptr_t)V_lds + v_rd_base(lane);
  const int qw = qpos0 + wid * 32;
  const ALAS float* lutb = (const ALAS float*)(lds + OFF_LUT);
  const ALAS float* lutp = lutb + (2047 - (qw + r32) + 4 * hi);
  float cpos = 0.f, cneg = 0.f;
#define PSM(P0, P1, MN, AL, TILE) do { if constexpr (MODE == 0) partialSM<false>(P0, P1, m_reg, MN, AL, C, lutp, 0.f); else { const int k0_ = (TILE) * 64; \
    if ((k0_ >= qw + 122) || (k0_ + 154 <= qw)) partialSM<false>(P0, P1, m_reg, MN, AL, C, lutp, k0_ > qw ? cpos : cneg); else partialSM<true>(P0, P1, m_reg, MN, AL, C, lutp + k0_, 0.f); } } while (0)
  f32x16 pA0, pA1; float mnA, alA; bf16x8 pa0, pa1, pa2, pa3; const int NT = seq / 64;
  if constexpr (MODE == 0) {
    DMA_K(0, 0); DMA_V(0, 0); STEP_END();
    int vbj = 0, vbp = 0;
    for (int j = 0; j < NT; ++j) {
      const int kb = j & 1, vbn = vbj == 2 ? 0 : vbj + 1;
      if (j + 1 < NT) { DMA_K(j + 1, kb ^ 1); DMA_V(j + 1, vbn); }
      if (late && j > 0) pv_d0(o, vb0 + vbp * SHM_V, pa0, pa1, pa2, pa3);
      SBAR();
      QKT(pA0, pA1, kb); PSM(pA0, pA1, mnA, alA, j);
      RESC(alA);
      finishSM(pA0, pA1, alA, l_reg, pa0, pa1, pa2, pa3); SBAR();
      if (!late) pv_d0(o, vb0 + vbj * SHM_V, pa0, pa1, pa2, pa3);
      STEP_END();
      vbp = vbj; vbj = vbn;
    }
    if (late) pv_d0(o, vb0 + vbp * SHM_V, pa0, pa1, pa2, pa3);
  } else {
    f32x16 pB0, pB1; float mnB, alB;
    DMA_K(0, 0); STEP_END();
    cpos = lutb[2047 + 128]; cneg = lutb[2047 - 128];
#define DIFF_LOOP(LATE) do { \
      \
    DMA_K(1, 1); DMA_V(0, 0); \
    QKT(pA0, pA1, 0); \
    if (!(LATE)) { PSM(pA0, pA1, mnA, alA, 0); } \
    STEP_END(); \
    for (int j = 1; j + 1 < NT; j += 2) { \
        \
      DMA_K(j + 1, 0); DMA_V(j, 1); \
      if (LATE) { PSM(pA0, pA1, mnA, alA, j - 1); RESC(alA); } \
      SBAR(); QKT(pB0, pB1, 1); \
      finishSM(pA0, pA1, alA, l_reg, pa0, pa1, pa2, pa3); SBAR(); \
      pv_d0(o, vb0, pa0, pa1, pa2, pa3); \
      if (!(LATE)) { PSM(pB0, pB1, mnB, alB, j); RESC(alB); } \
      STEP_END(); \
        \
      DMA_K(j + 2, 1); DMA_V(j + 1, 0); \
      if (LATE) { PSM(pB0, pB1, mnB, alB, j); RESC(alB); } \
      SBAR(); QKT(pA0, pA1, 0); \
      finishSM(pB0, pB1, alB, l_reg, pa0, pa1, pa2, pa3); SBAR(); \
      pv_d0(o, vb0 + SHM_V, pa0, pa1, pa2, pa3); \
      if (!(LATE)) { PSM(pA0, pA1, mnA, alA, j + 1); RESC(alA); } \
      STEP_END(); \
    } \
      \
    DMA_V(NT - 1, 1); \
    if (LATE) { PSM(pA0, pA1, mnA, alA, NT - 2); RESC(alA); } \
    SBAR(); QKT(pB0, pB1, 1); \
    finishSM(pA0, pA1, alA, l_reg, pa0, pa1, pa2, pa3); SBAR(); \
    pv_d0(o, vb0, pa0, pa1, pa2, pa3); \
    PSM(pB0, pB1, mnB, alB, NT - 1); RESC(alB); \
    STEP_END(); \
    finishSM(pB0, pB1, alB, l_reg, pa0, pa1, pa2, pa3); SBAR(); \
    pv_d0(o, vb0 + SHM_V, pa0, pa1, pa2, pa3); } while (0)
    if (late) DIFF_LOOP(true); else DIFF_LOOP(false);
#undef DIFF_LOOP
  }
  if (hi == 0) li_l[r32] = l_reg; asm volatile("s_waitcnt lgkmcnt(0)" ::: "memory");
#pragma unroll
  for (int r = 0; r < 16; ++r) { const float rl = __builtin_amdgcn_rcpf(li_l[crow(r, hi)]);
#pragma unroll
    for (int d = 0; d < 4; ++d) o[d][r] *= rl; }
#undef DMA16
#undef DMA_V
#undef DMA_K
#undef STEP_END
#undef QKT
#undef RESC
#undef PSM
}
}
#define XB_TMO      128
#define XB_XCNT(j)  (256  + 64 * (j))
#define XB_XSUB(j)  (1280 + 64 * (j))
#define XB_XGEN(j)  (2304 + 64 * (j))
#define XB_TOP      3328
#define XB_TOPGEN   3392
#define XCD_BAR_WORDS 3456
#define XB_SPIN_CAP (1u << 18)
#define LAS __attribute__((address_space(3)))

__device__ __forceinline__ unsigned xb_ld(unsigned* p)              { return __hip_atomic_load(p, __ATOMIC_RELAXED, __HIP_MEMORY_SCOPE_AGENT); }
__device__ __forceinline__ unsigned xb_add(unsigned* p, unsigned v) { return __hip_atomic_fetch_add(p, v, __ATOMIC_RELAXED, __HIP_MEMORY_SCOPE_AGENT); }
__device__ __forceinline__ unsigned xb_xcc_id() { return (unsigned)__builtin_amdgcn_s_getreg((3 << 11) | 20) & 0xFu; }
#define XB_SPIN(cond, bar) do { unsigned _sp = 0; while (cond) { __builtin_amdgcn_s_sleep(1); \
    if ((++_sp & 255u) == 0u) { if (xb_ld(&(bar)[XB_TMO])) break; if (_sp > XB_SPIN_CAP) { atomicAdd(&(bar)[XB_TMO], 1u); break; } } } } while (0)

struct XcdBarrier {
    unsigned* bar; unsigned x, w;
    volatile LAS unsigned* st;
};

__device__ __forceinline__ XcdBarrier xcd_barrier_post(unsigned* bar, volatile LAS unsigned* st, unsigned wave) {
    XcdBarrier b; b.bar = bar; b.x = xb_xcc_id(); b.st = st; b.w = wave;
    if (wave == 0 && hw_lane() == 0) (void)xb_add(&bar[XB_XCNT(b.x)], 1u);
    return b;
}
__device__ __forceinline__ void xcd_barrier_complete(unsigned* bar, unsigned x, unsigned& nloc, unsigned& nx) {
    const unsigned G = gridDim.x * gridDim.y * gridDim.z;
    unsigned sum, cnt, mine, sp = 0u;
    for (;;) {
        sum = 0u; cnt = 0u; mine = 0u;
#pragma unroll
        for (unsigned j = 0; j < 16; ++j) { const unsigned c = xb_ld(&bar[XB_XCNT(j)]); sum += c; cnt += (c > 0u) ? 1u : 0u; mine = (j == x) ? c : mine; }
        if (sum == G) break;
        __builtin_amdgcn_s_sleep(1);
        if ((++sp & 255u) == 0u) { if (xb_ld(&bar[XB_TMO])) break; if (sp > XB_SPIN_CAP) { atomicAdd(&bar[XB_TMO], 1u); break; } }
    }
    nloc = mine > 0u ? mine : 1u; nx = cnt > 0u ? cnt : 1u;
}

__device__ __forceinline__ void xcd_barrier(const XcdBarrier& b) {
    asm volatile("s_waitcnt vmcnt(0)" ::: "memory");
    __syncthreads();
    if (b.w == 0 && hw_lane() == 0) {
        unsigned* bar = b.bar;
        __builtin_amdgcn_s_waitcnt(0);
        unsigned nloc = b.st[0], nx = b.st[1];
        if (nloc == 0u) { xcd_barrier_complete(bar, b.x, nloc, nx); b.st[0] = nloc; b.st[1] = nx; }
        const unsigned old = xb_add(&bar[XB_XSUB(b.x)], 1u);
        const unsigned gen = old / nloc;
        if (old + 1u == (gen + 1u) * nloc) {
            __builtin_amdgcn_fence(__ATOMIC_RELEASE, "agent");
            asm volatile("s_waitcnt vmcnt(0)" ::: "memory");
            const unsigned og = xb_add(&bar[XB_TOP], 1u);
            const unsigned tg = og / nx;
            if (og + 1u == (tg + 1u) * nx) xb_add(&bar[XB_TOPGEN], 1u);
            else XB_SPIN(xb_ld(&bar[XB_TOPGEN]) == tg, bar);
            __builtin_amdgcn_fence(__ATOMIC_ACQUIRE, "agent");
            xb_add(&bar[XB_XGEN(b.x)], 1u);
            asm volatile("s_waitcnt vmcnt(0)" ::: "memory");
        } else {
            XB_SPIN(xb_ld(&bar[XB_XGEN(b.x)]) == gen, bar);
            __builtin_amdgcn_fence(__ATOMIC_ACQUIRE, "agent");
            asm volatile("s_waitcnt vmcnt(0)" ::: "memory");
        }
    }
    __syncthreads();
}


constexpr int NB = 32, SEQ = 2048, T = NB * SEQ, D = 1024, IN_COLS = 1984, PROJ_LD = 2048;
constexpr int NE = 32, TOPK = 4, NA = T * TOPK, HALF_T = T / 2, HALF_A = NA / 2;
constexpr int ROWS_ALL = NA + NE * 256, TILES_MAX = ROWS_ALL / 256;
constexpr float NORM_EPS = 1e-5f, LOG2E = 1.4426950408889634f;
constexpr float SC_W = 64.f, SC_X = 4.f, SC_A = 4.f, SC_Y = 16.f;
constexpr int NWAVES = 8, NTHREADS = 512;

constexpr size_t KiB = 1024, MiB = 1u << 20;
constexpr size_t WS_CTL = 0, CTL_ZERO_BYTES = 64 * KiB;
constexpr size_t WS_ROPE = 1 * MiB;
constexpr size_t WS_BIAS = 1 * MiB + 512 * KiB;
constexpr size_t WS_LAM = 1 * MiB + 768 * KiB;
constexpr size_t WS_RINV = 2 * MiB;
constexpr size_t WS_EIDX = 3 * MiB, WS_GATE = 4 * MiB, WS_LRANK = 5 * MiB;
constexpr size_t WS_HIST = 6 * MiB;
constexpr size_t WS_ROWA = 7 * MiB, WS_ROWG = 9 * MiB;
constexpr size_t WS_TINFO = 11 * MiB;
constexpr size_t WS_WRH = 12 * MiB, WS_WRL = 12 * MiB + 64 * KiB;
constexpr size_t WS_WUQ = 13 * MiB, WS_WUKV = 13 * MiB + 512 * KiB;
constexpr size_t WS_WIN = 16 * MiB, WS_WO = 20 * MiB;
constexpr size_t WS_WD8 = 24 * MiB, WS_WGU8 = 56 * MiB;
constexpr size_t WS_XB = 120 * MiB;
constexpr size_t WS_XB8 = 248 * MiB;
constexpr size_t WS_PROJ = 312 * MiB, WS_QM = 568 * MiB, WS_KV = 664 * MiB, WS_MIXED = 792 * MiB, WS_CQN = 920 * MiB, WS_CKVN = 952 * MiB, WS_KPE = 968 * MiB;
constexpr size_t WS_ACT8 = 312 * MiB, WS_Y48 = 576 * MiB;
constexpr size_t WS_END = 976 * MiB;
static_assert(WS_ACT8 + (size_t)ROWS_ALL * 1024 <= WS_Y48 && WS_Y48 + (size_t)NA * 1024 <= WS_CQN && WS_ROWA + (size_t)ROWS_ALL * 4 <= WS_ROWG && WS_ROWG + (size_t)ROWS_ALL * 4 <= WS_TINFO, "ws map");

constexpr int SCRATCH_BYTES = 141312;
constexpr int MISC_OFF = SCRATCH_BYTES;
constexpr int LDS_BYTES = SCRATCH_BYTES + 1024;
static_assert(att::ATT_LDS <= SCRATCH_BYTES && pg8::STAGE_BYTES <= SCRATCH_BYTES, "LDS map");

#define GAS __attribute__((address_space(1)))
typedef unsigned short bf16;
typedef float f32x4 __attribute__((ext_vector_type(4)));
typedef float f32x2 __attribute__((ext_vector_type(2)));
typedef unsigned u32x4 __attribute__((ext_vector_type(4)));
typedef unsigned u32x2 __attribute__((ext_vector_type(2)));
typedef short bf16x8 __attribute__((ext_vector_type(8)));
typedef float f32x16 __attribute__((ext_vector_type(16)));
#define LDS_WAIT() asm volatile("s_waitcnt lgkmcnt(0)" ::: "memory")
#define VM_WAIT() asm volatile("s_waitcnt vmcnt(0)" ::: "memory")
__device__ __forceinline__ unsigned pk2(float lo, float hi) { return pg8::cvt_pk_bf16(lo, hi); }
__device__ __forceinline__ unsigned cvt8(float a, float b, float c, float d) { int w = 0; w = __builtin_amdgcn_cvt_pk_fp8_f32(a, b, w, false); w = __builtin_amdgcn_cvt_pk_fp8_f32(c, d, w, true); return (unsigned)w; }
__device__ __forceinline__ float bf2f(unsigned short v) { return __uint_as_float(((unsigned)v) << 16); }
__device__ __forceinline__ float wave_sum(float v) {
#pragma unroll
    for (int o = 1; o < 64; o <<= 1) v += __shfl_xor(v, o);
    return v;
}

struct Args {
    const float* in[22]; float* out; unsigned char* ws; int ph_lo, ph_hi;
};

template <bool F8OUT, class RowMap>
__device__ __forceinline__ void transpose_item(const float* W, int K, int N, void* WTv, LAS float* scr, int item, int lane, const float* kscale, RowMap rm) {
    const int nblk = N / 32, kb = item / nblk, nb = item % nblk, k0 = 64 * kb, n0 = 32 * nb;
    float v[32];
#pragma unroll
    for (int i = 0; i < 32; ++i) v[i] = W[(size_t)(k0 + 2 * i + (lane >> 5)) * N + n0 + (lane & 31)];
    if (kscale) {
#pragma unroll
        for (int i = 0; i < 32; ++i) v[i] *= kscale[k0 + 2 * i + (lane >> 5)];
    }
    if constexpr (F8OUT) {
#pragma unroll
        for (int i = 0; i < 32; ++i) v[i] *= SC_W;
    }
#pragma unroll
    for (int i = 0; i < 32; ++i) scr[(2 * i + (lane >> 5)) * 33 + (lane & 31)] = v[i];
    LDS_WAIT(); asm volatile("" ::: "memory");
    const int c = lane & 7;
#pragma unroll
    for (int j = 0; j < 4; ++j) { const int n = (lane >> 3) + 8 * j; const LAS float* s = scr + (8 * c) * 33 + n;
        if constexpr (F8OUT) { u32x2 o; o.x = cvt8(s[0 * 33], s[1 * 33], s[2 * 33], s[3 * 33]); o.y = cvt8(s[4 * 33], s[5 * 33], s[6 * 33], s[7 * 33]);
            *(u32x2*)((unsigned char*)WTv + (size_t)rm(n0 + n) * K + k0 + 8 * c) = o; }
        else { u32x4 o; o.x = pk2(s[0 * 33], s[1 * 33]); o.y = pk2(s[2 * 33], s[3 * 33]); o.z = pk2(s[4 * 33], s[5 * 33]); o.w = pk2(s[6 * 33], s[7 * 33]);
            *(u32x4*)((bf16*)WTv + (size_t)rm(n0 + n) * K + k0 + 8 * c) = o; } }
    LDS_WAIT(); asm volatile("" ::: "memory");
}
struct RmId { __device__ __forceinline__ int operator()(int n) const { return n; } };
struct RmGu { __device__ __forceinline__ int operator()(int n) const { const int up = n >> 10, j = n & 1023; return 256 * (j >> 7) + 128 * up + (j & 127); } };

__device__ __forceinline__ void rms_row_to_bf16(const float* xrow, const float* g, bf16* orow, int lane) {
    const f32x4* xr = (const f32x4*)xrow + lane; const f32x4* gr = (const f32x4*)g + lane;
    f32x4 v[4]; float s = 0.f;
#pragma unroll
    for (int j = 0; j < 4; ++j) { v[j] = xr[64 * j]; s += (v[j].x * v[j].x + v[j].y * v[j].y) + (v[j].z * v[j].z + v[j].w * v[j].w); }
    const float r = 1.f / sqrtf(wave_sum(s) * (1.f / D) + NORM_EPS);
    u32x2* o8 = (u32x2*)orow + lane;
#pragma unroll
    for (int j = 0; j < 4; ++j) { const f32x4 gg = gr[64 * j]; u32x2 w; w.x = pk2(v[j].x * r * gg.x, v[j].y * r * gg.y); w.y = pk2(v[j].z * r * gg.z, v[j].w * r * gg.w); o8[64 * j] = w; }
}
__device__ __forceinline__ int t5_bucket(int rel) {
    const int n = rel < 0 ? -rel : rel; int b;
    if (n < 8) b = n; else { const int n2 = n * n; b = n2 >= 8192 ? 15 : n2 >= 4096 ? 14 : n2 >= 2048 ? 13 : n2 >= 1024 ? 12 : n2 >= 512 ? 11 : n2 >= 256 ? 10 : n2 >= 128 ? 9 : 8; }
    return (rel > 0 ? 16 : 0) + b;
}
__device__ __forceinline__ void p0_prologue(const Args& a, LAS unsigned char* lds, int vcu, int G, int wave, int lane) {
    unsigned char* ws = a.ws;
    LAS float* scr = (LAS float*)(lds + wave * 16384);
    const int gw = vcu * NWAVES + wave, NGW = G * NWAVES;
    const float* ffn_g = a.in[14];
    constexpr int I_IN = 16 * 62, I_UQ = 4 * 24, I_UKV = 2 * 32, I_O = 16 * 32, I_GU1 = 16 * 64, I_GU = NE * I_GU1, I_D1 = 16 * 32, I_D = NE * I_D1;
    constexpr int NITEMS = I_IN + I_UQ + I_UKV + I_O + I_GU + I_D;
    for (int it = gw; it < NITEMS; it += NGW) {
        int r = it;
        if (r < I_GU) { const int e = r / I_GU1; transpose_item<true>(a.in[17] + (size_t)e * 1024 * 2048, 1024, 2048, ws + WS_WGU8 + (size_t)e * 2048 * 1024, scr, r % I_GU1, lane, ffn_g, RmGu{}); continue; } r -= I_GU;
        if (r < I_D) { const int e = r / I_D1; transpose_item<true>(a.in[19] + (size_t)e * 1024 * 1024, 1024, 1024, ws + WS_WD8 + (size_t)e * 1024 * 1024, scr, r % I_D1, lane, nullptr, RmId{}); continue; } r -= I_D;
        if (r < I_IN) { transpose_item<false>(a.in[3], 1024, IN_COLS, (bf16*)(ws + WS_WIN), scr, r, lane, nullptr, RmId{}); continue; } r -= I_IN;
        if (r < I_O) { transpose_item<false>(a.in[13], 1024, 1024, (bf16*)(ws + WS_WO), scr, r, lane, nullptr, RmId{}); continue; } r -= I_O;
        if (r < I_UQ) { transpose_item<false>(a.in[10], 256, 768, (bf16*)(ws + WS_WUQ), scr, r, lane, nullptr, RmId{}); continue; } r -= I_UQ;
        transpose_item<false>(a.in[12], 128, 1024, (bf16*)(ws + WS_WUKV), scr, r, lane, nullptr, RmId{});
    }
    const int gt = gw * 64 + lane, NGT = NGW * 64;
    for (int i = gt; i < 64 * 1024 / 8; i += NGT) *((u32x4*)((bf16*)(ws + WS_WIN) + (size_t)IN_COLS * 1024) + i) = (u32x4){0u, 0u, 0u, 0u};
    for (int i = gt; i < 1024 * NE; i += NGT) { const int k = i >> 5, e = i & 31; const float w = a.in[15][i] * ffn_g[k];
        const unsigned h = pk2(w, 0.f) & 0xffffu; const float wl = w - bf2f((unsigned short)h);
        ((bf16*)(ws + WS_WRH))[e * 1024 + k] = (bf16)h; ((bf16*)(ws + WS_WRL))[e * 1024 + k] = (bf16)(pk2(wl, 0.f) & 0xffffu); }
    for (int i = gt; i < SEQ * 32; i += NGT) { const int pos = i >> 5, fi = i & 31;
        const float inv = (float)::exp2(-(double)fi * (13.287712379549449 / 32.0)); const float ang = (float)pos * inv;
        double tt = (double)ang * 0.15915494309189535; tt -= __builtin_rint(tt); const double rr = tt * 6.283185307179586, r2 = rr * rr;
        double cs_ = 1.0, sn = rr, term_c = 1.0, term_s = rr;
#pragma unroll
        for (int k = 1; k <= 13; ++k) { term_c *= -r2 / (double)((2 * k - 1) * (2 * k)); term_s *= -r2 / (double)((2 * k) * (2 * k + 1)); cs_ += term_c; sn += term_s; }
        ((f32x2*)(ws + WS_ROPE))[i] = (f32x2){(float)cs_, (float)sn}; }
    for (int i = gt; i < 8 * 4096; i += NGT) { const int m = i >> 12, d = i & 4095; ((float*)(ws + WS_BIAS))[i] = d < 4095 ? a.in[1][t5_bucket(d - 2047) * 8 + m] * LOG2E : 0.f; }
    if (gw == 0) { const float s1 = wave_sum(a.in[4][lane] * a.in[5][lane]), s2 = wave_sum(a.in[6][lane] * a.in[7][lane]);
        if (lane == 0) *(float*)(ws + WS_LAM) = __expf(s1) - __expf(s2) + 0.2f; }
    for (int m = gw; m < T; m += 2 * NGW) {
        const int m2 = m + NGW < T ? m + NGW : m;
        const f32x4* xr0 = (const f32x4*)(a.in[0] + (size_t)m * D) + lane; const f32x4* xr1 = (const f32x4*)(a.in[0] + (size_t)m2 * D) + lane; const f32x4* gr = (const f32x4*)a.in[2] + lane;
        f32x4 v0[4], v1[4]; float s0 = 0.f, s1 = 0.f;
#pragma unroll
        for (int j = 0; j < 4; ++j) { v0[j] = xr0[64 * j]; v1[j] = xr1[64 * j]; }
#pragma unroll
        for (int j = 0; j < 4; ++j) { s0 += (v0[j].x * v0[j].x + v0[j].y * v0[j].y) + (v0[j].z * v0[j].z + v0[j].w * v0[j].w); s1 += (v1[j].x * v1[j].x + v1[j].y * v1[j].y) + (v1[j].z * v1[j].z + v1[j].w * v1[j].w); }
        const float r0 = 1.f / sqrtf(wave_sum(s0) * (1.f / D) + NORM_EPS), r1 = 1.f / sqrtf(wave_sum(s1) * (1.f / D) + NORM_EPS);
        u32x2* o0 = (u32x2*)((bf16*)(ws + WS_XB) + (size_t)m * D) + lane; u32x2* o1 = (u32x2*)((bf16*)(ws + WS_XB) + (size_t)m2 * D) + lane;
#pragma unroll
        for (int j = 0; j < 4; ++j) { const f32x4 gg = gr[64 * j]; u32x2 w;
            w.x = pk2(v0[j].x * r0 * gg.x, v0[j].y * r0 * gg.y); w.y = pk2(v0[j].z * r0 * gg.z, v0[j].w * r0 * gg.w); o0[64 * j] = w;
            w.x = pk2(v1[j].x * r1 * gg.x, v1[j].y * r1 * gg.y); w.y = pk2(v1[j].z * r1 * gg.z, v1[j].w * r1 * gg.w); o1[64 * j] = w; }
    }
}

__device__ __forceinline__ void p1b_latent(const Args& a, int vcu, int G, int wave, int lane) {
    unsigned char* ws = a.ws; const int gw = vcu * NWAVES + wave, NGW = G * NWAVES;
    const float* gq = a.in[9]; const float* gkv = a.in[11];
    float gl[8];
#pragma unroll
    for (int j = 0; j < 8; ++j) gl[j] = lane < 32 ? gq[8 * lane + j] : (lane < 48 ? gkv[8 * (lane - 32) + j] : 1.f);
    constexpr int R = 4;
    for (int t0 = gw; t0 < T; t0 += R * NGW) {
        bf16x8 v[R];
#pragma unroll
        for (int q = 0; q < R; ++q) { const int t = t0 + q * NGW; v[q] = (bf16x8){0, 0, 0, 0, 0, 0, 0, 0};
            if (lane < 56 && t < T) v[q] = *(const bf16x8*)((const bf16*)(ws + WS_PROJ) + (size_t)t * PROJ_LD + 1536 + 8 * lane); }
#pragma unroll
        for (int q = 0; q < R; ++q) { const int t = t0 + q * NGW; if (t >= T) break;
            float f[8], sq = 0.f;
#pragma unroll
            for (int j = 0; j < 8; ++j) { f[j] = bf2f((unsigned short)v[q][j]); sq += f[j] * f[j]; }
            const float sq_q = wave_sum(lane < 32 ? sq : 0.f), sq_kv = wave_sum((lane >= 32 && lane < 48) ? sq : 0.f);
            const float rq = 1.f / sqrtf(sq_q * (1.f / 256.f) + NORM_EPS), rkv = 1.f / sqrtf(sq_kv * (1.f / 128.f) + NORM_EPS);
            float part[8];
#pragma unroll
            for (int j = 0; j < 8; ++j) part[j] = __shfl_xor(f[j], 4);
            float o[8];
            if (lane < 48) { const float rr = lane < 32 ? rq : rkv;
#pragma unroll
                for (int j = 0; j < 8; ++j) o[j] = f[j] * rr * gl[j];
            } else {
                const int aa = lane - 48; const f32x2* cp = (const f32x2*)(ws + WS_ROPE) + (size_t)(t & (SEQ - 1)) * 32 + 8 * (aa & 3);
#pragma unroll
                for (int j = 0; j < 8; ++j) { const f32x2 c = lane < 56 ? cp[j] : (f32x2){0.f, 0.f};
                    o[j] = (aa < 4) ? (f[j] * c.x - part[j] * c.y) : (part[j] * c.y + f[j] * c.x); }
            }
            u32x4 w; w.x = pk2(o[0], o[1]); w.y = pk2(o[2], o[3]); w.z = pk2(o[4], o[5]); w.w = pk2(o[6], o[7]);
            if (lane < 32) *(u32x4*)((bf16*)(ws + WS_CQN) + (size_t)t * 256 + 8 * lane) = w;
            else if (lane < 48) *(u32x4*)((bf16*)(ws + WS_CKVN) + (size_t)t * 128 + 8 * (lane - 32)) = w;
            else if (lane < 56) *(u32x4*)((bf16*)(ws + WS_KPE) + (size_t)t * 64 + 8 * (lane - 48)) = w;
        }
    }
}

template <int WHICH  >
__device__ __forceinline__ void p2_attention(const Args& a, LAS unsigned char* lds, int vcu, int G, int wave) {
    unsigned char* ws = a.ws;
    const int tid = threadIdx.x, wid = tid >> 6, lane = tid & 63, r32 = lane & 31, hi = lane >> 5;
    const bf16* proj = (const bf16*)(ws + WS_PROJ); bf16* mixed = (bf16*)(ws + WS_MIXED);
    const float lam = *(const float*)(ws + WS_LAM);
    if constexpr (WHICH & 1) {
        const float C = 0.125f * LOG2E;
        float sg[4];
#pragma unroll
        for (int d0 = 0; d0 < 4; ++d0) sg[d0] = a.in[8][32 * d0 + r32] * 0.8f;
        LAS unsigned* stash = (LAS unsigned*)(lds + att::OFF_STASH) + (wid * 32) * 64 + lane;
        for (int it = 0;; ++it) {
            const int u = (it >> 1) * G + vcu, j = it & 1; if (u >= NB * 4 * 8) break;
            const int qb = u & 7, h = (u >> 3) & 3, b = u >> 5, q0 = qb * 256, mp = 2 * h + j;
            { const float* src = (const float*)(ws + WS_BIAS) + mp * 4096; LAS float* lut = (LAS float*)(lds + att::OFF_LUT);
#pragma unroll
              for (int i = 0; i < 8; ++i) lut[tid + 512 * i] = src[tid + 512 * i]; }
            const bf16* base = proj + (size_t)b * SEQ * PROJ_LD;
            f32x16 o[4];
            att::attn_unit<1>(base + (size_t)q0 * PROJ_LD + 64 * mp, PROJ_LD, base + 512 + 64 * mp, PROJ_LD, nullptr, base + 1024 + 128 * h, PROJ_LD, SEQ,
                                 (LAS char*)lds, C, nullptr, q0, o, wave, lane);
            if (j == 0) {
#pragma unroll
                for (int d0 = 0; d0 < 4; ++d0)
#pragma unroll
                    for (int r = 0; r < 16; r += 2) stash[(d0 * 8 + (r >> 1)) * 64] = pk2(o[d0][r], o[d0][r + 1]);
            } else {
                bf16* orow = mixed + (size_t)(b * SEQ + q0 + wid * 32) * D + 128 * h + r32;
#pragma unroll
                for (int rp = 0; rp < 8; ++rp) {
                    float v[2][4], ss[2] = {0.f, 0.f};
#pragma unroll
                    for (int d0 = 0; d0 < 4; ++d0) { const unsigned w = stash[(d0 * 8 + rp) * 64];
                        v[0][d0] = bf2f((unsigned short)(w & 0xffffu)) - lam * o[d0][2 * rp]; v[1][d0] = bf2f((unsigned short)(w >> 16)) - lam * o[d0][2 * rp + 1];
                        ss[0] += v[0][d0] * v[0][d0]; ss[1] += v[1][d0] * v[1][d0]; }
#pragma unroll
                    for (int q = 0; q < 2; ++q) {
#pragma unroll
                        for (int sft = 1; sft < 32; sft <<= 1) ss[q] += __shfl_xor(ss[q], sft);
                        const float rn = 1.f / sqrtf(ss[q] * (1.f / 128.f) + NORM_EPS);
                        bf16* op = orow + (size_t)att::crow(2 * rp + q, hi) * D;
#pragma unroll
                        for (int d0 = 0; d0 < 4; ++d0) op[32 * d0] = (bf16)(pk2(v[q][d0] * rn * sg[d0], 0.f) & 0xffffu);
                    }
                }
            }
        }
    }
    if constexpr (WHICH & 2) {
        const float C = 0.07216878364870322f * LOG2E;
        for (int it = 0;; ++it) {
            const int u = it * G + vcu; if (u >= NB * 4 * 8) break;
            const int qb = u & 7, h = (u >> 3) & 3, b = u >> 5, q0 = qb * 256;
            const bf16* qm = (const bf16*)(ws + WS_QM) + (size_t)(b * SEQ + q0) * 768 + 192 * h;
            const bf16* kv = (const bf16*)(ws + WS_KV) + (size_t)b * SEQ * 1024 + 256 * h;
            const bf16* kpe = (const bf16*)(ws + WS_KPE) + (size_t)b * SEQ * 64;
            f32x16 o[4];
            att::attn_unit<0>(qm, 768, kv, 1024, kpe, kv + 128, 1024, SEQ, (LAS char*)lds, C, (const att::f32x2*)(ws + WS_ROPE), q0, o, wave, lane);
            bf16* orow = mixed + (size_t)(b * SEQ + q0 + wid * 32) * D + 512 + 128 * h + r32;
#pragma unroll
            for (int r = 0; r < 16; ++r) { bf16* op = orow + (size_t)att::crow(r, hi) * D;
#pragma unroll
                for (int d0 = 0; d0 < 4; ++d0) op[32 * d0] = (bf16)(pk2(o[d0][r], 0.f) & 0xffffu); }
        }
    }
}

constexpr int WR_PITCH = 2064;
__device__ __forceinline__ void p3b_router(const Args& a, LAS unsigned char* lds, int G, int wave) {
    unsigned char* ws = a.ws;
    const int wid = wave, lane = hw_lane(), tid = wid * 64 + lane, r32 = lane & 31, hi = lane >> 5;
    LAS unsigned char* wrh = lds; LAS unsigned char* wrl = lds + 32 * WR_PITCH; LAS unsigned* cnt = (LAS unsigned*)(lds + 64 * WR_PITCH);
    for (int i = tid; i < 2 * 32 * 128; i += NTHREADS) { const int tb = i >> 12, e = (i >> 7) & 31, c = i & 127;
        *(LAS u32x4*)(lds + (tb * 32 + e) * WR_PITCH + c * 16) = *((const u32x4*)(ws + (tb ? WS_WRL : WS_WRH)) + e * 128 + c); }
    const bf16* x1 = (const bf16*)(ws + WS_XB); unsigned char* xb = ws + WS_XB8;
    for (int c = blockIdx.x; c < T / 256; c += G) {
        if (tid < 32) cnt[tid] = 0u;
        __syncthreads();
        const int t = c * 256 + wid * 32 + r32;
        const bf16* xr = x1 + (size_t)t * D + 64 * hi; unsigned char* xo = xb + (size_t)t * D + 64 * hi;
        f32x16 acc = f32x16{}; float ss = 0.f;
#pragma unroll 2
        for (int sg = 0; sg < 8; ++sg) {
            u32x4 v[8];
#pragma unroll
            for (int q = 0; q < 8; ++q) v[q] = *(const u32x4*)(xr + 128 * sg + 8 * q);
#pragma unroll
            for (int j = 0; j < 8; ++j) {
                const u32x4 hw = v[j];
                const float f0 = __uint_as_float(hw.x << 16), f1 = __uint_as_float(hw.x & 0xffff0000u), f2 = __uint_as_float(hw.y << 16), f3 = __uint_as_float(hw.y & 0xffff0000u);
                const float f4 = __uint_as_float(hw.z << 16), f5 = __uint_as_float(hw.z & 0xffff0000u), f6 = __uint_as_float(hw.w << 16), f7 = __uint_as_float(hw.w & 0xffff0000u);
                ss += (f0 * f0 + f1 * f1) + (f2 * f2 + f3 * f3) + (f4 * f4 + f5 * f5) + (f6 * f6 + f7 * f7);
                { u32x2 w8; w8.x = cvt8(f0 * SC_X, f1 * SC_X, f2 * SC_X, f3 * SC_X); w8.y = cvt8(f4 * SC_X, f5 * SC_X, f6 * SC_X, f7 * SC_X); *(u32x2*)(xo + 128 * sg + 8 * j) = w8; }
                const int kb = (128 * sg + 64 * hi + 8 * j) * 2;
                const bf16x8 wh = *(const LAS bf16x8*)(wrh + r32 * WR_PITCH + kb), wl = *(const LAS bf16x8*)(wrl + r32 * WR_PITCH + kb);
                const bf16x8 xh = __builtin_bit_cast(bf16x8, hw);
                acc = __builtin_amdgcn_mfma_f32_32x32x16_bf16(wh, xh, acc, 0, 0, 0);
                acc = __builtin_amdgcn_mfma_f32_32x32x16_bf16(wl, xh, acc, 0, 0, 0);
            }
        }
        ss += __shfl_xor(ss, 32);
        const float rinv = 1.f / sqrtf(ss * (1.f / D) + NORM_EPS);
        if (hi == 0) ((float*)(ws + WS_RINV))[t] = rinv;
        float lg[16];
#pragma unroll
        for (int r = 0; r < 16; ++r) lg[r] = acc[r] * rinv + a.in[16][att::crow(r, hi)];
        float tv[4]; int ti[4];
#pragma unroll
        for (int k = 0; k < 4; ++k) {
            float bv = lg[0]; int bi = att::crow(0, hi);
#pragma unroll
            for (int r = 1; r < 16; ++r) { const int e = att::crow(r, hi); if (lg[r] > bv) { bv = lg[r]; bi = e; } }
            const float ov = __shfl_xor(bv, 32); const int oi = __shfl_xor(bi, 32);
            const bool mine = (bv > ov) || (bv == ov && bi < oi);
            tv[k] = mine ? bv : ov; ti[k] = mine ? bi : oi;
#pragma unroll
            for (int r = 0; r < 16; ++r) if (att::crow(r, hi) == ti[k]) lg[r] = -3.0e38f;
        }
        const float e1 = __expf(tv[1] - tv[0]), e2 = __expf(tv[2] - tv[0]), e3 = __expf(tv[3] - tv[0]), rs = 1.f / (1.f + e1 + e2 + e3);
        if (hi == 0) {
            int lr[4];
#pragma unroll
            for (int k = 0; k < 4; ++k) lr[k] = (int)__hip_atomic_fetch_add(cnt + ti[k], 1u, __ATOMIC_RELAXED, __HIP_MEMORY_SCOPE_WORKGROUP);
            *((int4*)(ws + WS_EIDX) + t) = make_int4(ti[0], ti[1], ti[2], ti[3]);
            *((f32x4*)(ws + WS_GATE) + t) = (f32x4){rs, e1 * rs, e2 * rs, e3 * rs};
            *((int4*)(ws + WS_LRANK) + t) = make_int4(lr[0], lr[1], lr[2], lr[3]);
        }
        __syncthreads();
        if (tid < 32) ((int*)(ws + WS_HIST))[c * 32 + tid] = (int)cnt[tid];
        __syncthreads();
    }
}

__device__ __forceinline__ void p4_scatter(const Args& a, LAS unsigned char* lds, int G, int wave) {
    unsigned char* ws = a.ws; const int tid = wave * 64 + hw_lane();
    LAS int* hist = (LAS int*)lds;
    LAS int* cntE = hist + 256 * 32;
    LAS int* pst = cntE + 32;
    for (int i = tid; i < 256 * 32; i += NTHREADS) hist[i] = ((const int*)(ws + WS_HIST))[i];
    __syncthreads();
    if (tid < 32) { int run = 0;
        for (int c = 0; c < 256; ++c) { const int v = hist[c * 32 + tid]; hist[c * 32 + tid] = run; run += v; }
        cntE[tid] = run; }
    __syncthreads();
    if (tid < 32) { int s = 0;
        for (int q = 0; q < tid; ++q) s += (cntE[q] + 255) & ~255;
        pst[tid] = s; }
    __syncthreads();
    int* rowa = (int*)(ws + WS_ROWA); float* rowg = (float*)(ws + WS_ROWG);
    for (int c = blockIdx.x; c < T / 256; c += G) {
        for (int i = tid; i < 1024; i += NTHREADS) { const int asg = c * 1024 + i; const int e = ((const int*)(ws + WS_EIDX))[asg];
            const int p = pst[e] + hist[c * 32 + e] + ((const int*)(ws + WS_LRANK))[asg];
            rowa[p] = asg; rowg[p] = ((const float*)(ws + WS_GATE))[asg]; } }
    if (blockIdx.x == 0 && tid < 32) { const int e = tid; const int n = cntE[e], st = pst[e], pad = (n + 255) & ~255;
        for (int p = st + n; p < st + pad; ++p) { rowa[p] = -1; rowg[p] = 0.f; }
        int* tinfo = (int*)(ws + WS_TINFO);
        for (int tt = st >> 8; tt < (st + pad) >> 8; ++tt) tinfo[tt] = e;
        if (e == 31) tinfo[2048] = (st + pad) >> 8; }
}

struct MoeOrder {
    const int* tinfo; const int* rowa; int ntiles, nN, lgN, G, c;
    __device__ __forceinline__ bool next(int i, pg8::Unit& u) const {
        const int L = i * G + c; if (L >= ntiles * nN) return false;
        const int tile = L >> lgN, pn = L & (nN - 1); const int e = tinfo[tile]; u.pm = tile; u.pn = e * nN + pn; return true;
    }
    __device__ __forceinline__ int gather_row(const pg8::Unit& u, int i) const { const int as = rowa[u.pm * 256 + i]; return as < 0 ? 0 : (as >> 2); }
};
struct EpiSwiglu {
    static constexpr bool PERM = true;
    unsigned char* act; const float* rinv; const int* rowa; const float* bgu;
    __device__ __forceinline__ void operator()(const pg8::f32x4 (&acc)[2][2][4][2], const pg8::Unit& u, int wr, int wc, int fr, int fq) const {
        const int e = u.pn >> 3, pn = u.pn & 7, col0 = 128 * pn + 32 * wc + 8 * fq;
        const float* bp = bgu + (size_t)e * 2048 + col0;
        f32x4 bg[2], bu[2];
#pragma unroll
        for (int n = 0; n < 2; ++n) { bg[n] = *(const f32x4*)(bp + 4 * n); bu[n] = *(const f32x4*)(bp + 1024 + 4 * n); }
#pragma unroll
        for (int ai = 0; ai < 2; ++ai)
#pragma unroll
            for (int m = 0; m < 4; ++m) {
                const int p = u.pm * 256 + ai * 128 + wr * 64 + m * 16 + fr; const int as = rowa[p]; const float ri = rinv[as < 0 ? 0 : (as >> 2)] * (1.f / (SC_W * SC_X));
                float o[8];
#pragma unroll
                for (int n = 0; n < 2; ++n)
#pragma unroll
                    for (int q = 0; q < 4; ++q) {
                        float g = fminf(acc[ai][0][m][n][q] * ri + bg[n][q], 7.f); const float up = fminf(fmaxf(acc[ai][1][m][n][q] * ri + bu[n][q], -7.f), 7.f);
                        const float sg = __builtin_amdgcn_rcpf(1.f + __builtin_amdgcn_exp2f(g * (-1.702f * LOG2E)));
                        o[4 * n + q] = (up + 1.f) * (g * sg) * SC_A; }
                u32x2 w; w.x = cvt8(o[0], o[1], o[2], o[3]); w.y = cvt8(o[4], o[5], o[6], o[7]);
                *(u32x2*)(act + (size_t)p * 1024 + col0) = w; }
    }
};
struct EpiDown {
    static constexpr bool PERM = true;
    unsigned char* y4; const int* rowa; const float* rowg; const float* bd;
    __device__ __forceinline__ void operator()(const pg8::f32x4 (&acc)[2][2][4][2], const pg8::Unit& u, int wr, int wc, int fr, int fq) const {
        const int e = u.pn >> 2, pn = u.pn & 3, col0 = 256 * pn + 32 * wc + 8 * fq;
        const float* bp = bd + (size_t)e * 1024 + col0;
        f32x4 bv[2][2];
#pragma unroll
        for (int bj = 0; bj < 2; ++bj)
#pragma unroll
            for (int n = 0; n < 2; ++n) bv[bj][n] = *(const f32x4*)(bp + 128 * bj + 4 * n);
#pragma unroll
        for (int ai = 0; ai < 2; ++ai)
#pragma unroll
            for (int m = 0; m < 4; ++m) {
                const int p = u.pm * 256 + ai * 128 + wr * 64 + m * 16 + fr; const int as = rowa[p];
                if (as >= 0) { const float gt = rowg[p] * SC_Y; unsigned char* yr = y4 + (size_t)as * 1024 + col0;
#pragma unroll
                    for (int bj = 0; bj < 2; ++bj) { const f32x4 v0 = (acc[ai][bj][m][0] * (1.f / (SC_W * SC_A)) + bv[bj][0]) * gt, v1 = (acc[ai][bj][m][1] * (1.f / (SC_W * SC_A)) + bv[bj][1]) * gt;
                        u32x2 w; w.x = cvt8(v0[0], v0[1], v0[2], v0[3]); w.y = cvt8(v1[0], v1[1], v1[2], v1[3]);
                        *(u32x2*)(yr + 128 * bj) = w; } } }
    }
};

__device__ __forceinline__ void p7_final(const Args& a, int vcu, int G, int wave, int lane) {
    unsigned char* ws = a.ws; const int gw = vcu * NWAVES + wave, NGW = G * NWAVES;
    const f32x4* gr = (const f32x4*)a.in[21] + lane;
    for (int t = gw; t < T; t += NGW) {
        const u32x2* xr = (const u32x2*)((const bf16*)(ws + WS_XB) + (size_t)t * D) + lane;
        const unsigned* yr = (const unsigned*)(ws + WS_Y48 + (size_t)t * 4 * D) + lane;
        u32x2 xw[4]; unsigned yw[4][4];
#pragma unroll
        for (int j = 0; j < 4; ++j) { xw[j] = xr[64 * j];
#pragma unroll
            for (int k = 0; k < 4; ++k) yw[k][j] = yr[k * 256 + 64 * j]; }
        f32x4 v[4]; float s = 0.f;
#pragma unroll
        for (int j = 0; j < 4; ++j) { f32x4 ys = (f32x4){0.f, 0.f, 0.f, 0.f};
#pragma unroll
            for (int k = 0; k < 4; ++k) { const f32x2 lo = __builtin_amdgcn_cvt_pk_f32_fp8((int)yw[k][j], false), hi = __builtin_amdgcn_cvt_pk_f32_fp8((int)yw[k][j], true);
                ys.x += lo.x; ys.y += lo.y; ys.z += hi.x; ys.w += hi.y; }
            v[j].x = __uint_as_float(xw[j].x << 16) + ys.x * (1.f / SC_Y); v[j].y = __uint_as_float(xw[j].x & 0xffff0000u) + ys.y * (1.f / SC_Y);
            v[j].z = __uint_as_float(xw[j].y << 16) + ys.z * (1.f / SC_Y); v[j].w = __uint_as_float(xw[j].y & 0xffff0000u) + ys.w * (1.f / SC_Y);
            s += (v[j].x * v[j].x + v[j].y * v[j].y) + (v[j].z * v[j].z + v[j].w * v[j].w); }
        const float r = 1.f / sqrtf(wave_sum(s) * (1.f / D) + NORM_EPS);
        f32x4* orow = (f32x4*)(a.out + (size_t)t * D) + lane;
#pragma unroll
        for (int j = 0; j < 4; ++j) { const f32x4 gg = gr[64 * j]; orow[64 * j] = (f32x4){v[j].x * r * gg.x, v[j].y * r * gg.y, v[j].z * r * gg.z, v[j].w * r * gg.w}; }
    }
}

constexpr int N_PHASES = 11;
__global__ void __launch_bounds__(NTHREADS, 2) fwd(Args args) {
    extern __shared__ __attribute__((aligned(16))) unsigned char lds_raw[];
    LAS unsigned char* lds = (LAS unsigned char*)lds_raw;
    volatile LAS unsigned* MISC = (volatile LAS unsigned*)(lds + MISC_OFF);
    const int wave = __builtin_amdgcn_readfirstlane((int)threadIdx.x >> 6);
    const int G = gridDim.x; const int bx = blockIdx.x; const int vcu = (G % 8 == 0) ? (bx % 8) * (G / 8) + bx / 8 : bx;
    unsigned char* ws = args.ws;
    for (int u = wave * 64 + hw_lane(); u < (LDS_BYTES - MISC_OFF) / 4; u += NTHREADS) MISC[u] = 0u;
    __syncthreads();
    const int lo = args.ph_lo, hi = args.ph_hi;
    const bool use_bar = (hi - lo) > 1;
    XcdBarrier bar; bar.bar = (unsigned*)(ws + WS_CTL); bar.x = 0; bar.st = nullptr;
    if (use_bar) bar = xcd_barrier_post((unsigned*)(ws + WS_CTL), MISC + 8, (unsigned)wave);
#ifdef ONLY_PHASE
#define IN(k) ((k) == ONLY_PHASE)
#else
#define IN(k) (lo <= (k) && (k) < hi)
#endif
#define SEAM(k) do { if (IN(k) && IN((k) + 1)) xcd_barrier(bar); } while (0)

    if (IN(0)) { p0_prologue(args, lds, vcu, G, wave, hw_lane()); }
    SEAM(0);
    if (IN(1)) {
        pg8::Gemm g{(const bf16*)(ws + WS_XB), (const bf16*)(ws + WS_WIN), T, PROJ_LD, D}; pg8::StaticOrder S; S.init(T, PROJ_LD, G, bx);
        pg8::EpiBf16 E{(bf16*)(ws + WS_PROJ), PROJ_LD};
        pg8::gemm_phase<pg8::EpiBf16, pg8::StaticOrder, true, false>(lds, g, S, E, wave);
    }
    SEAM(1);
    if (IN(2)) { p1b_latent(args, vcu, G, wave, hw_lane()); }
    SEAM(2);
    if (IN(3)) {
        { pg8::Gemm g{(const bf16*)(ws + WS_CQN), (const bf16*)(ws + WS_WUQ), T, 768, 256}; pg8::StaticOrder S; S.init(T, 768, G, bx);
          pg8::EpiBf16 E{(bf16*)(ws + WS_QM), 768}; pg8::gemm_phase<pg8::EpiBf16, pg8::StaticOrder, true, false>(lds, g, S, E, wave); }
        { pg8::Gemm g{(const bf16*)(ws + WS_CKVN), (const bf16*)(ws + WS_WUKV), T, 1024, 128}; pg8::StaticOrder S; S.init(T, 1024, G, bx);
          pg8::EpiBf16 E{(bf16*)(ws + WS_KV), 1024}; pg8::gemm_phase<pg8::EpiBf16, pg8::StaticOrder, true, false>(lds, g, S, E, wave); }
    }
    SEAM(3);
    if (IN(4)) { p2_attention<3>(args, lds, vcu, G, wave); }
    SEAM(4);
    if (IN(5)) {
        pg8::Gemm g{(const bf16*)(ws + WS_MIXED), (const bf16*)(ws + WS_WO), T, D, D}; pg8::StaticOrder S; S.init(T, D, G, bx);
        pg8::EpiResid E{args.in[0], (bf16*)(ws + WS_XB), D};
        pg8::gemm_phase<pg8::EpiResid, pg8::StaticOrder, true, false>(lds, g, S, E, wave);
    }
    SEAM(5);
    if (IN(6)) { p3b_router(args, lds, G, wave); }
    SEAM(6);
    if (IN(7)) { p4_scatter(args, lds, G, wave); }
    SEAM(7);
    if (IN(8)) {
        const int* tinfo = (const int*)(ws + WS_TINFO); MoeOrder S{tinfo, (const int*)(ws + WS_ROWA), tinfo[2048], 8, 3, G, bx};
        pg8::Gemm g{(const bf16*)(ws + WS_XB8), (const bf16*)(ws + WS_WGU8), 0, 2048, D / 2};
        EpiSwiglu E{ws + WS_ACT8, (const float*)(ws + WS_RINV), (const int*)(ws + WS_ROWA), args.in[18]};
        pg8::gemm_phase<EpiSwiglu, MoeOrder, true, true, true>(lds, g, S, E, wave);
    }
    SEAM(8);
    if (IN(9)) {
        const int* tinfo = (const int*)(ws + WS_TINFO); MoeOrder S{tinfo, (const int*)(ws + WS_ROWA), tinfo[2048], 4, 2, G, bx};
        pg8::Gemm g{(const bf16*)(ws + WS_ACT8), (const bf16*)(ws + WS_WD8), 0, 1024, D / 2};
        EpiDown E{ws + WS_Y48, (const int*)(ws + WS_ROWA), (const float*)(ws + WS_ROWG), args.in[20]};
        pg8::gemm_phase<EpiDown, MoeOrder, true, false, true>(lds, g, S, E, wave);
    }
    SEAM(9);
    if (IN(10)) { p7_final(args, vcu, G, wave, hw_lane()); }
#ifdef PROBE_EXTRA
    if (IN(11)) { p2_attention<1>(args, lds, vcu, G, wave); }
    if (IN(12)) { p2_attention<2>(args, lds, vcu, G, wave); }
#endif
#undef IN
#undef SEAM
}

#ifndef MK_N_LAUNCHES
#define MK_N_LAUNCHES 1
#endif
extern "C" void kernel_launch(void* const* d_in, const int* in_sizes, int n_in, void* d_out, int out_size, void* d_ws, size_t ws_size, hipStream_t stream) {
    static int grid = 0;
    if (grid == 0) {
        if (n_in != 22 || in_sizes[0] != T * D || out_size != T * D || ws_size < WS_END) {
            fprintf(stderr, "kernel_launch: shape / workspace mismatch (n_in %d, in0 %d, out %d, ws %zu < %zu); nothing launched\n", n_in, n_in > 0 ? in_sizes[0] : -1, out_size, ws_size, (size_t)WS_END); grid = -1; return; }
        int dev = 0, cus = 0, per_cu = 0;
        if (hipGetDevice(&dev) != hipSuccess || hipDeviceGetAttribute(&cus, hipDeviceAttributeMultiprocessorCount, dev) != hipSuccess) { grid = -1; return; }
        if (hipFuncSetAttribute((const void*)fwd, hipFuncAttributeMaxDynamicSharedMemorySize, LDS_BYTES) != hipSuccess) { fprintf(stderr, "kernel_launch: hipFuncSetAttribute failed\n"); grid = -1; return; }
        if (hipOccupancyMaxActiveBlocksPerMultiprocessor(&per_cu, (const void*)fwd, NTHREADS, LDS_BYTES) != hipSuccess || per_cu < 1) { fprintf(stderr, "kernel_launch: occupancy query says %d\n", per_cu); }
        (void)hipGetLastError();
        grid = cus;
    }
    if (grid < 0) return;
    if (hipMemsetAsync((char*)d_ws + WS_CTL, 0, CTL_ZERO_BYTES, stream) != hipSuccess) return;
    Args a{};
    for (int i = 0; i < 22; ++i) a.in[i] = (const float*)d_in[i];
    a.out = (float*)d_out; a.ws = (unsigned char*)d_ws;
#if MK_N_LAUNCHES == 1
    a.ph_lo = 0; a.ph_hi = N_PHASES;
    hipLaunchKernelGGL(fwd, dim3(grid), dim3(NTHREADS), LDS_BYTES, stream, a);
#else
#ifndef PROBE_MASK
#define PROBE_MASK 0
#endif
    for (int p = 0; p < N_PHASES; ++p) { a.ph_lo = p; a.ph_hi = p + 1; hipLaunchKernelGGL(fwd, dim3(grid), dim3(NTHREADS), LDS_BYTES, stream, a);
        if ((PROBE_MASK >> p) & 1) hipLaunchKernelGGL(fwd, dim3(grid), dim3(NTHREADS), LDS_BYTES, stream, a);
#ifdef PROBE_EXTRA
        if (p == 4) { a.ph_lo = PROBE_EXTRA; a.ph_hi = PROBE_EXTRA + 1; hipLaunchKernelGGL(fwd, dim3(grid), dim3(NTHREADS), LDS_BYTES, stream, a); }
#endif
    }
#endif
}
```

```cpp
#include <hip/hip_runtime.h>
#include <cstdio>
#include <cstdint>

__device__ __forceinline__ int hw_lane() { int l; asm volatile("v_mbcnt_lo_u32_b32 %0, -1, 0\n\tv_mbcnt_hi_u32_b32 %0, -1, %0" : "=v"(l)); return l; }
namespace pg8 {
#define PG8_LAS __attribute__((address_space(3)))
typedef unsigned short bf16_t;
typedef short bf16x8 __attribute__((ext_vector_type(8)));
typedef float f32x4 __attribute__((ext_vector_type(4)));
typedef unsigned u32x4 __attribute__((ext_vector_type(4)));
typedef unsigned u32x2 __attribute__((ext_vector_type(2)));
typedef int v8i __attribute__((ext_vector_type(8)));
typedef short bf16x16 __attribute__((ext_vector_type(16)));
constexpr int BM = 256, BK = 64, HALF = 128, HTB = HALF * BK * 2  , STAGE_BYTES = 8 * HTB, NXCD = 8, WGM = 8;

__host__ __device__ __forceinline__ int lds_byte(int r, int c) { const int st = (r >> 4) * 2 + (c >> 5), rr = r & 15, cc = c & 31, ob = rr * 64 + cc * 2; return st * 1024 + (ob ^ (((ob >> 9) & 1) << 5)); }
__host__ __device__ __forceinline__ void stage_rc(int b, int& R, int& C) { const int st = b / 1024, sb = b % 1024, swz = sb ^ (((sb >> 9) & 1) << 5); R = (st >> 1) * 16 + swz / 64; C = (st & 1) * 32 + (swz % 64) / 2; }
__host__ __device__ __forceinline__ int perm32(int rho) { const int n = rho >> 4, i = rho & 15; return 8 * (i >> 2) + 4 * n + (i & 3); }

struct Unit { int pm, pn; };
struct Gemm { const bf16_t* A; const bf16_t* Bt; int M, N, K; };

struct StaticOrder {
    int nM, nN, nwg, G, c;
    __host__ __device__ void init(int M, int N, int G_, int c_) { nM = M / BM; nN = N / BM; nwg = nM * nN; G = G_; c = c_; }
    __host__ __device__ bool next(int i, Unit& u) const {
        const long L = (long)i * G + c; if (L >= nwg) return false;
        int wgid = (int)L; { const int q = nwg / NXCD, r = nwg % NXCD, xcd = wgid % NXCD, off = wgid / NXCD; wgid = (xcd < r ? xcd * (q + 1) : r * (q + 1) + (xcd - r) * q) + off; }
        const int nig = WGM * nN, gid = wgid / nig, fm = gid * WGM, gsz = (nM - fm) < WGM ? (nM - fm) : WGM;
        u.pm = fm + ((wgid % nig) % gsz); u.pn = (wgid % nig) / gsz; return true;
    }
    __device__ __forceinline__ int gather_row(const Unit&, int) const { return 0; }
};

__device__ __forceinline__ unsigned cvt_pk_bf16(float lo, float hi) { unsigned r; asm volatile("v_cvt_pk_bf16_f32 %0, %1, %2" : "=v"(r) : "v"(lo), "v"(hi)); return r; }

struct EpiBf16 {
    static constexpr bool PERM = true;
    bf16_t* O; int ldc;
    __device__ __forceinline__ void operator()(const f32x4 (&acc)[2][2][4][2], const Unit& u, int wr, int wc, int fr, int fq) const {
        const int row0 = u.pm * BM + wr * 64 + fr; const int col0 = u.pn * BM + wc * 32 + 8 * fq;
#pragma unroll
        for (int ai = 0; ai < 2; ++ai)
#pragma unroll
            for (int m = 0; m < 4; ++m) { bf16_t* rowp = O + (size_t)(row0 + ai * HALF + m * 16) * ldc + col0;
#pragma unroll
                for (int bj = 0; bj < 2; ++bj) { const f32x4 v0 = acc[ai][bj][m][0], v1 = acc[ai][bj][m][1];
                    u32x4 w; w.x = cvt_pk_bf16(v0[0], v0[1]); w.y = cvt_pk_bf16(v0[2], v0[3]); w.z = cvt_pk_bf16(v1[0], v1[1]); w.w = cvt_pk_bf16(v1[2], v1[3]);
                    *(u32x4*)(rowp + bj * HALF) = w; } }
    }
};
struct EpiResid {
    static constexpr bool PERM = true;
    const float* base; bf16_t* out; int ldc;
    __device__ __forceinline__ void operator()(const f32x4 (&acc)[2][2][4][2], const Unit& u, int wr, int wc, int fr, int fq) const {
        const int row0 = u.pm * BM + wr * 64 + fr; const int col0 = u.pn * BM + wc * 32 + 8 * fq;
#pragma unroll
        for (int ai = 0; ai < 2; ++ai)
#pragma unroll
            for (int m = 0; m < 4; ++m) { const size_t off = (size_t)(row0 + ai * HALF + m * 16) * ldc + col0;
#pragma unroll
                for (int bj = 0; bj < 2; ++bj) { const f32x4 v0 = *(const f32x4*)(base + off + bj * HALF) + acc[ai][bj][m][0], v1 = *(const f32x4*)(base + off + bj * HALF + 4) + acc[ai][bj][m][1];
                    u32x4 w; w.x = cvt_pk_bf16(v0[0], v0[1]); w.y = cvt_pk_bf16(v0[2], v0[3]); w.z = cvt_pk_bf16(v1[0], v1[1]); w.w = cvt_pk_bf16(v1[2], v1[3]);
                    *(u32x4*)(out + off + bj * HALF) = w; } }
    }
};

template <class Epi, class Sched, bool ALIGN_EPI = false, bool GATHER = false, bool F8 = false>
__device__ __forceinline__ void gemm_phase(PG8_LAS unsigned char* lds, const Gemm g, const Sched& S, const Epi& E, int wave) {
    const int wid = wave, lane = hw_lane(), tid = wid * 64 + lane, wr = wid >> 2, wc = wid & 3, fr = lane & 15, fq = lane >> 4;
    const int K = g.K, nt = K / BK;
    unsigned voffA[2], voffB[2]; int RA[2], CA[2];
#pragma unroll
    for (int i = 0; i < 2; ++i) { int R, C; stage_rc(tid * 16 + i * 8192, R, C); const int Rb = Epi::PERM ? ((R & ~31) + perm32(R & 31)) : R;
        voffA[i] = (unsigned)(R * K + C) * 2u; voffB[i] = (unsigned)(Rb * K + C) * 2u; RA[i] = R; CA[i] = C; }
    const size_t kstep = (size_t)(BK * 2);
    const size_t hstep = (size_t)HALF * K * 2;
    const size_t tstep = 2 * hstep;
    const unsigned ldsw = (unsigned)wid * 1024u, ldsu = (unsigned)(uintptr_t)lds;
    const int aoff = lds_byte(wr * 64 + fr, fq * (F8 ? 16 : 8)), boff = lds_byte(wc * 32 + fr, fq * (F8 ? 16 : 8));
    PG8_LAS unsigned char* ldsA = lds + aoff; PG8_LAS unsigned char* ldsB = lds + 4 * HTB + boff;
    if constexpr (F8) { asm volatile("" : "+v"(ldsA)); asm volatile("" : "+v"(ldsB)); }
#define PG8_SA(b, h) (((b) * 2 + (h)) * HTB)
#define PG8_SB(b, h) ((4 + (b) * 2 + (h)) * HTB)
#define PG8_SBR(b, h) (((b) * 2 + (h)) * HTB)
#define PG8_DMA1(ldsaddr, gbase, vo) asm volatile("s_mov_b32 m0, %0\n\ts_nop 0\n\tglobal_load_lds_dwordx4 %1, %2" :: "s"(ldsaddr), "v"(vo), "s"(gbase) : "memory", "m0")
#define PG8_STAGE(bufoff, gbase, voff) do { PG8_DMA1(ldsu + (unsigned)(bufoff) + ldsw, (const char*)(gbase), (voff)[0]); PG8_DMA1(ldsu + (unsigned)(bufoff) + ldsw + 8192u, (const char*)(gbase), (voff)[1]); } while (0)
#define PG8_STAGE_A(bufoff, h, base, O) do { if constexpr (GATHER) { PG8_STAGE(bufoff, base, O[h]); } else { PG8_STAGE(bufoff, (base) + (h) * hstep, voffA); } } while (0)
#define PG8_CAT8(lo, hi) ((v8i){(int)lo.x, (int)lo.y, (int)lo.z, (int)lo.w, (int)hi.x, (int)hi.y, (int)hi.z, (int)hi.w})
#define PG8_LDA(dst, b, h) do { if constexpr (F8) { _Pragma("unroll") for (int m = 0; m < 4; ++m) { const u32x4 lo_ = *(const PG8_LAS u32x4*)(ldsA + PG8_SA(b, h) + m * 2048), hi_ = *(const PG8_LAS u32x4*)(ldsA + PG8_SA(b, h) + m * 2048 + 16); dst##8[m] = PG8_CAT8(lo_, hi_); } } \
    else { _Pragma("unroll") for (int m = 0; m < 4; ++m) _Pragma("unroll") for (int k = 0; k < 2; ++k) dst[m][k] = *(const PG8_LAS bf16x8*)(lds + PG8_SA(b, h) + aoff + m * 2048 + k * 1024); } } while (0)
#define PG8_LDB(dst, b, h) do { if constexpr (F8) { _Pragma("unroll") for (int n = 0; n < 2; ++n) { const u32x4 lo_ = *(const PG8_LAS u32x4*)(ldsB + PG8_SBR(b, h) + n * 2048), hi_ = *(const PG8_LAS u32x4*)(ldsB + PG8_SBR(b, h) + n * 2048 + 16); dst##8[n] = PG8_CAT8(lo_, hi_); } } \
    else { _Pragma("unroll") for (int n = 0; n < 2; ++n) _Pragma("unroll") for (int k = 0; k < 2; ++k) dst[n][k] = *(const PG8_LAS bf16x8*)(lds + PG8_SB(b, h) + boff + n * 2048 + k * 1024); } } while (0)
#define PG8_MMA(ai, bj, At, Bt) do { __builtin_amdgcn_s_setprio(1); if constexpr (F8) { _Pragma("unroll") for (int m = 0; m < 4; ++m) _Pragma("unroll") for (int n = 0; n < 2; ++n) \
            acc[ai][bj][m][n] = __builtin_amdgcn_mfma_scale_f32_16x16x128_f8f6f4(Bt##8[n], At##8[m], acc[ai][bj][m][n], 0, 0, 0, 0x7f7f7f7f, 0, 0x7f7f7f7f); } \
    else { _Pragma("unroll") for (int m = 0; m < 4; ++m) _Pragma("unroll") for (int n = 0; n < 2; ++n) _Pragma("unroll") for (int k = 0; k < 2; ++k) \
        acc[ai][bj][m][n] = __builtin_amdgcn_mfma_f32_16x16x32_bf16(Bt[n][k], At[m][k], acc[ai][bj][m][n], 0, 0, 0); } __builtin_amdgcn_s_setprio(0); } while (0)
#define PG8_WAIT_V(n) asm volatile("s_waitcnt vmcnt(" #n ")" ::: "memory")
#define PG8_WAIT_L(n) asm volatile("s_waitcnt lgkmcnt(" #n ")" ::: "memory")
#define PG8_BAR __builtin_amdgcn_s_barrier()
#define PG8_SCHED __builtin_amdgcn_sched_barrier(0)
    Unit cur, nxt; int ui = 0;
    if (!S.next(0, cur)) return;
    f32x4 acc[2][2][4][2];
#pragma unroll
    for (int a = 0; a < 2; ++a)
#pragma unroll
        for (int b = 0; b < 2; ++b)
#pragma unroll
            for (int m = 0; m < 4; ++m)
#pragma unroll
                for (int n = 0; n < 2; ++n) acc[a][b][m][n] = (f32x4){0.f, 0.f, 0.f, 0.f};
    bf16x8 At[4][2], B0[2][2], B1[2][2]; v8i At8[4], B08[2], B18[2];
    unsigned gC[2][2], gN[2][2];
#pragma unroll
    for (int h = 0; h < 2; ++h)
#pragma unroll
        for (int i = 0; i < 2; ++i) { gC[h][i] = 0u; gN[h][i] = 0u; }
    if constexpr (GATHER) {
#pragma unroll
        for (int h = 0; h < 2; ++h)
#pragma unroll
            for (int i = 0; i < 2; ++i) gC[h][i] = (unsigned)S.gather_row(cur, h * HALF + RA[i]) * (unsigned)(K * 2) + (unsigned)(CA[i] * 2);
    }
    const char* cA = GATHER ? (const char*)g.A : (const char*)g.A + (size_t)cur.pm * tstep; const char* cB = (const char*)g.Bt + (size_t)cur.pn * tstep;
    PG8_STAGE(PG8_SB(0, 0), cB, voffB); PG8_STAGE(PG8_SB(0, 1), cB + hstep, voffB); PG8_STAGE_A(PG8_SA(0, 0), 0, cA, gC); PG8_STAGE_A(PG8_SA(0, 1), 1, cA, gC);
    if (wr == 1) PG8_BAR;
    PG8_WAIT_V(2); PG8_BAR;
    PG8_STAGE(PG8_SB(1, 0), cB + kstep, voffB); PG8_STAGE_A(PG8_SA(1, 0), 0, cA + kstep, gC); PG8_STAGE(PG8_SB(1, 1), cB + hstep + kstep, voffB);
    PG8_WAIT_V(6); PG8_BAR;
    for (;;) {
        const bool has_next = S.next(ui + 1, nxt);
        if constexpr (GATHER) {
            if (has_next) {
#pragma unroll
                for (int h = 0; h < 2; ++h)
#pragma unroll
                    for (int i = 0; i < 2; ++i) gN[h][i] = (unsigned)S.gather_row(nxt, h * HALF + RA[i]) * (unsigned)(K * 2) + (unsigned)(CA[i] * 2);
            } else {
#pragma unroll
                for (int h = 0; h < 2; ++h)
#pragma unroll
                    for (int i = 0; i < 2; ++i) gN[h][i] = gC[h][i];
            }
        }
        const char* nA = GATHER ? (const char*)g.A : (has_next ? (const char*)g.A + (size_t)nxt.pm * tstep : cA); const char* nB = has_next ? (const char*)g.Bt + (size_t)nxt.pn * tstep : cB;
#pragma unroll 1
        for (int t = 0; t < nt; t += 2) {
            const bool last = (t == nt - 2);
            const char* a1 = cA + (size_t)(t + 1) * kstep;
            const char* a2 = last ? nA : cA + (size_t)(t + 2) * kstep; const char* b2 = last ? nB : cB + (size_t)(t + 2) * kstep;
            const char* a3 = a2 + kstep; const char* b3 = b2 + kstep;
            PG8_LDB(B0, 0, 0); PG8_LDB(B1, 0, 1); PG8_SCHED; PG8_LDA(At, 0, 0); PG8_STAGE_A(PG8_SA(1, 1), 1, a1, gC);
            if constexpr (GATHER) { if (last) { _Pragma("unroll") for (int h = 0; h < 2; ++h) _Pragma("unroll") for (int i = 0; i < 2; ++i) gC[h][i] = gN[h][i]; } }
            PG8_WAIT_V(8); PG8_WAIT_L(0); PG8_BAR; PG8_MMA(0, 0, At, B0); PG8_MMA(0, 1, At, B1); PG8_BAR; PG8_SCHED;
            PG8_LDA(At, 0, 1); PG8_STAGE(PG8_SB(0, 0), b2, voffB); PG8_STAGE(PG8_SB(0, 1), b2 + hstep, voffB); PG8_STAGE_A(PG8_SA(0, 0), 0, a2, gC);
            PG8_WAIT_V(8); PG8_WAIT_L(0); PG8_BAR; PG8_MMA(1, 0, At, B0); PG8_MMA(1, 1, At, B1); PG8_BAR; PG8_SCHED;
            PG8_LDB(B0, 1, 0); PG8_LDB(B1, 1, 1); PG8_SCHED; PG8_LDA(At, 1, 0); PG8_STAGE_A(PG8_SA(0, 1), 1, a2, gC);
            PG8_WAIT_V(8); PG8_WAIT_L(0); PG8_BAR; PG8_MMA(0, 0, At, B0); PG8_MMA(0, 1, At, B1); PG8_BAR; PG8_SCHED;
            PG8_LDA(At, 1, 1); PG8_STAGE(PG8_SB(1, 0), b3, voffB); PG8_STAGE(PG8_SB(1, 1), b3 + hstep, voffB); PG8_STAGE_A(PG8_SA(1, 0), 0, a3, gC);
            PG8_WAIT_V(8); PG8_WAIT_L(0); PG8_BAR; PG8_MMA(1, 0, At, B0); PG8_MMA(1, 1, At, B1); PG8_BAR; PG8_SCHED;
        }
        if constexpr (ALIGN_EPI) { if (wr == 0) PG8_BAR; }
        E(acc, cur, wr, wc, fr, fq);
        if (!has_next) break;
#pragma unroll
        for (int a = 0; a < 2; ++a)
#pragma unroll
            for (int b = 0; b < 2; ++b)
#pragma unroll
                for (int m = 0; m < 4; ++m)
#pragma unroll
                    for (int n = 0; n < 2; ++n) acc[a][b][m][n] = (f32x4){0.f, 0.f, 0.f, 0.f};
        cur = nxt; cA = nA; cB = nB; ++ui;
#pragma unroll
        for (int h = 0; h < 2; ++h)
#pragma unroll
            for (int i = 0; i < 2; ++i) gC[h][i] = gN[h][i];
        if constexpr (ALIGN_EPI) { if (wr == 1) PG8_BAR; }
    }
    PG8_WAIT_V(0);
    if constexpr (!ALIGN_EPI) { if (wr == 0) PG8_BAR; }
    PG8_BAR;
#undef PG8_SA
#undef PG8_SB
#undef PG8_SBR
#undef PG8_STAGE
#undef PG8_DMA1
#undef PG8_STAGE_A
#undef PG8_LDA
#undef PG8_CAT8
#undef PG8_LDB
#undef PG8_MMA
#undef PG8_WAIT_V
#undef PG8_WAIT_L
#undef PG8_BAR
#undef PG8_SCHED
}
}

namespace att {
#define ALAS __attribute__((address_space(3)))
using bf16 = unsigned short;
using bf16x8 = __attribute__((ext_vector_type(8))) short;
using s16x4  = __attribute__((ext_vector_type(4))) short;
using f32x16 = __attribute__((ext_vector_type(16))) float;
using f32x2  = __attribute__((ext_vector_type(2))) float;
using u32x4  = __attribute__((ext_vector_type(4))) unsigned;
#define SBAR() __builtin_amdgcn_sched_barrier(0)
constexpr int SHM_V = 64 * 128 * 2;
constexpr int OFF_V = 0;
template <int MODE> struct L { static constexpr int NVB = MODE == 0 ? 3 : 2, SHM_K = 64 * (MODE == 0 ? 384 : 128), OFF_K = NVB * SHM_V, OFF_WS = OFF_K + 2 * SHM_K; };
constexpr int OFF_LUT = L<1>::OFF_WS + 2048;
constexpr int OFF_STASH = OFF_LUT + 16384;
constexpr int OFF_QPE = L<0>::OFF_WS + 2048;
constexpr int ATT_LDS = (OFF_STASH + 65536) > (OFF_QPE + 40960) ? (OFF_STASH + 65536) : (OFF_QPE + 40960);
__device__ __forceinline__ int crow(int r, int hi) { return (r & 3) + 8 * (r >> 2) + 4 * hi; }
__device__ __forceinline__ unsigned cvtpk(float lo, float hi) { unsigned r; asm volatile("v_cvt_pk_bf16_f32 %0, %1, %2" : "=v"(r) : "v"(lo), "v"(hi)); return r; }
__device__ __forceinline__ float bf2f(short v) { return __uint_as_float(((unsigned)(unsigned short)v) << 16); }
template <int RB> __device__ __forceinline__ int kaddr(int row, int colB) { return row * RB + (colB ^ (((row >> 1) & 7) << 4)); }

template <bool NEAR>
__device__ __forceinline__ void partialSM(f32x16& p0, f32x16& p1, float& m_reg, float& mn, float& alpha, float C, const ALAS float* lut, float cfar) {
  constexpr float THR2 = 8.f * 1.4426950408889634f;
  if constexpr (NEAR) {
#pragma unroll
    for (int r = 0; r < 16; ++r) { const int o = (r & 3) + 8 * (r >> 2); p0[r] = fmaf(p0[r], C, lut[o]); p1[r] = fmaf(p1[r], C, lut[32 + o]); }
  }
  float pmax = p0[0];
#pragma unroll
  for (int r = 1; r < 16; ++r) pmax = fmaxf(pmax, p0[r]);
#pragma unroll
  for (int r = 0; r < 16; ++r) pmax = fmaxf(pmax, p1[r]);
  { auto rr = __builtin_amdgcn_permlane32_swap(__float_as_uint(pmax), __float_as_uint(pmax), false, false);
    pmax = fmaxf(__uint_as_float(rr[0]), __uint_as_float(rr[1])); }
  if constexpr (!NEAR) pmax = fmaf(pmax, C, cfar);
  if (__builtin_expect(__all(pmax - m_reg <= THR2), 1)) { mn = m_reg; alpha = 1.f; }
  else { mn = fmaxf(m_reg, pmax); alpha = __builtin_amdgcn_exp2f(m_reg - mn); m_reg = mn; }
  if constexpr (NEAR) {
#pragma unroll
    for (int r = 0; r < 16; ++r) p0[r] = __builtin_amdgcn_exp2f(p0[r] - mn);
#pragma unroll
    for (int r = 0; r < 16; ++r) p1[r] = p1[r] - mn;
  } else {
    const float cm = cfar - mn;
#pragma unroll
    for (int r = 0; r < 16; ++r) p0[r] = __builtin_amdgcn_exp2f(fmaf(p0[r], C, cm));
#pragma unroll
    for (int r = 0; r < 16; ++r) p1[r] = fmaf(p1[r], C, cm);
  }
}
__device__ __forceinline__ void finishSM(f32x16& p0, f32x16& p1, float alpha, float& l_reg, bf16x8& pa0, bf16x8& pa1, bf16x8& pa2, bf16x8& pa3) {
#pragma unroll
  for (int r = 0; r < 16; ++r) p1[r] = __builtin_amdgcn_exp2f(p1[r]);
  float ps = 0;
#pragma unroll
  for (int r = 0; r < 16; ++r) ps += p0[r];
#pragma unroll
  for (int r = 0; r < 16; ++r) ps += p1[r];
  { auto rr = __builtin_amdgcn_permlane32_swap(__float_as_uint(ps), __float_as_uint(ps), false, false);
    ps = __uint_as_float(rr[0]) + __uint_as_float(rr[1]); }
  l_reg = l_reg * alpha + ps;
#define PK4(P, BASE, OUT) do { unsigned a0 = cvtpk(P[BASE + 0], P[BASE + 1]), a1 = cvtpk(P[BASE + 2], P[BASE + 3]);   \
    unsigned b0 = cvtpk(P[BASE + 4], P[BASE + 5]), b1 = cvtpk(P[BASE + 6], P[BASE + 7]);                              \
    auto r0 = __builtin_amdgcn_permlane32_swap(a0, b0, false, false); auto r1 = __builtin_amdgcn_permlane32_swap(a1, b1, false, false); \
    u32x4 w = {r0[0], r1[0], r0[1], r1[1]}; OUT = __builtin_bit_cast(bf16x8, w); } while (0)
  PK4(p0, 0, pa0); PK4(p0, 8, pa1); PK4(p1, 0, pa2); PK4(p1, 8, pa3);
#undef PK4
}
template <int NQ, int RB>
__device__ __forceinline__ void qkt(f32x16& p0, f32x16& p1, const ALAS char* Ks, const bf16x8* qr, int r32, int hi) {
  p0 = f32x16{}; p1 = f32x16{};
#pragma unroll
  for (int d0 = 0; d0 < NQ; ++d0) { const int cb = (d0 * 16 + hi * 8) * 2;
    const bf16x8 b0 = *reinterpret_cast<const ALAS bf16x8*>(Ks + kaddr<RB>(r32, cb));
    const bf16x8 b1 = *reinterpret_cast<const ALAS bf16x8*>(Ks + kaddr<RB>(32 + r32, cb));
    p0 = __builtin_amdgcn_mfma_f32_32x32x16_bf16(b0, qr[d0], p0, 0, 0, 0);
    p1 = __builtin_amdgcn_mfma_f32_32x32x16_bf16(b1, qr[d0], p1, 0, 0, 0); }
}
__device__ __forceinline__ int v_st(int k, int c) { const int kk = (k & ~0xC) | ((k & 4) << 1) | ((k & 8) >> 1); return ((kk >> 3) * 4 + (c >> 5)) * 512 + ((kk & 7) * 32 + (c & 31)) * 2; }
__device__ __forceinline__ int v_rd_base(int lane) { return ((lane & 3) << 3) | (((lane >> 2) & 3) << 6) | (((lane >> 4) & 1) << 5) | (((lane >> 5) & 1) << 8); }
constexpr int v_rd_off(int d0, int ks, int half) { return d0 * 512 + ks * 4096 + half * 2048; }
template <int OFF> __device__ __forceinline__ s16x4 tr_read(int vb) {
  s16x4 r; asm volatile("ds_read_b64_tr_b16 %0, %1 offset:%2" : "=&v"(r) : "v"(vb), "i"(OFF) : "memory"); return r;
}
template <int D0> __device__ __forceinline__ void pv_one(f32x16& od, int vb, bf16x8 pa0, bf16x8 pa1, bf16x8 pa2, bf16x8 pa3) {
  const s16x4 l0 = tr_read<v_rd_off(D0, 0, 0)>(vb), h0 = tr_read<v_rd_off(D0, 0, 1)>(vb), l1 = tr_read<v_rd_off(D0, 1, 0)>(vb), h1 = tr_read<v_rd_off(D0, 1, 1)>(vb);
  const s16x4 l2 = tr_read<v_rd_off(D0, 2, 0)>(vb), h2 = tr_read<v_rd_off(D0, 2, 1)>(vb), l3 = tr_read<v_rd_off(D0, 3, 0)>(vb), h3 = tr_read<v_rd_off(D0, 3, 1)>(vb);
  asm volatile("s_waitcnt lgkmcnt(0)" ::: "memory"); SBAR();
#define PK(L, H) (bf16x8){L[0], L[1], L[2], L[3], H[0], H[1], H[2], H[3]}
  od = __builtin_amdgcn_mfma_f32_32x32x16_bf16(pa0, PK(l0, h0), od, 0, 0, 0);
  od = __builtin_amdgcn_mfma_f32_32x32x16_bf16(pa1, PK(l1, h1), od, 0, 0, 0);
  od = __builtin_amdgcn_mfma_f32_32x32x16_bf16(pa2, PK(l2, h2), od, 0, 0, 0);
  od = __builtin_amdgcn_mfma_f32_32x32x16_bf16(pa3, PK(l3, h3), od, 0, 0, 0);
#undef PK
}
__device__ __forceinline__ void pv_d0(f32x16* o, int vb, bf16x8 pa0, bf16x8 pa1, bf16x8 pa2, bf16x8 pa3) {
  pv_one<0>(o[0], vb, pa0, pa1, pa2, pa3); pv_one<1>(o[1], vb, pa0, pa1, pa2, pa3); pv_one<2>(o[2], vb, pa0, pa1, pa2, pa3); pv_one<3>(o[3], vb, pa0, pa1, pa2, pa3);
}

__device__ __forceinline__ int kw_addr(int row, int colB) { return row * 256 + (colB ^ ((row & 15) << 4)); }
__device__ __forceinline__ int kn_addr(int row, int colB) { return row * 128 + (colB ^ (((row >> 1) & 7) << 4)); }
template <int MODE>
__device__ __forceinline__ void attn_unit(const bf16* __restrict__ Qb, int ldq, const bf16* __restrict__ Kh, int ldk, const bf16* __restrict__ Kp, const bf16* __restrict__ Vh, int ldv,
                                          int seq, ALAS char* lds, float C, const f32x2* __restrict__ cs, int qpos0, f32x16 (&o)[4], int wave, int lane_in) {
  constexpr int SHM_KW = MODE == 0 ? 64 * 256 : 0, SHM_KN = 64 * 128, SHM_K = SHM_KW + SHM_KN;
  static_assert(SHM_K == L<MODE>::SHM_K, "K buffers");
  const int tid = threadIdx.x, wid = __builtin_amdgcn_readfirstlane(tid >> 6), lane = tid & 63, r32 = lane & 31, hi = lane >> 5;
  const bool late = wid >= 4;
  ALAS char* V_lds = lds + OFF_V; ALAS char* K_lds = lds + L<MODE>::OFF_K;
  ALAS float* ws = (ALAS float*)(lds + L<MODE>::OFF_WS) + wid * 64; ALAS float* li_l = ws; ALAS float* al_l = ws + 32;
  __syncthreads();
  float m_reg = -1e30f, l_reg = 0;
#pragma unroll
  for (int d = 0; d < 4; ++d) o[d] = f32x16{};
  constexpr int NQR = MODE == 0 ? 7 : 4;
  bf16x8 qr[NQR];
  ALAS char* qpe_l = lds + OFF_QPE + wid * 5120 + lane * 16;
  const bf16* Qw = Qb + (long)(wid * 32 + r32) * ldq + hi * 8;
#pragma unroll
  for (int d0 = 0; d0 < NQR; ++d0) qr[d0] = *reinterpret_cast<const bf16x8*>(Qw + d0 * 16);
  if constexpr (MODE == 0) {
    bf16x8 qp[4];
#pragma unroll
    for (int d0 = 0; d0 < 4; ++d0) qp[d0] = *reinterpret_cast<const bf16x8*>(Qw + (8 + d0) * 16);
    *(ALAS bf16x8*)(qpe_l + 4 * 1024) = *reinterpret_cast<const bf16x8*>(Qw + 7 * 16);
    const f32x2* cp = cs + (long)(qpos0 + wid * 32 + r32) * 32 + hi * 8;
#pragma unroll
    for (int a = 0; a < 2; ++a) {
      unsigned w1[4], w2[4];
#pragma unroll
      for (int j = 0; j < 8; j += 2) {
        const f32x2 c0 = cp[16 * a + j], c1 = cp[16 * a + j + 1];
        const float x10 = bf2f(qp[a][j]), x20 = bf2f(qp[2 + a][j]), x11 = bf2f(qp[a][j + 1]), x21 = bf2f(qp[2 + a][j + 1]);
        w1[j >> 1] = cvtpk(x10 * c0.x - x20 * c0.y, x11 * c1.x - x21 * c1.y);
        w2[j >> 1] = cvtpk(x10 * c0.y + x20 * c0.x, x11 * c1.y + x21 * c1.x);
      }
      u32x4 v1 = {w1[0], w1[1], w1[2], w1[3]}, v2 = {w2[0], w2[1], w2[2], w2[3]};
      *(ALAS u32x4*)(qpe_l + a * 1024) = v1; *(ALAS u32x4*)(qpe_l + (2 + a) * 1024) = v2;
    }
  }
  unsigned vsrc[2], kwsrc[2], knsrc;
#pragma unroll
  for (int i = 0; i < 2; ++i) { const int s = (wid + 8 * i) * 64 + lane;
    const int kk = (s >> 7) * 8 + ((s & 31) >> 2), c = ((s >> 5) & 3) * 32 + (s & 3) * 8, k = (kk & ~0xC) | ((kk & 4) << 1) | ((kk & 8) >> 1);
    vsrc[i] = (unsigned)(k * ldv + c);
    const int row = s >> 4, ch = (s & 15) ^ (row & 15); kwsrc[i] = (unsigned)(row * ldk + ch * 8); }
  { const int s = wid * 64 + lane, row = s >> 3, ch = (s & 7) ^ ((row >> 1) & 7); knsrc = (unsigned)(row * (MODE == 0 ? 64 : ldk) + ch * 8); }
  const bf16* Kn = MODE == 0 ? Kp : Kh; const int ldn = MODE == 0 ? 64 : ldk;
#define DMA16(src, dst) __builtin_amdgcn_global_load_lds((const unsigned*)(src), (ALAS unsigned*)(dst), 16, 0, 0)
#define DMA_V(t, b) do { const bf16* vb_ = Vh + (long)(t) * 64 * ldv; DMA16(vb_ + vsrc[0], V_lds + (b) * SHM_V + wid * 1024); DMA16(vb_ + vsrc[1], V_lds + (b) * SHM_V + (wid + 8) * 1024); } while (0)
#define DMA_K(t, b) do { if constexpr (MODE == 0) { const bf16* kb_ = Kh + (long)(t) * 64 * ldk; DMA16(kb_ + kwsrc[0], K_lds + (b) * SHM_K + wid * 1024); DMA16(kb_ + kwsrc[1], K_lds + (b) * SHM_K + (wid + 8) * 1024); } \
    DMA16(Kn + (long)(t) * 64 * ldn + knsrc, K_lds + (b) * SHM_K + SHM_KW + wid * 1024); } while (0)
#define STEP_END() do { asm volatile("s_waitcnt vmcnt(0)" ::: "memory"); __syncthreads(); } while (0)
#define QKT(P0, P1, b) do { P0 = f32x16{}; P1 = f32x16{}; const ALAS char* kb_ = K_lds + (b) * SHM_K; \
    if constexpr (MODE == 0) { _Pragma("unroll") for (int d0 = 0; d0 < 8; ++d0) { const int cb = (d0 * 16 + hi * 8) * 2; \
        const bf16x8 b0 = *reinterpret_cast<const ALAS bf16x8*>(kb_ + kw_addr(r32, cb)); const bf16x8 b1 = *reinterpret_cast<const ALAS bf16x8*>(kb_ + kw_addr(32 + r32, cb)); \
        bf16x8 qn_; if (d0 < NQR) qn_ = qr[d0 < NQR ? d0 : 0]; else qn_ = *reinterpret_cast<const ALAS bf16x8*>(qpe_l + 4 * 1024); \
        P0 = __builtin_amdgcn_mfma_f32_32x32x16_bf16(b0, qn_, P0, 0, 0, 0); P1 = __builtin_amdgcn_mfma_f32_32x32x16_bf16(b1, qn_, P1, 0, 0, 0); } } \
    _Pragma("unroll") for (int d0 = 0; d0 < 4; ++d0) { const int cb = (d0 * 16 + hi * 8) * 2; \
        const bf16x8 b0 = *reinterpret_cast<const ALAS bf16x8*>(kb_ + SHM_KW + kn_addr(r32, cb)); const bf16x8 b1 = *reinterpret_cast<const ALAS bf16x8*>(kb_ + SHM_KW + kn_addr(32 + r32, cb)); \
        bf16x8 qf_; if constexpr (MODE == 0) qf_ = *reinterpret_cast<const ALAS bf16x8*>(qpe_l + d0 * 1024); else qf_ = qr[d0]; \
        P0 = __builtin_amdgcn_mfma_f32_32x32x16_bf16(b0, qf_, P0, 0, 0, 0); P1 = __builtin_amdgcn_mfma_f32_32x32x16_bf16(b1, qf_, P1, 0, 0, 0); } } while (0)
#define RESC(a) do { if (__any((a) < 1.f)) { if (hi == 0) al_l[r32] = (a); asm volatile("s_waitcnt lgkmcnt(0)" ::: "memory"); \
    _Pragma("unroll") for (int d = 0; d < 4; ++d) _Pragma("unroll") for (int r = 0; r < 16; ++r) o[d][r] *= al_l[crow(r, hi)]; } } while (0)
  const int vb0 = (int)(unsigned)(uintptr_t)V_lds + v_rd_base(lane);
  const int qw = qpos0 + wid * 32;
  const ALAS float* lutb = (const ALAS float*)(lds + OFF_LUT);
  const ALAS float* lutp = lutb + (2047 - (qw + r32) + 4 * hi);
  float cpos = 0.f, cneg = 0.f;
#define PSM(P0, P1, MN, AL, TILE) do { if constexpr (MODE == 0) partialSM<false>(P0, P1, m_reg, MN, AL, C, lutp, 0.f); else { const int k0_ = (TILE) * 64; \
    if ((k0_ >= qw + 122) || (k0_ + 154 <= qw)) partialSM<false>(P0, P1, m_reg, MN, AL, C, lutp, k0_ > qw ? cpos : cneg); else partialSM<true>(P0, P1, m_reg, MN, AL, C, lutp + k0_, 0.f); } } while (0)
  f32x16 pA0, pA1; float mnA, alA; bf16x8 pa0, pa1, pa2, pa3; const int NT = seq / 64;
  if constexpr (MODE == 0) {
    DMA_K(0, 0); DMA_V(0, 0); STEP_END();
    int vbj = 0, vbp = 0;
    for (int j = 0; j < NT; ++j) {
      const int kb = j & 1, vbn = vbj == 2 ? 0 : vbj + 1;
      if (j + 1 < NT) { DMA_K(j + 1, kb ^ 1); DMA_V(j + 1, vbn); }
      if (late && j > 0) pv_d0(o, vb0 + vbp * SHM_V, pa0, pa1, pa2, pa3);
      SBAR();
      QKT(pA0, pA1, kb); PSM(pA0, pA1, mnA, alA, j);
      RESC(alA);
      finishSM(pA0, pA1, alA, l_reg, pa0, pa1, pa2, pa3); SBAR();
      if (!late) pv_d0(o, vb0 + vbj * SHM_V, pa0, pa1, pa2, pa3);
      STEP_END();
      vbp = vbj; vbj = vbn;
    }
    if (late) pv_d0(o, vb0 + vbp * SHM_V, pa0, pa1, pa2, pa3);
  } else {
    f32x16 pB0, pB1; float mnB, alB;
    DMA_K(0, 0); STEP_END();
    cpos = lutb[2047 + 128]; cneg = lutb[2047 - 128];
#define DIFF_LOOP(LATE) do { \
      \
    DMA_K(1, 1); DMA_V(0, 0); \
    QKT(pA0, pA1, 0); \
    if (!(LATE)) { PSM(pA0, pA1, mnA, alA, 0); } \
    STEP_END(); \
    for (int j = 1; j + 1 < NT; j += 2) { \
        \
      DMA_K(j + 1, 0); DMA_V(j, 1); \
      if (LATE) { PSM(pA0, pA1, mnA, alA, j - 1); RESC(alA); } \
      SBAR(); QKT(pB0, pB1, 1); \
      finishSM(pA0, pA1, alA, l_reg, pa0, pa1, pa2, pa3); SBAR(); \
      pv_d0(o, vb0, pa0, pa1, pa2, pa3); \
      if (!(LATE)) { PSM(pB0, pB1, mnB, alB, j); RESC(alB); } \
      STEP_END(); \
        \
      DMA_K(j + 2, 1); DMA_V(j + 1, 0); \
      if (LATE) { PSM(pB0, pB1, mnB, alB, j); RESC(alB); } \
      SBAR(); QKT(pA0, pA1, 0); \
      finishSM(pB0, pB1, alB, l_reg, pa0, pa1, pa2, pa3); SBAR(); \
      pv_d0(o, vb0 + SHM_V, pa0, pa1, pa2, pa3); \
      if (!(LATE)) { PSM(pA0, pA1, mnA, alA, j + 1); RESC(alA); } \
      STEP_END(); \
    } \
      \
    DMA_V(NT - 1, 1); \
    if (LATE) { PSM(pA0, pA1, mnA, alA, NT - 2); RESC(alA); } \
    SBAR(); QKT(pB0, pB1, 1); \
    finishSM(pA0, pA1, alA, l_reg, pa0, pa1, pa2, pa3); SBAR(); \
    pv_d0(o, vb0, pa0, pa1, pa2, pa3); \
    PSM(pB0, pB1, mnB, alB, NT - 1); RESC(alB); \
    STEP_END(); \
    finishSM(pB0, pB1, alB, l_reg, pa0, pa1, pa2, pa3); SBAR(); \
    pv_d0(o, vb0 + SHM_V, pa0, pa1, pa2, pa3); } while (0)
    if (late) DIFF_LOOP(true); else DIFF_LOOP(false);
#undef DIFF_LOOP
  }
  if (hi == 0) li_l[r32] = l_reg; asm volatile("s_waitcnt lgkmcnt(0)" ::: "memory");
#pragma unroll
  for (int r = 0; r < 16; ++r) { const float rl = __builtin_amdgcn_rcpf(li_l[crow(r, hi)]);
#pragma unroll
    for (int d = 0; d < 4; ++d) o[d][r] *= rl; }
#undef DMA16
#undef DMA_V
#undef DMA_K
#undef STEP_END
#undef QKT
#undef RESC
#undef PSM
}
}
#define XB_TMO      128
#define XB_XCNT(j)  (256  + 64 * (j))
#define XB_XSUB(j)  (1280 + 64 * (j))
#define XB_XGEN(j)  (2304 + 64 * (j))
#define XB_TOP      3328
#define XB_TOPGEN   3392
#define XCD_BAR_WORDS 3456
#define XB_SPIN_CAP (1u << 18)
#define LAS __attribute__((address_space(3)))

__device__ __forceinline__ unsigned xb_ld(unsigned* p)              { return __hip_atomic_load(p, __ATOMIC_RELAXED, __HIP_MEMORY_SCOPE_AGENT); }
__device__ __forceinline__ unsigned xb_add(unsigned* p, unsigned v) { return __hip_atomic_fetch_add(p, v, __ATOMIC_RELAXED, __HIP_MEMORY_SCOPE_AGENT); }
__device__ __forceinline__ unsigned xb_xcc_id() { return (unsigned)__builtin_amdgcn_s_getreg((3 << 11) | 20) & 0xFu; }
#define XB_SPIN(cond, bar) do { unsigned _sp = 0; while (cond) { __builtin_amdgcn_s_sleep(1); \
    if ((++_sp & 255u) == 0u) { if (xb_ld(&(bar)[XB_TMO])) break; if (_sp > XB_SPIN_CAP) { atomicAdd(&(bar)[XB_TMO], 1u); break; } } } } while (0)

struct XcdBarrier {
    unsigned* bar; unsigned x, w;
    volatile LAS unsigned* st;
};

__device__ __forceinline__ XcdBarrier xcd_barrier_post(unsigned* bar, volatile LAS unsigned* st, unsigned wave) {
    XcdBarrier b; b.bar = bar; b.x = xb_xcc_id(); b.st = st; b.w = wave;
    if (wave == 0 && hw_lane() == 0) (void)xb_add(&bar[XB_XCNT(b.x)], 1u);
    return b;
}
__device__ __forceinline__ void xcd_barrier_complete(unsigned* bar, unsigned x, unsigned& nloc, unsigned& nx) {
    const unsigned G = gridDim.x * gridDim.y * gridDim.z;
    unsigned sum, cnt, mine, sp = 0u;
    for (;;) {
        sum = 0u; cnt = 0u; mine = 0u;
#pragma unroll
        for (unsigned j = 0; j < 16; ++j) { const unsigned c = xb_ld(&bar[XB_XCNT(j)]); sum += c; cnt += (c > 0u) ? 1u : 0u; mine = (j == x) ? c : mine; }
        if (sum == G) break;
        __builtin_amdgcn_s_sleep(1);
        if ((++sp & 255u) == 0u) { if (xb_ld(&bar[XB_TMO])) break; if (sp > XB_SPIN_CAP) { atomicAdd(&bar[XB_TMO], 1u); break; } }
    }
    nloc = mine > 0u ? mine : 1u; nx = cnt > 0u ? cnt : 1u;
}

__device__ __forceinline__ void xcd_barrier(const XcdBarrier& b) {
    asm volatile("s_waitcnt vmcnt(0)" ::: "memory");
    __syncthreads();
    if (b.w == 0 && hw_lane() == 0) {
        unsigned* bar = b.bar;
        __builtin_amdgcn_s_waitcnt(0);
        unsigned nloc = b.st[0], nx = b.st[1];
        if (nloc == 0u) { xcd_barrier_complete(bar, b.x, nloc, nx); b.st[0] = nloc; b.st[1] = nx; }
        const unsigned old = xb_add(&bar[XB_XSUB(b.x)], 1u);
        const unsigned gen = old / nloc;
        if (old + 1u == (gen + 1u) * nloc) {
            __builtin_amdgcn_fence(__ATOMIC_RELEASE, "agent");
            asm volatile("s_waitcnt vmcnt(0)" ::: "memory");
            const unsigned og = xb_add(&bar[XB_TOP], 1u);
            const unsigned tg = og / nx;
            if (og + 1u == (tg + 1u) * nx) xb_add(&bar[XB_TOPGEN], 1u);
            else XB_SPIN(xb_ld(&bar[XB_TOPGEN]) == tg, bar);
            __builtin_amdgcn_fence(__ATOMIC_ACQUIRE, "agent");
            xb_add(&bar[XB_XGEN(b.x)], 1u);
            asm volatile("s_waitcnt vmcnt(0)" ::: "memory");
        } else {
            XB_SPIN(xb_ld(&bar[XB_XGEN(b.x)]) == gen, bar);
            __builtin_amdgcn_fence(__ATOMIC_ACQUIRE, "agent");
            asm volatile("s_waitcnt vmcnt(0)" ::: "memory");
        }
    }
    __syncthreads();
}


constexpr int NB = 32, SEQ = 2048, T = NB * SEQ, D = 1024, IN_COLS = 1984, PROJ_LD = 2048;
constexpr int NE = 32, TOPK = 4, NA = T * TOPK, HALF_T = T / 2, HALF_A = NA / 2;
constexpr int ROWS_ALL = NA + NE * 256, TILES_MAX = ROWS_ALL / 256;
constexpr float NORM_EPS = 1e-5f, LOG2E = 1.4426950408889634f;
constexpr float SC_W = 64.f, SC_X = 4.f, SC_A = 4.f, SC_Y = 16.f;
constexpr int NWAVES = 8, NTHREADS = 512;

constexpr size_t KiB = 1024, MiB = 1u << 20;
constexpr size_t WS_CTL = 0, CTL_ZERO_BYTES = 64 * KiB;
constexpr size_t WS_ROPE = 1 * MiB;
constexpr size_t WS_BIAS = 1 * MiB + 512 * KiB;
constexpr size_t WS_LAM = 1 * MiB + 768 * KiB;
constexpr size_t WS_RINV = 2 * MiB;
constexpr size_t WS_EIDX = 3 * MiB, WS_GATE = 4 * MiB, WS_LRANK = 5 * MiB;
constexpr size_t WS_HIST = 6 * MiB;
constexpr size_t WS_ROWA = 7 * MiB, WS_ROWG = 9 * MiB;
constexpr size_t WS_TINFO = 11 * MiB;
constexpr size_t WS_WRH = 12 * MiB, WS_WRL = 12 * MiB + 64 * KiB;
constexpr size_t WS_WUQ = 13 * MiB, WS_WUKV = 13 * MiB + 512 * KiB;
constexpr size_t WS_WIN = 16 * MiB, WS_WO = 20 * MiB;
constexpr size_t WS_WD8 = 24 * MiB, WS_WGU8 = 56 * MiB;
constexpr size_t WS_XB = 120 * MiB;
constexpr size_t WS_XB8 = 248 * MiB;
constexpr size_t WS_PROJ = 312 * MiB, WS_QM = 568 * MiB, WS_KV = 664 * MiB, WS_MIXED = 792 * MiB, WS_CQN = 920 * MiB, WS_CKVN = 952 * MiB, WS_KPE = 968 * MiB;
constexpr size_t WS_ACT8 = 312 * MiB, WS_Y48 = 576 * MiB;
constexpr size_t WS_END = 976 * MiB;
static_assert(WS_ACT8 + (size_t)ROWS_ALL * 1024 <= WS_Y48 && WS_Y48 + (size_t)NA * 1024 <= WS_CQN && WS_ROWA + (size_t)ROWS_ALL * 4 <= WS_ROWG && WS_ROWG + (size_t)ROWS_ALL * 4 <= WS_TINFO, "ws map");

constexpr int SCRATCH_BYTES = 141312;
constexpr int MISC_OFF = SCRATCH_BYTES;
constexpr int LDS_BYTES = SCRATCH_BYTES + 1024;
static_assert(att::ATT_LDS <= SCRATCH_BYTES && pg8::STAGE_BYTES <= SCRATCH_BYTES, "LDS map");

#define GAS __attribute__((address_space(1)))
typedef unsigned short bf16;
typedef float f32x4 __attribute__((ext_vector_type(4)));
typedef float f32x2 __attribute__((ext_vector_type(2)));
typedef unsigned u32x4 __attribute__((ext_vector_type(4)));
typedef unsigned u32x2 __attribute__((ext_vector_type(2)));
typedef short bf16x8 __attribute__((ext_vector_type(8)));
typedef float f32x16 __attribute__((ext_vector_type(16)));
#define LDS_WAIT() asm volatile("s_waitcnt lgkmcnt(0)" ::: "memory")
#define VM_WAIT() asm volatile("s_waitcnt vmcnt(0)" ::: "memory")
__device__ __forceinline__ unsigned pk2(float lo, float hi) { return pg8::cvt_pk_bf16(lo, hi); }
__device__ __forceinline__ unsigned cvt8(float a, float b, float c, float d) { int w = 0; w = __builtin_amdgcn_cvt_pk_fp8_f32(a, b, w, false); w = __builtin_amdgcn_cvt_pk_fp8_f32(c, d, w, true); return (unsigned)w; }
__device__ __forceinline__ float bf2f(unsigned short v) { return __uint_as_float(((unsigned)v) << 16); }
__device__ __forceinline__ float wave_sum(float v) {
#pragma unroll
    for (int o = 1; o < 64; o <<= 1) v += __shfl_xor(v, o);
    return v;
}

struct Args {
    const float* in[22]; float* out; unsigned char* ws; int ph_lo, ph_hi;
};

template <bool F8OUT, class RowMap>
__device__ __forceinline__ void transpose_item(const float* W, int K, int N, void* WTv, LAS float* scr, int item, int lane, const float* kscale, RowMap rm) {
    const int nblk = N / 32, kb = item / nblk, nb = item % nblk, k0 = 64 * kb, n0 = 32 * nb;
    float v[32];
#pragma unroll
    for (int i = 0; i < 32; ++i) v[i] = W[(size_t)(k0 + 2 * i + (lane >> 5)) * N + n0 + (lane & 31)];
    if (kscale) {
#pragma unroll
        for (int i = 0; i < 32; ++i) v[i] *= kscale[k0 + 2 * i + (lane >> 5)];
    }
    if constexpr (F8OUT) {
#pragma unroll
        for (int i = 0; i < 32; ++i) v[i] *= SC_W;
    }
#pragma unroll
    for (int i = 0; i < 32; ++i) scr[(2 * i + (lane >> 5)) * 33 + (lane & 31)] = v[i];
    LDS_WAIT(); asm volatile("" ::: "memory");
    const int c = lane & 7;
#pragma unroll
    for (int j = 0; j < 4; ++j) { const int n = (lane >> 3) + 8 * j; const LAS float* s = scr + (8 * c) * 33 + n;
        if constexpr (F8OUT) { u32x2 o; o.x = cvt8(s[0 * 33], s[1 * 33], s[2 * 33], s[3 * 33]); o.y = cvt8(s[4 * 33], s[5 * 33], s[6 * 33], s[7 * 33]);
            *(u32x2*)((unsigned char*)WTv + (size_t)rm(n0 + n) * K + k0 + 8 * c) = o; }
        else { u32x4 o; o.x = pk2(s[0 * 33], s[1 * 33]); o.y = pk2(s[2 * 33], s[3 * 33]); o.z = pk2(s[4 * 33], s[5 * 33]); o.w = pk2(s[6 * 33], s[7 * 33]);
            *(u32x4*)((bf16*)WTv + (size_t)rm(n0 + n) * K + k0 + 8 * c) = o; } }
    LDS_WAIT(); asm volatile("" ::: "memory");
}
struct RmId { __device__ __forceinline__ int operator()(int n) const { return n; } };
struct RmGu { __device__ __forceinline__ int operator()(int n) const { const int up = n >> 10, j = n & 1023; return 256 * (j >> 7) + 128 * up + (j & 127); } };

__device__ __forceinline__ void rms_row_to_bf16(const float* xrow, const float* g, bf16* orow, int lane) {
    const f32x4* xr = (const f32x4*)xrow + lane; const f32x4* gr = (const f32x4*)g + lane;
    f32x4 v[4]; float s = 0.f;
#pragma unroll
    for (int j = 0; j < 4; ++j) { v[j] = xr[64 * j]; s += (v[j].x * v[j].x + v[j].y * v[j].y) + (v[j].z * v[j].z + v[j].w * v[j].w); }
    const float r = 1.f / sqrtf(wave_sum(s) * (1.f / D) + NORM_EPS);
    u32x2* o8 = (u32x2*)orow + lane;
#pragma unroll
    for (int j = 0; j < 4; ++j) { const f32x4 gg = gr[64 * j]; u32x2 w; w.x = pk2(v[j].x * r * gg.x, v[j].y * r * gg.y); w.y = pk2(v[j].z * r * gg.z, v[j].w * r * gg.w); o8[64 * j] = w; }
}
__device__ __forceinline__ int t5_bucket(int rel) {
    const int n = rel < 0 ? -rel : rel; int b;
    if (n < 8) b = n; else { const int n2 = n * n; b = n2 >= 8192 ? 15 : n2 >= 4096 ? 14 : n2 >= 2048 ? 13 : n2 >= 1024 ? 12 : n2 >= 512 ? 11 : n2 >= 256 ? 10 : n2 >= 128 ? 9 : 8; }
    return (rel > 0 ? 16 : 0) + b;
}
__device__ __forceinline__ void p0_prologue(const Args& a, LAS unsigned char* lds, int vcu, int G, int wave, int lane) {
    unsigned char* ws = a.ws;
    LAS float* scr = (LAS float*)(lds + wave * 16384);
    const int gw = vcu * NWAVES + wave, NGW = G * NWAVES;
    const float* ffn_g = a.in[14];
    constexpr int I_IN = 16 * 62, I_UQ = 4 * 24, I_UKV = 2 * 32, I_O = 16 * 32, I_GU1 = 16 * 64, I_GU = NE * I_GU1, I_D1 = 16 * 32, I_D = NE * I_D1;
    constexpr int NITEMS = I_IN + I_UQ + I_UKV + I_O + I_GU + I_D;
    for (int it = gw; it < NITEMS; it += NGW) {
        int r = it;
        if (r < I_GU) { const int e = r / I_GU1; transpose_item<true>(a.in[17] + (size_t)e * 1024 * 2048, 1024, 2048, ws + WS_WGU8 + (size_t)e * 2048 * 1024, scr, r % I_GU1, lane, ffn_g, RmGu{}); continue; } r -= I_GU;
        if (r < I_D) { const int e = r / I_D1; transpose_item<true>(a.in[19] + (size_t)e * 1024 * 1024, 1024, 1024, ws + WS_WD8 + (size_t)e * 1024 * 1024, scr, r % I_D1, lane, nullptr, RmId{}); continue; } r -= I_D;
        if (r < I_IN) { transpose_item<false>(a.in[3], 1024, IN_COLS, (bf16*)(ws + WS_WIN), scr, r, lane, nullptr, RmId{}); continue; } r -= I_IN;
        if (r < I_O) { transpose_item<false>(a.in[13], 1024, 1024, (bf16*)(ws + WS_WO), scr, r, lane, nullptr, RmId{}); continue; } r -= I_O;
        if (r < I_UQ) { transpose_item<false>(a.in[10], 256, 768, (bf16*)(ws + WS_WUQ), scr, r, lane, nullptr, RmId{}); continue; } r -= I_UQ;
        transpose_item<false>(a.in[12], 128, 1024, (bf16*)(ws + WS_WUKV), scr, r, lane, nullptr, RmId{});
    }
    const int gt = gw * 64 + lane, NGT = NGW * 64;
    for (int i = gt; i < 64 * 1024 / 8; i += NGT) *((u32x4*)((bf16*)(ws + WS_WIN) + (size_t)IN_COLS * 1024) + i) = (u32x4){0u, 0u, 0u, 0u};
    for (int i = gt; i < 1024 * NE; i += NGT) { const int k = i >> 5, e = i & 31; const float w = a.in[15][i] * ffn_g[k];
        const unsigned h = pk2(w, 0.f) & 0xffffu; const float wl = w - bf2f((unsigned short)h);
        ((bf16*)(ws + WS_WRH))[e * 1024 + k] = (bf16)h; ((bf16*)(ws + WS_WRL))[e * 1024 + k] = (bf16)(pk2(wl, 0.f) & 0xffffu); }
    for (int i = gt; i < SEQ * 32; i += NGT) { const int pos = i >> 5, fi = i & 31;
        const float inv = (float)::exp2(-(double)fi * (13.287712379549449 / 32.0)); const float ang = (float)pos * inv;
        double tt = (double)ang * 0.15915494309189535; tt -= __builtin_rint(tt); const double rr = tt * 6.283185307179586, r2 = rr * rr;
        double cs_ = 1.0, sn = rr, term_c = 1.0, term_s = rr;
#pragma unroll
        for (int k = 1; k <= 13; ++k) { term_c *= -r2 / (double)((2 * k - 1) * (2 * k)); term_s *= -r2 / (double)((2 * k) * (2 * k + 1)); cs_ += term_c; sn += term_s; }
        ((f32x2*)(ws + WS_ROPE))[i] = (f32x2){(float)cs_, (float)sn}; }
    for (int i = gt; i < 8 * 4096; i += NGT) { const int m = i >> 12, d = i & 4095; ((float*)(ws + WS_BIAS))[i] = d < 4095 ? a.in[1][t5_bucket(d - 2047) * 8 + m] * LOG2E : 0.f; }
    if (gw == 0) { const float s1 = wave_sum(a.in[4][lane] * a.in[5][lane]), s2 = wave_sum(a.in[6][lane] * a.in[7][lane]);
        if (lane == 0) *(float*)(ws + WS_LAM) = __expf(s1) - __expf(s2) + 0.2f; }
    for (int m = gw; m < T; m += 2 * NGW) {
        const int m2 = m + NGW < T ? m + NGW : m;
        const f32x4* xr0 = (const f32x4*)(a.in[0] + (size_t)m * D) + lane; const f32x4* xr1 = (const f32x4*)(a.in[0] + (size_t)m2 * D) + lane; const f32x4* gr = (const f32x4*)a.in[2] + lane;
        f32x4 v0[4], v1[4]; float s0 = 0.f, s1 = 0.f;
#pragma unroll
        for (int j = 0; j < 4; ++j) { v0[j] = xr0[64 * j]; v1[j] = xr1[64 * j]; }
#pragma unroll
        for (int j = 0; j < 4; ++j) { s0 += (v0[j].x * v0[j].x + v0[j].y * v0[j].y) + (v0[j].z * v0[j].z + v0[j].w * v0[j].w); s1 += (v1[j].x * v1[j].x + v1[j].y * v1[j].y) + (v1[j].z * v1[j].z + v1[j].w * v1[j].w); }
        const float r0 = 1.f / sqrtf(wave_sum(s0) * (1.f / D) + NORM_EPS), r1 = 1.f / sqrtf(wave_sum(s1) * (1.f / D) + NORM_EPS);
        u32x2* o0 = (u32x2*)((bf16*)(ws + WS_XB) + (size_t)m * D) + lane; u32x2* o1 = (u32x2*)((bf16*)(ws + WS_XB) + (size_t)m2 * D) + lane;
#pragma unroll
        for (int j = 0; j < 4; ++j) { const f32x4 gg = gr[64 * j]; u32x2 w;
            w.x = pk2(v0[j].x * r0 * gg.x, v0[j].y * r0 * gg.y); w.y = pk2(v0[j].z * r0 * gg.z, v0[j].w * r0 * gg.w); o0[64 * j] = w;
            w.x = pk2(v1[j].x * r1 * gg.x, v1[j].y * r1 * gg.y); w.y = pk2(v1[j].z * r1 * gg.z, v1[j].w * r1 * gg.w); o1[64 * j] = w; }
    }
}

__device__ __forceinline__ void p1b_latent(const Args& a, int vcu, int G, int wave, int lane) {
    unsigned char* ws = a.ws; const int gw = vcu * NWAVES + wave, NGW = G * NWAVES;
    const float* gq = a.in[9]; const float* gkv = a.in[11];
    float gl[8];
#pragma unroll
    for (int j = 0; j < 8; ++j) gl[j] = lane < 32 ? gq[8 * lane + j] : (lane < 48 ? gkv[8 * (lane - 32) + j] : 1.f);
    constexpr int R = 4;
    for (int t0 = gw; t0 < T; t0 += R * NGW) {
        bf16x8 v[R];
#pragma unroll
        for (int q = 0; q < R; ++q) { const int t = t0 + q * NGW; v[q] = (bf16x8){0, 0, 0, 0, 0, 0, 0, 0};
            if (lane < 56 && t < T) v[q] = *(const bf16x8*)((const bf16*)(ws + WS_PROJ) + (size_t)t * PROJ_LD + 1536 + 8 * lane); }
#pragma unroll
        for (int q = 0; q < R; ++q) { const int t = t0 + q * NGW; if (t >= T) break;
            float f[8], sq = 0.f;
#pragma unroll
            for (int j = 0; j < 8; ++j) { f[j] = bf2f((unsigned short)v[q][j]); sq += f[j] * f[j]; }
            const float sq_q = wave_sum(lane < 32 ? sq : 0.f), sq_kv = wave_sum((lane >= 32 && lane < 48) ? sq : 0.f);
            const float rq = 1.f / sqrtf(sq_q * (1.f / 256.f) + NORM_EPS), rkv = 1.f / sqrtf(sq_kv * (1.f / 128.f) + NORM_EPS);
            float part[8];
#pragma unroll
            for (int j = 0; j < 8; ++j) part[j] = __shfl_xor(f[j], 4);
            float o[8];
            if (lane < 48) { const float rr = lane < 32 ? rq : rkv;
#pragma unroll
                for (int j = 0; j < 8; ++j) o[j] = f[j] * rr * gl[j];
            } else {
                const int aa = lane - 48; const f32x2* cp = (const f32x2*)(ws + WS_ROPE) + (size_t)(t & (SEQ - 1)) * 32 + 8 * (aa & 3);
#pragma unroll
                for (int j = 0; j < 8; ++j) { const f32x2 c = lane < 56 ? cp[j] : (f32x2){0.f, 0.f};
                    o[j] = (aa < 4) ? (f[j] * c.x - part[j] * c.y) : (part[j] * c.y + f[j] * c.x); }
            }
            u32x4 w; w.x = pk2(o[0], o[1]); w.y = pk2(o[2], o[3]); w.z = pk2(o[4], o[5]); w.w = pk2(o[6], o[7]);
            if (lane < 32) *(u32x4*)((bf16*)(ws + WS_CQN) + (size_t)t * 256 + 8 * lane) = w;
            else if (lane < 48) *(u32x4*)((bf16*)(ws + WS_CKVN) + (size_t)t * 128 + 8 * (lane - 32)) = w;
            else if (lane < 56) *(u32x4*)((bf16*)(ws + WS_KPE) + (size_t)t * 64 + 8 * (lane - 48)) = w;
        }
    }
}

template <int WHICH  >
__device__ __forceinline__ void p2_attention(const Args& a, LAS unsigned char* lds, int vcu, int G, int wave) {
    unsigned char* ws = a.ws;
    const int tid = threadIdx.x, wid = tid >> 6, lane = tid & 63, r32 = lane & 31, hi = lane >> 5;
    const bf16* proj = (const bf16*)(ws + WS_PROJ); bf16* mixed = (bf16*)(ws + WS_MIXED);
    const float lam = *(const float*)(ws + WS_LAM);
    if constexpr (WHICH & 1) {
        const float C = 0.125f * LOG2E;
        float sg[4];
#pragma unroll
        for (int d0 = 0; d0 < 4; ++d0) sg[d0] = a.in[8][32 * d0 + r32] * 0.8f;
        LAS unsigned* stash = (LAS unsigned*)(lds + att::OFF_STASH) + (wid * 32) * 64 + lane;
        for (int it = 0;; ++it) {
            const int u = (it >> 1) * G + vcu, j = it & 1; if (u >= NB * 4 * 8) break;
            const int qb = u & 7, h = (u >> 3) & 3, b = u >> 5, q0 = qb * 256, mp = 2 * h + j;
            { const float* src = (const float*)(ws + WS_BIAS) + mp * 4096; LAS float* lut = (LAS float*)(lds + att::OFF_LUT);
#pragma unroll
              for (int i = 0; i < 8; ++i) lut[tid + 512 * i] = src[tid + 512 * i]; }
            const bf16* base = proj + (size_t)b * SEQ * PROJ_LD;
            f32x16 o[4];
            att::attn_unit<1>(base + (size_t)q0 * PROJ_LD + 64 * mp, PROJ_LD, base + 512 + 64 * mp, PROJ_LD, nullptr, base + 1024 + 128 * h, PROJ_LD, SEQ,
                                 (LAS char*)lds, C, nullptr, q0, o, wave, lane);
            if (j == 0) {
#pragma unroll
                for (int d0 = 0; d0 < 4; ++d0)
#pragma unroll
                    for (int r = 0; r < 16; r += 2) stash[(d0 * 8 + (r >> 1)) * 64] = pk2(o[d0][r], o[d0][r + 1]);
            } else {
                bf16* orow = mixed + (size_t)(b * SEQ + q0 + wid * 32) * D + 128 * h + r32;
#pragma unroll
                for (int rp = 0; rp < 8; ++rp) {
                    float v[2][4], ss[2] = {0.f, 0.f};
#pragma unroll
                    for (int d0 = 0; d0 < 4; ++d0) { const unsigned w = stash[(d0 * 8 + rp) * 64];
                        v[0][d0] = bf2f((unsigned short)(w & 0xffffu)) - lam * o[d0][2 * rp]; v[1][d0] = bf2f((unsigned short)(w >> 16)) - lam * o[d0][2 * rp + 1];
                        ss[0] += v[0][d0] * v[0][d0]; ss[1] += v[1][d0] * v[1][d0]; }
#pragma unroll
                    for (int q = 0; q < 2; ++q) {
#pragma unroll
                        for (int sft = 1; sft < 32; sft <<= 1) ss[q] += __shfl_xor(ss[q], sft);
                        const float rn = 1.f / sqrtf(ss[q] * (1.f / 128.f) + NORM_EPS);
                        bf16* op = orow + (size_t)att::crow(2 * rp + q, hi) * D;
#pragma unroll
                        for (int d0 = 0; d0 < 4; ++d0) op[32 * d0] = (bf16)(pk2(v[q][d0] * rn * sg[d0], 0.f) & 0xffffu);
                    }
                }
            }
        }
    }
    if constexpr (WHICH & 2) {
        const float C = 0.07216878364870322f * LOG2E;
        for (int it = 0;; ++it) {
            const int u = it * G + vcu; if (u >= NB * 4 * 8) break;
            const int qb = u & 7, h = (u >> 3) & 3, b = u >> 5, q0 = qb * 256;
            const bf16* qm = (const bf16*)(ws + WS_QM) + (size_t)(b * SEQ + q0) * 768 + 192 * h;
            const bf16* kv = (const bf16*)(ws + WS_KV) + (size_t)b * SEQ * 1024 + 256 * h;
            const bf16* kpe = (const bf16*)(ws + WS_KPE) + (size_t)b * SEQ * 64;
            f32x16 o[4];
            att::attn_unit<0>(qm, 768, kv, 1024, kpe, kv + 128, 1024, SEQ, (LAS char*)lds, C, (const att::f32x2*)(ws + WS_ROPE), q0, o, wave, lane);
            bf16* orow = mixed + (size_t)(b * SEQ + q0 + wid * 32) * D + 512 + 128 * h + r32;
#pragma unroll
            for (int r = 0; r < 16; ++r) { bf16* op = orow + (size_t)att::crow(r, hi) * D;
#pragma unroll
                for (int d0 = 0; d0 < 4; ++d0) op[32 * d0] = (bf16)(pk2(o[d0][r], 0.f) & 0xffffu); }
        }
    }
}

constexpr int WR_PITCH = 2064;
__device__ __forceinline__ void p3b_router(const Args& a, LAS unsigned char* lds, int G, int wave) {
    unsigned char* ws = a.ws;
    const int wid = wave, lane = hw_lane(), tid = wid * 64 + lane, r32 = lane & 31, hi = lane >> 5;
    LAS unsigned char* wrh = lds; LAS unsigned char* wrl = lds + 32 * WR_PITCH; LAS unsigned* cnt = (LAS unsigned*)(lds + 64 * WR_PITCH);
    for (int i = tid; i < 2 * 32 * 128; i += NTHREADS) { const int tb = i >> 12, e = (i >> 7) & 31, c = i & 127;
        *(LAS u32x4*)(lds + (tb * 32 + e) * WR_PITCH + c * 16) = *((const u32x4*)(ws + (tb ? WS_WRL : WS_WRH)) + e * 128 + c); }
    const bf16* x1 = (const bf16*)(ws + WS_XB); unsigned char* xb = ws + WS_XB8;
    for (int c = blockIdx.x; c < T / 256; c += G) {
        if (tid < 32) cnt[tid] = 0u;
        __syncthreads();
        const int t = c * 256 + wid * 32 + r32;
        const bf16* xr = x1 + (size_t)t * D + 64 * hi; unsigned char* xo = xb + (size_t)t * D + 64 * hi;
        f32x16 acc = f32x16{}; float ss = 0.f;
#pragma unroll 2
        for (int sg = 0; sg < 8; ++sg) {
            u32x4 v[8];
#pragma unroll
            for (int q = 0; q < 8; ++q) v[q] = *(const u32x4*)(xr + 128 * sg + 8 * q);
#pragma unroll
            for (int j = 0; j < 8; ++j) {
                const u32x4 hw = v[j];
                const float f0 = __uint_as_float(hw.x << 16), f1 = __uint_as_float(hw.x & 0xffff0000u), f2 = __uint_as_float(hw.y << 16), f3 = __uint_as_float(hw.y & 0xffff0000u);
                const float f4 = __uint_as_float(hw.z << 16), f5 = __uint_as_float(hw.z & 0xffff0000u), f6 = __uint_as_float(hw.w << 16), f7 = __uint_as_float(hw.w & 0xffff0000u);
                ss += (f0 * f0 + f1 * f1) + (f2 * f2 + f3 * f3) + (f4 * f4 + f5 * f5) + (f6 * f6 + f7 * f7);
                { u32x2 w8; w8.x = cvt8(f0 * SC_X, f1 * SC_X, f2 * SC_X, f3 * SC_X); w8.y = cvt8(f4 * SC_X, f5 * SC_X, f6 * SC_X, f7 * SC_X); *(u32x2*)(xo + 128 * sg + 8 * j) = w8; }
                const int kb = (128 * sg + 64 * hi + 8 * j) * 2;
                const bf16x8 wh = *(const LAS bf16x8*)(wrh + r32 * WR_PITCH + kb), wl = *(const LAS bf16x8*)(wrl + r32 * WR_PITCH + kb);
                const bf16x8 xh = __builtin_bit_cast(bf16x8, hw);
                acc = __builtin_amdgcn_mfma_f32_32x32x16_bf16(wh, xh, acc, 0, 0, 0);
                acc = __builtin_amdgcn_mfma_f32_32x32x16_bf16(wl, xh, acc, 0, 0, 0);
            }
        }
        ss += __shfl_xor(ss, 32);
        const float rinv = 1.f / sqrtf(ss * (1.f / D) + NORM_EPS);
        if (hi == 0) ((float*)(ws + WS_RINV))[t] = rinv;
        float lg[16];
#pragma unroll
        for (int r = 0; r < 16; ++r) lg[r] = acc[r] * rinv + a.in[16][att::crow(r, hi)];
        float tv[4]; int ti[4];
#pragma unroll
        for (int k = 0; k < 4; ++k) {
            float bv = lg[0]; int bi = att::crow(0, hi);
#pragma unroll
            for (int r = 1; r < 16; ++r) { const int e = att::crow(r, hi); if (lg[r] > bv) { bv = lg[r]; bi = e; } }
            const float ov = __shfl_xor(bv, 32); const int oi = __shfl_xor(bi, 32);
            const bool mine = (bv > ov) || (bv == ov && bi < oi);
            tv[k] = mine ? bv : ov; ti[k] = mine ? bi : oi;
#pragma unroll
            for (int r = 0; r < 16; ++r) if (att::crow(r, hi) == ti[k]) lg[r] = -3.0e38f;
        }
        const float e1 = __expf(tv[1] - tv[0]), e2 = __expf(tv[2] - tv[0]), e3 = __expf(tv[3] - tv[0]), rs = 1.f / (1.f + e1 + e2 + e3);
        if (hi == 0) {
            int lr[4];
#pragma unroll
            for (int k = 0; k < 4; ++k) lr[k] = (int)__hip_atomic_fetch_add(cnt + ti[k], 1u, __ATOMIC_RELAXED, __HIP_MEMORY_SCOPE_WORKGROUP);
            *((int4*)(ws + WS_EIDX) + t) = make_int4(ti[0], ti[1], ti[2], ti[3]);
            *((f32x4*)(ws + WS_GATE) + t) = (f32x4){rs, e1 * rs, e2 * rs, e3 * rs};
            *((int4*)(ws + WS_LRANK) + t) = make_int4(lr[0], lr[1], lr[2], lr[3]);
        }
        __syncthreads();
        if (tid < 32) ((int*)(ws + WS_HIST))[c * 32 + tid] = (int)cnt[tid];
        __syncthreads();
    }
}

__device__ __forceinline__ void p4_scatter(const Args& a, LAS unsigned char* lds, int G, int wave) {
    unsigned char* ws = a.ws; const int tid = wave * 64 + hw_lane();
    LAS int* hist = (LAS int*)lds;
    LAS int* cntE = hist + 256 * 32;
    LAS int* pst = cntE + 32;
    for (int i = tid; i < 256 * 32; i += NTHREADS) hist[i] = ((const int*)(ws + WS_HIST))[i];
    __syncthreads();
    if (tid < 32) { int run = 0;
        for (int c = 0; c < 256; ++c) { const int v = hist[c * 32 + tid]; hist[c * 32 + tid] = run; run += v; }
        cntE[tid] = run; }
    __syncthreads();
    if (tid < 32) { int s = 0;
        for (int q = 0; q < tid; ++q) s += (cntE[q] + 255) & ~255;
        pst[tid] = s; }
    __syncthreads();
    int* rowa = (int*)(ws + WS_ROWA); float* rowg = (float*)(ws + WS_ROWG);
    for (int c = blockIdx.x; c < T / 256; c += G) {
        for (int i = tid; i < 1024; i += NTHREADS) { const int asg = c * 1024 + i; const int e = ((const int*)(ws + WS_EIDX))[asg];
            const int p = pst[e] + hist[c * 32 + e] + ((const int*)(ws + WS_LRANK))[asg];
            rowa[p] = asg; rowg[p] = ((const float*)(ws + WS_GATE))[asg]; } }
    if (blockIdx.x == 0 && tid < 32) { const int e = tid; const int n = cntE[e], st = pst[e], pad = (n + 255) & ~255;
        for (int p = st + n; p < st + pad; ++p) { rowa[p] = -1; rowg[p] = 0.f; }
        int* tinfo = (int*)(ws + WS_TINFO);
        for (int tt = st >> 8; tt < (st + pad) >> 8; ++tt) tinfo[tt] = e;
        if (e == 31) tinfo[2048] = (st + pad) >> 8; }
}

struct MoeOrder {
    const int* tinfo; const int* rowa; int ntiles, nN, lgN, G, c;
    __device__ __forceinline__ bool next(int i, pg8::Unit& u) const {
        const int L = i * G + c; if (L >= ntiles * nN) return false;
        const int tile = L >> lgN, pn = L & (nN - 1); const int e = tinfo[tile]; u.pm = tile; u.pn = e * nN + pn; return true;
    }
    __device__ __forceinline__ int gather_row(const pg8::Unit& u, int i) const { const int as = rowa[u.pm * 256 + i]; return as < 0 ? 0 : (as >> 2); }
};
struct EpiSwiglu {
    static constexpr bool PERM = true;
    unsigned char* act; const float* rinv; const int* rowa; const float* bgu;
    __device__ __forceinline__ void operator()(const pg8::f32x4 (&acc)[2][2][4][2], const pg8::Unit& u, int wr, int wc, int fr, int fq) const {
        const int e = u.pn >> 3, pn = u.pn & 7, col0 = 128 * pn + 32 * wc + 8 * fq;
        const float* bp = bgu + (size_t)e * 2048 + col0;
        f32x4 bg[2], bu[2];
#pragma unroll
        for (int n = 0; n < 2; ++n) { bg[n] = *(const f32x4*)(bp + 4 * n); bu[n] = *(const f32x4*)(bp + 1024 + 4 * n); }
#pragma unroll
        for (int ai = 0; ai < 2; ++ai)
#pragma unroll
            for (int m = 0; m < 4; ++m) {
                const int p = u.pm * 256 + ai * 128 + wr * 64 + m * 16 + fr; const int as = rowa[p]; const float ri = rinv[as < 0 ? 0 : (as >> 2)] * (1.f / (SC_W * SC_X));
                float o[8];
#pragma unroll
                for (int n = 0; n < 2; ++n)
#pragma unroll
                    for (int q = 0; q < 4; ++q) {
                        float g = fminf(acc[ai][0][m][n][q] * ri + bg[n][q], 7.f); const float up = fminf(fmaxf(acc[ai][1][m][n][q] * ri + bu[n][q], -7.f), 7.f);
                        const float sg = __builtin_amdgcn_rcpf(1.f + __builtin_amdgcn_exp2f(g * (-1.702f * LOG2E)));
                        o[4 * n + q] = (up + 1.f) * (g * sg) * SC_A; }
                u32x2 w; w.x = cvt8(o[0], o[1], o[2], o[3]); w.y = cvt8(o[4], o[5], o[6], o[7]);
                *(u32x2*)(act + (size_t)p * 1024 + col0) = w; }
    }
};
struct EpiDown {
    static constexpr bool PERM = true;
    unsigned char* y4; const int* rowa; const float* rowg; const float* bd;
    __device__ __forceinline__ void operator()(const pg8::f32x4 (&acc)[2][2][4][2], const pg8::Unit& u, int wr, int wc, int fr, int fq) const {
        const int e = u.pn >> 2, pn = u.pn & 3, col0 = 256 * pn + 32 * wc + 8 * fq;
        const float* bp = bd + (size_t)e * 1024 + col0;
        f32x4 bv[2][2];
#pragma unroll
        for (int bj = 0; bj < 2; ++bj)
#pragma unroll
            for (int n = 0; n < 2; ++n) bv[bj][n] = *(const f32x4*)(bp + 128 * bj + 4 * n);
#pragma unroll
        for (int ai = 0; ai < 2; ++ai)
#pragma unroll
            for (int m = 0; m < 4; ++m) {
                const int p = u.pm * 256 + ai * 128 + wr * 64 + m * 16 + fr; const int as = rowa[p];
                if (as >= 0) { const float gt = rowg[p] * SC_Y; unsigned char* yr = y4 + (size_t)as * 1024 + col0;
#pragma unroll
                    for (int bj = 0; bj < 2; ++bj) { const f32x4 v0 = (acc[ai][bj][m][0] * (1.f / (SC_W * SC_A)) + bv[bj][0]) * gt, v1 = (acc[ai][bj][m][1] * (1.f / (SC_W * SC_A)) + bv[bj][1]) * gt;
                        u32x2 w; w.x = cvt8(v0[0], v0[1], v0[2], v0[3]); w.y = cvt8(v1[0], v1[1], v1[2], v1[3]);
                        *(u32x2*)(yr + 128 * bj) = w; } } }
    }
};

__device__ __forceinline__ void p7_final(const Args& a, int vcu, int G, int wave, int lane) {
    unsigned char* ws = a.ws; const int gw = vcu * NWAVES + wave, NGW = G * NWAVES;
    const f32x4* gr = (const f32x4*)a.in[21] + lane;
    for (int t = gw; t < T; t += NGW) {
        const u32x2* xr = (const u32x2*)((const bf16*)(ws + WS_XB) + (size_t)t * D) + lane;
        const unsigned* yr = (const unsigned*)(ws + WS_Y48 + (size_t)t * 4 * D) + lane;
        u32x2 xw[4]; unsigned yw[4][4];
#pragma unroll
        for (int j = 0; j < 4; ++j) { xw[j] = xr[64 * j];
#pragma unroll
            for (int k = 0; k < 4; ++k) yw[k][j] = yr[k * 256 + 64 * j]; }
        f32x4 v[4]; float s = 0.f;
#pragma unroll
        for (int j = 0; j < 4; ++j) { f32x4 ys = (f32x4){0.f, 0.f, 0.f, 0.f};
#pragma unroll
            for (int k = 0; k < 4; ++k) { const f32x2 lo = __builtin_amdgcn_cvt_pk_f32_fp8((int)yw[k][j], false), hi = __builtin_amdgcn_cvt_pk_f32_fp8((int)yw[k][j], true);
                ys.x += lo.x; ys.y += lo.y; ys.z += hi.x; ys.w += hi.y; }
            v[j].x = __uint_as_float(xw[j].x << 16) + ys.x * (1.f / SC_Y); v[j].y = __uint_as_float(xw[j].x & 0xffff0000u) + ys.y * (1.f / SC_Y);
            v[j].z = __uint_as_float(xw[j].y << 16) + ys.z * (1.f / SC_Y); v[j].w = __uint_as_float(xw[j].y & 0xffff0000u) + ys.w * (1.f / SC_Y);
            s += (v[j].x * v[j].x + v[j].y * v[j].y) + (v[j].z * v[j].z + v[j].w * v[j].w); }
        const float r = 1.f / sqrtf(wave_sum(s) * (1.f / D) + NORM_EPS);
        f32x4* orow = (f32x4*)(a.out + (size_t)t * D) + lane;
#pragma unroll
        for (int j = 0; j < 4; ++j) { const f32x4 gg = gr[64 * j]; orow[64 * j] = (f32x4){v[j].x * r * gg.x, v[j].y * r * gg.y, v[j].z * r * gg.z, v[j].w * r * gg.w}; }
    }
}

constexpr int N_PHASES = 11;
__global__ void __launch_bounds__(NTHREADS, 2) fwd(Args args) {
    extern __shared__ __attribute__((aligned(16))) unsigned char lds_raw[];
    LAS unsigned char* lds = (LAS unsigned char*)lds_raw;
    volatile LAS unsigned* MISC = (volatile LAS unsigned*)(lds + MISC_OFF);
    const int wave = __builtin_amdgcn_readfirstlane((int)threadIdx.x >> 6);
    const int G = gridDim.x; const int bx = blockIdx.x; const int vcu = (G % 8 == 0) ? (bx % 8) * (G / 8) + bx / 8 : bx;
    unsigned char* ws = args.ws;
    for (int u = wave * 64 + hw_lane(); u < (LDS_BYTES - MISC_OFF) / 4; u += NTHREADS) MISC[u] = 0u;
    __syncthreads();
    const int lo = args.ph_lo, hi = args.ph_hi;
    const bool use_bar = (hi - lo) > 1;
    XcdBarrier bar; bar.bar = (unsigned*)(ws + WS_CTL); bar.x = 0; bar.st = nullptr;
    if (use_bar) bar = xcd_barrier_post((unsigned*)(ws + WS_CTL), MISC + 8, (unsigned)wave);
#ifdef ONLY_PHASE
#define IN(k) ((k) == ONLY_PHASE)
#else
#define IN(k) (lo <= (k) && (k) < hi)
#endif
#define SEAM(k) do { if (IN(k) && IN((k) + 1)) xcd_barrier(bar); } while (0)

    if (IN(0)) { p0_prologue(args, lds, vcu, G, wave, hw_lane()); }
    SEAM(0);
    if (IN(1)) {
        pg8::Gemm g{(const bf16*)(ws + WS_XB), (const bf16*)(ws + WS_WIN), T, PROJ_LD, D}; pg8::StaticOrder S; S.init(T, PROJ_LD, G, bx);
        pg8::EpiBf16 E{(bf16*)(ws + WS_PROJ), PROJ_LD};
        pg8::gemm_phase<pg8::EpiBf16, pg8::StaticOrder, true, false>(lds, g, S, E, wave);
    }
    SEAM(1);
    if (IN(2)) { p1b_latent(args, vcu, G, wave, hw_lane()); }
    SEAM(2);
    if (IN(3)) {
        { pg8::Gemm g{(const bf16*)(ws + WS_CQN), (const bf16*)(ws + WS_WUQ), T, 768, 256}; pg8::StaticOrder S; S.init(T, 768, G, bx);
          pg8::EpiBf16 E{(bf16*)(ws + WS_QM), 768}; pg8::gemm_phase<pg8::EpiBf16, pg8::StaticOrder, true, false>(lds, g, S, E, wave); }
        { pg8::Gemm g{(const bf16*)(ws + WS_CKVN), (const bf16*)(ws + WS_WUKV), T, 1024, 128}; pg8::StaticOrder S; S.init(T, 1024, G, bx);
          pg8::EpiBf16 E{(bf16*)(ws + WS_KV), 1024}; pg8::gemm_phase<pg8::EpiBf16, pg8::StaticOrder, true, false>(lds, g, S, E, wave); }
    }
    SEAM(3);
    if (IN(4)) { p2_attention<3>(args, lds, vcu, G, wave); }
    SEAM(4);
    if (IN(5)) {
        pg8::Gemm g{(const bf16*)(ws + WS_MIXED), (const bf16*)(ws + WS_WO), T, D, D}; pg8::StaticOrder S; S.init(T, D, G, bx);
        pg8::EpiResid E{args.in[0], (bf16*)(ws + WS_XB), D};
        pg8::gemm_phase<pg8::EpiResid, pg8::StaticOrder, true, false>(lds, g, S, E, wave);
    }
    SEAM(5);
    if (IN(6)) { p3b_router(args, lds, G, wave); }
    SEAM(6);
    if (IN(7)) { p4_scatter(args, lds, G, wave); }
    SEAM(7);
    if (IN(8)) {
        const int* tinfo = (const int*)(ws + WS_TINFO); MoeOrder S{tinfo, (const int*)(ws + WS_ROWA), tinfo[2048], 8, 3, G, vcu};
        pg8::Gemm g{(const bf16*)(ws + WS_XB8), (const bf16*)(ws + WS_WGU8), 0, 2048, D / 2};
        EpiSwiglu E{ws + WS_ACT8, (const float*)(ws + WS_RINV), (const int*)(ws + WS_ROWA), args.in[18]};
        pg8::gemm_phase<EpiSwiglu, MoeOrder, true, true, true>(lds, g, S, E, wave);
    }
    SEAM(8);
    if (IN(9)) {
        const int* tinfo = (const int*)(ws + WS_TINFO); MoeOrder S{tinfo, (const int*)(ws + WS_ROWA), tinfo[2048], 4, 2, G, vcu};
        pg8::Gemm g{(const bf16*)(ws + WS_ACT8), (const bf16*)(ws + WS_WD8), 0, 1024, D / 2};
        EpiDown E{ws + WS_Y48, (const int*)(ws + WS_ROWA), (const float*)(ws + WS_ROWG), args.in[20]};
        pg8::gemm_phase<EpiDown, MoeOrder, true, false, true>(lds, g, S, E, wave);
    }
    SEAM(9);
    if (IN(10)) { p7_final(args, vcu, G, wave, hw_lane()); }
#ifdef PROBE_EXTRA
    if (IN(11)) { p2_attention<1>(args, lds, vcu, G, wave); }
    if (IN(12)) { p2_attention<2>(args, lds, vcu, G, wave); }
#endif
#undef IN
#undef SEAM
}

#ifndef MK_N_LAUNCHES
#define MK_N_LAUNCHES 1
#endif
extern "C" void kernel_launch(void* const* d_in, const int* in_sizes, int n_in, void* d_out, int out_size, void* d_ws, size_t ws_size, hipStream_t stream) {
    static int grid = 0;
    if (grid == 0) {
        if (n_in != 22 || in_sizes[0] != T * D || out_size != T * D || ws_size < WS_END) {
            fprintf(stderr, "kernel_launch: shape / workspace mismatch (n_in %d, in0 %d, out %d, ws %zu < %zu); nothing launched\n", n_in, n_in > 0 ? in_sizes[0] : -1, out_size, ws_size, (size_t)WS_END); grid = -1; return; }
        int dev = 0, cus = 0, per_cu = 0;
        if (hipGetDevice(&dev) != hipSuccess || hipDeviceGetAttribute(&cus, hipDeviceAttributeMultiprocessorCount, dev) != hipSuccess) { grid = -1; return; }
        if (hipFuncSetAttribute((const void*)fwd, hipFuncAttributeMaxDynamicSharedMemorySize, LDS_BYTES) != hipSuccess) { fprintf(stderr, "kernel_launch: hipFuncSetAttribute failed\n"); grid = -1; return; }
        if (hipOccupancyMaxActiveBlocksPerMultiprocessor(&per_cu, (const void*)fwd, NTHREADS, LDS_BYTES) != hipSuccess || per_cu < 1) { fprintf(stderr, "kernel_launch: occupancy query says %d\n", per_cu); }
        (void)hipGetLastError();
        grid = cus;
    }
    if (grid < 0) return;
    if (hipMemsetAsync((char*)d_ws + WS_CTL, 0, CTL_ZERO_BYTES, stream) != hipSuccess) return;
    Args a{};
    for (int i = 0; i < 22; ++i) a.in[i] = (const float*)d_in[i];
    a.out = (float*)d_out; a.ws = (unsigned char*)d_ws;
#if MK_N_LAUNCHES == 1
    a.ph_lo = 0; a.ph_hi = N_PHASES;
    hipLaunchKernelGGL(fwd, dim3(grid), dim3(NTHREADS), LDS_BYTES, stream, a);
#else
#ifndef PROBE_MASK
#define PROBE_MASK 0
#endif
    for (int p = 0; p < N_PHASES; ++p) { a.ph_lo = p; a.ph_hi = p + 1; hipLaunchKernelGGL(fwd, dim3(grid), dim3(NTHREADS), LDS_BYTES, stream, a);
        if ((PROBE_MASK >> p) & 1) hipLaunchKernelGGL(fwd, dim3(grid), dim3(NTHREADS), LDS_BYTES, stream, a);
#ifdef PROBE_EXTRA
        if (p == 4) { a.ph_lo = PROBE_EXTRA; a.ph_hi = PROBE_EXTRA + 1; hipLaunchKernelGGL(fwd, dim3(grid), dim3(NTHREADS), LDS_BYTES, stream, a); }
#endif
    }
#endif
}
```

```cpp
#include <hip/hip_runtime.h>
#include <cstdio>
#include <cstdint>

__device__ __forceinline__ int hw_lane() { int l; asm volatile("v_mbcnt_lo_u32_b32 %0, -1, 0\n\tv_mbcnt_hi_u32_b32 %0, -1, %0" : "=v"(l)); return l; }
namespace pg8 {
#define PG8_LAS __attribute__((address_space(3)))
typedef unsigned short bf16_t;
typedef short bf16x8 __attribute__((ext_vector_type(8)));
typedef float f32x4 __attribute__((ext_vector_type(4)));
typedef unsigned u32x4 __attribute__((ext_vector_type(4)));
typedef unsigned u32x2 __attribute__((ext_vector_type(2)));
typedef int v8i __attribute__((ext_vector_type(8)));
typedef short bf16x16 __attribute__((ext_vector_type(16)));
constexpr int BM = 256, BK = 64, HALF = 128, HTB = HALF * BK * 2  , STAGE_BYTES = 8 * HTB, NXCD = 8, WGM = 8;

__host__ __device__ __forceinline__ int lds_byte(int r, int c) { const int st = (r >> 4) * 2 + (c >> 5), rr = r & 15, cc = c & 31, ob = rr * 64 + cc * 2; return st * 1024 + (ob ^ (((ob >> 9) & 1) << 5)); }
__host__ __device__ __forceinline__ void stage_rc(int b, int& R, int& C) { const int st = b / 1024, sb = b % 1024, swz = sb ^ (((sb >> 9) & 1) << 5); R = (st >> 1) * 16 + swz / 64; C = (st & 1) * 32 + (swz % 64) / 2; }
__host__ __device__ __forceinline__ int perm32(int rho) { const int n = rho >> 4, i = rho & 15; return 8 * (i >> 2) + 4 * n + (i & 3); }

struct Unit { int pm, pn; };
struct Gemm { const bf16_t* A; const bf16_t* Bt; int M, N, K; };

struct StaticOrder {
    int nM, nN, nwg, G, c;
    __host__ __device__ void init(int M, int N, int G_, int c_) { nM = M / BM; nN = N / BM; nwg = nM * nN; G = G_; c = c_; }
    __host__ __device__ bool next(int i, Unit& u) const {
        const long L = (long)i * G + c; if (L >= nwg) return false;
        int wgid = (int)L; { const int q = nwg / NXCD, r = nwg % NXCD, xcd = wgid % NXCD, off = wgid / NXCD; wgid = (xcd < r ? xcd * (q + 1) : r * (q + 1) + (xcd - r) * q) + off; }
        const int nig = WGM * nN, gid = wgid / nig, fm = gid * WGM, gsz = (nM - fm) < WGM ? (nM - fm) : WGM;
        u.pm = fm + ((wgid % nig) % gsz); u.pn = (wgid % nig) / gsz; return true;
    }
    __device__ __forceinline__ int gather_row(const Unit&, int) const { return 0; }
};

__device__ __forceinline__ unsigned cvt_pk_bf16(float lo, float hi) { unsigned r; asm volatile("v_cvt_pk_bf16_f32 %0, %1, %2" : "=v"(r) : "v"(lo), "v"(hi)); return r; }

#define PG8_DMA4(ldsaddr, gbase, vo) asm volatile("s_mov_b32 m0, %0\n\ts_nop 0\n\tglobal_load_lds_dword %1, %2" :: "s"(ldsaddr), "v"(vo), "s"(gbase) : "memory", "m0")
#define PG8_DMA16(ldsaddr, gbase, vo) asm volatile("s_mov_b32 m0, %0\n\ts_nop 0\n\tglobal_load_lds_dwordx4 %1, %2" :: "s"(ldsaddr), "v"(vo), "s"(gbase) : "memory", "m0")
typedef float zf32x2 __attribute__((ext_vector_type(2)));
__device__ __forceinline__ f32x4 zero4() { zf32x2 a, b; asm volatile("v_pk_mov_b32 %0, 0, 0" : "=v"(a)); asm volatile("v_pk_mov_b32 %0, 0, 0" : "=v"(b)); return (f32x4){a.x, a.y, b.x, b.y}; }
struct NoPre {};
struct EpiBf16 {
    static constexpr bool PERM = true; typedef NoPre Pre;
    bf16_t* O; int ldc;
    __device__ __forceinline__ void prefetch(const Unit&, int, PG8_LAS unsigned char*, int, int, int, int, int, int, Pre&) const {}
    __device__ __forceinline__ void operator()(const f32x4 (&acc)[2][2][4][2], const Unit& u, int wr, int wc, int fr, int fq, const Pre&, int, PG8_LAS unsigned char*) const {
        const int row0 = u.pm * BM + wr * 64 + fr; const int col0 = u.pn * BM + wc * 32 + 8 * fq;
#pragma unroll
        for (int ai = 0; ai < 2; ++ai)
#pragma unroll
            for (int m = 0; m < 4; ++m) { bf16_t* rowp = O + (size_t)(row0 + ai * HALF + m * 16) * ldc + col0;
#pragma unroll
                for (int bj = 0; bj < 2; ++bj) { const f32x4 v0 = acc[ai][bj][m][0], v1 = acc[ai][bj][m][1];
                    u32x4 w; w.x = cvt_pk_bf16(v0[0], v0[1]); w.y = cvt_pk_bf16(v0[2], v0[3]); w.z = cvt_pk_bf16(v1[0], v1[1]); w.w = cvt_pk_bf16(v1[2], v1[3]);
                    *(u32x4*)(rowp + bj * HALF) = w; } }
    }
};
struct EpiBf16KN {
    static constexpr bool PERM = true; typedef NoPre Pre;
    bf16_t* O; int ldc; unsigned* kn; unsigned char* k8;
    __device__ __forceinline__ void prefetch(const Unit&, int, PG8_LAS unsigned char*, int, int, int, int, int, int, Pre&) const {}
    __device__ __forceinline__ void operator()(const f32x4 (&acc)[2][2][4][2], const Unit& u, int wr, int wc, int fr, int fq, const Pre&, int, PG8_LAS unsigned char*) const {
        const int row0 = u.pm * BM + wr * 64 + fr; const int col0 = u.pn * BM + wc * 32 + 8 * fq;
        float mx = 0.f;
#pragma unroll
        for (int ai = 0; ai < 2; ++ai)
#pragma unroll
            for (int m = 0; m < 4; ++m) { bf16_t* rowp = O + (size_t)(row0 + ai * HALF + m * 16) * ldc + col0;
                { const f32x4 v0 = acc[ai][1][m][0], v1 = acc[ai][1][m][1];
                    u32x4 w; w.x = cvt_pk_bf16(v0[0], v0[1]); w.y = cvt_pk_bf16(v0[2], v0[3]); w.z = cvt_pk_bf16(v1[0], v1[1]); w.w = cvt_pk_bf16(v1[2], v1[3]);
                    *(u32x4*)(rowp + HALF) = w; }
                const f32x4 a0 = acc[ai][0][m][0], a1 = acc[ai][0][m][1];
                { int u0 = 0, u1 = 0; u0 = __builtin_amdgcn_cvt_pk_fp8_f32(a0[0], a0[1], u0, false); u0 = __builtin_amdgcn_cvt_pk_fp8_f32(a0[2], a0[3], u0, true);
                  u1 = __builtin_amdgcn_cvt_pk_fp8_f32(a1[0], a1[1], u1, false); u1 = __builtin_amdgcn_cvt_pk_fp8_f32(a1[2], a1[3], u1, true);
                  typedef unsigned u32x2_ __attribute__((ext_vector_type(2))); u32x2_ w8; w8.x = (unsigned)u0; w8.y = (unsigned)u1;
                  *(u32x2_*)(k8 + (size_t)(row0 + ai * HALF + m * 16) * 512 + u.pn * 128 + wc * 32 + 8 * fq) = w8; }
                float s = a0[0] * a0[0] + a0[1] * a0[1] + a0[2] * a0[2] + a0[3] * a0[3] + a1[0] * a1[0] + a1[1] * a1[1] + a1[2] * a1[2] + a1[3] * a1[3];
                s += __shfl_xor(s, 16); s += __shfl_xor(s, 32); mx = fmaxf(mx, s); }
        mx = fmaxf(mx, __shfl_xor(mx, 1)); mx = fmaxf(mx, __shfl_xor(mx, 2)); mx = fmaxf(mx, __shfl_xor(mx, 4)); mx = fmaxf(mx, __shfl_xor(mx, 8));
        if (fr == 0 && fq == 0) atomicMax(kn + ((u.pm * BM) >> 11) * 32 + u.pn * 4 + wc, __float_as_uint(mx));
        asm volatile("s_waitcnt vmcnt(0)" ::: "memory"); __builtin_amdgcn_s_barrier();
        { const int tid_ = (wr * 4 + wc) * 64 + fq * 16 + fr;
#pragma unroll
          for (int i = 0; i < 2; ++i) { const int blk = tid_ + 512 * i; unsigned char* pb = k8 + (size_t)(u.pm * BM + (blk >> 2)) * 512 + u.pn * 128 + (blk & 3) * 32;
            const u32x4 lo = *(const u32x4*)pb, hi = *(const u32x4*)(pb + 16);
            typedef float v16f_ __attribute__((ext_vector_type(16))); typedef int v6i_ __attribute__((ext_vector_type(6)));
            v16f_ fa, fb;
#pragma unroll
            for (int w = 0; w < 4; ++w) { const auto a0 = __builtin_amdgcn_cvt_pk_f32_fp8((int)lo[w], false), a1 = __builtin_amdgcn_cvt_pk_f32_fp8((int)lo[w], true);
              const auto b0 = __builtin_amdgcn_cvt_pk_f32_fp8((int)hi[w], false), b1 = __builtin_amdgcn_cvt_pk_f32_fp8((int)hi[w], true);
              fa[4 * w] = a0[0]; fa[4 * w + 1] = a0[1]; fa[4 * w + 2] = a1[0]; fa[4 * w + 3] = a1[1]; fb[4 * w] = b0[0]; fb[4 * w + 1] = b0[1]; fb[4 * w + 2] = b1[0]; fb[4 * w + 3] = b1[1]; }
            v6i_ pk; asm volatile("v_cvt_scalef32_2xpk16_fp6_f32 %0, %1, %2, 1.0\n\ts_nop 7\n\ts_nop 7" : "=&v"(pk) : "v"(fa), "v"(fb));
            *(u32x4*)pb = (u32x4){(unsigned)pk[0], (unsigned)pk[1], (unsigned)pk[2], (unsigned)pk[3]}; *(u32x4*)(pb + 16) = (u32x4){(unsigned)pk[4], (unsigned)pk[5], 0u, 0u}; } }
    }
};
struct EpiResid {
    static constexpr bool PERM = true; typedef NoPre Pre;
    const float* base; bf16_t* out; int ldc;
    __device__ __forceinline__ void prefetch(const Unit&, int, PG8_LAS unsigned char*, int, int, int, int, int, int, Pre&) const {}
    __device__ __forceinline__ void operator()(const f32x4 (&acc)[2][2][4][2], const Unit& u, int wr, int wc, int fr, int fq, const Pre&, int, PG8_LAS unsigned char*) const {
        const int row0 = u.pm * BM + wr * 64 + fr; const int col0 = u.pn * BM + wc * 32 + 8 * fq;
#pragma unroll
        for (int ai = 0; ai < 2; ++ai)
#pragma unroll
            for (int m = 0; m < 4; ++m) { const size_t off = (size_t)(row0 + ai * HALF + m * 16) * ldc + col0;
#pragma unroll
                for (int bj = 0; bj < 2; ++bj) { const f32x4 v0 = *(const f32x4*)(base + off + bj * HALF) + acc[ai][bj][m][0], v1 = *(const f32x4*)(base + off + bj * HALF + 4) + acc[ai][bj][m][1];
                    u32x4 w; w.x = cvt_pk_bf16(v0[0], v0[1]); w.y = cvt_pk_bf16(v0[2], v0[3]); w.z = cvt_pk_bf16(v1[0], v1[1]); w.w = cvt_pk_bf16(v1[2], v1[3]);
                    *(u32x4*)(out + off + bj * HALF) = w; } }
    }
};

template <class Epi, class Sched, bool ALIGN_EPI = false, bool GATHER = false, bool F8 = false, bool F6 = false>
__device__ __forceinline__ void gemm_phase(PG8_LAS unsigned char* lds, const Gemm g, const Sched& S, const Epi& E, int wave) {
    const int wid = wave, lane = hw_lane(), tid = wid * 64 + lane, wr = wid >> 2, wc = wid & 3, fr = lane & 15, fq = lane >> 4;
    const int K = g.K, nt = K / BK;
    unsigned voffA[2], voffB[2]; int RA[2], CA[2];
#pragma unroll
    for (int i = 0; i < 2; ++i) { int R, C; stage_rc(tid * 16 + i * 8192, R, C); const int Rb = Epi::PERM ? ((R & ~31) + perm32(R & 31)) : R;
        voffA[i] = (unsigned)(R * K + C) * 2u; voffB[i] = (unsigned)(Rb * K + C) * 2u; RA[i] = R; CA[i] = C; }
    const size_t kstep = (size_t)(BK * 2);
    const size_t hstep = (size_t)HALF * K * 2;
    const size_t tstep = 2 * hstep;
    const unsigned ldsw = (unsigned)wid * 1024u, ldsu = (unsigned)(uintptr_t)lds;
    const int aoff = lds_byte(wr * 64 + fr, fq * (F8 ? 16 : 8)), boff = lds_byte(wc * 32 + fr, fq * (F8 ? 16 : 8));
    PG8_LAS unsigned char* ldsA = lds + aoff + (F8 ? 16 * (fq & 1) : 0); PG8_LAS unsigned char* ldsB = lds + 4 * HTB + boff + (F8 ? 16 * (fq & 1) : 0);
    PG8_LAS unsigned char* ldsA2 = lds + aoff + 16 * (1 - (fq & 1)); PG8_LAS unsigned char* ldsB2 = lds + 4 * HTB + boff + 16 * (1 - (fq & 1));
    if constexpr (F8) { asm volatile("" : "+v"(ldsA)); asm volatile("" : "+v"(ldsB)); asm volatile("" : "+v"(ldsA2)); asm volatile("" : "+v"(ldsB2)); }
#define PG8_SA(b, h) (((b) * 2 + (h)) * HTB)
#define PG8_SB(b, h) ((4 + (b) * 2 + (h)) * HTB)
#define PG8_SBR(b, h) (((b) * 2 + (h)) * HTB)
#define PG8_DMA1(ldsaddr, gbase, vo) asm volatile("s_mov_b32 m0, %0\n\ts_nop 0\n\tglobal_load_lds_dwordx4 %1, %2" :: "s"(ldsaddr), "v"(vo), "s"(gbase) : "memory", "m0")
#define PG8_STAGE(bufoff, gbase, voff) do { PG8_DMA1(ldsu + (unsigned)(bufoff) + ldsw, (const char*)(gbase), (voff)[0]); PG8_DMA1(ldsu + (unsigned)(bufoff) + ldsw + 8192u, (const char*)(gbase), (voff)[1]); } while (0)
#define PG8_STAGE_A(bufoff, h, base, O) do { if constexpr (GATHER) { PG8_STAGE(bufoff, base, O[h]); } else { PG8_STAGE(bufoff, (base) + (h) * hstep, voffA); } } while (0)
#define PG8_CAT8(lo, hi) ((v8i){(int)lo.x, (int)lo.y, (int)lo.z, (int)lo.w, (int)hi.x, (int)hi.y, (int)hi.z, (int)hi.w})
#define PG8_LDA(dst, b, h) do { if constexpr (F8) { _Pragma("unroll") for (int m = 0; m < 4; ++m) { const u32x4 lo_ = *(const PG8_LAS u32x4*)(ldsA + PG8_SA(b, h) + m * 2048), hi_ = *(const PG8_LAS u32x4*)(ldsA2 + PG8_SA(b, h) + m * 2048); dst##8[m] = PG8_CAT8(lo_, hi_); } } \
    else { _Pragma("unroll") for (int m = 0; m < 4; ++m) _Pragma("unroll") for (int k = 0; k < 2; ++k) dst[m][k] = *(const PG8_LAS bf16x8*)(lds + PG8_SA(b, h) + aoff + m * 2048 + k * 1024); } } while (0)
#define PG8_LDB(dst, b, h) do { if constexpr (F8) { _Pragma("unroll") for (int n = 0; n < 2; ++n) { const u32x4 lo_ = *(const PG8_LAS u32x4*)(ldsB + PG8_SBR(b, h) + n * 2048), hi_ = *(const PG8_LAS u32x4*)(ldsB2 + PG8_SBR(b, h) + n * 2048); dst##8[n] = PG8_CAT8(lo_, hi_); } } \
    else { _Pragma("unroll") for (int n = 0; n < 2; ++n) _Pragma("unroll") for (int k = 0; k < 2; ++k) dst[n][k] = *(const PG8_LAS bf16x8*)(lds + PG8_SB(b, h) + boff + n * 2048 + k * 1024); } } while (0)
#define PG8_MMA(ai, bj, At, Bt) do { __builtin_amdgcn_s_setprio(1); if constexpr (F8) { _Pragma("unroll") for (int m = 0; m < 4; ++m) _Pragma("unroll") for (int n = 0; n < 2; ++n) \
            { if constexpr (F6) acc[ai][bj][m][n] = __builtin_amdgcn_mfma_scale_f32_16x16x128_f8f6f4(Bt##8[n], At##8[m], acc[ai][bj][m][n], 2, 2, 0, 0x7f7f7f7f, 0, 0x7f7f7f7f); \
              else acc[ai][bj][m][n] = __builtin_amdgcn_mfma_scale_f32_16x16x128_f8f6f4(Bt##8[n], At##8[m], acc[ai][bj][m][n], 0, 0, 0, 0x7f7f7f7f, 0, 0x7f7f7f7f); } } \
    else { _Pragma("unroll") for (int m = 0; m < 4; ++m) _Pragma("unroll") for (int n = 0; n < 2; ++n) _Pragma("unroll") for (int k = 0; k < 2; ++k) \
        acc[ai][bj][m][n] = __builtin_amdgcn_mfma_f32_16x16x32_bf16(Bt[n][k], At[m][k], acc[ai][bj][m][n], 0, 0, 0); } __builtin_amdgcn_s_setprio(0); } while (0)
#define PG8_WAIT_V(n) asm volatile("s_waitcnt vmcnt(" #n ")" ::: "memory")
#define PG8_WAIT_L(n) asm volatile("s_waitcnt lgkmcnt(" #n ")" ::: "memory")
#define PG8_BAR __builtin_amdgcn_s_barrier()
#define PG8_SCHED __builtin_amdgcn_sched_barrier(0)
#ifdef PROBE_SEG
    unsigned long long pacc = 0, pt = 0; const unsigned long long ptot0 = __builtin_amdgcn_s_memtime();
#define PS_B(id) do { if ((id) == PROBE_SEG) pt = __builtin_amdgcn_s_memtime(); } while (0)
#define PS_E(id) do { if ((id) == PROBE_SEG) pacc += __builtin_amdgcn_s_memtime() - pt; } while (0)
#else
#define PS_B(id)
#define PS_E(id)
#endif
    Unit cur, nxt; int ui = 0;
    if (!S.next(0, cur)) return;
    PG8_LAS unsigned char* spare = lds + STAGE_BYTES;
    typename Epi::Pre pre; E.prefetch(cur, 0, spare, wid, lane, wr, wc, fr, fq, pre);
    f32x4 acc[2][2][4][2];
#pragma unroll
    for (int a = 0; a < 2; ++a)
#pragma unroll
        for (int b = 0; b < 2; ++b)
#pragma unroll
            for (int m = 0; m < 4; ++m)
#pragma unroll
                for (int n = 0; n < 2; ++n) acc[a][b][m][n] = (f32x4){0.f, 0.f, 0.f, 0.f};
    bf16x8 At[4][2], B0[2][2], B1[2][2]; v8i At8[4], B08[2], B18[2];
    unsigned gC[2][2], gN[2][2];
#pragma unroll
    for (int h = 0; h < 2; ++h)
#pragma unroll
        for (int i = 0; i < 2; ++i) { gC[h][i] = 0u; gN[h][i] = 0u; }
    if constexpr (GATHER) {
#pragma unroll
        for (int h = 0; h < 2; ++h)
#pragma unroll
            for (int i = 0; i < 2; ++i) gC[h][i] = (unsigned)S.gather_row(cur, h * HALF + RA[i]) * (unsigned)(K * 2) + (unsigned)(CA[i] * 2);
    }
    const char* cA = GATHER ? (const char*)g.A : (const char*)g.A + (size_t)cur.pm * tstep; const char* cB = (const char*)g.Bt + (size_t)cur.pn * tstep;
    PG8_STAGE(PG8_SB(0, 0), cB, voffB); PG8_STAGE(PG8_SB(0, 1), cB + hstep, voffB); PG8_STAGE_A(PG8_SA(0, 0), 0, cA, gC); PG8_STAGE_A(PG8_SA(0, 1), 1, cA, gC);
    if (wr == 1) PG8_BAR;
    PG8_WAIT_V(2); PG8_BAR;
    PG8_STAGE(PG8_SB(1, 0), cB + kstep, voffB); PG8_STAGE_A(PG8_SA(1, 0), 0, cA + kstep, gC); PG8_STAGE(PG8_SB(1, 1), cB + hstep + kstep, voffB);
    PG8_WAIT_V(6); PG8_BAR;
    for (;;) {
        const bool has_next = S.next(ui + 1, nxt);
        if constexpr (GATHER) {
            if (has_next) {
#pragma unroll
                for (int h = 0; h < 2; ++h)
#pragma unroll
                    for (int i = 0; i < 2; ++i) gN[h][i] = (unsigned)S.gather_row(nxt, h * HALF + RA[i]) * (unsigned)(K * 2) + (unsigned)(CA[i] * 2);
            } else {
#pragma unroll
                for (int h = 0; h < 2; ++h)
#pragma unroll
                    for (int i = 0; i < 2; ++i) gN[h][i] = gC[h][i];
            }
        }
        const char* nA = GATHER ? (const char*)g.A : (has_next ? (const char*)g.A + (size_t)nxt.pm * tstep : cA); const char* nB = has_next ? (const char*)g.Bt + (size_t)nxt.pn * tstep : cB;
#pragma unroll 1
        for (int t = 0; t < nt; t += 2) {
            const bool last = (t == nt - 2);
            const char* a1 = cA + (size_t)(t + 1) * kstep;
            const char* a2 = last ? nA : cA + (size_t)(t + 2) * kstep; const char* b2 = last ? nB : cB + (size_t)(t + 2) * kstep;
            const char* a3 = a2 + kstep; const char* b3 = b2 + kstep;
            PG8_LDB(B0, 0, 0); PG8_LDB(B1, 0, 1); PG8_SCHED; PG8_LDA(At, 0, 0); PG8_STAGE_A(PG8_SA(1, 1), 1, a1, gC);
            if constexpr (GATHER) { if (last) { _Pragma("unroll") for (int h = 0; h < 2; ++h) _Pragma("unroll") for (int i = 0; i < 2; ++i) gC[h][i] = gN[h][i]; } }
            PS_B(1); PG8_WAIT_V(8); PG8_WAIT_L(0); PS_E(1); PS_B(3); PG8_BAR; PS_E(3); PS_B(4); PG8_MMA(0, 0, At, B0); PG8_MMA(0, 1, At, B1); PS_E(4); PS_B(5); PG8_BAR; PS_E(5); PG8_SCHED;
            PG8_LDA(At, 0, 1); PG8_STAGE(PG8_SB(0, 0), b2, voffB); PG8_STAGE(PG8_SB(0, 1), b2 + hstep, voffB); PG8_STAGE_A(PG8_SA(0, 0), 0, a2, gC);
            PS_B(1); PG8_WAIT_V(8); PG8_WAIT_L(0); PS_E(1); PS_B(3); PG8_BAR; PS_E(3); PS_B(4); PG8_MMA(1, 0, At, B0); PG8_MMA(1, 1, At, B1); PS_E(4); PS_B(5); PG8_BAR; PS_E(5); PG8_SCHED;
            PG8_LDB(B0, 1, 0); PG8_LDB(B1, 1, 1); PG8_SCHED; PG8_LDA(At, 1, 0); PG8_STAGE_A(PG8_SA(0, 1), 1, a2, gC);
            PS_B(1); PG8_WAIT_V(8); PG8_WAIT_L(0); PS_E(1); PS_B(3); PG8_BAR; PS_E(3); PS_B(4); PG8_MMA(0, 0, At, B0); PG8_MMA(0, 1, At, B1); PS_E(4); PS_B(5); PG8_BAR; PS_E(5); PG8_SCHED;
            PG8_LDA(At, 1, 1); PG8_STAGE(PG8_SB(1, 0), b3, voffB); PG8_STAGE(PG8_SB(1, 1), b3 + hstep, voffB); PG8_STAGE_A(PG8_SA(1, 0), 0, a3, gC);
            PS_B(1); PG8_WAIT_V(8); PG8_WAIT_L(0); PS_E(1); PS_B(3); PG8_BAR; PS_E(3); PS_B(4); PG8_MMA(1, 0, At, B0); PG8_MMA(1, 1, At, B1); PS_E(4); PS_B(5); PG8_BAR; PS_E(5); PG8_SCHED;
        }
        if constexpr (ALIGN_EPI) { if (wr == 0) PG8_BAR; }
        { const int l2_ = hw_lane();
          PS_B(6); E(acc, cur, wr, wc, l2_ & 15, l2_ >> 4, pre, ui & 1, spare); PS_E(6); }
        if (!has_next) break;
#pragma unroll
        for (int a = 0; a < 2; ++a)
#pragma unroll
            for (int b = 0; b < 2; ++b)
#pragma unroll
                for (int m = 0; m < 4; ++m)
#pragma unroll
                    for (int n = 0; n < 2; ++n) acc[a][b][m][n] = zero4();
        cur = nxt; cA = nA; cB = nB; ++ui;
        { const int l3_ = hw_lane(); E.prefetch(cur, ui & 1, spare, wid, l3_, wr, wc, l3_ & 15, l3_ >> 4, pre); }
#pragma unroll
        for (int h = 0; h < 2; ++h)
#pragma unroll
            for (int i = 0; i < 2; ++i) gC[h][i] = gN[h][i];
        if constexpr (ALIGN_EPI) { if (wr == 1) PG8_BAR; }
    }
#ifdef PROBE_SEG
    if constexpr (GATHER && F8) { if (blockIdx.x == 0 && wid == PROBE_WAVE && lane == 0) { const unsigned long long tot = __builtin_amdgcn_s_memtime() - ptot0; ((float*)S.tinfo)[3000] = PROBE_SEG == 0 ? (float)tot * (0.25f / 1.5e6f) : 0.5f * (float)pacc / (float)tot; } }
#endif
    PG8_WAIT_V(0);
    if constexpr (!ALIGN_EPI) { if (wr == 0) PG8_BAR; }
    PG8_BAR;
#undef PS_B
#undef PS_E
#undef PG8_SA
#undef PG8_SB
#undef PG8_SBR
#undef PG8_STAGE
#undef PG8_DMA1
#undef PG8_STAGE_A
#undef PG8_LDA
#undef PG8_CAT8
#undef PG8_LDB
#undef PG8_MMA
#undef PG8_WAIT_V
#undef PG8_WAIT_L
#undef PG8_BAR
#undef PG8_SCHED
}
}

namespace att {
constexpr bool MLA_PD2 = true;
#define ALAS __attribute__((address_space(3)))
using bf16 = unsigned short;
using bf16x8 = __attribute__((ext_vector_type(8))) short;
using s16x4  = __attribute__((ext_vector_type(4))) short;
using f32x16 = __attribute__((ext_vector_type(16))) float;
using f32x2  = __attribute__((ext_vector_type(2))) float;
using u32x4  = __attribute__((ext_vector_type(4))) unsigned;
using v8i    = __attribute__((ext_vector_type(8))) int;
using v6i    = __attribute__((ext_vector_type(6))) int;
using v16f   = __attribute__((ext_vector_type(16))) float;
__device__ __forceinline__ v6i cvt6(v16f a, v16f b) { v6i r; asm volatile("v_cvt_scalef32_2xpk16_fp6_f32 %0, %1, %2, 1.0\n\ts_nop 7\n\ts_nop 7" : "=&v"(r) : "v"(a), "v"(b)); return r; }
using f32x4  = __attribute__((ext_vector_type(4))) float;
#define SBAR() __builtin_amdgcn_sched_barrier(0)
constexpr int SHM_V = 64 * 128 * 2;
constexpr int OFF_V = 0;
template <int MODE> struct L { static constexpr int NVB = MODE == 0 ? 3 : 2, SHM_K = 64 * (MODE == 0 ? 384 : 128), OFF_K = NVB * SHM_V, OFF_WS = OFF_K + 2 * SHM_K; };
constexpr int OFF_LUT = L<1>::OFF_WS + 2048;
constexpr int OFF_STASH = OFF_LUT + 16384;
constexpr int OFF_QPE = L<0>::OFF_WS + 2048;
constexpr int ATT_LDS = (OFF_STASH + 65536) > (OFF_QPE + 40960) ? (OFF_STASH + 65536) : (OFF_QPE + 40960);
__device__ __forceinline__ int crow(int r, int hi) { return (r & 3) + 8 * (r >> 2) + 4 * hi; }
__device__ __forceinline__ unsigned cvtpk(float lo, float hi) { unsigned r; asm volatile("v_cvt_pk_bf16_f32 %0, %1, %2" : "=v"(r) : "v"(lo), "v"(hi)); return r; }
__device__ __forceinline__ float bf2f(short v) { return __uint_as_float(((unsigned)(unsigned short)v) << 16); }
template <int RB> __device__ __forceinline__ int kaddr(int row, int colB) { return row * RB + (colB ^ (((row >> 1) & 7) << 4)); }

template <bool NEAR>
__device__ __forceinline__ void partialSM(f32x16& p0, f32x16& p1, float& m_reg, float& mn, float& alpha, float C, const ALAS float* lut, float cfar) {
  constexpr float THR2 = 8.f * 1.4426950408889634f;
  if constexpr (NEAR) {
#pragma unroll
    for (int r = 0; r < 16; ++r) { const int o = (r & 3) + 8 * (r >> 2); p0[r] = fmaf(p0[r], C, lut[o]); p1[r] = fmaf(p1[r], C, lut[32 + o]); }
  }
  float pmax = p0[0];
#pragma unroll
  for (int r = 1; r < 16; ++r) pmax = fmaxf(pmax, p0[r]);
#pragma unroll
  for (int r = 0; r < 16; ++r) pmax = fmaxf(pmax, p1[r]);
  { auto rr = __builtin_amdgcn_permlane32_swap(__float_as_uint(pmax), __float_as_uint(pmax), false, false);
    pmax = fmaxf(__uint_as_float(rr[0]), __uint_as_float(rr[1])); }
  if constexpr (!NEAR) pmax = fmaf(pmax, C, cfar);
  if (__builtin_expect(__all(pmax - m_reg <= THR2), 1)) { mn = m_reg; alpha = 1.f; }
  else { mn = fmaxf(m_reg, pmax); alpha = __builtin_amdgcn_exp2f(m_reg - mn); m_reg = mn; }
  if constexpr (NEAR) {
#pragma unroll
    for (int r = 0; r < 16; ++r) p0[r] = __builtin_amdgcn_exp2f(p0[r] - mn);
#pragma unroll
    for (int r = 0; r < 16; ++r) p1[r] = p1[r] - mn;
  } else {
    const float cm = cfar - mn;
#pragma unroll
    for (int r = 0; r < 16; ++r) p0[r] = __builtin_amdgcn_exp2f(fmaf(p0[r], C, cm));
#pragma unroll
    for (int r = 0; r < 16; ++r) p1[r] = fmaf(p1[r], C, cm);
  }
}
template <bool NEAR>
__device__ __forceinline__ void partialSM_fixed(f32x16& p0, f32x16& p1, float C, const ALAS float* lut, float cm) {
  if constexpr (NEAR) {
#pragma unroll
    for (int r = 0; r < 16; ++r) { const int o = (r & 3) + 8 * (r >> 2); p0[r] = __builtin_amdgcn_exp2f(fmaf(p0[r], C, lut[o]) + cm); p1[r] = fmaf(p1[r], C, lut[32 + o]) + cm; }
  } else {
#pragma unroll
    for (int r = 0; r < 16; ++r) p0[r] = __builtin_amdgcn_exp2f(fmaf(p0[r], C, cm));
#pragma unroll
    for (int r = 0; r < 16; ++r) p1[r] = fmaf(p1[r], C, cm);
  }
}
template <bool NEAR>
__device__ __forceinline__ void partialSM_acc(f32x16& p0, f32x16& p1, const ALAS float* lut) {
  if constexpr (NEAR) {
#pragma unroll
    for (int r = 0; r < 16; ++r) { const int o = (r & 3) + 8 * (r >> 2); p0[r] = __builtin_amdgcn_exp2f(p0[r] + lut[o]); p1[r] = p1[r] + lut[32 + o]; }
  } else {
#pragma unroll
    for (int r = 0; r < 16; ++r) p0[r] = __builtin_amdgcn_exp2f(p0[r]);
  }
}
__device__ __forceinline__ void finishSM(f32x16& p0, f32x16& p1, float alpha, float& l_reg, bf16x8& pa0, bf16x8& pa1, bf16x8& pa2, bf16x8& pa3) {
#pragma unroll
  for (int r = 0; r < 16; ++r) p1[r] = __builtin_amdgcn_exp2f(p1[r]);
  float ps = 0;
#pragma unroll
  for (int r = 0; r < 16; ++r) ps += p0[r];
#pragma unroll
  for (int r = 0; r < 16; ++r) ps += p1[r];
  { auto rr = __builtin_amdgcn_permlane32_swap(__float_as_uint(ps), __float_as_uint(ps), false, false);
    ps = __uint_as_float(rr[0]) + __uint_as_float(rr[1]); }
  l_reg = l_reg * alpha + ps;
#define PK4(P, BASE, OUT) do { unsigned a0 = cvtpk(P[BASE + 0], P[BASE + 1]), a1 = cvtpk(P[BASE + 2], P[BASE + 3]);   \
    unsigned b0 = cvtpk(P[BASE + 4], P[BASE + 5]), b1 = cvtpk(P[BASE + 6], P[BASE + 7]);                              \
    u32x4 w = {a0, a1, b0, b1}; OUT = __builtin_bit_cast(bf16x8, w); } while (0)
  PK4(p0, 0, pa0); PK4(p0, 8, pa1); PK4(p1, 0, pa2); PK4(p1, 8, pa3);
#undef PK4
}
template <int NQ, int RB>
__device__ __forceinline__ void qkt(f32x16& p0, f32x16& p1, const ALAS char* Ks, const bf16x8* qr, int r32, int hi) {
  p0 = f32x16{}; p1 = f32x16{};
#pragma unroll
  for (int d0 = 0; d0 < NQ; ++d0) { const int cb = (d0 * 16 + hi * 8) * 2;
    const bf16x8 b0 = *reinterpret_cast<const ALAS bf16x8*>(Ks + kaddr<RB>(r32, cb));
    const bf16x8 b1 = *reinterpret_cast<const ALAS bf16x8*>(Ks + kaddr<RB>(32 + r32, cb));
    p0 = __builtin_amdgcn_mfma_f32_32x32x16_bf16(b0, qr[d0], p0, 0, 0, 0);
    p1 = __builtin_amdgcn_mfma_f32_32x32x16_bf16(b1, qr[d0], p1, 0, 0, 0); }
}
__device__ __forceinline__ int v_st(int k, int c) { const int kk = (k & ~0xC) | ((k & 4) << 1) | ((k & 8) >> 1); return ((kk >> 3) * 4 + (c >> 5)) * 512 + ((kk & 7) * 32 + (c & 31)) * 2; }
__device__ __forceinline__ int v_rd_base(int lane) { return ((lane & 3) << 3) | (((lane >> 2) & 3) << 6) | (((lane >> 4) & 1) << 5) | (((lane >> 5) & 1) << 8); }
constexpr int v_rd_off(int d0, int ks, int half) { return d0 * 512 + ks * 4096 + half * 2048; }
template <int OFF> __device__ __forceinline__ s16x4 tr_read(int vb) {
  s16x4 r; asm volatile("ds_read_b64_tr_b16 %0, %1 offset:%2" : "=&v"(r) : "v"(vb), "i"(OFF) : "memory"); return r;
}
template <int D0> __device__ __forceinline__ void pv_one(f32x16& od, int vb, bf16x8 pa0, bf16x8 pa1, bf16x8 pa2, bf16x8 pa3) {
  const s16x4 l0 = tr_read<v_rd_off(D0, 0, 0)>(vb), h0 = tr_read<v_rd_off(D0, 0, 1)>(vb), l1 = tr_read<v_rd_off(D0, 1, 0)>(vb), h1 = tr_read<v_rd_off(D0, 1, 1)>(vb);
  const s16x4 l2 = tr_read<v_rd_off(D0, 2, 0)>(vb), h2 = tr_read<v_rd_off(D0, 2, 1)>(vb), l3 = tr_read<v_rd_off(D0, 3, 0)>(vb), h3 = tr_read<v_rd_off(D0, 3, 1)>(vb);
  asm volatile("s_waitcnt lgkmcnt(0)" ::: "memory"); SBAR();
#define PK(L, H) (bf16x8){L[0], L[1], L[2], L[3], H[0], H[1], H[2], H[3]}
  od = __builtin_amdgcn_mfma_f32_32x32x16_bf16(PK(l0, h0), pa0, od, 0, 0, 0);
  od = __builtin_amdgcn_mfma_f32_32x32x16_bf16(PK(l1, h1), pa1, od, 0, 0, 0);
  od = __builtin_amdgcn_mfma_f32_32x32x16_bf16(PK(l2, h2), pa2, od, 0, 0, 0);
  od = __builtin_amdgcn_mfma_f32_32x32x16_bf16(PK(l3, h3), pa3, od, 0, 0, 0);
#undef PK
}
__device__ __forceinline__ void pv_d0(f32x16* o, int vb, bf16x8 pa0, bf16x8 pa1, bf16x8 pa2, bf16x8 pa3) {
  pv_one<0>(o[0], vb, pa0, pa1, pa2, pa3); pv_one<1>(o[1], vb, pa0, pa1, pa2, pa3); pv_one<2>(o[2], vb, pa0, pa1, pa2, pa3); pv_one<3>(o[3], vb, pa0, pa1, pa2, pa3);
}

__device__ __forceinline__ int kw_addr(int row, int colB) { return row * 256 + (colB ^ ((row & 15) << 4)); }
__device__ __forceinline__ int kn_addr(int row, int colB) { return row * 128 + (colB ^ (((row >> 1) & 7) << 4)); }
template <int MODE, bool K8 = false>
__device__ __forceinline__ void attn_unit(const bf16* __restrict__ Qb, int ldq, const bf16* __restrict__ Kh, int ldk, const bf16* __restrict__ Kp, const bf16* __restrict__ Vh, int ldv,
                                          int seq, ALAS char* lds, float C, const f32x2* __restrict__ cs, int qpos0, f32x16 (&o)[4], int wave, int lane_in, float kmax2) {
  constexpr int SHM_KW = MODE == 0 ? 64 * 256 : 0, SHM_KN = 64 * 128, SHM_K = SHM_KW + SHM_KN;
  static_assert(SHM_K == L<MODE>::SHM_K, "K buffers");
  const int tid = threadIdx.x, wid = __builtin_amdgcn_readfirstlane(tid >> 6), lane = tid & 63, r32 = lane & 31, hi = lane >> 5;
  const bool late = MODE == 0 ? (wid >= 4) : false;
  ALAS char* V_lds = lds + OFF_V; ALAS char* K_lds = lds + L<MODE>::OFF_K;
  __syncthreads();
  float m_reg = -1e30f, l_reg = 0;
  float mbnd = 0.f;
#pragma unroll
  for (int d = 0; d < 4; ++d) o[d] = f32x16{};
  constexpr int NQR = 4;
  bf16x8 qr[NQR];
  v8i qf[3];
  const bf16* Qw = Qb + (long)(wid * 32 + r32) * ldq + hi * 8;
  float qn2 = 0.f;
  if constexpr (MODE == 1 && !K8) {
#pragma unroll
    for (int d0 = 0; d0 < NQR; ++d0) { qr[d0] = *reinterpret_cast<const bf16x8*>(Qw + d0 * 16);
#pragma unroll
      for (int j = 0; j < 8; ++j) { const float f = bf2f(qr[d0][j]); qn2 = fmaf(f, f, qn2); } }
  } else if constexpr (MODE == 1) {
    const bf16* Qrow = Qb + (long)(wid * 32 + r32) * ldq + 32 * hi;
    bf16x8 tq[4]; int w[8];
#pragma unroll
    for (int c = 0; c < 4; ++c) tq[c] = *reinterpret_cast<const bf16x8*>(Qrow + 8 * c);
#pragma unroll
    for (int c = 0; c < 4; ++c) { float f[8];
#pragma unroll
      for (int j = 0; j < 8; ++j) { f[j] = bf2f(tq[c][j]); qn2 = fmaf(f[j], f[j], qn2); f[j] *= 8.f; }
      int u = 0; u = __builtin_amdgcn_cvt_pk_fp8_f32(f[0], f[1], u, false); u = __builtin_amdgcn_cvt_pk_fp8_f32(f[2], f[3], u, true); w[2 * c] = u;
      u = 0; u = __builtin_amdgcn_cvt_pk_fp8_f32(f[4], f[5], u, false); u = __builtin_amdgcn_cvt_pk_fp8_f32(f[6], f[7], u, true); w[2 * c + 1] = u; }
    qf[0] = (v8i){w[0], w[1], w[2], w[3], w[4], w[5], w[6], w[7]};
  } else {
    const bf16* Qrow = Qb + (long)(wid * 32 + r32) * ldq;
    bf16x8 tn[2][4], x1[4], x2[4];
#pragma unroll
    for (int s = 0; s < 2; ++s)
#pragma unroll
      for (int c = 0; c < 4; ++c) tn[s][c] = *reinterpret_cast<const bf16x8*>(Qrow + 64 * s + 32 * hi + 8 * c);
#pragma unroll
    for (int c = 0; c < 4; ++c) { x1[c] = *reinterpret_cast<const bf16x8*>(Qrow + 128 + 8 * c); x2[c] = *reinterpret_cast<const bf16x8*>(Qrow + 160 + 8 * c); }
    const f32x4* cp = reinterpret_cast<const f32x4*>(cs + (long)(qpos0 + wid * 32 + r32) * 32);
    float q2 = 0.f;
#pragma unroll
    for (int s = 0; s < 2; ++s) { v16f fa, fb;
#pragma unroll
      for (int c = 0; c < 4; ++c)
#pragma unroll
        for (int j = 0; j < 8; ++j) { const float f = bf2f(tn[s][c][j]); q2 = fmaf(f, f, q2); if (c < 2) fa[8 * c + j] = f * 16.f; else fb[8 * (c - 2) + j] = f * 16.f; }
      const v6i pk = cvt6(fa, fb); qf[s] = (v8i){pk[0], pk[1], pk[2], pk[3], pk[4], pk[5], 0, 0}; }
    { v16f fa, fb;
#pragma unroll
      for (int c = 0; c < 4; ++c) { float f[8];
#pragma unroll
        for (int j = 0; j < 8; j += 2) { const f32x4 cc = cp[(8 * c + j) >> 1];
          const float a0 = bf2f(x1[c][j]), b0 = bf2f(x2[c][j]), a1 = bf2f(x1[c][j + 1]), b1 = bf2f(x2[c][j + 1]);
          f[j] = hi ? (a0 * cc.y + b0 * cc.x) : (a0 * cc.x - b0 * cc.y); f[j + 1] = hi ? (a1 * cc.w + b1 * cc.z) : (a1 * cc.z - b1 * cc.w); }
#pragma unroll
        for (int j = 0; j < 8; ++j) { q2 = fmaf(f[j], f[j], q2); if (c < 2) fa[8 * c + j] = f[j] * 16.f; else fb[8 * (c - 2) + j] = f[j] * 16.f; } }
      const v6i pk = cvt6(fa, fb); qf[2] = (v8i){pk[0], pk[1], pk[2], pk[3], pk[4], pk[5], 0, 0}; }
    { auto rr = __builtin_amdgcn_permlane32_swap(__float_as_uint(q2), __float_as_uint(q2), false, false); q2 = __uint_as_float(rr[0]) + __uint_as_float(rr[1]); }
    mbnd = C * sqrtf(q2 * kmax2) * 1.02f + 1.f;
    if (lane == 0) ((ALAS unsigned*)(lds + OFF_V + 2 * SHM_V))[wid] = __all(mbnd < 56.f) ? 1u : 0u;
  }
  unsigned vsrc[2], kwsrc[2], knsrc;
#pragma unroll
  for (int i = 0; i < 2; ++i) { const int s = (wid + 8 * i) * 64 + lane;
    const int kk = (s >> 7) * 8 + ((s & 31) >> 2), c = ((s >> 5) & 3) * 32 + (s & 3) * 8, k = kk;
    vsrc[i] = (unsigned)(k * ldv + c);
    const int row = s >> 4, ch = (s & 15) ^ (row & 15); kwsrc[i] = (unsigned)(row * ldk + ch * 8); }
  { const int s = wid * 64 + lane, row = s >> 3, ch = (s & 7) ^ ((row >> 1) & 7); knsrc = (unsigned)(row * ldk + ch * 8); }
  unsigned k8src = 0, p8src = 0;
  if constexpr (MODE == 0) { { const int s = wid * 64 + lane, row = s >> 3, ch = (s & 7) ^ ((row >> 1) & 7); k8src = (unsigned)(row * ldk + ch * 16); }
                             { const int s = (wid & 3) * 64 + lane, row = s >> 2, ch = (s & 3) ^ ((row >> 2) & 3); p8src = (unsigned)(row * 64 + ch * 16); } }
  else if constexpr (K8) { const int s = (wid & 3) * 64 + lane, row = s >> 2, ch = (s & 3) ^ ((row >> 2) & 3); p8src = (unsigned)(row * ldk + ch * 16); }
  const bf16* Kn = Kh; const int ldn = ldk;
  const int kaw = (int)(unsigned)(uintptr_t)K_lds + (MODE == 0 ? r32 * 128 + (((2 * hi) ^ ((r32 >> 1) & 7)) << 4) : 0);
  const int kan = (int)(unsigned)(uintptr_t)K_lds + SHM_KW + ((MODE == 0 || K8) ? r32 * 64 + (((2 * hi) ^ ((r32 >> 2) & 3)) << 4) : kn_addr(r32, hi * 16));
#define DMA16(src, dst) __builtin_amdgcn_global_load_lds((const unsigned*)(src), (ALAS unsigned*)(dst), 16, 0, 0)
#define DMA_V(t, b) do { const bf16* vb_ = Vh + (long)(t) * 64 * ldv; DMA16(vb_ + vsrc[0], V_lds + (b) * SHM_V + wid * 1024); DMA16(vb_ + vsrc[1], V_lds + (b) * SHM_V + (wid + 8) * 1024); } while (0)
#define DMA_K(t, b) do { if constexpr (MODE == 0) { DMA16((const char*)Kh + (long)(t) * 64 * ldk + k8src, K_lds + (b) * SHM_K + wid * 1024); \
      if (wid < 4) DMA16((const char*)Kp + (long)(t) * 64 * 64 + p8src, K_lds + (b) * SHM_K + SHM_KW + wid * 1024); } \
    else if constexpr (K8) { if (wid < 4) DMA16((const char*)Kh + (long)(t) * 64 * ldk + p8src, K_lds + (b) * SHM_K + wid * 1024); } \
    else DMA16(Kn + (long)(t) * 64 * ldn + knsrc, K_lds + (b) * SHM_K + SHM_KW + wid * 1024); } while (0)
#define STEP_END() do { asm volatile("s_waitcnt vmcnt(0)" ::: "memory"); __syncthreads(); } while (0)
#define QKT(P0, P1, b) do { int aw_ = kaw, an_ = kan; \
    if constexpr (MODE == 0) { asm volatile("" : "+v"(aw_), "+v"(an_));     \
      P0 = f32x16{}; P1 = f32x16{}; \
      _Pragma("unroll") for (int s = 0; s < 3; ++s) { const int x_ = s < 2 ? (aw_ ^ (64 * s)) : an_; const int half_ = s < 2 ? 4096 : 2048; \
        const ALAS char* p0_ = (const ALAS char*)(unsigned)x_ + (b) * SHM_K; const ALAS char* p1_ = (const ALAS char*)(unsigned)(x_ ^ 16) + (b) * SHM_K; \
        const u32x4 a0_ = *reinterpret_cast<const ALAS u32x4*>(p0_), a1_ = *reinterpret_cast<const ALAS u32x4*>(p1_); \
        const u32x4 b0_ = *reinterpret_cast<const ALAS u32x4*>(p0_ + half_), b1_ = *reinterpret_cast<const ALAS u32x4*>(p1_ + half_); \
        const v8i ka_ = (v8i){(int)a0_.x, (int)a0_.y, (int)a0_.z, (int)a0_.w, (int)a1_.x, (int)a1_.y, (int)a1_.z, (int)a1_.w}; \
        const v8i kb_ = (v8i){(int)b0_.x, (int)b0_.y, (int)b0_.z, (int)b0_.w, (int)b1_.x, (int)b1_.y, (int)b1_.z, (int)b1_.w}; \
        P0 = __builtin_amdgcn_mfma_scale_f32_32x32x64_f8f6f4(ka_, qf[s], P0, 2, 2, 0, 0x7f7f7f7f, 0, 0x7b7b7b7b); \
        P1 = __builtin_amdgcn_mfma_scale_f32_32x32x64_f8f6f4(kb_, qf[s], P1, 2, 2, 0, 0x7f7f7f7f, 0, 0x7b7b7b7b); } } \
    else if constexpr (!K8) { asm volatile("" : "+v"(an_)); \
    _Pragma("unroll") for (int d0 = 0; d0 < 4; ++d0) { const ALAS char* p_ = (const ALAS char*)(unsigned)(an_ ^ (d0 * 32)) + (b) * SHM_K; \
        const bf16x8 b0 = *reinterpret_cast<const ALAS bf16x8*>(p_); const bf16x8 b1 = *reinterpret_cast<const ALAS bf16x8*>(p_ + 32 * 128); \
        const bf16x8 qf_ = qr[d0]; \
        if (d0 == 0) { P0 = __builtin_amdgcn_mfma_f32_32x32x16_bf16(b0, qf_, ci, 0, 0, 0); P1 = __builtin_amdgcn_mfma_f32_32x32x16_bf16(b1, qf_, ci, 0, 0, 0); } \
        else { P0 = __builtin_amdgcn_mfma_f32_32x32x16_bf16(b0, qf_, P0, 0, 0, 0); P1 = __builtin_amdgcn_mfma_f32_32x32x16_bf16(b1, qf_, P1, 0, 0, 0); } } } \
    else { asm volatile("" : "+v"(an_)); \
      const ALAS char* p0_ = (const ALAS char*)(unsigned)an_ + (b) * SHM_K; const ALAS char* p1_ = (const ALAS char*)(unsigned)(an_ ^ 16) + (b) * SHM_K; \
      const u32x4 a0_ = *reinterpret_cast<const ALAS u32x4*>(p0_), a1_ = *reinterpret_cast<const ALAS u32x4*>(p1_); \
      const u32x4 b0_ = *reinterpret_cast<const ALAS u32x4*>(p0_ + 2048), b1_ = *reinterpret_cast<const ALAS u32x4*>(p1_ + 2048); \
      const v8i ka_ = (v8i){(int)a0_.x, (int)a0_.y, (int)a0_.z, (int)a0_.w, (int)a1_.x, (int)a1_.y, (int)a1_.z, (int)a1_.w}; \
      const v8i kb_ = (v8i){(int)b0_.x, (int)b0_.y, (int)b0_.z, (int)b0_.w, (int)b1_.x, (int)b1_.y, (int)b1_.z, (int)b1_.w}; \
      P0 = __builtin_amdgcn_mfma_scale_f32_32x32x64_f8f6f4(ka_, qf[0], ci, 0, 0, 0, 0x7f7f7f7f, 0, 0x7c7c7c7c); \
      P1 = __builtin_amdgcn_mfma_scale_f32_32x32x64_f8f6f4(kb_, qf[0], ci, 0, 0, 0, 0x7f7f7f7f, 0, 0x7c7c7c7c); } } while (0)
#define CIUPD(TILE, FASTV) do { if constexpr (MODE == 1) { if (FASTV) { const int k0_ = (TILE) * 64; const bool far_ = (k0_ >= qw + 122) || (k0_ + 154 <= qw); const int sd_ = far_ ? (k0_ > qw ? 2 : 1) : 0; \
      if (sd_ != side) { asm volatile("" ::: "memory");   side = sd_; const float cm_ = (sd_ == 0 ? 0.f : (sd_ == 2 ? cpos : cneg)) - mbnd; _Pragma("unroll") for (int r = 0; r < 16; ++r) ci[r] = cm_; } } } } while (0)
#define QKTJ(P0, P1, b, TILE, FASTV) do { CIUPD(TILE, FASTV); QKT(P0, P1, b); } while (0)
#define RESC(a) do { if (__any((a) < 1.f)) { \
    _Pragma("unroll") for (int d = 0; d < 4; ++d) _Pragma("unroll") for (int r = 0; r < 16; ++r) o[d][r] *= (a); } } while (0)
  const int vb0 = (int)(unsigned)(uintptr_t)V_lds + v_rd_base(lane);
  const int qw = qpos0 + wid * 32;
  const ALAS float* lutb = (const ALAS float*)(lds + OFF_LUT);
  const ALAS float* lutp = lutb + (2047 - (qw + r32) + 4 * hi);
  float cpos = 0.f, cneg = 0.f; bool fast = false;
#define PSM(P0, P1, MN, AL, TILE) PSMX(P0, P1, MN, AL, TILE, 0)
#define PSMX(P0, P1, MN, AL, TILE, FASTV) do { if constexpr (MODE == 0) { if (FASTV) { AL = 1.f; partialSM_acc<false>(P0, P1, lutp);   } else partialSM<false>(P0, P1, m_reg, MN, AL, C, lutp, 0.f); } else { const int k0_ = (TILE) * 64; const bool far_ = (k0_ >= qw + 122) || (k0_ + 154 <= qw); \
    if (FASTV) { AL = 1.f; if (far_) partialSM_acc<false>(P0, P1, lutp); else partialSM_acc<true>(P0, P1, lutp + k0_); } \
    else if (far_) partialSM<false>(P0, P1, m_reg, MN, AL, C, lutp, k0_ > qw ? cpos : cneg); else partialSM<true>(P0, P1, m_reg, MN, AL, C, lutp + k0_, 0.f); } } while (0)
  f32x16 ci = f32x16{}; int side = -1;
  f32x16 pA0, pA1; float mnA, alA; bf16x8 pa0, pa1, pa2, pa3; const int NT = seq / 64;
  if constexpr (MODE == 0 && !MLA_PD2) {
    DMA_K(0, 0); DMA_V(0, 0); STEP_END();
    int vbj = 0, vbp = 0;
    if (!late) {
      for (int j = 0; j < NT; ++j) {
        const int kb = j & 1, vbn = vbj == 2 ? 0 : vbj + 1;
        if (j + 1 < NT) { DMA_K(j + 1, kb ^ 1); DMA_V(j + 1, vbn); }
        SBAR();
        QKT(pA0, pA1, kb); PSM(pA0, pA1, mnA, alA, j);
        RESC(alA);
        finishSM(pA0, pA1, alA, l_reg, pa0, pa1, pa2, pa3); SBAR();
        pv_d0(o, vb0 + vbj * SHM_V, pa0, pa1, pa2, pa3);
        STEP_END();
        vbp = vbj; vbj = vbn;
      }
    } else {
      for (int j = 0; j < NT; ++j) {
        const int kb = j & 1, vbn = vbj == 2 ? 0 : vbj + 1;
        if (j + 1 < NT) { DMA_K(j + 1, kb ^ 1); DMA_V(j + 1, vbn); }
        if (j > 0) {
          PSM(pA0, pA1, mnA, alA, j - 1);
          RESC(alA);
          finishSM(pA0, pA1, alA, l_reg, pa0, pa1, pa2, pa3); SBAR();
          pv_d0(o, vb0 + vbp * SHM_V, pa0, pa1, pa2, pa3);
        }
        SBAR();
        QKT(pA0, pA1, kb);
        STEP_END();
        vbp = vbj; vbj = vbn;
      }
      PSM(pA0, pA1, mnA, alA, NT - 1);
      RESC(alA);
      finishSM(pA0, pA1, alA, l_reg, pa0, pa1, pa2, pa3); SBAR();
      pv_d0(o, vb0 + vbp * SHM_V, pa0, pa1, pa2, pa3);
    }
  } else {
    f32x16 pB0, pB1; float mnB, alB;
    DMA_K(0, 0); STEP_END();
    if constexpr (MODE == 1) {
    cpos = lutb[2047 + 128]; cneg = lutb[2047 - 128];
    { float q2 = qn2;
      { auto rr = __builtin_amdgcn_permlane32_swap(__float_as_uint(q2), __float_as_uint(q2), false, false); q2 = __uint_as_float(rr[0]) + __uint_as_float(rr[1]); }
      mbnd = C * sqrtf(q2 * kmax2) * 1.02f + lutb[4095] + 1.f;
      fast = __all(mbnd < 56.f); }
    }
#define DIFF_LOOP(LATE, FASTV) do { \
      \
    DMA_K(1, 1); DMA_V(0, 0); \
    QKTJ(pA0, pA1, 0, 0, FASTV); \
    if (!(LATE)) { PSMX(pA0, pA1, mnA, alA, 0, FASTV); } \
    STEP_END(); \
    for (int j = 1; j + 1 < NT; j += 2) { \
        \
      DMA_K(j + 1, 0); DMA_V(j, 1); \
      if (LATE) { PSMX(pA0, pA1, mnA, alA, j - 1, FASTV); RESC(alA); } \
      SBAR(); QKTJ(pB0, pB1, 1, j, FASTV); \
      finishSM(pA0, pA1, alA, l_reg, pa0, pa1, pa2, pa3); SBAR(); \
      pv_d0(o, vb0, pa0, pa1, pa2, pa3); \
      if (!(LATE)) { PSMX(pB0, pB1, mnB, alB, j, FASTV); RESC(alB); } \
      STEP_END(); \
        \
      DMA_K(j + 2, 1); DMA_V(j + 1, 0); \
      if (LATE) { PSMX(pB0, pB1, mnB, alB, j, FASTV); RESC(alB); } \
      SBAR(); QKTJ(pA0, pA1, 0, j + 1, FASTV); \
      finishSM(pB0, pB1, alB, l_reg, pa0, pa1, pa2, pa3); SBAR(); \
      pv_d0(o, vb0 + SHM_V, pa0, pa1, pa2, pa3); \
      if (!(LATE)) { PSMX(pA0, pA1, mnA, alA, j + 1, FASTV); RESC(alA); } \
      STEP_END(); \
    } \
      \
    DMA_V(NT - 1, 1); \
    if (LATE) { PSMX(pA0, pA1, mnA, alA, NT - 2, FASTV); RESC(alA); } \
    SBAR(); QKTJ(pB0, pB1, 1, NT - 1, FASTV); \
    finishSM(pA0, pA1, alA, l_reg, pa0, pa1, pa2, pa3); SBAR(); \
    pv_d0(o, vb0, pa0, pa1, pa2, pa3); \
    PSMX(pB0, pB1, mnB, alB, NT - 1, FASTV); RESC(alB); \
    STEP_END(); \
    finishSM(pB0, pB1, alB, l_reg, pa0, pa1, pa2, pa3); SBAR(); \
    pv_d0(o, vb0 + SHM_V, pa0, pa1, pa2, pa3); } while (0)
    if constexpr (MODE == 0) { const u32x4 v0_ = *(const ALAS u32x4*)(lds + OFF_V + 2 * SHM_V), v1_ = *(const ALAS u32x4*)(lds + OFF_V + 2 * SHM_V + 16);
      const bool fastu = __builtin_amdgcn_readfirstlane((v0_.x & v0_.y & v0_.z & v0_.w & v1_.x & v1_.y & v1_.z & v1_.w)) != 0u;
      if (fastu) DIFF_LOOP(false, 1); else DIFF_LOOP(false, 0); }
    else { if (fast) DIFF_LOOP(false, 1); else DIFF_LOOP(false, 0); }
#undef DIFF_LOOP
  }
  { const float rl = __builtin_amdgcn_rcpf(l_reg);
#pragma unroll
    for (int d = 0; d < 4; ++d)
#pragma unroll
      for (int r = 0; r < 16; ++r) o[d][r] *= rl; }
#undef DMA16
#undef DMA_V
#undef DMA_K
#undef STEP_END
#undef QKT
#undef RESC
#undef PSM
}
}
#define XB_TMO      128
#define XB_XCNT(j)  (256  + 64 * (j))
#define XB_XSUB(j)  (1280 + 64 * (j))
#define XB_XGEN(j)  (2304 + 64 * (j))
#define XB_TOP      3328
#define XB_TOPGEN   3392
#define XCD_BAR_WORDS 3456
#define XB_SPIN_CAP (1u << 18)
#define LAS __attribute__((address_space(3)))

__device__ __forceinline__ unsigned xb_ld(unsigned* p)              { return __hip_atomic_load(p, __ATOMIC_RELAXED, __HIP_MEMORY_SCOPE_AGENT); }
__device__ __forceinline__ unsigned xb_add(unsigned* p, unsigned v) { return __hip_atomic_fetch_add(p, v, __ATOMIC_RELAXED, __HIP_MEMORY_SCOPE_AGENT); }
__device__ __forceinline__ unsigned xb_xcc_id() { return (unsigned)__builtin_amdgcn_s_getreg((3 << 11) | 20) & 0xFu; }
#define XB_SPIN(cond, bar) do { unsigned _sp = 0; while (cond) { __builtin_amdgcn_s_sleep(1); \
    if ((++_sp & 255u) == 0u) { if (xb_ld(&(bar)[XB_TMO])) break; if (_sp > XB_SPIN_CAP) { atomicAdd(&(bar)[XB_TMO], 1u); break; } } } } while (0)

struct XcdBarrier {
    unsigned* bar; unsigned x, w;
    volatile LAS unsigned* st;
};

__device__ __forceinline__ XcdBarrier xcd_barrier_post(unsigned* bar, volatile LAS unsigned* st, unsigned wave) {
    XcdBarrier b; b.bar = bar; b.x = xb_xcc_id(); b.st = st; b.w = wave;
    if (wave == 0 && hw_lane() == 0) (void)xb_add(&bar[XB_XCNT(b.x)], 1u);
    return b;
}
__device__ __forceinline__ void xcd_barrier_complete(unsigned* bar, unsigned x, unsigned& nloc, unsigned& nx) {
    const unsigned G = gridDim.x * gridDim.y * gridDim.z;
    unsigned sum, cnt, mine, sp = 0u;
    for (;;) {
        sum = 0u; cnt = 0u; mine = 0u;
#pragma unroll
        for (unsigned j = 0; j < 16; ++j) { const unsigned c = xb_ld(&bar[XB_XCNT(j)]); sum += c; cnt += (c > 0u) ? 1u : 0u; mine = (j == x) ? c : mine; }
        if (sum == G) break;
        __builtin_amdgcn_s_sleep(1);
        if ((++sp & 255u) == 0u) { if (xb_ld(&bar[XB_TMO])) break; if (sp > XB_SPIN_CAP) { atomicAdd(&bar[XB_TMO], 1u); break; } }
    }
    nloc = mine > 0u ? mine : 1u; nx = cnt > 0u ? cnt : 1u;
}

__device__ __forceinline__ void xcd_barrier(const XcdBarrier& b) {
    asm volatile("s_waitcnt vmcnt(0)" ::: "memory");
    __syncthreads();
    if (b.w == 0 && hw_lane() == 0) {
        unsigned* bar = b.bar;
        __builtin_amdgcn_s_waitcnt(0);
        unsigned nloc = b.st[0], nx = b.st[1];
        if (nloc == 0u) { xcd_barrier_complete(bar, b.x, nloc, nx); b.st[0] = nloc; b.st[1] = nx; }
        const unsigned old = xb_add(&bar[XB_XSUB(b.x)], 1u);
        const unsigned gen = old / nloc;
        if (old + 1u == (gen + 1u) * nloc) {
            __builtin_amdgcn_fence(__ATOMIC_RELEASE, "agent");
            asm volatile("s_waitcnt vmcnt(0)" ::: "memory");
            const unsigned og = xb_add(&bar[XB_TOP], 1u);
            const unsigned tg = og / nx;
            if (og + 1u == (tg + 1u) * nx) xb_add(&bar[XB_TOPGEN], 1u);
            else XB_SPIN(xb_ld(&bar[XB_TOPGEN]) == tg, bar);
            __builtin_amdgcn_fence(__ATOMIC_ACQUIRE, "agent");
            xb_add(&bar[XB_XGEN(b.x)], 1u);
            asm volatile("s_waitcnt vmcnt(0)" ::: "memory");
        } else {
            XB_SPIN(xb_ld(&bar[XB_XGEN(b.x)]) == gen, bar);
            __builtin_amdgcn_fence(__ATOMIC_ACQUIRE, "agent");
            asm volatile("s_waitcnt vmcnt(0)" ::: "memory");
        }
    }
    __syncthreads();
}


constexpr int NB = 32, SEQ = 2048, T = NB * SEQ, D = 1024, IN_COLS = 1984, PROJ_LD = 2048;
constexpr int NE = 32, TOPK = 4, NA = T * TOPK, HALF_T = T / 2, HALF_A = NA / 2;
constexpr int ROWS_ALL = NA + NE * 256, TILES_MAX = ROWS_ALL / 256;
constexpr float NORM_EPS = 1e-5f, LOG2E = 1.4426950408889634f;
constexpr float SC_W6 = 32.f, SC_X6 = 1.f;
constexpr float SC_W = 64.f, SC_X = 4.f, SC_A = 4.f, SC_Y = 16.f;
constexpr int NWAVES = 8, NTHREADS = 512;

constexpr size_t KiB = 1024, MiB = 1u << 20;
constexpr size_t WS_CTL = 0, CTL_ZERO_BYTES = 64 * KiB;
constexpr size_t WS_KN = 34 * KiB;
constexpr size_t WS_KMAX = 32 * KiB;
constexpr size_t WS_ROPE = 1 * MiB;
constexpr size_t WS_BIAS = 1 * MiB + 512 * KiB;
constexpr size_t WS_LAM = 1 * MiB + 768 * KiB;
constexpr size_t WS_RINV = 2 * MiB;
constexpr size_t WS_EIDX = 3 * MiB, WS_GATE = 4 * MiB, WS_LRANK = 5 * MiB;
constexpr size_t WS_HIST = 6 * MiB;
constexpr size_t WS_ROWA = 7 * MiB, WS_ROWG = 9 * MiB;
constexpr size_t WS_ROWRI = 14 * MiB;
constexpr size_t WS_TINFO = 11 * MiB;
constexpr size_t WS_WRH = 12 * MiB, WS_WRL = 12 * MiB + 64 * KiB;
constexpr size_t WS_WUQ = 13 * MiB, WS_WUKV = 13 * MiB + 512 * KiB;
constexpr size_t WS_WIN = 16 * MiB, WS_WO = 20 * MiB;
constexpr size_t WS_WD8 = 24 * MiB, WS_WGU8 = 56 * MiB;
constexpr size_t WS_XB = 120 * MiB;
constexpr size_t WS_XB8 = 248 * MiB;
constexpr size_t WS_PROJ = 312 * MiB, WS_QM = 568 * MiB, WS_KV = 664 * MiB, WS_MIXED = 792 * MiB, WS_CQN = 920 * MiB, WS_CKVN = 952 * MiB, WS_KPE = 968 * MiB;
constexpr size_t WS_ACT8 = 312 * MiB, WS_Y48 = 576 * MiB;
constexpr size_t WS_KD8 = 248 * MiB;
constexpr size_t WS_KN8 = 976 * MiB, WS_KPE8 = 1008 * MiB;
constexpr size_t WS_END = 1012 * MiB;
static_assert(WS_ACT8 + (size_t)ROWS_ALL * 1024 <= WS_Y48 && WS_Y48 + (size_t)NA * 1024 <= WS_CQN && WS_ROWA + (size_t)ROWS_ALL * 4 <= WS_ROWG && WS_ROWG + (size_t)ROWS_ALL * 4 <= WS_TINFO, "ws map");

constexpr int SCRATCH_BYTES = 141312;
constexpr int MISC_OFF = SCRATCH_BYTES;
constexpr int LDS_BYTES = SCRATCH_BYTES + 1024;
static_assert(att::ATT_LDS <= SCRATCH_BYTES && pg8::STAGE_BYTES <= SCRATCH_BYTES, "LDS map");

#define GAS __attribute__((address_space(1)))
typedef unsigned short bf16;
typedef float f32x4 __attribute__((ext_vector_type(4)));
typedef float f32x2 __attribute__((ext_vector_type(2)));
typedef unsigned u32x4 __attribute__((ext_vector_type(4)));
typedef unsigned u32x2 __attribute__((ext_vector_type(2)));
typedef short bf16x8 __attribute__((ext_vector_type(8)));
typedef float f32x16 __attribute__((ext_vector_type(16)));
#define LDS_WAIT() asm volatile("s_waitcnt lgkmcnt(0)" ::: "memory")
#define VM_WAIT() asm volatile("s_waitcnt vmcnt(0)" ::: "memory")
__device__ __forceinline__ unsigned pk2(float lo, float hi) { return pg8::cvt_pk_bf16(lo, hi); }
__device__ __forceinline__ unsigned cvt8(float a, float b, float c, float d) { int w = 0; w = __builtin_amdgcn_cvt_pk_fp8_f32(a, b, w, false); w = __builtin_amdgcn_cvt_pk_fp8_f32(c, d, w, true); return (unsigned)w; }
__device__ __forceinline__ float bf2f(unsigned short v) { return __uint_as_float(((unsigned)v) << 16); }
__device__ __forceinline__ float wave_sum(float v) {
#pragma unroll
    for (int o = 1; o < 64; o <<= 1) v += __shfl_xor(v, o);
    return v;
}

struct Args {
    const float* in[22]; float* out; unsigned char* ws; int ph_lo, ph_hi;
};

template <bool F8OUT, class RowMap>
__device__ __forceinline__ void transpose_item(const float* W, int K, int N, void* WTv, LAS float* scr, int item, int lane, const float* kscale, RowMap rm, float nscale = 1.f, int nsplit = 0) {
    const int nblk = N / 32, kb = item / nblk, nb = item % nblk, k0 = 64 * kb, n0 = 32 * nb;
    float v[32];
#pragma unroll
    for (int i = 0; i < 32; ++i) v[i] = W[(size_t)(k0 + 2 * i + (lane >> 5)) * N + n0 + (lane & 31)];
    if (kscale) {
#pragma unroll
        for (int i = 0; i < 32; ++i) v[i] *= kscale[k0 + 2 * i + (lane >> 5)];
    }
    if (n0 < nsplit) {
#pragma unroll
        for (int i = 0; i < 32; ++i) v[i] *= nscale;
    }
    if constexpr (F8OUT) {
#pragma unroll
        for (int i = 0; i < 32; ++i) v[i] *= SC_W;
    }
#pragma unroll
    for (int i = 0; i < 32; ++i) scr[(2 * i + (lane >> 5)) * 33 + (lane & 31)] = v[i];
    LDS_WAIT(); asm volatile("" ::: "memory");
    const int c = lane & 7;
#pragma unroll
    for (int j = 0; j < 4; ++j) { const int n = (lane >> 3) + 8 * j; const LAS float* s = scr + (8 * c) * 33 + n;
        if constexpr (F8OUT) { u32x2 o; o.x = cvt8(s[0 * 33], s[1 * 33], s[2 * 33], s[3 * 33]); o.y = cvt8(s[4 * 33], s[5 * 33], s[6 * 33], s[7 * 33]);
            *(u32x2*)((unsigned char*)WTv + (size_t)rm(n0 + n) * K + k0 + 8 * c) = o; }
        else { u32x4 o; o.x = pk2(s[0 * 33], s[1 * 33]); o.y = pk2(s[2 * 33], s[3 * 33]); o.z = pk2(s[4 * 33], s[5 * 33]); o.w = pk2(s[6 * 33], s[7 * 33]);
            *(u32x4*)((bf16*)WTv + (size_t)rm(n0 + n) * K + k0 + 8 * c) = o; } }
    LDS_WAIT(); asm volatile("" ::: "memory");
}
template <class RowMap>
__device__ __forceinline__ void transpose_item8(const float* W, int K, int N, unsigned char* WT, LAS float* scr, int item, int lane, const float* kscale, RowMap rm) {
    const int nblk = N / 64, kb = item / nblk, nb = item % nblk, k0 = 64 * kb, n0 = 64 * nb;
    const int lr = lane >> 4, lc = (lane & 15) * 4;
    f32x4 v[16];
#pragma unroll
    for (int i = 0; i < 16; ++i) v[i] = *(const f32x4*)(W + (size_t)(k0 + 4 * i + lr) * N + n0 + lc);
#pragma unroll
    for (int i = 0; i < 16; ++i) { const float sc = (kscale ? kscale[k0 + 4 * i + lr] : 1.f) * SC_W; LAS float* d = scr + (4 * i + lr) * 65 + lc;
        d[0] = v[i].x * sc; d[1] = v[i].y * sc; d[2] = v[i].z * sc; d[3] = v[i].w * sc; }
    LDS_WAIT(); asm volatile("" ::: "memory");
    const int c = lane & 3;
#pragma unroll
    for (int j = 0; j < 4; ++j) { const int n = (lane >> 2) + 16 * j; const LAS float* s = scr + (16 * c) * 65 + n;
        u32x4 o; o.x = cvt8(s[0 * 65], s[1 * 65], s[2 * 65], s[3 * 65]); o.y = cvt8(s[4 * 65], s[5 * 65], s[6 * 65], s[7 * 65]);
        o.z = cvt8(s[8 * 65], s[9 * 65], s[10 * 65], s[11 * 65]); o.w = cvt8(s[12 * 65], s[13 * 65], s[14 * 65], s[15 * 65]);
        *(u32x4*)(WT + (size_t)rm(n0 + n) * K + k0 + 16 * c) = o; }
    LDS_WAIT(); asm volatile("" ::: "memory");
}
struct RmId { __device__ __forceinline__ int operator()(int n) const { return n; } };
typedef float v16f __attribute__((ext_vector_type(16)));
typedef int v6i __attribute__((ext_vector_type(6)));
__device__ __forceinline__ v6i cvt_fp6x32(v16f a, v16f b) { v6i r; asm volatile("v_cvt_scalef32_2xpk16_fp6_f32 %0, %1, %2, 1.0\n\ts_nop 7\n\ts_nop 7" : "=&v"(r) : "v"(a), "v"(b)); return r; }
__device__ __forceinline__ void store_fp6_block(unsigned char* blk, v6i pk, bool odd) {
    asm volatile("s_nop 7\n\ts_nop 7" : "+v"(pk));
    u32x4 a, b;
    if (!odd) { a = (u32x4){(unsigned)pk[0], (unsigned)pk[1], (unsigned)pk[2], (unsigned)pk[3]}; b = (u32x4){(unsigned)pk[4], (unsigned)pk[5], 0u, 0u}; }
    else      { a = (u32x4){(unsigned)pk[4], (unsigned)pk[5], 0u, 0u}; b = (u32x4){(unsigned)pk[0], (unsigned)pk[1], (unsigned)pk[2], (unsigned)pk[3]}; }
    *(u32x4*)blk = a; *(u32x4*)(blk + 16) = b;
}
template <class RowMap>
__device__ __forceinline__ void transpose_item6(const float* W, int K, int N, unsigned char* WT, LAS float* scr, int item, int lane, const float* kscale, RowMap rm) {
    const int nblk = N / 64, kb = item / nblk, nb = item % nblk, k0 = 64 * kb, n0 = 64 * nb;
    const int lr = lane >> 4, lc = (lane & 15) * 4;
    f32x4 v[16];
#pragma unroll
    for (int i = 0; i < 16; ++i) v[i] = *(const f32x4*)(W + (size_t)(k0 + 4 * i + lr) * N + n0 + lc);
#pragma unroll
    for (int i = 0; i < 16; ++i) { const float sc = (kscale ? kscale[k0 + 4 * i + lr] : 1.f) * SC_W6; LAS float* d = scr + (4 * i + lr) * 65 + lc;
        d[0] = v[i].x * sc; d[1] = v[i].y * sc; d[2] = v[i].z * sc; d[3] = v[i].w * sc; }
    LDS_WAIT(); asm volatile("" ::: "memory");
    const int c = lane & 1;
#pragma unroll
    for (int j = 0; j < 2; ++j) { const int n = (lane >> 1) + 32 * j; const LAS float* s = scr + (32 * c) * 65 + n;
        v16f a, b;
#pragma unroll
        for (int e = 0; e < 16; ++e) { a[e] = s[e * 65]; b[e] = s[(16 + e) * 65]; }
        const v6i pk = cvt_fp6x32(a, b);
        const int blk = (k0 >> 5) + c;
        store_fp6_block(WT + (size_t)rm(n0 + n) * K + blk * 32, pk, (blk & 1) != 0); }
    LDS_WAIT(); asm volatile("" ::: "memory");
}
struct RmGu { __device__ __forceinline__ int operator()(int n) const { const int up = n >> 10, j = n & 1023; return 256 * (j >> 7) + 128 * up + (j & 127); } };

__device__ __forceinline__ void rms_row_to_bf16(const float* xrow, const float* g, bf16* orow, int lane) {
    const f32x4* xr = (const f32x4*)xrow + lane; const f32x4* gr = (const f32x4*)g + lane;
    f32x4 v[4]; float s = 0.f;
#pragma unroll
    for (int j = 0; j < 4; ++j) { v[j] = xr[64 * j]; s += (v[j].x * v[j].x + v[j].y * v[j].y) + (v[j].z * v[j].z + v[j].w * v[j].w); }
    const float r = 1.f / sqrtf(wave_sum(s) * (1.f / D) + NORM_EPS);
    u32x2* o8 = (u32x2*)orow + lane;
#pragma unroll
    for (int j = 0; j < 4; ++j) { const f32x4 gg = gr[64 * j]; u32x2 w; w.x = pk2(v[j].x * r * gg.x, v[j].y * r * gg.y); w.y = pk2(v[j].z * r * gg.z, v[j].w * r * gg.w); o8[64 * j] = w; }
}
__device__ __forceinline__ int t5_bucket(int rel) {
    const int n = rel < 0 ? -rel : rel; int b;
    if (n < 8) b = n; else { const int n2 = n * n; b = n2 >= 8192 ? 15 : n2 >= 4096 ? 14 : n2 >= 2048 ? 13 : n2 >= 1024 ? 12 : n2 >= 512 ? 11 : n2 >= 256 ? 10 : n2 >= 128 ? 9 : 8; }
    return (rel > 0 ? 16 : 0) + b;
}
__device__ __forceinline__ void p0_prologue(const Args& a, LAS unsigned char* lds, int vcu, int G, int wave, int lane) {
    unsigned char* ws = a.ws;
    LAS float* scr = (LAS float*)(lds + wave * 16896);
    const int gw = vcu * NWAVES + wave, NGW = G * NWAVES;
    const float* ffn_g = a.in[14];
    constexpr int I_IN = 16 * 62, I_UQ = 4 * 24, I_UKV = 2 * 32, I_O = 16 * 32, I_GU1 = 16 * 32, I_GU = NE * I_GU1, I_D1 = 16 * 16, I_D = NE * I_D1;
    constexpr int NITEMS = I_IN + I_UQ + I_UKV + I_O + I_GU + I_D;
    for (int it = gw; it < NITEMS; it += NGW) {
        int r = it;
        if (r < I_GU) { const int e = r / I_GU1; transpose_item6(a.in[17] + (size_t)e * 1024 * 2048, 1024, 2048, ws + WS_WGU8 + (size_t)e * 2048 * 1024, scr, r % I_GU1, lane, ffn_g, RmGu{}); continue; } r -= I_GU;
        if (r < I_D) { const int e = r / I_D1; transpose_item8(a.in[19] + (size_t)e * 1024 * 1024, 1024, 1024, ws + WS_WD8 + (size_t)e * 1024 * 1024, scr, r % I_D1, lane, nullptr, RmId{}); continue; } r -= I_D;
        if (r < I_IN) { transpose_item<false>(a.in[3], 1024, IN_COLS, (bf16*)(ws + WS_WIN), scr, r, lane, nullptr, RmId{}, 0.125f * LOG2E, 512); continue; } r -= I_IN;
        if (r < I_O) { transpose_item<false>(a.in[13], 1024, 1024, (bf16*)(ws + WS_WO), scr, r, lane, nullptr, RmId{}); continue; } r -= I_O;
        if (r < I_UQ) { transpose_item<false>(a.in[10], 256, 768, (bf16*)(ws + WS_WUQ), scr, r, lane, nullptr, RmId{}, 0.07216878364870322f * LOG2E, 768); continue; } r -= I_UQ;
        transpose_item<false>(a.in[12], 128, 1024, (bf16*)(ws + WS_WUKV), scr, r, lane, nullptr, RmId{});
    }
    const int gt = gw * 64 + lane, NGT = NGW * 64;
    for (int i = gt; i < 64 * 1024 / 8; i += NGT) *((u32x4*)((bf16*)(ws + WS_WIN) + (size_t)IN_COLS * 1024) + i) = (u32x4){0u, 0u, 0u, 0u};
    for (int i = gt; i < 1024 * NE; i += NGT) { const int k = i >> 5, e = i & 31; const float w = a.in[15][i] * ffn_g[k];
        const unsigned h = pk2(w, 0.f) & 0xffffu; const float wl = w - bf2f((unsigned short)h);
        ((bf16*)(ws + WS_WRH))[e * 1024 + k] = (bf16)h; ((bf16*)(ws + WS_WRL))[e * 1024 + k] = (bf16)(pk2(wl, 0.f) & 0xffffu); }
    for (int i = gt; i < SEQ * 32; i += NGT) { const int pos = i >> 5, fi = i & 31;
        const float inv = (float)::exp2(-(double)fi * (13.287712379549449 / 32.0)); const float ang = (float)pos * inv;
        double tt = (double)ang * 0.15915494309189535; tt -= __builtin_rint(tt); const double rr = tt * 6.283185307179586, r2 = rr * rr;
        double cs_ = 1.0, sn = rr, term_c = 1.0, term_s = rr;
#pragma unroll
        for (int k = 1; k <= 13; ++k) { term_c *= -r2 / (double)((2 * k - 1) * (2 * k)); term_s *= -r2 / (double)((2 * k) * (2 * k + 1)); cs_ += term_c; sn += term_s; }
        ((f32x2*)(ws + WS_ROPE))[i] = (f32x2){(float)cs_, (float)sn}; }
    for (int i = gt; i < 8 * 4096; i += NGT) { const int m = i >> 12, d = i & 4095; float v; if (d < 4095) v = a.in[1][t5_bucket(d - 2047) * 8 + m] * LOG2E; else { v = -3.0e38f; for (int b = 0; b < 32; ++b) v = fmaxf(v, a.in[1][b * 8 + m] * LOG2E); }
        ((float*)(ws + WS_BIAS))[i] = v; }
    if (gw == 0) { const float s1 = wave_sum(a.in[4][lane] * a.in[5][lane]), s2 = wave_sum(a.in[6][lane] * a.in[7][lane]);
        if (lane == 0) *(float*)(ws + WS_LAM) = __expf(s1) - __expf(s2) + 0.2f; }
    for (int m = gw; m < T; m += 2 * NGW) {
        const int m2 = m + NGW < T ? m + NGW : m;
        const f32x4* xr0 = (const f32x4*)(a.in[0] + (size_t)m * D) + lane; const f32x4* xr1 = (const f32x4*)(a.in[0] + (size_t)m2 * D) + lane; const f32x4* gr = (const f32x4*)a.in[2] + lane;
        f32x4 v0[4], v1[4]; float s0 = 0.f, s1 = 0.f;
#pragma unroll
        for (int j = 0; j < 4; ++j) { v0[j] = xr0[64 * j]; v1[j] = xr1[64 * j]; }
#pragma unroll
        for (int j = 0; j < 4; ++j) { s0 += (v0[j].x * v0[j].x + v0[j].y * v0[j].y) + (v0[j].z * v0[j].z + v0[j].w * v0[j].w); s1 += (v1[j].x * v1[j].x + v1[j].y * v1[j].y) + (v1[j].z * v1[j].z + v1[j].w * v1[j].w); }
        const float r0 = 1.f / sqrtf(wave_sum(s0) * (1.f / D) + NORM_EPS), r1 = 1.f / sqrtf(wave_sum(s1) * (1.f / D) + NORM_EPS);
        u32x2* o0 = (u32x2*)((bf16*)(ws + WS_XB) + (size_t)m * D) + lane; u32x2* o1 = (u32x2*)((bf16*)(ws + WS_XB) + (size_t)m2 * D) + lane;
#pragma unroll
        for (int j = 0; j < 4; ++j) { const f32x4 gg = gr[64 * j]; u32x2 w;
            w.x = pk2(v0[j].x * r0 * gg.x, v0[j].y * r0 * gg.y); w.y = pk2(v0[j].z * r0 * gg.z, v0[j].w * r0 * gg.w); o0[64 * j] = w;
            w.x = pk2(v1[j].x * r1 * gg.x, v1[j].y * r1 * gg.y); w.y = pk2(v1[j].z * r1 * gg.z, v1[j].w * r1 * gg.w); o1[64 * j] = w; }
    }
}

__device__ __forceinline__ void p1b_latent(const Args& a, int vcu, int G, int wave, int lane) {
    unsigned char* ws = a.ws; const int gw = vcu * NWAVES + wave, NGW = G * NWAVES;
    const float* gq = a.in[9]; const float* gkv = a.in[11];
    float gl[8];
#pragma unroll
    for (int j = 0; j < 8; ++j) gl[j] = lane < 32 ? gq[8 * lane + j] : (lane < 48 ? gkv[8 * (lane - 32) + j] : 1.f);
    constexpr int R = 8;
    const int aa = lane - 48; const bool rope_lane = lane >= 48 && lane < 56;
    float k2max = 0.f;
    float kpe2 = 0.f;
    const int rows_per_wave = T / NGW;
    for (int t0 = gw * rows_per_wave; t0 < (gw + 1) * rows_per_wave; t0 += R) {
        bf16x8 v[R], kk[R]; f32x4 cr[R][4];
#pragma unroll
        for (int q = 0; q < R; ++q) { const int t = t0 + q; v[q] = (bf16x8){0, 0, 0, 0, 0, 0, 0, 0};
#pragma unroll
            for (int j = 0; j < 4; ++j) cr[q][j] = (f32x4){0.f, 0.f, 0.f, 0.f};
            kk[q] = *(const bf16x8*)((const bf16*)(ws + WS_PROJ) + (size_t)t * PROJ_LD + 512 + 8 * lane);
            if (lane < 56) v[q] = *(const bf16x8*)((const bf16*)(ws + WS_PROJ) + (size_t)t * PROJ_LD + 1536 + 8 * lane);
            if (rope_lane) { const f32x4* cp = (const f32x4*)((const f32x2*)(ws + WS_ROPE) + (size_t)(t & (SEQ - 1)) * 32 + 8 * (aa & 3));
#pragma unroll
                for (int j = 0; j < 4; ++j) cr[q][j] = cp[j]; } }
#pragma unroll
        for (int q = 0; q < R; ++q) { float s = 0.f; float fk[8];
#pragma unroll
            for (int j = 0; j < 8; ++j) { const float f = bf2f((unsigned short)kk[q][j]); s = fmaf(f, f, s); fk[j] = f; }
            { u32x2 w8; w8.x = cvt8(fk[0], fk[1], fk[2], fk[3]); w8.y = cvt8(fk[4], fk[5], fk[6], fk[7]); *(u32x2*)(ws + WS_KD8 + (size_t)(t0 + q) * 512 + 8 * lane) = w8; }
            s += __shfl_xor(s, 1); s += __shfl_xor(s, 2); s += __shfl_xor(s, 4); k2max = fmaxf(k2max, s); }
#pragma unroll
        for (int q = 0; q < R; ++q) { const int t = t0 + q;
            float f[8], sq = 0.f;
#pragma unroll
            for (int j = 0; j < 8; ++j) { f[j] = bf2f((unsigned short)v[q][j]); sq += f[j] * f[j]; }
            { float s = sq; s += __shfl_xor(s, 1); s += __shfl_xor(s, 2); s += __shfl_xor(s, 4); kpe2 = fmaxf(kpe2, s); }
            const float sq_q = wave_sum(lane < 32 ? sq : 0.f), sq_kv = wave_sum((lane >= 32 && lane < 48) ? sq : 0.f);
            const float rq = 1.f / sqrtf(sq_q * (1.f / 256.f) + NORM_EPS), rkv = 1.f / sqrtf(sq_kv * (1.f / 128.f) + NORM_EPS);
            float part[8];
#pragma unroll
            for (int j = 0; j < 8; ++j) part[j] = __shfl_xor(f[j], 4);
            float o[8];
            if (lane < 48) { const float rr = lane < 32 ? rq : rkv;
#pragma unroll
                for (int j = 0; j < 8; ++j) o[j] = f[j] * rr * gl[j];
            } else {
#pragma unroll
                for (int j = 0; j < 8; ++j) { const float cc = cr[q][j >> 1][2 * (j & 1)], sn = cr[q][j >> 1][2 * (j & 1) + 1];
                    o[j] = (aa < 4) ? (f[j] * cc - part[j] * sn) : (part[j] * sn + f[j] * cc); }
            }
            u32x4 w; w.x = pk2(o[0], o[1]); w.y = pk2(o[2], o[3]); w.z = pk2(o[4], o[5]); w.w = pk2(o[6], o[7]);
            if (lane < 32) *(u32x4*)((bf16*)(ws + WS_CQN) + (size_t)t * 256 + 8 * lane) = w;
            else if (lane < 48) *(u32x4*)((bf16*)(ws + WS_CKVN) + (size_t)t * 128 + 8 * (lane - 32)) = w;
            else if (lane < 56) { u32x2 w8; w8.x = cvt8(o[0], o[1], o[2], o[3]); w8.y = cvt8(o[4], o[5], o[6], o[7]); *(u32x2*)(ws + WS_KPE8 + (size_t)t * 64 + 8 * (lane - 48)) = w8; }
        }
    }
    { asm volatile("s_waitcnt vmcnt(0)" ::: "memory");
      unsigned char* pb = ws + WS_KPE8 + (size_t)(gw * rows_per_wave) * 64 + lane * 32;
      const u32x4 lo = *(const u32x4*)pb, hi = *(const u32x4*)(pb + 16); v16f fa, fb;
#pragma unroll
      for (int w = 0; w < 4; ++w) { const auto a0 = __builtin_amdgcn_cvt_pk_f32_fp8((int)lo[w], false), a1 = __builtin_amdgcn_cvt_pk_f32_fp8((int)lo[w], true);
        const auto b0 = __builtin_amdgcn_cvt_pk_f32_fp8((int)hi[w], false), b1 = __builtin_amdgcn_cvt_pk_f32_fp8((int)hi[w], true);
        fa[4 * w] = a0[0]; fa[4 * w + 1] = a0[1]; fa[4 * w + 2] = a1[0]; fa[4 * w + 3] = a1[1]; fb[4 * w] = b0[0]; fb[4 * w + 1] = b0[1]; fb[4 * w + 2] = b1[0]; fb[4 * w + 3] = b1[1]; }
      store_fp6_block(pb, cvt_fp6x32(fa, fb), false); }
    if (lane == 48) atomicMax((unsigned*)(ws + WS_KN) + ((gw * rows_per_wave) >> 11) * 32 + 16, __float_as_uint(kpe2));
    if ((lane & 7) == 0) atomicMax((unsigned*)(ws + WS_KMAX) + ((gw * rows_per_wave) >> 11) * 8 + (lane >> 3), __float_as_uint(k2max));
}

template <int WHICH  >
__device__ __forceinline__ void p2_attention(const Args& a, LAS unsigned char* lds, int vcu, int G, int wave) {
    unsigned char* ws = a.ws;
    const int tid = threadIdx.x, wid = tid >> 6, lane = tid & 63, r32 = lane & 31, hi = lane >> 5;
    const bf16* proj = (const bf16*)(ws + WS_PROJ); bf16* mixed = (bf16*)(ws + WS_MIXED);
    const float lam = *(const float*)(ws + WS_LAM);
    if constexpr (WHICH & 1) {
        const float C = 1.f;
        const float* gsub = a.in[8];
        LAS unsigned* stash = (LAS unsigned*)(lds + att::OFF_STASH) + (wid * 32) * 64 + lane;
        for (int it = 0;; ++it) {
            const int u = (it >> 1) * G + vcu, j = it & 1; if (u >= NB * 4 * 8) break;
            const int qb = u & 7, h = (u >> 3) & 3, b = u >> 5, q0 = qb * 256, mp = 2 * h + j;
            { const float* src = (const float*)(ws + WS_BIAS) + mp * 4096; LAS float* lut = (LAS float*)(lds + att::OFF_LUT);
#pragma unroll
              for (int i = 0; i < 8; ++i) lut[tid + 512 * i] = src[tid + 512 * i]; }
            const bf16* base = proj + (size_t)b * SEQ * PROJ_LD;
            f32x16 o[4];
            if (j == 0) att::attn_unit<1, false>(base + (size_t)q0 * PROJ_LD + 64 * mp, PROJ_LD, base + 512 + 64 * mp, PROJ_LD, nullptr, base + 1024 + 128 * h, PROJ_LD, SEQ,
                                 (LAS char*)lds, C, nullptr, q0, o, wave, lane, __uint_as_float(((const unsigned*)(ws + WS_KMAX))[b * 8 + mp]));
            else att::attn_unit<1, true>(base + (size_t)q0 * PROJ_LD + 64 * mp, PROJ_LD, (const bf16*)(ws + WS_KD8 + (size_t)b * SEQ * 512 + 64 * mp), 512, nullptr, base + 1024 + 128 * h, PROJ_LD, SEQ,
                                 (LAS char*)lds, C, nullptr, q0, o, wave, lane, __uint_as_float(((const unsigned*)(ws + WS_KMAX))[b * 8 + mp]));
            if (j == 0) {
#pragma unroll
                for (int d0 = 0; d0 < 4; ++d0)
#pragma unroll
                    for (int r = 0; r < 16; r += 2) stash[(d0 * 8 + (r >> 1)) * 64] = pk2(o[d0][r], o[d0][r + 1]);
            } else {
                bf16* orow = mixed + (size_t)(b * SEQ + q0 + wid * 32 + r32) * D + 128 * h + 8 * hi;
                float ss = 0.f;
#pragma unroll
                for (int d0 = 0; d0 < 4; ++d0)
#pragma unroll
                    for (int rp = 0; rp < 8; ++rp) { const unsigned w = stash[(d0 * 8 + rp) * 64];
                        const float v0 = bf2f((unsigned short)(w & 0xffffu)) - lam * o[d0][2 * rp], v1 = bf2f((unsigned short)(w >> 16)) - lam * o[d0][2 * rp + 1];
                        o[d0][2 * rp] = v0; o[d0][2 * rp + 1] = v1; ss = fmaf(v0, v0, fmaf(v1, v1, ss)); }
                { auto rr = __builtin_amdgcn_permlane32_swap(__float_as_uint(ss), __float_as_uint(ss), false, false); ss = __uint_as_float(rr[0]) + __uint_as_float(rr[1]); }
                const float rn = 0.8f / sqrtf(ss * (1.f / 128.f) + NORM_EPS);
#pragma unroll
                for (int d0 = 0; d0 < 4; ++d0)
#pragma unroll
                    for (int gp = 0; gp < 2; ++gp) {
                        const f32x4 gA = *(const f32x4*)(gsub + 32 * d0 + 16 * gp + 4 * hi), gB = *(const f32x4*)(gsub + 32 * d0 + 16 * gp + 8 + 4 * hi);
                        const int r0 = 8 * gp;
                        unsigned ax = pk2(o[d0][r0] * rn * gA.x, o[d0][r0 + 1] * rn * gA.y), ay = pk2(o[d0][r0 + 2] * rn * gA.z, o[d0][r0 + 3] * rn * gA.w);
                        unsigned bx = pk2(o[d0][r0 + 4] * rn * gB.x, o[d0][r0 + 5] * rn * gB.y), by = pk2(o[d0][r0 + 6] * rn * gB.z, o[d0][r0 + 7] * rn * gB.w);
                        { auto rr = __builtin_amdgcn_permlane32_swap(ax, bx, false, false); ax = rr[0]; bx = rr[1]; }
                        { auto rr = __builtin_amdgcn_permlane32_swap(ay, by, false, false); ay = rr[0]; by = rr[1]; }
                        u32x4 w4; w4.x = ax; w4.y = ay; w4.z = bx; w4.w = by;
                        *(u32x4*)(orow + 32 * d0 + 16 * gp) = w4; }
            }
        }
    }
    if constexpr (WHICH & 2) {
        const float C = 1.f;
        for (int it = 0;; ++it) {
            const int u = it * G + vcu; if (u >= NB * 4 * 8) break;
            const int qb = u & 7, h = (u >> 3) & 3, b = u >> 5, q0 = qb * 256;
            const bf16* qm = (const bf16*)(ws + WS_QM) + (size_t)(b * SEQ + q0) * 768 + 192 * h;
            const bf16* kv = (const bf16*)(ws + WS_KV) + (size_t)b * SEQ * 1024 + 256 * h;
            const bf16* kpe = (const bf16*)(ws + WS_KPE8 + (size_t)b * SEQ * 64);
            const bf16* kn8 = (const bf16*)(ws + WS_KN8 + (size_t)b * SEQ * 512 + 128 * h);
            f32x16 o[4];
            const unsigned* kn = (const unsigned*)(ws + WS_KN) + b * 32;
            const float k2 = __uint_as_float(kn[4 * h]) + __uint_as_float(kn[4 * h + 1]) + __uint_as_float(kn[4 * h + 2]) + __uint_as_float(kn[4 * h + 3]) + __uint_as_float(kn[16]);
            att::attn_unit<0>(qm, 768, kn8, 512, kpe, kv + 128, 1024, SEQ, (LAS char*)lds, C, (const att::f32x2*)(ws + WS_ROPE), q0, o, wave, lane, k2);
            bf16* orow = mixed + (size_t)(b * SEQ + q0 + wid * 32 + r32) * D + 512 + 128 * h + 8 * hi;
#pragma unroll
            for (int d0 = 0; d0 < 4; ++d0)
#pragma unroll
                for (int gp = 0; gp < 2; ++gp) { const int r0 = 8 * gp;
                    unsigned ax = pk2(o[d0][r0], o[d0][r0 + 1]), ay = pk2(o[d0][r0 + 2], o[d0][r0 + 3]), bx = pk2(o[d0][r0 + 4], o[d0][r0 + 5]), by = pk2(o[d0][r0 + 6], o[d0][r0 + 7]);
                    { auto rr = __builtin_amdgcn_permlane32_swap(ax, bx, false, false); ax = rr[0]; bx = rr[1]; }
                    { auto rr = __builtin_amdgcn_permlane32_swap(ay, by, false, false); ay = rr[0]; by = rr[1]; }
                    u32x4 w4; w4.x = ax; w4.y = ay; w4.z = bx; w4.w = by;
                    *(u32x4*)(orow + 32 * d0 + 16 * gp) = w4; }
        }
    }
}

constexpr int WR_PITCH = 2064;
__device__ __forceinline__ void p3b_router(const Args& a, LAS unsigned char* lds, int G, int wave) {
    unsigned char* ws = a.ws;
    const int wid = wave, lane = hw_lane(), tid = wid * 64 + lane, r32 = lane & 31, hi = lane >> 5;
    LAS unsigned char* wrh = lds; LAS unsigned char* wrl = lds + 32 * WR_PITCH; LAS unsigned* cnt = (LAS unsigned*)(lds + 64 * WR_PITCH);
    for (int i = tid; i < 2 * 32 * 128; i += NTHREADS) { const int tb = i >> 12, e = (i >> 7) & 31, c = i & 127;
        *(LAS u32x4*)(lds + (tb * 32 + e) * WR_PITCH + c * 16) = *((const u32x4*)(ws + (tb ? WS_WRL : WS_WRH)) + e * 128 + c); }
    const bf16* x1 = (const bf16*)(ws + WS_XB); unsigned char* xb = ws + WS_XB8;
    for (int c = blockIdx.x; c < T / 256; c += G) {
        if (tid < 32) cnt[tid] = 0u;
        __syncthreads();
        const int t = c * 256 + wid * 32 + r32;
        const bf16* xr = x1 + (size_t)t * D + 64 * hi; unsigned char* xo = xb + (size_t)t * D + 64 * hi;
        f32x16 acc = f32x16{}; float ss = 0.f;
#pragma unroll 2
        for (int sg = 0; sg < 8; ++sg) {
            u32x4 v[8];
#pragma unroll
            for (int q = 0; q < 8; ++q) v[q] = *(const u32x4*)(xr + 128 * sg + 8 * q);
            v16f xa0, xb0, xa1, xb1;
#pragma unroll
            for (int j = 0; j < 8; ++j) {
                const u32x4 hw = v[j];
                const float f0 = __uint_as_float(hw.x << 16), f1 = __uint_as_float(hw.x & 0xffff0000u), f2 = __uint_as_float(hw.y << 16), f3 = __uint_as_float(hw.y & 0xffff0000u);
                const float f4 = __uint_as_float(hw.z << 16), f5 = __uint_as_float(hw.z & 0xffff0000u), f6 = __uint_as_float(hw.w << 16), f7 = __uint_as_float(hw.w & 0xffff0000u);
                ss += (f0 * f0 + f1 * f1) + (f2 * f2 + f3 * f3) + (f4 * f4 + f5 * f5) + (f6 * f6 + f7 * f7);
                { v16f& dst_ = (j < 2) ? xa0 : (j < 4) ? xb0 : (j < 6) ? xa1 : xb1; const int o_ = 8 * (j & 1);
                  dst_[o_] = f0 * SC_X6; dst_[o_ + 1] = f1 * SC_X6; dst_[o_ + 2] = f2 * SC_X6; dst_[o_ + 3] = f3 * SC_X6; dst_[o_ + 4] = f4 * SC_X6; dst_[o_ + 5] = f5 * SC_X6; dst_[o_ + 6] = f6 * SC_X6; dst_[o_ + 7] = f7 * SC_X6; }
                const int kb = (128 * sg + 64 * hi + 8 * j) * 2;
                const bf16x8 wh = *(const LAS bf16x8*)(wrh + r32 * WR_PITCH + kb), wl = *(const LAS bf16x8*)(wrl + r32 * WR_PITCH + kb);
                const bf16x8 xh = __builtin_bit_cast(bf16x8, hw);
                acc = __builtin_amdgcn_mfma_f32_32x32x16_bf16(wh, xh, acc, 0, 0, 0);
                acc = __builtin_amdgcn_mfma_f32_32x32x16_bf16(wl, xh, acc, 0, 0, 0);
            }
            { const v6i p0_ = cvt_fp6x32(xa0, xb0), p1_ = cvt_fp6x32(xa1, xb1);
              unsigned char* blk_ = xb + (size_t)t * D + (size_t)(4 * sg + 2 * hi) * 32;
              store_fp6_block(blk_, p0_, false); store_fp6_block(blk_ + 32, p1_, true); }
        }
        ss += __shfl_xor(ss, 32);
        const float rinv = 1.f / sqrtf(ss * (1.f / D) + NORM_EPS);
        if (hi == 0) ((float*)(ws + WS_RINV))[t] = rinv;
        float lg[16];
#pragma unroll
        for (int r = 0; r < 16; ++r) lg[r] = acc[r] * rinv + a.in[16][att::crow(r, hi)];
        float tv[4]; int ti[4];
#pragma unroll
        for (int k = 0; k < 4; ++k) {
            float bv = lg[0]; int bi = att::crow(0, hi);
#pragma unroll
            for (int r = 1; r < 16; ++r) { const int e = att::crow(r, hi); if (lg[r] > bv) { bv = lg[r]; bi = e; } }
            const float ov = __shfl_xor(bv, 32); const int oi = __shfl_xor(bi, 32);
            const bool mine = (bv > ov) || (bv == ov && bi < oi);
            tv[k] = mine ? bv : ov; ti[k] = mine ? bi : oi;
#pragma unroll
            for (int r = 0; r < 16; ++r) if (att::crow(r, hi) == ti[k]) lg[r] = -3.0e38f;
        }
        const float e1 = __expf(tv[1] - tv[0]), e2 = __expf(tv[2] - tv[0]), e3 = __expf(tv[3] - tv[0]), rs = 1.f / (1.f + e1 + e2 + e3);
        if (hi == 0) {
            int lr[4];
#pragma unroll
            for (int k = 0; k < 4; ++k) lr[k] = (int)__hip_atomic_fetch_add(cnt + ti[k], 1u, __ATOMIC_RELAXED, __HIP_MEMORY_SCOPE_WORKGROUP);
            *((int4*)(ws + WS_EIDX) + t) = make_int4(ti[0], ti[1], ti[2], ti[3]);
            *((f32x4*)(ws + WS_GATE) + t) = (f32x4){rs, e1 * rs, e2 * rs, e3 * rs};
            *((int4*)(ws + WS_LRANK) + t) = make_int4(lr[0], lr[1], lr[2], lr[3]);
        }
        __syncthreads();
        if (tid < 32) ((int*)(ws + WS_HIST))[c * 32 + tid] = (int)cnt[tid];
        __syncthreads();
    }
}

__device__ __forceinline__ void p4_scatter(const Args& a, LAS unsigned char* lds, int G, int wave) {
    unsigned char* ws = a.ws; const int tid = wave * 64 + hw_lane();
    LAS int* hist = (LAS int*)lds;
    LAS int* cntE = hist + 256 * 32;
    LAS int* pst = cntE + 32;
    for (int i = tid; i < 256 * 32; i += NTHREADS) hist[i] = ((const int*)(ws + WS_HIST))[i];
    __syncthreads();
    LAS int* segs = pst + 32;
    { const int e = tid & 31, sg = tid >> 5; int sum = 0;
        for (int c = 16 * sg; c < 16 * sg + 16; ++c) sum += hist[c * 32 + e];
        segs[sg * 32 + e] = sum; }
    __syncthreads();
    if (tid < 32) { int run = 0;
        for (int sg = 0; sg < 16; ++sg) { const int v = segs[sg * 32 + tid]; segs[sg * 32 + tid] = run; run += v; }
        cntE[tid] = run; }
    __syncthreads();
    { const int e = tid & 31, sg = tid >> 5; int run = segs[sg * 32 + e];
        for (int c = 16 * sg; c < 16 * sg + 16; ++c) { const int v = hist[c * 32 + e]; hist[c * 32 + e] = run; run += v; } }
    __syncthreads();
    if (tid < 32) { int s = 0;
        for (int q = 0; q < tid; ++q) s += (cntE[q] + 255) & ~255;
        pst[tid] = s; }
    __syncthreads();
    int* rowa = (int*)(ws + WS_ROWA); float* rowg = (float*)(ws + WS_ROWG); float* rowri = (float*)(ws + WS_ROWRI);
    for (int c = blockIdx.x; c < T / 256; c += G) {
        for (int i = tid; i < 1024; i += NTHREADS) { const int asg = c * 1024 + i; const int e = ((const int*)(ws + WS_EIDX))[asg];
            const int p = pst[e] + hist[c * 32 + e] + ((const int*)(ws + WS_LRANK))[asg];
            rowa[p] = asg; rowg[p] = ((const float*)(ws + WS_GATE))[asg]; rowri[p] = ((const float*)(ws + WS_RINV))[asg >> 2] * (1.f / (SC_W6 * SC_X6)); } }
    if (blockIdx.x == 0 && tid < 32) { const int e = tid; const int n = cntE[e], st = pst[e], pad = (n + 255) & ~255;
        for (int p = st + n; p < st + pad; ++p) { rowa[p] = -1; rowg[p] = 0.f; rowri[p] = 0.f; }
        int* tinfo = (int*)(ws + WS_TINFO);
        for (int tt = st >> 8; tt < (st + pad) >> 8; ++tt) tinfo[tt] = e;
        if (e == 31) tinfo[2048] = (st + pad) >> 8; }
}

struct MoeOrder {
    const int* tinfo; const int* rowa; int ntiles, nN, lgN, G, c;
    __device__ __forceinline__ bool next(int i, pg8::Unit& u) const {
        const int L = i * G + c; if (L >= ntiles * nN) return false;
        const int tile = L >> lgN, pn = L & (nN - 1); const int e = tinfo[tile]; u.pm = tile; u.pn = e * nN + pn; return true;
    }
    __device__ __forceinline__ int gather_row(const pg8::Unit& u, int i) const { const int as = rowa[u.pm * 256 + i]; return as < 0 ? 0 : (as >> 2); }
};
struct EpiSwiglu {
    static constexpr bool PERM = true;
    unsigned char* act; const float* rowri; const float* bgu;
    struct Pre { float ri[8]; };
    __device__ __forceinline__ void prefetch(const pg8::Unit& u, int par, LAS unsigned char* sp, int wid, int lane, int wr, int wc, int fr, int fq, Pre& pre) const {
#pragma unroll
        for (int ai = 0; ai < 2; ++ai)
#pragma unroll
            for (int m = 0; m < 4; ++m) pre.ri[ai * 4 + m] = rowri[u.pm * 256 + ai * 128 + wr * 64 + m * 16 + fr];
        if (wid == 0) { const int e = u.pn >> 3, pn = u.pn & 7;
            PG8_DMA16((unsigned)(uintptr_t)sp + (unsigned)par * 3072u + 2048u, (const char*)(bgu + (size_t)e * 2048 + 128 * pn), (unsigned)(lane < 32 ? lane * 16 : 4096 + (lane - 32) * 16)); }
    }
    __device__ __forceinline__ void operator()(const pg8::f32x4 (&acc)[2][2][4][2], const pg8::Unit& u, int wr, int wc, int fr, int fq, const Pre& pre, int par, LAS unsigned char* sp) const {
        const int pn = u.pn & 7, col0 = 128 * pn + 32 * wc + 8 * fq;
        const LAS float* bp = (const LAS float*)(sp + par * 3072 + 2048) + 32 * wc + 8 * fq;
        f32x2 bg[4], bu[4];
#pragma unroll
        for (int q = 0; q < 4; ++q) { bg[q] = *(const LAS f32x2*)(bp + 2 * q); const f32x2 t = *(const LAS f32x2*)(bp + 128 + 2 * q); bu[q] = t * SC_A + SC_A; }
#pragma unroll
        for (int ai = 0; ai < 2; ++ai)
#pragma unroll
            for (int m = 0; m < 4; ++m) {
                const int p = u.pm * 256 + ai * 128 + wr * 64 + m * 16 + fr; const float ri = pre.ri[ai * 4 + m];
                const f32x2 rg = (f32x2){ri, ri}, ru = rg * SC_A;
                unsigned w[2];
#pragma unroll
                for (int n = 0; n < 2; ++n) {
                    f32x2 o2[2];
#pragma unroll
                    for (int h = 0; h < 2; ++h) {
                        const f32x2 ag = (f32x2){acc[ai][0][m][n][2 * h], acc[ai][0][m][n][2 * h + 1]}, au = (f32x2){acc[ai][1][m][n][2 * h], acc[ai][1][m][n][2 * h + 1]};
                        f32x2 g = ag * rg + bg[2 * n + h], up = au * ru + bu[2 * n + h];
                        g.x = fminf(g.x, 7.f); g.y = fminf(g.y, 7.f);
                        up.x = __builtin_amdgcn_fmed3f(up.x, -6.f * SC_A, 8.f * SC_A); up.y = __builtin_amdgcn_fmed3f(up.y, -6.f * SC_A, 8.f * SC_A);
                        const f32x2 t = g * (-1.702f * LOG2E);
                        f32x2 ex; ex.x = __builtin_amdgcn_exp2f(t.x); ex.y = __builtin_amdgcn_exp2f(t.y);
                        const f32x2 d = ex + 1.f;
                        f32x2 rc; rc.x = __builtin_amdgcn_rcpf(d.x); rc.y = __builtin_amdgcn_rcpf(d.y);
                        o2[h] = up * (g * rc);
                    }
                    w[n] = cvt8(o2[0].x, o2[0].y, o2[1].x, o2[1].y);
                }
                u32x2 ww; ww.x = w[0]; ww.y = w[1];
                *(u32x2*)(act + (size_t)p * 1024 + col0) = ww; }
    }
};
struct EpiDown {
    static constexpr bool PERM = true;
    unsigned char* y4; const int* rowa; const float* rowg; const float* bd;
    typedef pg8::NoPre Pre;
    __device__ __forceinline__ void prefetch(const pg8::Unit& u, int par, LAS unsigned char* sp, int wid, int lane, int, int, int, int, Pre&) const {
        const unsigned base = (unsigned)(uintptr_t)sp + (unsigned)par * 3072u;
        if (wid < 4) PG8_DMA4(base + (unsigned)wid * 256u, (const char*)(rowa + u.pm * 256 + wid * 64), (unsigned)lane * 4u);
        else PG8_DMA4(base + 1024u + (unsigned)(wid - 4) * 256u, (const char*)(rowg + u.pm * 256 + (wid - 4) * 64), (unsigned)lane * 4u);
        if (wid == 0) { const int e = u.pn >> 2, pn = u.pn & 3; PG8_DMA16(base + 2048u, (const char*)(bd + (size_t)e * 1024 + 256 * pn), (unsigned)lane * 16u); }
    }
    __device__ __forceinline__ void operator()(const pg8::f32x4 (&acc)[2][2][4][2], const pg8::Unit& u, int wr, int wc, int fr, int fq, const Pre& pre, int par, LAS unsigned char* sp) const {
        const int pn = u.pn & 3, col0 = 256 * pn + 32 * wc + 8 * fq;
        const LAS int* l_as = (const LAS int*)(sp + par * 3072); const LAS float* l_gt = (const LAS float*)(sp + par * 3072 + 1024);
        const LAS float* bp = (const LAS float*)(sp + par * 3072 + 2048) + 32 * wc + 8 * fq;
        f32x4 bv[2][2];
#pragma unroll
        for (int bj = 0; bj < 2; ++bj)
#pragma unroll
            for (int n = 0; n < 2; ++n) bv[bj][n] = *(const LAS f32x4*)(bp + 128 * bj + 4 * n);
#pragma unroll
        for (int ai = 0; ai < 2; ++ai)
#pragma unroll
            for (int m = 0; m < 4; ++m) {
                const int rt = ai * 128 + wr * 64 + m * 16 + fr; const int as = l_as[rt];
                if (as >= 0) { const float gt = l_gt[rt] * SC_Y; unsigned char* yr = y4 + (size_t)as * 1024 + col0;
                    const f32x2 gs = (f32x2){gt * (1.f / (SC_W * SC_A)), gt * (1.f / (SC_W * SC_A))}, g2 = (f32x2){gt, gt};
#pragma unroll
                    for (int bj = 0; bj < 2; ++bj) { unsigned w[2];
#pragma unroll
                        for (int n = 0; n < 2; ++n) {
                            const f32x2 a0 = (f32x2){acc[ai][bj][m][n][0], acc[ai][bj][m][n][1]}, a1 = (f32x2){acc[ai][bj][m][n][2], acc[ai][bj][m][n][3]};
                            const f32x2 b0 = (f32x2){bv[bj][n][0], bv[bj][n][1]}, b1 = (f32x2){bv[bj][n][2], bv[bj][n][3]};
                            const f32x2 v0 = a0 * gs + b0 * g2, v1 = a1 * gs + b1 * g2;
                            w[n] = cvt8(v0.x, v0.y, v1.x, v1.y); }
                        u32x2 ww; ww.x = w[0]; ww.y = w[1];
                        *(u32x2*)(yr + 128 * bj) = ww; } } }
    }
};

__device__ __forceinline__ void p7_final(const Args& a, int vcu, int G, int wave, int lane) {
    unsigned char* ws = a.ws; const int gw = vcu * NWAVES + wave, NGW = G * NWAVES;
    const f32x4* gr = (const f32x4*)a.in[21] + lane;
    constexpr int TW = 2;
    for (int t0 = gw * TW; t0 < T; t0 += NGW * TW) {
        u32x2 xw[TW][4]; unsigned yw[TW][4][4];
#pragma unroll
        for (int q = 0; q < TW; ++q) { const int t = t0 + q;
            const u32x2* xr = (const u32x2*)((const bf16*)(ws + WS_XB) + (size_t)t * D) + lane;
            const unsigned* yr = (const unsigned*)(ws + WS_Y48 + (size_t)t * 4 * D) + lane;
#pragma unroll
            for (int j = 0; j < 4; ++j) { xw[q][j] = xr[64 * j];
#pragma unroll
                for (int k = 0; k < 4; ++k) yw[q][k][j] = yr[k * 256 + 64 * j]; } }
#pragma unroll
        for (int q = 0; q < TW; ++q) { const int t = t0 + q;
            f32x4 v[4]; float s = 0.f;
#pragma unroll
            for (int j = 0; j < 4; ++j) { f32x4 ys = (f32x4){0.f, 0.f, 0.f, 0.f};
#pragma unroll
                for (int k = 0; k < 4; ++k) { const f32x2 lo = __builtin_amdgcn_cvt_pk_f32_fp8((int)yw[q][k][j], false), hi = __builtin_amdgcn_cvt_pk_f32_fp8((int)yw[q][k][j], true);
                    ys.x += lo.x; ys.y += lo.y; ys.z += hi.x; ys.w += hi.y; }
                v[j].x = __uint_as_float(xw[q][j].x << 16) + ys.x * (1.f / SC_Y); v[j].y = __uint_as_float(xw[q][j].x & 0xffff0000u) + ys.y * (1.f / SC_Y);
                v[j].z = __uint_as_float(xw[q][j].y << 16) + ys.z * (1.f / SC_Y); v[j].w = __uint_as_float(xw[q][j].y & 0xffff0000u) + ys.w * (1.f / SC_Y);
                s += (v[j].x * v[j].x + v[j].y * v[j].y) + (v[j].z * v[j].z + v[j].w * v[j].w); }
            const float r = 1.f / sqrtf(wave_sum(s) * (1.f / D) + NORM_EPS);
            f32x4* orow = (f32x4*)(a.out + (size_t)t * D) + lane;
#pragma unroll
            for (int j = 0; j < 4; ++j) { const f32x4 gg = gr[64 * j]; orow[64 * j] = (f32x4){v[j].x * r * gg.x, v[j].y * r * gg.y, v[j].z * r * gg.z, v[j].w * r * gg.w}; } }
    }
}

typedef const __attribute__((address_space(4))) Args* KArgP;
__device__ __forceinline__ Args fresh_args() { KArgP p = (KArgP)__builtin_amdgcn_kernarg_segment_ptr(); asm volatile("" : "+s"(p)); Args a;
#pragma unroll
    for (int i = 0; i < 22; ++i) a.in[i] = p->in[i];
    a.out = p->out; a.ws = p->ws; a.ph_lo = p->ph_lo; a.ph_hi = p->ph_hi; return a; }
constexpr int N_PHASES = 11;
__global__ void __launch_bounds__(NTHREADS, 2) fwd(Args args) {
    extern __shared__ __attribute__((aligned(1024))) unsigned char lds_raw[];
    LAS unsigned char* lds = (LAS unsigned char*)lds_raw;
    volatile LAS unsigned* MISC = (volatile LAS unsigned*)(lds + MISC_OFF);
    const int wave = __builtin_amdgcn_readfirstlane((int)threadIdx.x >> 6);
    const int G = gridDim.x; const int bx = blockIdx.x; const int vcu = (G % 8 == 0) ? (bx % 8) * (G / 8) + bx / 8 : bx;
    unsigned char* ws = args.ws;
    for (int u = wave * 64 + hw_lane(); u < (LDS_BYTES - MISC_OFF) / 4; u += NTHREADS) MISC[u] = 0u;
    __syncthreads();
    const int lo = args.ph_lo, hi = args.ph_hi;
#ifdef PROBE_CLK
    if (blockIdx.x == 0 && wave == 0 && hw_lane() == 0) { *(volatile unsigned*)(ws + WS_LAM + 256) = *(volatile unsigned*)(ws + WS_LAM + 128); }
#endif
    const bool use_bar = (hi - lo) > 1;
    XcdBarrier bar; bar.bar = (unsigned*)(ws + WS_CTL); bar.x = 0; bar.st = nullptr;
    if (use_bar) bar = xcd_barrier_post((unsigned*)(ws + WS_CTL), MISC + 8, (unsigned)wave);
#ifdef ONLY_PHASE
#define IN(k) ((k) == ONLY_PHASE)
#else
#define IN(k) (lo <= (k) && (k) < hi)
#endif
#ifdef PROBE_CLK
    unsigned long long pc0 = 0, pr0 = 0;
#define PCLK_BEGIN(k) do { if ((k) == PROBE_CLK) { pc0 = __builtin_readcyclecounter(); pr0 = __builtin_amdgcn_s_memrealtime(); } } while (0)
#define PCLK_END(k) do { if ((k) == PROBE_CLK) { const unsigned long long c1 = __builtin_readcyclecounter(), r1 = __builtin_amdgcn_s_memrealtime(); if (bx == 0 && wave == 0 && hw_lane() == 0) { PROBE_EXPR; } } } while (0)
#else
#define PCLK_BEGIN(k)
#define PCLK_END(k)
#endif
#define SEAM(k) do { if (IN(k) && IN((k) + 1)) xcd_barrier(bar); } while (0)

    if (IN(0)) { const Args A_ = fresh_args(); p0_prologue(A_, lds, vcu, G, wave, hw_lane()); }
    SEAM(0);
    if (IN(1)) {
        pg8::Gemm g{(const bf16*)(ws + WS_XB), (const bf16*)(ws + WS_WIN), T, PROJ_LD, D}; pg8::StaticOrder S; S.init(T, PROJ_LD, G, bx);
        pg8::EpiBf16 E{(bf16*)(ws + WS_PROJ), PROJ_LD};
        PCLK_BEGIN(1); pg8::gemm_phase<pg8::EpiBf16, pg8::StaticOrder, true, false>(lds, g, S, E, wave); PCLK_END(1);
    }
    SEAM(1);
    if (IN(2)) { const Args A_ = fresh_args(); p1b_latent(A_, vcu, G, wave, hw_lane()); }
    SEAM(2);
    if (IN(3)) {
        { pg8::Gemm g{(const bf16*)(ws + WS_CQN), (const bf16*)(ws + WS_WUQ), T, 768, 256}; pg8::StaticOrder S; S.init(T, 768, G, bx);
          pg8::EpiBf16 E{(bf16*)(ws + WS_QM), 768}; pg8::gemm_phase<pg8::EpiBf16, pg8::StaticOrder, true, false>(lds, g, S, E, wave); }
        { pg8::Gemm g{(const bf16*)(ws + WS_CKVN), (const bf16*)(ws + WS_WUKV), T, 1024, 128}; pg8::StaticOrder S; S.init(T, 1024, G, bx);
          pg8::EpiBf16KN E{(bf16*)(ws + WS_KV), 1024, (unsigned*)(ws + WS_KN), ws + WS_KN8}; pg8::gemm_phase<pg8::EpiBf16KN, pg8::StaticOrder, true, false>(lds, g, S, E, wave); }
    }
    SEAM(3);
    if (IN(4)) { const Args A_ = fresh_args(); PCLK_BEGIN(4); p2_attention<3>(A_, lds, vcu, G, wave); PCLK_END(4); }
    SEAM(4);
    if (IN(5)) {
        pg8::Gemm g{(const bf16*)(ws + WS_MIXED), (const bf16*)(ws + WS_WO), T, D, D}; pg8::StaticOrder S; S.init(T, D, G, bx);
        const Args A_ = fresh_args(); pg8::EpiResid E{A_.in[0], (bf16*)(ws + WS_XB), D};
        pg8::gemm_phase<pg8::EpiResid, pg8::StaticOrder, true, false>(lds, g, S, E, wave);
    }
    SEAM(5);
    if (IN(6)) { const Args A_ = fresh_args(); p3b_router(A_, lds, G, wave); }
    SEAM(6);
    if (IN(7)) { const Args A_ = fresh_args(); p4_scatter(A_, lds, G, wave); }
    SEAM(7);
    if (IN(8)) {
        const int* tinfo = (const int*)(ws + WS_TINFO); MoeOrder S{tinfo, (const int*)(ws + WS_ROWA), tinfo[2048], 8, 3, G, vcu};
        pg8::Gemm g{(const bf16*)(ws + WS_XB8), (const bf16*)(ws + WS_WGU8), 0, 2048, D / 2};
        const Args A_ = fresh_args(); EpiSwiglu E{ws + WS_ACT8, (const float*)(ws + WS_ROWRI), A_.in[18]};
        PCLK_BEGIN(8); pg8::gemm_phase<EpiSwiglu, MoeOrder, true, true, true, true>(lds, g, S, E, wave); PCLK_END(8);
    }
    SEAM(8);
    if (IN(9)) {
        const int* tinfo = (const int*)(ws + WS_TINFO); MoeOrder S{tinfo, (const int*)(ws + WS_ROWA), tinfo[2048], 4, 2, G, vcu};
        pg8::Gemm g{(const bf16*)(ws + WS_ACT8), (const bf16*)(ws + WS_WD8), 0, 1024, D / 2};
        const Args A_ = fresh_args(); EpiDown E{ws + WS_Y48, (const int*)(ws + WS_ROWA), (const float*)(ws + WS_ROWG), A_.in[20]};
        pg8::gemm_phase<EpiDown, MoeOrder, true, false, true>(lds, g, S, E, wave);
    }
    SEAM(9);
    if (IN(10)) { const Args A_ = fresh_args(); p7_final(A_, vcu, G, wave, hw_lane()); }
#ifdef PROBE_CLK
    if (blockIdx.x == 0 && wave == 0 && hw_lane() == 0) { *(volatile unsigned*)(ws + WS_LAM + 128) = 0x600DF00Du; }
#endif
#ifdef PROBE_EXTRA
    if (IN(11)) { const Args A_ = fresh_args(); p2_attention<1>(A_, lds, vcu, G, wave); }
    if (IN(12)) { const Args A_ = fresh_args(); p2_attention<2>(A_, lds, vcu, G, wave); }
#endif
#undef IN
#undef SEAM
}

#ifndef MK_N_LAUNCHES
#define MK_N_LAUNCHES 1
#endif
extern "C" void kernel_launch(void* const* d_in, const int* in_sizes, int n_in, void* d_out, int out_size, void* d_ws, size_t ws_size, hipStream_t stream) {
    static int grid = 0;
    if (grid == 0) {
        if (n_in != 22 || in_sizes[0] != T * D || out_size != T * D || ws_size < WS_END) {
            fprintf(stderr, "kernel_launch: shape / workspace mismatch (n_in %d, in0 %d, out %d, ws %zu < %zu); nothing launched\n", n_in, n_in > 0 ? in_sizes[0] : -1, out_size, ws_size, (size_t)WS_END); grid = -1; return; }
        int dev = 0, cus = 0, per_cu = 0;
        if (hipGetDevice(&dev) != hipSuccess || hipDeviceGetAttribute(&cus, hipDeviceAttributeMultiprocessorCount, dev) != hipSuccess) { grid = -1; return; }
        if (hipFuncSetAttribute((const void*)fwd, hipFuncAttributeMaxDynamicSharedMemorySize, LDS_BYTES) != hipSuccess) { fprintf(stderr, "kernel_launch: hipFuncSetAttribute failed\n"); grid = -1; return; }
        if (hipOccupancyMaxActiveBlocksPerMultiprocessor(&per_cu, (const void*)fwd, NTHREADS, LDS_BYTES) != hipSuccess || per_cu < 1) { fprintf(stderr, "kernel_launch: occupancy query says %d\n", per_cu); }
        (void)hipGetLastError();
        grid = cus;
    }
    if (grid < 0) return;
    if (hipMemsetAsync((char*)d_ws + WS_CTL, 0, CTL_ZERO_BYTES, stream) != hipSuccess) return;
    Args a{};
    for (int i = 0; i < 22; ++i) a.in[i] = (const float*)d_in[i];
    a.out = (float*)d_out; a.ws = (unsigned char*)d_ws;
#if MK_N_LAUNCHES == 1
    a.ph_lo = 0; a.ph_hi = N_PHASES;
    hipLaunchKernelGGL(fwd, dim3(grid), dim3(NTHREADS), LDS_BYTES, stream, a);
#else
#ifndef PROBE_MASK
#define PROBE_MASK 0
#endif
    for (int p = 0; p < N_PHASES; ++p) { a.ph_lo = p; a.ph_hi = p + 1; hipLaunchKernelGGL(fwd, dim3(grid), dim3(NTHREADS), LDS_BYTES, stream, a);
        if ((PROBE_MASK >> p) & 1) hipLaunchKernelGGL(fwd, dim3(grid), dim3(NTHREADS), LDS_BYTES, stream, a);
#ifdef PROBE_EXTRA
        if (p == 4) { a.ph_lo = PROBE_EXTRA; a.ph_hi = PROBE_EXTRA + 1; hipLaunchKernelGGL(fwd, dim3(grid), dim3(NTHREADS), LDS_BYTES, stream, a); }
#endif
    }
#endif
}
```

```cpp
#include <hip/hip_runtime.h>
#include <cstdio>
#include <cstdint>

__device__ __forceinline__ int hw_lane() { int l; asm volatile("v_mbcnt_lo_u32_b32 %0, -1, 0\n\tv_mbcnt_hi_u32_b32 %0, -1, %0" : "=v"(l)); return l; }
namespace pg8 {
#define PG8_LAS __attribute__((address_space(3)))
typedef unsigned short bf16_t;
typedef short bf16x8 __attribute__((ext_vector_type(8)));
typedef float f32x4 __attribute__((ext_vector_type(4)));
typedef unsigned u32x4 __attribute__((ext_vector_type(4)));
typedef unsigned u32x2 __attribute__((ext_vector_type(2)));
typedef int v8i __attribute__((ext_vector_type(8)));
typedef short bf16x16 __attribute__((ext_vector_type(16)));
constexpr int BM = 256, BK = 64, HALF = 128, HTB = HALF * BK * 2  , STAGE_BYTES = 8 * HTB, NXCD = 8, WGM = 8;

__host__ __device__ __forceinline__ int lds_byte(int r, int c) { const int st = (r >> 4) * 2 + (c >> 5), rr = r & 15, cc = c & 31, ob = rr * 64 + cc * 2; return st * 1024 + (ob ^ (((ob >> 9) & 1) << 5)); }
__host__ __device__ __forceinline__ void stage_rc(int b, int& R, int& C) { const int st = b / 1024, sb = b % 1024, swz = sb ^ (((sb >> 9) & 1) << 5); R = (st >> 1) * 16 + swz / 64; C = (st & 1) * 32 + (swz % 64) / 2; }
__host__ __device__ __forceinline__ int perm32(int rho) { const int n = rho >> 4, i = rho & 15; return 8 * (i >> 2) + 4 * n + (i & 3); }

struct Unit { int pm, pn; };
struct Gemm { const bf16_t* A; const bf16_t* Bt; int M, N, K; };

struct StaticOrder {
    int nM, nN, nwg, G, c;
    __host__ __device__ void init(int M, int N, int G_, int c_) { nM = M / BM; nN = N / BM; nwg = nM * nN; G = G_; c = c_; }
    __host__ __device__ bool next(int i, Unit& u) const {
        const long L = (long)i * G + c; if (L >= nwg) return false;
        int wgid = (int)L; { const int q = nwg / NXCD, r = nwg % NXCD, xcd = wgid % NXCD, off = wgid / NXCD; wgid = (xcd < r ? xcd * (q + 1) : r * (q + 1) + (xcd - r) * q) + off; }
        const int nig = WGM * nN, gid = wgid / nig, fm = gid * WGM, gsz = (nM - fm) < WGM ? (nM - fm) : WGM;
        u.pm = fm + ((wgid % nig) % gsz); u.pn = (wgid % nig) / gsz; return true;
    }
    __device__ __forceinline__ int gather_row(const Unit&, int) const { return 0; }
};

__device__ __forceinline__ unsigned cvt_pk_bf16(float lo, float hi) { unsigned r; asm volatile("v_cvt_pk_bf16_f32 %0, %1, %2" : "=v"(r) : "v"(lo), "v"(hi)); return r; }

#define PG8_DMA4(ldsaddr, gbase, vo) asm volatile("s_mov_b32 m0, %0\n\ts_nop 0\n\tglobal_load_lds_dword %1, %2" :: "s"(ldsaddr), "v"(vo), "s"(gbase) : "memory", "m0")
#define PG8_DMA16(ldsaddr, gbase, vo) asm volatile("s_mov_b32 m0, %0\n\ts_nop 0\n\tglobal_load_lds_dwordx4 %1, %2" :: "s"(ldsaddr), "v"(vo), "s"(gbase) : "memory", "m0")
typedef float zf32x2 __attribute__((ext_vector_type(2)));
__device__ __forceinline__ f32x4 zero4() { zf32x2 a, b; asm volatile("v_pk_mov_b32 %0, 0, 0" : "=v"(a)); asm volatile("v_pk_mov_b32 %0, 0, 0" : "=v"(b)); return (f32x4){a.x, a.y, b.x, b.y}; }
struct NoPre {};
struct EpiBf16 {
    static constexpr bool PERM = true; typedef NoPre Pre;
    bf16_t* O; int ldc;
    __device__ __forceinline__ void prefetch(const Unit&, int, PG8_LAS unsigned char*, int, int, int, int, int, int, Pre&) const {}
    __device__ __forceinline__ void operator()(const f32x4 (&acc)[2][2][4][2], const Unit& u, int wr, int wc, int fr, int fq, const Pre&, int, PG8_LAS unsigned char*) const {
        const int row0 = u.pm * BM + wr * 64 + fr; const int col0 = u.pn * BM + wc * 32 + 8 * fq;
#pragma unroll
        for (int ai = 0; ai < 2; ++ai)
#pragma unroll
            for (int m = 0; m < 4; ++m) { bf16_t* rowp = O + (size_t)(row0 + ai * HALF + m * 16) * ldc + col0;
#pragma unroll
                for (int bj = 0; bj < 2; ++bj) { const f32x4 v0 = acc[ai][bj][m][0], v1 = acc[ai][bj][m][1];
                    u32x4 w; w.x = cvt_pk_bf16(v0[0], v0[1]); w.y = cvt_pk_bf16(v0[2], v0[3]); w.z = cvt_pk_bf16(v1[0], v1[1]); w.w = cvt_pk_bf16(v1[2], v1[3]);
                    *(u32x4*)(rowp + bj * HALF) = w; } }
    }
};
struct EpiBf16KN {
    static constexpr bool PERM = true; typedef NoPre Pre;
    bf16_t* O; int ldc; unsigned* kn; unsigned char* k8;
    __device__ __forceinline__ void prefetch(const Unit&, int, PG8_LAS unsigned char*, int, int, int, int, int, int, Pre&) const {}
    __device__ __forceinline__ void operator()(const f32x4 (&acc)[2][2][4][2], const Unit& u, int wr, int wc, int fr, int fq, const Pre&, int, PG8_LAS unsigned char*) const {
        const int row0 = u.pm * BM + wr * 64 + fr; const int col0 = u.pn * BM + wc * 32 + 8 * fq;
        float mx = 0.f;
#pragma unroll
        for (int ai = 0; ai < 2; ++ai)
#pragma unroll
            for (int m = 0; m < 4; ++m) { bf16_t* rowp = O + (size_t)(row0 + ai * HALF + m * 16) * ldc + col0;
                { const f32x4 v0 = acc[ai][1][m][0], v1 = acc[ai][1][m][1];
                    u32x4 w; w.x = cvt_pk_bf16(v0[0], v0[1]); w.y = cvt_pk_bf16(v0[2], v0[3]); w.z = cvt_pk_bf16(v1[0], v1[1]); w.w = cvt_pk_bf16(v1[2], v1[3]);
                    *(u32x4*)(rowp + HALF) = w; }
                const f32x4 a0 = acc[ai][0][m][0], a1 = acc[ai][0][m][1];
                { int u0 = 0, u1 = 0; u0 = __builtin_amdgcn_cvt_pk_fp8_f32(a0[0], a0[1], u0, false); u0 = __builtin_amdgcn_cvt_pk_fp8_f32(a0[2], a0[3], u0, true);
                  u1 = __builtin_amdgcn_cvt_pk_fp8_f32(a1[0], a1[1], u1, false); u1 = __builtin_amdgcn_cvt_pk_fp8_f32(a1[2], a1[3], u1, true);
                  typedef unsigned u32x2_ __attribute__((ext_vector_type(2))); u32x2_ w8; w8.x = (unsigned)u0; w8.y = (unsigned)u1;
                  *(u32x2_*)(k8 + (size_t)(row0 + ai * HALF + m * 16) * 512 + u.pn * 128 + wc * 32 + 8 * fq) = w8; }
                float s = a0[0] * a0[0] + a0[1] * a0[1] + a0[2] * a0[2] + a0[3] * a0[3] + a1[0] * a1[0] + a1[1] * a1[1] + a1[2] * a1[2] + a1[3] * a1[3];
                s += __shfl_xor(s, 16); s += __shfl_xor(s, 32); mx = fmaxf(mx, s); }
        mx = fmaxf(mx, __shfl_xor(mx, 1)); mx = fmaxf(mx, __shfl_xor(mx, 2)); mx = fmaxf(mx, __shfl_xor(mx, 4)); mx = fmaxf(mx, __shfl_xor(mx, 8));
        if (fr == 0 && fq == 0) atomicMax(kn + ((u.pm * BM) >> 11) * 32 + u.pn * 4 + wc, __float_as_uint(mx));
    }
};
struct EpiResid {
    static constexpr bool PERM = true; typedef NoPre Pre;
    const float* base; bf16_t* out; int ldc;
    __device__ __forceinline__ void prefetch(const Unit&, int, PG8_LAS unsigned char*, int, int, int, int, int, int, Pre&) const {}
    __device__ __forceinline__ void operator()(const f32x4 (&acc)[2][2][4][2], const Unit& u, int wr, int wc, int fr, int fq, const Pre&, int, PG8_LAS unsigned char*) const {
        const int row0 = u.pm * BM + wr * 64 + fr; const int col0 = u.pn * BM + wc * 32 + 8 * fq;
#pragma unroll
        for (int ai = 0; ai < 2; ++ai)
#pragma unroll
            for (int m = 0; m < 4; ++m) { const size_t off = (size_t)(row0 + ai * HALF + m * 16) * ldc + col0;
#pragma unroll
                for (int bj = 0; bj < 2; ++bj) { const f32x4 v0 = *(const f32x4*)(base + off + bj * HALF) + acc[ai][bj][m][0], v1 = *(const f32x4*)(base + off + bj * HALF + 4) + acc[ai][bj][m][1];
                    u32x4 w; w.x = cvt_pk_bf16(v0[0], v0[1]); w.y = cvt_pk_bf16(v0[2], v0[3]); w.z = cvt_pk_bf16(v1[0], v1[1]); w.w = cvt_pk_bf16(v1[2], v1[3]);
                    *(u32x4*)(out + off + bj * HALF) = w; } }
    }
};

template <class Epi, class Sched, bool ALIGN_EPI = false, bool GATHER = false, bool F8 = false, bool F6 = false, bool DMM = false>
__device__ __forceinline__ void gemm_phase(PG8_LAS unsigned char* lds, const Gemm g, const Sched& S, const Epi& E, int wave) {
    const int wid = wave, lane = hw_lane(), tid = wid * 64 + lane, wr = wid >> 2, wc = wid & 3, fr = lane & 15, fq = lane >> 4;
    const int K = g.K, nt = K / BK;
    unsigned voffA[2], voffB[2]; int RA[2], CA[2];
#pragma unroll
    for (int i = 0; i < 2; ++i) { int R, C; stage_rc(tid * 16 + i * 8192, R, C); const int Rb = Epi::PERM ? ((R & ~31) + perm32(R & 31)) : R;
        voffA[i] = (unsigned)(R * K + C) * 2u; voffB[i] = (unsigned)(Rb * K + C) * 2u; RA[i] = R; CA[i] = C; }
    const size_t kstep = (size_t)(BK * 2);
    const size_t hstep = (size_t)HALF * K * 2;
    const size_t tstep = 2 * hstep;
    const unsigned ldsw = (unsigned)wid * 1024u, ldsu = (unsigned)(uintptr_t)lds;
    const int aoff = lds_byte(wr * 64 + fr, fq * (F8 ? 16 : 8)), boff = lds_byte(wc * 32 + fr, fq * (F8 ? 16 : 8));
    PG8_LAS unsigned char* ldsA = lds + aoff + (F8 ? 16 * (fq & 1) : 0); PG8_LAS unsigned char* ldsB = lds + 4 * HTB + boff + (F8 ? 16 * (fq & 1) : 0);
    PG8_LAS unsigned char* ldsA2 = lds + aoff + 16 * (1 - (fq & 1)); PG8_LAS unsigned char* ldsB2 = lds + 4 * HTB + boff + 16 * (1 - (fq & 1));
    if constexpr (F8) { asm volatile("" : "+v"(ldsA)); asm volatile("" : "+v"(ldsB)); asm volatile("" : "+v"(ldsA2)); asm volatile("" : "+v"(ldsB2)); }
#define PG8_SA(b, h) (((b) * 2 + (h)) * HTB)
#define PG8_SB(b, h) ((4 + (b) * 2 + (h)) * HTB)
#define PG8_SBR(b, h) (((b) * 2 + (h)) * HTB)
#define PG8_DMA1(ldsaddr, gbase, vo) asm volatile("s_mov_b32 m0, %0\n\ts_nop 0\n\tglobal_load_lds_dwordx4 %1, %2" :: "s"(ldsaddr), "v"(vo), "s"(gbase) : "memory", "m0")
#define PG8_STAGE(bufoff, gbase, voff) do { PG8_DMA1(ldsu + (unsigned)(bufoff) + ldsw, (const char*)(gbase), (voff)[0]); PG8_DMA1(ldsu + (unsigned)(bufoff) + ldsw + 8192u, (const char*)(gbase), (voff)[1]); } while (0)
#define PG8_STAGE_A(bufoff, h, base, O) do { if constexpr (GATHER) { PG8_STAGE(bufoff, base, O[h]); } else { PG8_STAGE(bufoff, (base) + (h) * hstep, voffA); } } while (0)
#define PG8_CAT8(lo, hi) ((v8i){(int)lo.x, (int)lo.y, (int)lo.z, (int)lo.w, (int)hi.x, (int)hi.y, (int)hi.z, (int)hi.w})
#define PG8_LDA(dst, b, h) do { if constexpr (F8) { _Pragma("unroll") for (int m = 0; m < 4; ++m) { const u32x4 lo_ = *(const PG8_LAS u32x4*)(ldsA + PG8_SA(b, h) + m * 2048), hi_ = *(const PG8_LAS u32x4*)(ldsA2 + PG8_SA(b, h) + m * 2048); dst##8[m] = PG8_CAT8(lo_, hi_); } } \
    else { _Pragma("unroll") for (int m = 0; m < 4; ++m) _Pragma("unroll") for (int k = 0; k < 2; ++k) dst[m][k] = *(const PG8_LAS bf16x8*)(lds + PG8_SA(b, h) + aoff + m * 2048 + k * 1024); } } while (0)
#define PG8_LDB(dst, b, h) do { if constexpr (F8) { _Pragma("unroll") for (int n = 0; n < 2; ++n) { const u32x4 lo_ = *(const PG8_LAS u32x4*)(ldsB + PG8_SBR(b, h) + n * 2048), hi_ = *(const PG8_LAS u32x4*)(ldsB2 + PG8_SBR(b, h) + n * 2048); dst##8[n] = PG8_CAT8(lo_, hi_); } } \
    else { _Pragma("unroll") for (int n = 0; n < 2; ++n) _Pragma("unroll") for (int k = 0; k < 2; ++k) dst[n][k] = *(const PG8_LAS bf16x8*)(lds + PG8_SB(b, h) + boff + n * 2048 + k * 1024); } } while (0)
#define PG8_MMA(ai, bj, At, Bt) do { __builtin_amdgcn_s_setprio(1); if constexpr (F8) { _Pragma("unroll") for (int m = 0; m < 4; ++m) _Pragma("unroll") for (int n = 0; n < 2; ++n) \
            { if constexpr (F6) acc[ai][bj][m][n] = __builtin_amdgcn_mfma_scale_f32_16x16x128_f8f6f4(Bt##8[n], At##8[m], acc[ai][bj][m][n], 2, 2, 0, 0x7f7f7f7f, 0, 0x7f7f7f7f); \
              else acc[ai][bj][m][n] = __builtin_amdgcn_mfma_scale_f32_16x16x128_f8f6f4(Bt##8[n], At##8[m], acc[ai][bj][m][n], 0, 0, 0, 0x7f7f7f7f, 0, 0x7f7f7f7f); } } \
    else { _Pragma("unroll") for (int m = 0; m < 4; ++m) _Pragma("unroll") for (int n = 0; n < 2; ++n) _Pragma("unroll") for (int k = 0; k < 2; ++k) \
        acc[ai][bj][m][n] = __builtin_amdgcn_mfma_f32_16x16x32_bf16(Bt[n][k], At[m][k], acc[ai][bj][m][n], 0, 0, 0); } __builtin_amdgcn_s_setprio(0); } while (0)
#define PG8_WAIT_V(n) asm volatile("s_waitcnt vmcnt(" #n ")" ::: "memory")
#define PG8_WAIT_L(n) asm volatile("s_waitcnt lgkmcnt(" #n ")" ::: "memory")
#define PG8_BAR __builtin_amdgcn_s_barrier()
#define PG8_SCHED __builtin_amdgcn_sched_barrier(0)
#ifdef PROBE_SEG
    unsigned long long pacc = 0, pt = 0; const unsigned long long ptot0 = __builtin_amdgcn_s_memtime();
#define PS_B(id) do { if ((id) == PROBE_SEG) pt = __builtin_amdgcn_s_memtime(); } while (0)
#define PS_E(id) do { if ((id) == PROBE_SEG) pacc += __builtin_amdgcn_s_memtime() - pt; } while (0)
#else
#define PS_B(id)
#define PS_E(id)
#endif
    Unit cur, nxt; int ui = 0;
    if (!S.next(0, cur)) return;
    PG8_LAS unsigned char* spare = lds + STAGE_BYTES;
    typename Epi::Pre pre; E.prefetch(cur, 0, spare, wid, lane, wr, wc, fr, fq, pre);
    f32x4 acc[2][2][4][2];
#pragma unroll
    for (int a = 0; a < 2; ++a)
#pragma unroll
        for (int b = 0; b < 2; ++b)
#pragma unroll
            for (int m = 0; m < 4; ++m)
#pragma unroll
                for (int n = 0; n < 2; ++n) acc[a][b][m][n] = (f32x4){0.f, 0.f, 0.f, 0.f};
    bf16x8 At[4][2], B0[2][2], B1[2][2]; v8i At8[4], B08[2], B18[2];
    unsigned gC[2][2], gN[2][2];
#pragma unroll
    for (int h = 0; h < 2; ++h)
#pragma unroll
        for (int i = 0; i < 2; ++i) { gC[h][i] = 0u; gN[h][i] = 0u; }
    if constexpr (GATHER) {
#pragma unroll
        for (int h = 0; h < 2; ++h)
#pragma unroll
            for (int i = 0; i < 2; ++i) gC[h][i] = (unsigned)S.gather_row(cur, h * HALF + RA[i]) * (unsigned)(K * 2) + (unsigned)(CA[i] * 2);
    }
    const char* cA = GATHER ? (const char*)g.A : (const char*)g.A + (size_t)cur.pm * tstep; const char* cB = (const char*)g.Bt + (size_t)cur.pn * tstep;
    PG8_STAGE(PG8_SB(0, 0), cB, voffB); PG8_STAGE(PG8_SB(0, 1), cB + hstep, voffB); PG8_STAGE_A(PG8_SA(0, 0), 0, cA, gC); PG8_STAGE_A(PG8_SA(0, 1), 1, cA, gC);
    if (wr == 1) PG8_BAR;
    PG8_WAIT_V(2); PG8_BAR;
    PG8_STAGE(PG8_SB(1, 0), cB + kstep, voffB); PG8_STAGE_A(PG8_SA(1, 0), 0, cA + kstep, gC); PG8_STAGE(PG8_SB(1, 1), cB + hstep + kstep, voffB);
    PG8_WAIT_V(6); PG8_BAR;
    for (;;) {
        const bool has_next = S.next(ui + 1, nxt);
        if constexpr (GATHER) {
            if (has_next) {
#pragma unroll
                for (int h = 0; h < 2; ++h)
#pragma unroll
                    for (int i = 0; i < 2; ++i) gN[h][i] = (unsigned)S.gather_row(nxt, h * HALF + RA[i]) * (unsigned)(K * 2) + (unsigned)(CA[i] * 2);
            } else {
#pragma unroll
                for (int h = 0; h < 2; ++h)
#pragma unroll
                    for (int i = 0; i < 2; ++i) gN[h][i] = gC[h][i];
            }
        }
        const char* nA = GATHER ? (const char*)g.A : (has_next ? (const char*)g.A + (size_t)nxt.pm * tstep : cA); const char* nB = has_next ? (const char*)g.Bt + (size_t)nxt.pn * tstep : cB;
#pragma unroll 1
        for (int t = 0; t < nt; t += 2) {
            const bool last = (t == nt - 2);
            const char* a1 = cA + (size_t)(t + 1) * kstep;
            const char* a2 = last ? nA : cA + (size_t)(t + 2) * kstep; const char* b2 = last ? nB : cB + (size_t)(t + 2) * kstep;
            const char* a3 = a2 + kstep; const char* b3 = b2 + kstep;
            if constexpr (DMM) {
            PG8_LDB(B0, 0, 0); PG8_LDB(B1, 0, 1); PG8_SCHED; PG8_LDA(At, 0, 0); PG8_STAGE_A(PG8_SA(1, 1), 1, a1, gC);
            if constexpr (GATHER) { if (last) { _Pragma("unroll") for (int h = 0; h < 2; ++h) _Pragma("unroll") for (int i = 0; i < 2; ++i) gC[h][i] = gN[h][i]; } }
            PG8_WAIT_V(8); PG8_WAIT_L(0); PG8_BAR; PG8_MMA(0, 0, At, B0); PG8_MMA(0, 1, At, B1); PG8_BAR; PG8_SCHED;
            PG8_LDA(At, 0, 1); PG8_STAGE(PG8_SB(0, 0), b2, voffB); PG8_STAGE(PG8_SB(0, 1), b2 + hstep, voffB);
            PG8_WAIT_V(6); PG8_WAIT_L(0); PG8_BAR; PG8_STAGE_A(PG8_SA(0, 0), 0, a2, gC);
            PG8_MMA(1, 0, At, B0); PG8_MMA(1, 1, At, B1); PG8_BAR; PG8_SCHED;
            PG8_LDB(B0, 1, 0); PG8_LDB(B1, 1, 1); PG8_SCHED; PG8_LDA(At, 1, 0); PG8_STAGE_A(PG8_SA(0, 1), 1, a2, gC);
            PG8_WAIT_V(8); PG8_WAIT_L(0); PG8_BAR; PG8_MMA(0, 0, At, B0); PG8_MMA(0, 1, At, B1); PG8_BAR; PG8_SCHED;
            PG8_LDA(At, 1, 1); PG8_STAGE(PG8_SB(1, 0), b3, voffB); PG8_STAGE(PG8_SB(1, 1), b3 + hstep, voffB);
            PG8_WAIT_V(6); PG8_WAIT_L(0); PG8_BAR; PG8_STAGE_A(PG8_SA(1, 0), 0, a3, gC);
            PG8_MMA(1, 0, At, B0); PG8_MMA(1, 1, At, B1); PG8_BAR; PG8_SCHED;
            } else {
            PG8_LDB(B0, 0, 0); PG8_LDB(B1, 0, 1); PG8_SCHED; PG8_LDA(At, 0, 0); PG8_STAGE_A(PG8_SA(1, 1), 1, a1, gC);
            if constexpr (GATHER) { if (last) { _Pragma("unroll") for (int h = 0; h < 2; ++h) _Pragma("unroll") for (int i = 0; i < 2; ++i) gC[h][i] = gN[h][i]; } }
            PS_B(1); PG8_WAIT_V(8); PG8_WAIT_L(0); PS_E(1); PS_B(3); PG8_BAR; PS_E(3); PS_B(4); PG8_MMA(0, 0, At, B0); PG8_MMA(0, 1, At, B1); PS_E(4); PS_B(5); PG8_BAR; PS_E(5); PG8_SCHED;
            PG8_LDA(At, 0, 1); PG8_STAGE(PG8_SB(0, 0), b2, voffB); PG8_STAGE(PG8_SB(0, 1), b2 + hstep, voffB); PG8_STAGE_A(PG8_SA(0, 0), 0, a2, gC);
            PS_B(1); PG8_WAIT_V(8); PG8_WAIT_L(0); PS_E(1); PS_B(3); PG8_BAR; PS_E(3); PS_B(4); PG8_MMA(1, 0, At, B0); PG8_MMA(1, 1, At, B1); PS_E(4); PS_B(5); PG8_BAR; PS_E(5); PG8_SCHED;
            PG8_LDB(B0, 1, 0); PG8_LDB(B1, 1, 1); PG8_SCHED; PG8_LDA(At, 1, 0); PG8_STAGE_A(PG8_SA(0, 1), 1, a2, gC);
            PS_B(1); PG8_WAIT_V(8); PG8_WAIT_L(0); PS_E(1); PS_B(3); PG8_BAR; PS_E(3); PS_B(4); PG8_MMA(0, 0, At, B0); PG8_MMA(0, 1, At, B1); PS_E(4); PS_B(5); PG8_BAR; PS_E(5); PG8_SCHED;
            PG8_LDA(At, 1, 1); PG8_STAGE(PG8_SB(1, 0), b3, voffB); PG8_STAGE(PG8_SB(1, 1), b3 + hstep, voffB); PG8_STAGE_A(PG8_SA(1, 0), 0, a3, gC);
            PS_B(1); PG8_WAIT_V(8); PG8_WAIT_L(0); PS_E(1); PS_B(3); PG8_BAR; PS_E(3); PS_B(4); PG8_MMA(1, 0, At, B0); PG8_MMA(1, 1, At, B1); PS_E(4); PS_B(5); PG8_BAR; PS_E(5); PG8_SCHED;
            }
        }
        if constexpr (ALIGN_EPI) { if (wr == 0) PG8_BAR; }
        { const int l2_ = hw_lane();
          PS_B(6); E(acc, cur, wr, wc, l2_ & 15, l2_ >> 4, pre, ui & 1, spare); PS_E(6); }
        if (!has_next) break;
#pragma unroll
        for (int a = 0; a < 2; ++a)
#pragma unroll
            for (int b = 0; b < 2; ++b)
#pragma unroll
                for (int m = 0; m < 4; ++m)
#pragma unroll
                    for (int n = 0; n < 2; ++n) acc[a][b][m][n] = zero4();
        cur = nxt; cA = nA; cB = nB; ++ui;
        { const int l3_ = hw_lane(); E.prefetch(cur, ui & 1, spare, wid, l3_, wr, wc, l3_ & 15, l3_ >> 4, pre); }
#pragma unroll
        for (int h = 0; h < 2; ++h)
#pragma unroll
            for (int i = 0; i < 2; ++i) gC[h][i] = gN[h][i];
        if constexpr (ALIGN_EPI) { if (wr == 1) PG8_BAR; }
    }
#ifdef PROBE_SEG
    if constexpr (GATHER && F8) { if (blockIdx.x == 0 && wid == PROBE_WAVE && lane == 0) { const unsigned long long tot = __builtin_amdgcn_s_memtime() - ptot0; ((float*)S.tinfo)[3000] = PROBE_SEG == 0 ? (float)tot * (0.25f / 1.5e6f) : 0.5f * (float)pacc / (float)tot; } }
#endif
    PG8_WAIT_V(0);
    if constexpr (!ALIGN_EPI) { if (wr == 0) PG8_BAR; }
    PG8_BAR;
#undef PS_B
#undef PS_E
#undef PG8_SA
#undef PG8_SB
#undef PG8_SBR
#undef PG8_STAGE
#undef PG8_DMA1
#undef PG8_STAGE_A
#undef PG8_LDA
#undef PG8_CAT8
#undef PG8_LDB
#undef PG8_MMA
#undef PG8_WAIT_V
#undef PG8_WAIT_L
#undef PG8_BAR
#undef PG8_SCHED
}
}

namespace att {
constexpr bool MLA_PD2 = true;
#define ALAS __attribute__((address_space(3)))
using bf16 = unsigned short;
using bf16x8 = __attribute__((ext_vector_type(8))) short;
using s16x4  = __attribute__((ext_vector_type(4))) short;
using f32x16 = __attribute__((ext_vector_type(16))) float;
using f32x2  = __attribute__((ext_vector_type(2))) float;
using u32x4  = __attribute__((ext_vector_type(4))) unsigned;
using v8i    = __attribute__((ext_vector_type(8))) int;
using f32x4  = __attribute__((ext_vector_type(4))) float;
#define SBAR() __builtin_amdgcn_sched_barrier(0)
constexpr int SHM_V = 64 * 128 * 2;
constexpr int OFF_V = 0;
template <int MODE> struct L { static constexpr int NVB = MODE == 0 ? 3 : 2, SHM_K = 64 * (MODE == 0 ? 384 : 128), OFF_K = NVB * SHM_V, OFF_WS = OFF_K + 2 * SHM_K; };
constexpr int OFF_LUT = L<1>::OFF_WS + 2048;
constexpr int OFF_STASH = OFF_LUT + 16384;
constexpr int OFF_QPE = L<0>::OFF_WS + 2048;
constexpr int ATT_LDS = (OFF_STASH + 65536) > (OFF_QPE + 40960) ? (OFF_STASH + 65536) : (OFF_QPE + 40960);
__device__ __forceinline__ int crow(int r, int hi) { return (r & 3) + 8 * (r >> 2) + 4 * hi; }
__device__ __forceinline__ unsigned cvtpk(float lo, float hi) { unsigned r; asm volatile("v_cvt_pk_bf16_f32 %0, %1, %2" : "=v"(r) : "v"(lo), "v"(hi)); return r; }
__device__ __forceinline__ float bf2f(short v) { return __uint_as_float(((unsigned)(unsigned short)v) << 16); }
template <int RB> __device__ __forceinline__ int kaddr(int row, int colB) { return row * RB + (colB ^ (((row >> 1) & 7) << 4)); }

template <bool NEAR>
__device__ __forceinline__ void partialSM(f32x16& p0, f32x16& p1, float& m_reg, float& mn, float& alpha, float C, const ALAS float* lut, float cfar) {
  constexpr float THR2 = 8.f * 1.4426950408889634f;
  if constexpr (NEAR) {
#pragma unroll
    for (int r = 0; r < 16; ++r) { const int o = (r & 3) + 8 * (r >> 2); p0[r] = fmaf(p0[r], C, lut[o]); p1[r] = fmaf(p1[r], C, lut[32 + o]); }
  }
  float pmax = p0[0];
#pragma unroll
  for (int r = 1; r < 16; ++r) pmax = fmaxf(pmax, p0[r]);
#pragma unroll
  for (int r = 0; r < 16; ++r) pmax = fmaxf(pmax, p1[r]);
  { auto rr = __builtin_amdgcn_permlane32_swap(__float_as_uint(pmax), __float_as_uint(pmax), false, false);
    pmax = fmaxf(__uint_as_float(rr[0]), __uint_as_float(rr[1])); }
  if constexpr (!NEAR) pmax = fmaf(pmax, C, cfar);
  if (__builtin_expect(__all(pmax - m_reg <= THR2), 1)) { mn = m_reg; alpha = 1.f; }
  else { mn = fmaxf(m_reg, pmax); alpha = __builtin_amdgcn_exp2f(m_reg - mn); m_reg = mn; }
  if constexpr (NEAR) {
#pragma unroll
    for (int r = 0; r < 16; ++r) p0[r] = __builtin_amdgcn_exp2f(p0[r] - mn);
#pragma unroll
    for (int r = 0; r < 16; ++r) p1[r] = p1[r] - mn;
  } else {
    const float cm = cfar - mn;
#pragma unroll
    for (int r = 0; r < 16; ++r) p0[r] = __builtin_amdgcn_exp2f(fmaf(p0[r], C, cm));
#pragma unroll
    for (int r = 0; r < 16; ++r) p1[r] = fmaf(p1[r], C, cm);
  }
}
template <bool NEAR>
__device__ __forceinline__ void partialSM_fixed(f32x16& p0, f32x16& p1, float C, const ALAS float* lut, float cm) {
  if constexpr (NEAR) {
#pragma unroll
    for (int r = 0; r < 16; ++r) { const int o = (r & 3) + 8 * (r >> 2); p0[r] = __builtin_amdgcn_exp2f(fmaf(p0[r], C, lut[o]) + cm); p1[r] = fmaf(p1[r], C, lut[32 + o]) + cm; }
  } else {
#pragma unroll
    for (int r = 0; r < 16; ++r) p0[r] = __builtin_amdgcn_exp2f(fmaf(p0[r], C, cm));
#pragma unroll
    for (int r = 0; r < 16; ++r) p1[r] = fmaf(p1[r], C, cm);
  }
}
template <bool NEAR>
__device__ __forceinline__ void partialSM_acc(f32x16& p0, f32x16& p1, const ALAS float* lut) {
  if constexpr (NEAR) {
#pragma unroll
    for (int r = 0; r < 16; ++r) { const int o = (r & 3) + 8 * (r >> 2); p0[r] = __builtin_amdgcn_exp2f(p0[r] + lut[o]); p1[r] = p1[r] + lut[32 + o]; }
  } else {
#pragma unroll
    for (int r = 0; r < 16; ++r) p0[r] = __builtin_amdgcn_exp2f(p0[r]);
  }
}
__device__ __forceinline__ void finishSM(f32x16& p0, f32x16& p1, float alpha, float& l_reg, bf16x8& pa0, bf16x8& pa1, bf16x8& pa2, bf16x8& pa3) {
#pragma unroll
  for (int r = 0; r < 16; ++r) p1[r] = __builtin_amdgcn_exp2f(p1[r]);
  float ps = 0;
#pragma unroll
  for (int r = 0; r < 16; ++r) ps += p0[r];
#pragma unroll
  for (int r = 0; r < 16; ++r) ps += p1[r];
  { auto rr = __builtin_amdgcn_permlane32_swap(__float_as_uint(ps), __float_as_uint(ps), false, false);
    ps = __uint_as_float(rr[0]) + __uint_as_float(rr[1]); }
  l_reg = l_reg * alpha + ps;
#define PK4(P, BASE, OUT) do { unsigned a0 = cvtpk(P[BASE + 0], P[BASE + 1]), a1 = cvtpk(P[BASE + 2], P[BASE + 3]);   \
    unsigned b0 = cvtpk(P[BASE + 4], P[BASE + 5]), b1 = cvtpk(P[BASE + 6], P[BASE + 7]);                              \
    u32x4 w = {a0, a1, b0, b1}; OUT = __builtin_bit_cast(bf16x8, w); } while (0)
  PK4(p0, 0, pa0); PK4(p0, 8, pa1); PK4(p1, 0, pa2); PK4(p1, 8, pa3);
#undef PK4
}
template <int NQ, int RB>
__device__ __forceinline__ void qkt(f32x16& p0, f32x16& p1, const ALAS char* Ks, const bf16x8* qr, int r32, int hi) {
  p0 = f32x16{}; p1 = f32x16{};
#pragma unroll
  for (int d0 = 0; d0 < NQ; ++d0) { const int cb = (d0 * 16 + hi * 8) * 2;
    const bf16x8 b0 = *reinterpret_cast<const ALAS bf16x8*>(Ks + kaddr<RB>(r32, cb));
    const bf16x8 b1 = *reinterpret_cast<const ALAS bf16x8*>(Ks + kaddr<RB>(32 + r32, cb));
    p0 = __builtin_amdgcn_mfma_f32_32x32x16_bf16(b0, qr[d0], p0, 0, 0, 0);
    p1 = __builtin_amdgcn_mfma_f32_32x32x16_bf16(b1, qr[d0], p1, 0, 0, 0); }
}
__device__ __forceinline__ int v_st(int k, int c) { const int kk = (k & ~0xC) | ((k & 4) << 1) | ((k & 8) >> 1); return ((kk >> 3) * 4 + (c >> 5)) * 512 + ((kk & 7) * 32 + (c & 31)) * 2; }
__device__ __forceinline__ int v_rd_base(int lane) { return ((lane & 3) << 3) | (((lane >> 2) & 3) << 6) | (((lane >> 4) & 1) << 5) | (((lane >> 5) & 1) << 8); }
constexpr int v_rd_off(int d0, int ks, int half) { return d0 * 512 + ks * 4096 + half * 2048; }
template <int OFF> __device__ __forceinline__ s16x4 tr_read(int vb) {
  s16x4 r; asm volatile("ds_read_b64_tr_b16 %0, %1 offset:%2" : "=&v"(r) : "v"(vb), "i"(OFF) : "memory"); return r;
}
template <int D0> __device__ __forceinline__ void pv_one(f32x16& od, int vb, bf16x8 pa0, bf16x8 pa1, bf16x8 pa2, bf16x8 pa3) {
  const s16x4 l0 = tr_read<v_rd_off(D0, 0, 0)>(vb), h0 = tr_read<v_rd_off(D0, 0, 1)>(vb), l1 = tr_read<v_rd_off(D0, 1, 0)>(vb), h1 = tr_read<v_rd_off(D0, 1, 1)>(vb);
  const s16x4 l2 = tr_read<v_rd_off(D0, 2, 0)>(vb), h2 = tr_read<v_rd_off(D0, 2, 1)>(vb), l3 = tr_read<v_rd_off(D0, 3, 0)>(vb), h3 = tr_read<v_rd_off(D0, 3, 1)>(vb);
  asm volatile("s_waitcnt lgkmcnt(0)" ::: "memory"); SBAR();
#define PK(L, H) (bf16x8){L[0], L[1], L[2], L[3], H[0], H[1], H[2], H[3]}
  od = __builtin_amdgcn_mfma_f32_32x32x16_bf16(PK(l0, h0), pa0, od, 0, 0, 0);
  od = __builtin_amdgcn_mfma_f32_32x32x16_bf16(PK(l1, h1), pa1, od, 0, 0, 0);
  od = __builtin_amdgcn_mfma_f32_32x32x16_bf16(PK(l2, h2), pa2, od, 0, 0, 0);
  od = __builtin_amdgcn_mfma_f32_32x32x16_bf16(PK(l3, h3), pa3, od, 0, 0, 0);
#undef PK
}
__device__ __forceinline__ void pv_d0(f32x16* o, int vb, bf16x8 pa0, bf16x8 pa1, bf16x8 pa2, bf16x8 pa3) {
  pv_one<0>(o[0], vb, pa0, pa1, pa2, pa3); pv_one<1>(o[1], vb, pa0, pa1, pa2, pa3); pv_one<2>(o[2], vb, pa0, pa1, pa2, pa3); pv_one<3>(o[3], vb, pa0, pa1, pa2, pa3);
}

__device__ __forceinline__ int kw_addr(int row, int colB) { return row * 256 + (colB ^ ((row & 15) << 4)); }
__device__ __forceinline__ int kn_addr(int row, int colB) { return row * 128 + (colB ^ (((row >> 1) & 7) << 4)); }
template <int MODE, bool K8 = false>
__device__ __forceinline__ void attn_unit(const bf16* __restrict__ Qb, int ldq, const bf16* __restrict__ Kh, int ldk, const bf16* __restrict__ Kp, const bf16* __restrict__ Vh, int ldv,
                                          int seq, ALAS char* lds, float C, const f32x2* __restrict__ cs, int qpos0, f32x16 (&o)[4], int wave, int lane_in, float kmax2) {
  constexpr int SHM_KW = MODE == 0 ? 64 * 256 : 0, SHM_KN = 64 * 128, SHM_K = SHM_KW + SHM_KN;
  static_assert(SHM_K == L<MODE>::SHM_K, "K buffers");
  const int tid = threadIdx.x, wid = __builtin_amdgcn_readfirstlane(tid >> 6), lane = tid & 63, r32 = lane & 31, hi = lane >> 5;
  const bool late = MODE == 0 ? (wid >= 4) : false;
  ALAS char* V_lds = lds + OFF_V; ALAS char* K_lds = lds + L<MODE>::OFF_K;
  __syncthreads();
  float m_reg = -1e30f, l_reg = 0;
  float mbnd = 0.f;
#pragma unroll
  for (int d = 0; d < 4; ++d) o[d] = f32x16{};
  constexpr int NQR = 4;
  bf16x8 qr[NQR];
  v8i qf[3];
  const bf16* Qw = Qb + (long)(wid * 32 + r32) * ldq + hi * 8;
  float qn2 = 0.f;
  if constexpr (MODE == 1 && !K8) {
#pragma unroll
    for (int d0 = 0; d0 < NQR; ++d0) { qr[d0] = *reinterpret_cast<const bf16x8*>(Qw + d0 * 16);
#pragma unroll
      for (int j = 0; j < 8; ++j) { const float f = bf2f(qr[d0][j]); qn2 = fmaf(f, f, qn2); } }
  } else if constexpr (MODE == 1) {
    const bf16* Qrow = Qb + (long)(wid * 32 + r32) * ldq + 32 * hi;
    bf16x8 tq[4]; int w[8];
#pragma unroll
    for (int c = 0; c < 4; ++c) tq[c] = *reinterpret_cast<const bf16x8*>(Qrow + 8 * c);
#pragma unroll
    for (int c = 0; c < 4; ++c) { float f[8];
#pragma unroll
      for (int j = 0; j < 8; ++j) { f[j] = bf2f(tq[c][j]); qn2 = fmaf(f[j], f[j], qn2); f[j] *= 8.f; }
      int u = 0; u = __builtin_amdgcn_cvt_pk_fp8_f32(f[0], f[1], u, false); u = __builtin_amdgcn_cvt_pk_fp8_f32(f[2], f[3], u, true); w[2 * c] = u;
      u = 0; u = __builtin_amdgcn_cvt_pk_fp8_f32(f[4], f[5], u, false); u = __builtin_amdgcn_cvt_pk_fp8_f32(f[6], f[7], u, true); w[2 * c + 1] = u; }
    qf[0] = (v8i){w[0], w[1], w[2], w[3], w[4], w[5], w[6], w[7]};
  } else {
    const bf16* Qrow = Qb + (long)(wid * 32 + r32) * ldq;
    bf16x8 tn[2][4], x1[4], x2[4];
#pragma unroll
    for (int s = 0; s < 2; ++s)
#pragma unroll
      for (int c = 0; c < 4; ++c) tn[s][c] = *reinterpret_cast<const bf16x8*>(Qrow + 64 * s + 32 * hi + 8 * c);
#pragma unroll
    for (int c = 0; c < 4; ++c) { x1[c] = *reinterpret_cast<const bf16x8*>(Qrow + 128 + 8 * c); x2[c] = *reinterpret_cast<const bf16x8*>(Qrow + 160 + 8 * c); }
    const f32x4* cp = reinterpret_cast<const f32x4*>(cs + (long)(qpos0 + wid * 32 + r32) * 32);
    float q2 = 0.f;
#pragma unroll
    for (int s = 0; s < 2; ++s) { int w[8];
#pragma unroll
      for (int c = 0; c < 4; ++c) { float f[8];
#pragma unroll
        for (int j = 0; j < 8; ++j) { f[j] = bf2f(tn[s][c][j]); q2 = fmaf(f[j], f[j], q2); f[j] *= 8.f; }
        int u = 0; u = __builtin_amdgcn_cvt_pk_fp8_f32(f[0], f[1], u, false); u = __builtin_amdgcn_cvt_pk_fp8_f32(f[2], f[3], u, true); w[2 * c] = u;
        u = 0; u = __builtin_amdgcn_cvt_pk_fp8_f32(f[4], f[5], u, false); u = __builtin_amdgcn_cvt_pk_fp8_f32(f[6], f[7], u, true); w[2 * c + 1] = u; }
      qf[s] = (v8i){w[0], w[1], w[2], w[3], w[4], w[5], w[6], w[7]}; }
    { int w[8];
#pragma unroll
      for (int c = 0; c < 4; ++c) { float f[8];
#pragma unroll
        for (int j = 0; j < 8; j += 2) { const f32x4 cc = cp[(8 * c + j) >> 1];
          const float a0 = bf2f(x1[c][j]), b0 = bf2f(x2[c][j]), a1 = bf2f(x1[c][j + 1]), b1 = bf2f(x2[c][j + 1]);
          f[j] = hi ? (a0 * cc.y + b0 * cc.x) : (a0 * cc.x - b0 * cc.y); f[j + 1] = hi ? (a1 * cc.w + b1 * cc.z) : (a1 * cc.z - b1 * cc.w); }
#pragma unroll
        for (int j = 0; j < 8; ++j) { q2 = fmaf(f[j], f[j], q2); f[j] *= 8.f; }
        int u = 0; u = __builtin_amdgcn_cvt_pk_fp8_f32(f[0], f[1], u, false); u = __builtin_amdgcn_cvt_pk_fp8_f32(f[2], f[3], u, true); w[2 * c] = u;
        u = 0; u = __builtin_amdgcn_cvt_pk_fp8_f32(f[4], f[5], u, false); u = __builtin_amdgcn_cvt_pk_fp8_f32(f[6], f[7], u, true); w[2 * c + 1] = u; }
      qf[2] = (v8i){w[0], w[1], w[2], w[3], w[4], w[5], w[6], w[7]}; }
    { auto rr = __builtin_amdgcn_permlane32_swap(__float_as_uint(q2), __float_as_uint(q2), false, false); q2 = __uint_as_float(rr[0]) + __uint_as_float(rr[1]); }
    mbnd = C * sqrtf(q2 * kmax2) * 1.02f + 1.f;
    if (lane == 0) ((ALAS unsigned*)(lds + OFF_V + 2 * SHM_V))[wid] = __all(mbnd < 56.f) ? 1u : 0u;
  }
  unsigned vsrc[2], kwsrc[2], knsrc;
#pragma unroll
  for (int i = 0; i < 2; ++i) { const int s = (wid + 8 * i) * 64 + lane;
    const int kk = (s >> 7) * 8 + ((s & 31) >> 2), c = ((s >> 5) & 3) * 32 + (s & 3) * 8, k = kk;
    vsrc[i] = (unsigned)(k * ldv + c);
    const int row = s >> 4, ch = (s & 15) ^ (row & 15); kwsrc[i] = (unsigned)(row * ldk + ch * 8); }
  { const int s = wid * 64 + lane, row = s >> 3, ch = (s & 7) ^ ((row >> 1) & 7); knsrc = (unsigned)(row * ldk + ch * 8); }
  unsigned k8src = 0, p8src = 0;
  if constexpr (MODE == 0) { { const int s = wid * 64 + lane, row = s >> 3, ch = (s & 7) ^ ((row >> 1) & 7); k8src = (unsigned)(row * ldk + ch * 16); }
                             { const int s = (wid & 3) * 64 + lane, row = s >> 2, ch = (s & 3) ^ ((row >> 2) & 3); p8src = (unsigned)(row * 64 + ch * 16); } }
  else if constexpr (K8) { const int s = (wid & 3) * 64 + lane, row = s >> 2, ch = (s & 3) ^ ((row >> 2) & 3); p8src = (unsigned)(row * ldk + ch * 16); }
  const bf16* Kn = Kh; const int ldn = ldk;
  const int kaw = (int)(unsigned)(uintptr_t)K_lds + (MODE == 0 ? r32 * 128 + (((2 * hi) ^ ((r32 >> 1) & 7)) << 4) : 0);
  const int kan = (int)(unsigned)(uintptr_t)K_lds + SHM_KW + ((MODE == 0 || K8) ? r32 * 64 + (((2 * hi) ^ ((r32 >> 2) & 3)) << 4) : kn_addr(r32, hi * 16));
#define DMA16(src, dst) __builtin_amdgcn_global_load_lds((const unsigned*)(src), (ALAS unsigned*)(dst), 16, 0, 0)
#define DMA_V(t, b) do { const bf16* vb_ = Vh + (long)(t) * 64 * ldv; DMA16(vb_ + vsrc[0], V_lds + (b) * SHM_V + wid * 1024); DMA16(vb_ + vsrc[1], V_lds + (b) * SHM_V + (wid + 8) * 1024); } while (0)
#define DMA_K(t, b) do { if constexpr (MODE == 0) { DMA16((const char*)Kh + (long)(t) * 64 * ldk + k8src, K_lds + (b) * SHM_K + wid * 1024); \
      if (wid < 4) DMA16((const char*)Kp + (long)(t) * 64 * 64 + p8src, K_lds + (b) * SHM_K + SHM_KW + wid * 1024); } \
    else if constexpr (K8) { if (wid < 4) DMA16((const char*)Kh + (long)(t) * 64 * ldk + p8src, K_lds + (b) * SHM_K + wid * 1024); } \
    else DMA16(Kn + (long)(t) * 64 * ldn + knsrc, K_lds + (b) * SHM_K + SHM_KW + wid * 1024); } while (0)
#define STEP_END() do { asm volatile("s_waitcnt vmcnt(0)" ::: "memory"); __syncthreads(); } while (0)
#define QKT(P0, P1, b) do { int aw_ = kaw, an_ = kan; \
    if constexpr (MODE == 0) { asm volatile("" : "+v"(aw_), "+v"(an_));     \
      P0 = f32x16{}; P1 = f32x16{}; \
      _Pragma("unroll") for (int s = 0; s < 3; ++s) { const int x_ = s < 2 ? (aw_ ^ (64 * s)) : an_; const int half_ = s < 2 ? 4096 : 2048; \
        const ALAS char* p0_ = (const ALAS char*)(unsigned)x_ + (b) * SHM_K; const ALAS char* p1_ = (const ALAS char*)(unsigned)(x_ ^ 16) + (b) * SHM_K; \
        const u32x4 a0_ = *reinterpret_cast<const ALAS u32x4*>(p0_), a1_ = *reinterpret_cast<const ALAS u32x4*>(p1_); \
        const u32x4 b0_ = *reinterpret_cast<const ALAS u32x4*>(p0_ + half_), b1_ = *reinterpret_cast<const ALAS u32x4*>(p1_ + half_); \
        const v8i ka_ = (v8i){(int)a0_.x, (int)a0_.y, (int)a0_.z, (int)a0_.w, (int)a1_.x, (int)a1_.y, (int)a1_.z, (int)a1_.w}; \
        const v8i kb_ = (v8i){(int)b0_.x, (int)b0_.y, (int)b0_.z, (int)b0_.w, (int)b1_.x, (int)b1_.y, (int)b1_.z, (int)b1_.w}; \
        P0 = __builtin_amdgcn_mfma_scale_f32_32x32x64_f8f6f4(ka_, qf[s], P0, 0, 0, 0, 0x7f7f7f7f, 0, 0x7c7c7c7c); \
        P1 = __builtin_amdgcn_mfma_scale_f32_32x32x64_f8f6f4(kb_, qf[s], P1, 0, 0, 0, 0x7f7f7f7f, 0, 0x7c7c7c7c); } } \
    else if constexpr (!K8) { asm volatile("" : "+v"(an_)); \
    _Pragma("unroll") for (int d0 = 0; d0 < 4; ++d0) { const ALAS char* p_ = (const ALAS char*)(unsigned)(an_ ^ (d0 * 32)) + (b) * SHM_K; \
        const bf16x8 b0 = *reinterpret_cast<const ALAS bf16x8*>(p_); const bf16x8 b1 = *reinterpret_cast<const ALAS bf16x8*>(p_ + 32 * 128); \
        const bf16x8 qf_ = qr[d0]; \
        if (d0 == 0) { P0 = __builtin_amdgcn_mfma_f32_32x32x16_bf16(b0, qf_, ci, 0, 0, 0); P1 = __builtin_amdgcn_mfma_f32_32x32x16_bf16(b1, qf_, ci, 0, 0, 0); } \
        else { P0 = __builtin_amdgcn_mfma_f32_32x32x16_bf16(b0, qf_, P0, 0, 0, 0); P1 = __builtin_amdgcn_mfma_f32_32x32x16_bf16(b1, qf_, P1, 0, 0, 0); } } } \
    else { asm volatile("" : "+v"(an_)); \
      const ALAS char* p0_ = (const ALAS char*)(unsigned)an_ + (b) * SHM_K; const ALAS char* p1_ = (const ALAS char*)(unsigned)(an_ ^ 16) + (b) * SHM_K; \
      const u32x4 a0_ = *reinterpret_cast<const ALAS u32x4*>(p0_), a1_ = *reinterpret_cast<const ALAS u32x4*>(p1_); \
      const u32x4 b0_ = *reinterpret_cast<const ALAS u32x4*>(p0_ + 2048), b1_ = *reinterpret_cast<const ALAS u32x4*>(p1_ + 2048); \
      const v8i ka_ = (v8i){(int)a0_.x, (int)a0_.y, (int)a0_.z, (int)a0_.w, (int)a1_.x, (int)a1_.y, (int)a1_.z, (int)a1_.w}; \
      const v8i kb_ = (v8i){(int)b0_.x, (int)b0_.y, (int)b0_.z, (int)b0_.w, (int)b1_.x, (int)b1_.y, (int)b1_.z, (int)b1_.w}; \
      P0 = __builtin_amdgcn_mfma_scale_f32_32x32x64_f8f6f4(ka_, qf[0], ci, 0, 0, 0, 0x7f7f7f7f, 0, 0x7c7c7c7c); \
      P1 = __builtin_amdgcn_mfma_scale_f32_32x32x64_f8f6f4(kb_, qf[0], ci, 0, 0, 0, 0x7f7f7f7f, 0, 0x7c7c7c7c); } } while (0)
#define CIUPD(TILE, FASTV) do { if constexpr (MODE == 1) { if (FASTV) { const int k0_ = (TILE) * 64; const bool far_ = (k0_ >= qw + 122) || (k0_ + 154 <= qw); const int sd_ = far_ ? (k0_ > qw ? 2 : 1) : 0; \
      if (sd_ != side) { asm volatile("" ::: "memory");   side = sd_; const float cm_ = (sd_ == 0 ? 0.f : (sd_ == 2 ? cpos : cneg)) - mbnd; _Pragma("unroll") for (int r = 0; r < 16; ++r) ci[r] = cm_; } } } } while (0)
#define QKTJ(P0, P1, b, TILE, FASTV) do { CIUPD(TILE, FASTV); QKT(P0, P1, b); } while (0)
#define RESC(a) do { if (__any((a) < 1.f)) { \
    _Pragma("unroll") for (int d = 0; d < 4; ++d) _Pragma("unroll") for (int r = 0; r < 16; ++r) o[d][r] *= (a); } } while (0)
  const int vb0 = (int)(unsigned)(uintptr_t)V_lds + v_rd_base(lane);
  const int qw = qpos0 + wid * 32;
  const ALAS float* lutb = (const ALAS float*)(lds + OFF_LUT);
  const ALAS float* lutp = lutb + (2047 - (qw + r32) + 4 * hi);
  float cpos = 0.f, cneg = 0.f; bool fast = false;
#define PSM(P0, P1, MN, AL, TILE) PSMX(P0, P1, MN, AL, TILE, 0)
#define PSMX(P0, P1, MN, AL, TILE, FASTV) do { if constexpr (MODE == 0) { if (FASTV) { AL = 1.f; partialSM_acc<false>(P0, P1, lutp);   } else partialSM<false>(P0, P1, m_reg, MN, AL, C, lutp, 0.f); } else { const int k0_ = (TILE) * 64; const bool far_ = (k0_ >= qw + 122) || (k0_ + 154 <= qw); \
    if (FASTV) { AL = 1.f; if (far_) partialSM_acc<false>(P0, P1, lutp); else partialSM_acc<true>(P0, P1, lutp + k0_); } \
    else if (far_) partialSM<false>(P0, P1, m_reg, MN, AL, C, lutp, k0_ > qw ? cpos : cneg); else partialSM<true>(P0, P1, m_reg, MN, AL, C, lutp + k0_, 0.f); } } while (0)
  f32x16 ci = f32x16{}; int side = -1;
  f32x16 pA0, pA1; float mnA, alA; bf16x8 pa0, pa1, pa2, pa3; const int NT = seq / 64;
  if constexpr (MODE == 0 && !MLA_PD2) {
    DMA_K(0, 0); DMA_V(0, 0); STEP_END();
    int vbj = 0, vbp = 0;
    if (!late) {
      for (int j = 0; j < NT; ++j) {
        const int kb = j & 1, vbn = vbj == 2 ? 0 : vbj + 1;
        if (j + 1 < NT) { DMA_K(j + 1, kb ^ 1); DMA_V(j + 1, vbn); }
        SBAR();
        QKT(pA0, pA1, kb); PSM(pA0, pA1, mnA, alA, j);
        RESC(alA);
        finishSM(pA0, pA1, alA, l_reg, pa0, pa1, pa2, pa3); SBAR();
        pv_d0(o, vb0 + vbj * SHM_V, pa0, pa1, pa2, pa3);
        STEP_END();
        vbp = vbj; vbj = vbn;
      }
    } else {
      for (int j = 0; j < NT; ++j) {
        const int kb = j & 1, vbn = vbj == 2 ? 0 : vbj + 1;
        if (j + 1 < NT) { DMA_K(j + 1, kb ^ 1); DMA_V(j + 1, vbn); }
        if (j > 0) {
          PSM(pA0, pA1, mnA, alA, j - 1);
          RESC(alA);
          finishSM(pA0, pA1, alA, l_reg, pa0, pa1, pa2, pa3); SBAR();
          pv_d0(o, vb0 + vbp * SHM_V, pa0, pa1, pa2, pa3);
        }
        SBAR();
        QKT(pA0, pA1, kb);
        STEP_END();
        vbp = vbj; vbj = vbn;
      }
      PSM(pA0, pA1, mnA, alA, NT - 1);
      RESC(alA);
      finishSM(pA0, pA1, alA, l_reg, pa0, pa1, pa2, pa3); SBAR();
      pv_d0(o, vb0 + vbp * SHM_V, pa0, pa1, pa2, pa3);
    }
  } else {
    f32x16 pB0, pB1; float mnB, alB;
    DMA_K(0, 0); STEP_END();
    if constexpr (MODE == 1) {
    cpos = lutb[2047 + 128]; cneg = lutb[2047 - 128];
    { float q2 = qn2;
      { auto rr = __builtin_amdgcn_permlane32_swap(__float_as_uint(q2), __float_as_uint(q2), false, false); q2 = __uint_as_float(rr[0]) + __uint_as_float(rr[1]); }
      mbnd = C * sqrtf(q2 * kmax2) * 1.02f + lutb[4095] + 1.f;
      fast = __all(mbnd < 56.f); }
    }
#define DIFF_LOOP(LATE, FASTV) do { \
      \
    DMA_K(1, 1); DMA_V(0, 0); \
    QKTJ(pA0, pA1, 0, 0, FASTV); \
    if (!(LATE)) { PSMX(pA0, pA1, mnA, alA, 0, FASTV); } \
    STEP_END(); \
    for (int j = 1; j + 1 < NT; j += 2) { \
        \
      DMA_K(j + 1, 0); DMA_V(j, 1); \
      if (LATE) { PSMX(pA0, pA1, mnA, alA, j - 1, FASTV); RESC(alA); } \
      SBAR(); QKTJ(pB0, pB1, 1, j, FASTV); \
      finishSM(pA0, pA1, alA, l_reg, pa0, pa1, pa2, pa3); SBAR(); \
      pv_d0(o, vb0, pa0, pa1, pa2, pa3); \
      if (!(LATE)) { PSMX(pB0, pB1, mnB, alB, j, FASTV); RESC(alB); } \
      STEP_END(); \
        \
      DMA_K(j + 2, 1); DMA_V(j + 1, 0); \
      if (LATE) { PSMX(pB0, pB1, mnB, alB, j, FASTV); RESC(alB); } \
      SBAR(); QKTJ(pA0, pA1, 0, j + 1, FASTV); \
      finishSM(pB0, pB1, alB, l_reg, pa0, pa1, pa2, pa3); SBAR(); \
      pv_d0(o, vb0 + SHM_V, pa0, pa1, pa2, pa3); \
      if (!(LATE)) { PSMX(pA0, pA1, mnA, alA, j + 1, FASTV); RESC(alA); } \
      STEP_END(); \
    } \
      \
    DMA_V(NT - 1, 1); \
    if (LATE) { PSMX(pA0, pA1, mnA, alA, NT - 2, FASTV); RESC(alA); } \
    SBAR(); QKTJ(pB0, pB1, 1, NT - 1, FASTV); \
    finishSM(pA0, pA1, alA, l_reg, pa0, pa1, pa2, pa3); SBAR(); \
    pv_d0(o, vb0, pa0, pa1, pa2, pa3); \
    PSMX(pB0, pB1, mnB, alB, NT - 1, FASTV); RESC(alB); \
    STEP_END(); \
    finishSM(pB0, pB1, alB, l_reg, pa0, pa1, pa2, pa3); SBAR(); \
    pv_d0(o, vb0 + SHM_V, pa0, pa1, pa2, pa3); } while (0)
    if constexpr (MODE == 0) { const u32x4 v0_ = *(const ALAS u32x4*)(lds + OFF_V + 2 * SHM_V), v1_ = *(const ALAS u32x4*)(lds + OFF_V + 2 * SHM_V + 16);
      const bool fastu = __builtin_amdgcn_readfirstlane((v0_.x & v0_.y & v0_.z & v0_.w & v1_.x & v1_.y & v1_.z & v1_.w)) != 0u;
      if (fastu) DIFF_LOOP(false, 1); else DIFF_LOOP(false, 0); }
    else { if (fast) DIFF_LOOP(false, 1); else DIFF_LOOP(false, 0); }
#undef DIFF_LOOP
  }
  { const float rl = __builtin_amdgcn_rcpf(l_reg);
#pragma unroll
    for (int d = 0; d < 4; ++d)
#pragma unroll
      for (int r = 0; r < 16; ++r) o[d][r] *= rl; }
#undef DMA16
#undef DMA_V
#undef DMA_K
#undef STEP_END
#undef QKT
#undef RESC
#undef PSM
}
}
#define XB_TMO      128
#define XB_XCNT(j)  (256  + 64 * (j))
#define XB_XSUB(j)  (1280 + 64 * (j))
#define XB_XGEN(j)  (2304 + 64 * (j))
#define XB_TOP      3328
#define XB_TOPGEN   3392
#define XCD_BAR_WORDS 3456
#define XB_SPIN_CAP (1u << 18)
#define LAS __attribute__((address_space(3)))

__device__ __forceinline__ unsigned xb_ld(unsigned* p)              { return __hip_atomic_load(p, __ATOMIC_RELAXED, __HIP_MEMORY_SCOPE_AGENT); }
__device__ __forceinline__ unsigned xb_add(unsigned* p, unsigned v) { return __hip_atomic_fetch_add(p, v, __ATOMIC_RELAXED, __HIP_MEMORY_SCOPE_AGENT); }
__device__ __forceinline__ unsigned xb_xcc_id() { return (unsigned)__builtin_amdgcn_s_getreg((3 << 11) | 20) & 0xFu; }
#define XB_SPIN(cond, bar) do { unsigned _sp = 0; while (cond) { __builtin_amdgcn_s_sleep(1); \
    if ((++_sp & 255u) == 0u) { if (xb_ld(&(bar)[XB_TMO])) break; if (_sp > XB_SPIN_CAP) { atomicAdd(&(bar)[XB_TMO], 1u); break; } } } } while (0)

struct XcdBarrier {
    unsigned* bar; unsigned x, w;
    volatile LAS unsigned* st;
};

__device__ __forceinline__ XcdBarrier xcd_barrier_post(unsigned* bar, volatile LAS unsigned* st, unsigned wave) {
    XcdBarrier b; b.bar = bar; b.x = xb_xcc_id(); b.st = st; b.w = wave;
    if (wave == 0 && hw_lane() == 0) (void)xb_add(&bar[XB_XCNT(b.x)], 1u);
    return b;
}
__device__ __forceinline__ void xcd_barrier_complete(unsigned* bar, unsigned x, unsigned& nloc, unsigned& nx) {
    const unsigned G = gridDim.x * gridDim.y * gridDim.z;
    unsigned sum, cnt, mine, sp = 0u;
    for (;;) {
        sum = 0u; cnt = 0u; mine = 0u;
#pragma unroll
        for (unsigned j = 0; j < 16; ++j) { const unsigned c = xb_ld(&bar[XB_XCNT(j)]); sum += c; cnt += (c > 0u) ? 1u : 0u; mine = (j == x) ? c : mine; }
        if (sum == G) break;
        __builtin_amdgcn_s_sleep(1);
        if ((++sp & 255u) == 0u) { if (xb_ld(&bar[XB_TMO])) break; if (sp > XB_SPIN_CAP) { atomicAdd(&bar[XB_TMO], 1u); break; } }
    }
    nloc = mine > 0u ? mine : 1u; nx = cnt > 0u ? cnt : 1u;
}

__device__ __forceinline__ void xcd_barrier(const XcdBarrier& b) {
    asm volatile("s_waitcnt vmcnt(0)" ::: "memory");
    __syncthreads();
    if (b.w == 0 && hw_lane() == 0) {
        unsigned* bar = b.bar;
        __builtin_amdgcn_s_waitcnt(0);
        unsigned nloc = b.st[0], nx = b.st[1];
        if (nloc == 0u) { xcd_barrier_complete(bar, b.x, nloc, nx); b.st[0] = nloc; b.st[1] = nx; }
        const unsigned old = xb_add(&bar[XB_XSUB(b.x)], 1u);
        const unsigned gen = old / nloc;
        if (old + 1u == (gen + 1u) * nloc) {
            __builtin_amdgcn_fence(__ATOMIC_RELEASE, "agent");
            asm volatile("s_waitcnt vmcnt(0)" ::: "memory");
            const unsigned og = xb_add(&bar[XB_TOP], 1u);
            const unsigned tg = og / nx;
            if (og + 1u == (tg + 1u) * nx) xb_add(&bar[XB_TOPGEN], 1u);
            else XB_SPIN(xb_ld(&bar[XB_TOPGEN]) == tg, bar);
            __builtin_amdgcn_fence(__ATOMIC_ACQUIRE, "agent");
            xb_add(&bar[XB_XGEN(b.x)], 1u);
            asm volatile("s_waitcnt vmcnt(0)" ::: "memory");
        } else {
            XB_SPIN(xb_ld(&bar[XB_XGEN(b.x)]) == gen, bar);
            __builtin_amdgcn_fence(__ATOMIC_ACQUIRE, "agent");
            asm volatile("s_waitcnt vmcnt(0)" ::: "memory");
        }
    }
    __syncthreads();
}


constexpr int NB = 32, SEQ = 2048, T = NB * SEQ, D = 1024, IN_COLS = 1984, PROJ_LD = 2048;
constexpr int NE = 32, TOPK = 4, NA = T * TOPK, HALF_T = T / 2, HALF_A = NA / 2;
constexpr int ROWS_ALL = NA + NE * 256, TILES_MAX = ROWS_ALL / 256;
constexpr float NORM_EPS = 1e-5f, LOG2E = 1.4426950408889634f;
constexpr float SC_W6 = 32.f, SC_X6 = 1.f;
constexpr float SC_W = 64.f, SC_X = 4.f, SC_A = 4.f, SC_Y = 16.f;
constexpr int NWAVES = 8, NTHREADS = 512;

constexpr size_t KiB = 1024, MiB = 1u << 20;
constexpr size_t WS_CTL = 0, CTL_ZERO_BYTES = 64 * KiB;
constexpr size_t WS_KN = 34 * KiB;
constexpr size_t WS_KMAX = 32 * KiB;
constexpr size_t WS_ROPE = 1 * MiB;
constexpr size_t WS_BIAS = 1 * MiB + 512 * KiB;
constexpr size_t WS_LAM = 1 * MiB + 768 * KiB;
constexpr size_t WS_RINV = 2 * MiB;
constexpr size_t WS_EIDX = 3 * MiB, WS_GATE = 4 * MiB, WS_LRANK = 5 * MiB;
constexpr size_t WS_HIST = 6 * MiB;
constexpr size_t WS_ROWA = 7 * MiB, WS_ROWG = 9 * MiB;
constexpr size_t WS_ROWRI = 14 * MiB;
constexpr size_t WS_TINFO = 11 * MiB;
constexpr size_t WS_WRH = 12 * MiB, WS_WRL = 12 * MiB + 64 * KiB;
constexpr size_t WS_WUQ = 13 * MiB, WS_WUKV = 13 * MiB + 512 * KiB;
constexpr size_t WS_WIN = 16 * MiB, WS_WO = 20 * MiB;
constexpr size_t WS_WD8 = 24 * MiB, WS_WGU8 = 56 * MiB;
constexpr size_t WS_XB = 120 * MiB;
constexpr size_t WS_XB8 = 248 * MiB;
constexpr size_t WS_PROJ = 312 * MiB, WS_QM = 568 * MiB, WS_KV = 664 * MiB, WS_MIXED = 792 * MiB, WS_CQN = 920 * MiB, WS_CKVN = 952 * MiB, WS_KPE = 968 * MiB;
constexpr size_t WS_ACT8 = 312 * MiB, WS_Y48 = 576 * MiB;
constexpr size_t WS_KD8 = 248 * MiB;
constexpr size_t WS_KN8 = 976 * MiB, WS_KPE8 = 1008 * MiB;
constexpr size_t WS_END = 1012 * MiB;
static_assert(WS_ACT8 + (size_t)ROWS_ALL * 1024 <= WS_Y48 && WS_Y48 + (size_t)NA * 1024 <= WS_CQN && WS_ROWA + (size_t)ROWS_ALL * 4 <= WS_ROWG && WS_ROWG + (size_t)ROWS_ALL * 4 <= WS_TINFO, "ws map");

constexpr int SCRATCH_BYTES = 141312;
constexpr int MISC_OFF = SCRATCH_BYTES;
constexpr int LDS_BYTES = SCRATCH_BYTES + 1024;
static_assert(att::ATT_LDS <= SCRATCH_BYTES && pg8::STAGE_BYTES <= SCRATCH_BYTES, "LDS map");

#define GAS __attribute__((address_space(1)))
typedef unsigned short bf16;
typedef float f32x4 __attribute__((ext_vector_type(4)));
typedef float f32x2 __attribute__((ext_vector_type(2)));
typedef unsigned u32x4 __attribute__((ext_vector_type(4)));
typedef unsigned u32x2 __attribute__((ext_vector_type(2)));
typedef short bf16x8 __attribute__((ext_vector_type(8)));
typedef float f32x16 __attribute__((ext_vector_type(16)));
#define LDS_WAIT() asm volatile("s_waitcnt lgkmcnt(0)" ::: "memory")
#define VM_WAIT() asm volatile("s_waitcnt vmcnt(0)" ::: "memory")
__device__ __forceinline__ unsigned pk2(float lo, float hi) { return pg8::cvt_pk_bf16(lo, hi); }
__device__ __forceinline__ unsigned cvt8(float a, float b, float c, float d) { int w = 0; w = __builtin_amdgcn_cvt_pk_fp8_f32(a, b, w, false); w = __builtin_amdgcn_cvt_pk_fp8_f32(c, d, w, true); return (unsigned)w; }
__device__ __forceinline__ float bf2f(unsigned short v) { return __uint_as_float(((unsigned)v) << 16); }
__device__ __forceinline__ float wave_sum(float v) {
#pragma unroll
    for (int o = 1; o < 64; o <<= 1) v += __shfl_xor(v, o);
    return v;
}

struct Args {
    const float* in[22]; float* out; unsigned char* ws; int ph_lo, ph_hi;
};

template <bool F8OUT, class RowMap>
__device__ __forceinline__ void transpose_item(const float* W, int K, int N, void* WTv, LAS float* scr, int item, int lane, const float* kscale, RowMap rm, float nscale = 1.f, int nsplit = 0) {
    const int nblk = N / 32, kb = item / nblk, nb = item % nblk, k0 = 64 * kb, n0 = 32 * nb;
    float v[32];
#pragma unroll
    for (int i = 0; i < 32; ++i) v[i] = W[(size_t)(k0 + 2 * i + (lane >> 5)) * N + n0 + (lane & 31)];
    if (kscale) {
#pragma unroll
        for (int i = 0; i < 32; ++i) v[i] *= kscale[k0 + 2 * i + (lane >> 5)];
    }
    if (n0 < nsplit) {
#pragma unroll
        for (int i = 0; i < 32; ++i) v[i] *= nscale;
    }
    if constexpr (F8OUT) {
#pragma unroll
        for (int i = 0; i < 32; ++i) v[i] *= SC_W;
    }
#pragma unroll
    for (int i = 0; i < 32; ++i) scr[(2 * i + (lane >> 5)) * 33 + (lane & 31)] = v[i];
    LDS_WAIT(); asm volatile("" ::: "memory");
    const int c = lane & 7;
#pragma unroll
    for (int j = 0; j < 4; ++j) { const int n = (lane >> 3) + 8 * j; const LAS float* s = scr + (8 * c) * 33 + n;
        if constexpr (F8OUT) { u32x2 o; o.x = cvt8(s[0 * 33], s[1 * 33], s[2 * 33], s[3 * 33]); o.y = cvt8(s[4 * 33], s[5 * 33], s[6 * 33], s[7 * 33]);
            *(u32x2*)((unsigned char*)WTv + (size_t)rm(n0 + n) * K + k0 + 8 * c) = o; }
        else { u32x4 o; o.x = pk2(s[0 * 33], s[1 * 33]); o.y = pk2(s[2 * 33], s[3 * 33]); o.z = pk2(s[4 * 33], s[5 * 33]); o.w = pk2(s[6 * 33], s[7 * 33]);
            *(u32x4*)((bf16*)WTv + (size_t)rm(n0 + n) * K + k0 + 8 * c) = o; } }
    LDS_WAIT(); asm volatile("" ::: "memory");
}
template <class RowMap>
__device__ __forceinline__ void transpose_item8(const float* W, int K, int N, unsigned char* WT, LAS float* scr, int item, int lane, const float* kscale, RowMap rm) {
    const int nblk = N / 64, kb = item / nblk, nb = item % nblk, k0 = 64 * kb, n0 = 64 * nb;
    const int lr = lane >> 4, lc = (lane & 15) * 4;
    f32x4 v[16];
#pragma unroll
    for (int i = 0; i < 16; ++i) v[i] = *(const f32x4*)(W + (size_t)(k0 + 4 * i + lr) * N + n0 + lc);
#pragma unroll
    for (int i = 0; i < 16; ++i) { const float sc = (kscale ? kscale[k0 + 4 * i + lr] : 1.f) * SC_W; LAS float* d = scr + (4 * i + lr) * 65 + lc;
        d[0] = v[i].x * sc; d[1] = v[i].y * sc; d[2] = v[i].z * sc; d[3] = v[i].w * sc; }
    LDS_WAIT(); asm volatile("" ::: "memory");
    const int c = lane & 3;
#pragma unroll
    for (int j = 0; j < 4; ++j) { const int n = (lane >> 2) + 16 * j; const LAS float* s = scr + (16 * c) * 65 + n;
        u32x4 o; o.x = cvt8(s[0 * 65], s[1 * 65], s[2 * 65], s[3 * 65]); o.y = cvt8(s[4 * 65], s[5 * 65], s[6 * 65], s[7 * 65]);
        o.z = cvt8(s[8 * 65], s[9 * 65], s[10 * 65], s[11 * 65]); o.w = cvt8(s[12 * 65], s[13 * 65], s[14 * 65], s[15 * 65]);
        *(u32x4*)(WT + (size_t)rm(n0 + n) * K + k0 + 16 * c) = o; }
    LDS_WAIT(); asm volatile("" ::: "memory");
}
struct RmId { __device__ __forceinline__ int operator()(int n) const { return n; } };
typedef float v16f __attribute__((ext_vector_type(16)));
typedef int v6i __attribute__((ext_vector_type(6)));
__device__ __forceinline__ v6i cvt_fp6x32(v16f a, v16f b) { v6i r; asm volatile("v_cvt_scalef32_2xpk16_fp6_f32 %0, %1, %2, 1.0\n\ts_nop 7\n\ts_nop 7" : "=&v"(r) : "v"(a), "v"(b)); return r; }
__device__ __forceinline__ void store_fp6_block(unsigned char* blk, v6i pk, bool odd) {
    asm volatile("s_nop 7\n\ts_nop 7" : "+v"(pk));
    u32x4 a, b;
    if (!odd) { a = (u32x4){(unsigned)pk[0], (unsigned)pk[1], (unsigned)pk[2], (unsigned)pk[3]}; b = (u32x4){(unsigned)pk[4], (unsigned)pk[5], 0u, 0u}; }
    else      { a = (u32x4){(unsigned)pk[4], (unsigned)pk[5], 0u, 0u}; b = (u32x4){(unsigned)pk[0], (unsigned)pk[1], (unsigned)pk[2], (unsigned)pk[3]}; }
    *(u32x4*)blk = a; *(u32x4*)(blk + 16) = b;
}
template <class RowMap>
__device__ __forceinline__ void transpose_item6(const float* W, int K, int N, unsigned char* WT, LAS float* scr, int item, int lane, const float* kscale, RowMap rm) {
    const int nblk = N / 64, kb = item / nblk, nb = item % nblk, k0 = 64 * kb, n0 = 64 * nb;
    const int lr = lane >> 4, lc = (lane & 15) * 4;
    f32x4 v[16];
#pragma unroll
    for (int i = 0; i < 16; ++i) v[i] = *(const f32x4*)(W + (size_t)(k0 + 4 * i + lr) * N + n0 + lc);
#pragma unroll
    for (int i = 0; i < 16; ++i) { const float sc = (kscale ? kscale[k0 + 4 * i + lr] : 1.f) * SC_W6; LAS float* d = scr + (4 * i + lr) * 65 + lc;
        d[0] = v[i].x * sc; d[1] = v[i].y * sc; d[2] = v[i].z * sc; d[3] = v[i].w * sc; }
    LDS_WAIT(); asm volatile("" ::: "memory");
    const int c = lane & 1;
#pragma unroll
    for (int j = 0; j < 2; ++j) { const int n = (lane >> 1) + 32 * j; const LAS float* s = scr + (32 * c) * 65 + n;
        v16f a, b;
#pragma unroll
        for (int e = 0; e < 16; ++e) { a[e] = s[e * 65]; b[e] = s[(16 + e) * 65]; }
        const v6i pk = cvt_fp6x32(a, b);
        const int blk = (k0 >> 5) + c;
        store_fp6_block(WT + (size_t)rm(n0 + n) * K + blk * 32, pk, (blk & 1) != 0); }
    LDS_WAIT(); asm volatile("" ::: "memory");
}
struct RmGu { __device__ __forceinline__ int operator()(int n) const { const int up = n >> 10, j = n & 1023; return 256 * (j >> 7) + 128 * up + (j & 127); } };

__device__ __forceinline__ void rms_row_to_bf16(const float* xrow, const float* g, bf16* orow, int lane) {
    const f32x4* xr = (const f32x4*)xrow + lane; const f32x4* gr = (const f32x4*)g + lane;
    f32x4 v[4]; float s = 0.f;
#pragma unroll
    for (int j = 0; j < 4; ++j) { v[j] = xr[64 * j]; s += (v[j].x * v[j].x + v[j].y * v[j].y) + (v[j].z * v[j].z + v[j].w * v[j].w); }
    const float r = 1.f / sqrtf(wave_sum(s) * (1.f / D) + NORM_EPS);
    u32x2* o8 = (u32x2*)orow + lane;
#pragma unroll
    for (int j = 0; j < 4; ++j) { const f32x4 gg = gr[64 * j]; u32x2 w; w.x = pk2(v[j].x * r * gg.x, v[j].y * r * gg.y); w.y = pk2(v[j].z * r * gg.z, v[j].w * r * gg.w); o8[64 * j] = w; }
}
__device__ __forceinline__ int t5_bucket(int rel) {
    const int n = rel < 0 ? -rel : rel; int b;
    if (n < 8) b = n; else { const int n2 = n * n; b = n2 >= 8192 ? 15 : n2 >= 4096 ? 14 : n2 >= 2048 ? 13 : n2 >= 1024 ? 12 : n2 >= 512 ? 11 : n2 >= 256 ? 10 : n2 >= 128 ? 9 : 8; }
    return (rel > 0 ? 16 : 0) + b;
}
__device__ __forceinline__ void p0_prologue(const Args& a, LAS unsigned char* lds, int vcu, int G, int wave, int lane) {
    unsigned char* ws = a.ws;
    LAS float* scr = (LAS float*)(lds + wave * 16896);
    const int gw = vcu * NWAVES + wave, NGW = G * NWAVES;
    const float* ffn_g = a.in[14];
    constexpr int I_IN = 16 * 62, I_UQ = 4 * 24, I_UKV = 2 * 32, I_O = 16 * 32, I_GU1 = 16 * 32, I_GU = NE * I_GU1, I_D1 = 16 * 16, I_D = NE * I_D1;
    constexpr int NITEMS = I_IN + I_UQ + I_UKV + I_O + I_GU + I_D;
    for (int it = gw; it < NITEMS; it += NGW) {
        int r = it;
        if (r < I_GU) { const int e = r / I_GU1; transpose_item6(a.in[17] + (size_t)e * 1024 * 2048, 1024, 2048, ws + WS_WGU8 + (size_t)e * 2048 * 1024, scr, r % I_GU1, lane, ffn_g, RmGu{}); continue; } r -= I_GU;
        if (r < I_D) { const int e = r / I_D1; transpose_item8(a.in[19] + (size_t)e * 1024 * 1024, 1024, 1024, ws + WS_WD8 + (size_t)e * 1024 * 1024, scr, r % I_D1, lane, nullptr, RmId{}); continue; } r -= I_D;
        if (r < I_IN) { transpose_item<false>(a.in[3], 1024, IN_COLS, (bf16*)(ws + WS_WIN), scr, r, lane, nullptr, RmId{}, 0.125f * LOG2E, 512); continue; } r -= I_IN;
        if (r < I_O) { transpose_item<false>(a.in[13], 1024, 1024, (bf16*)(ws + WS_WO), scr, r, lane, nullptr, RmId{}); continue; } r -= I_O;
        if (r < I_UQ) { transpose_item<false>(a.in[10], 256, 768, (bf16*)(ws + WS_WUQ), scr, r, lane, nullptr, RmId{}, 0.07216878364870322f * LOG2E, 768); continue; } r -= I_UQ;
        transpose_item<false>(a.in[12], 128, 1024, (bf16*)(ws + WS_WUKV), scr, r, lane, nullptr, RmId{});
    }
    const int gt = gw * 64 + lane, NGT = NGW * 64;
    for (int i = gt; i < 64 * 1024 / 8; i += NGT) *((u32x4*)((bf16*)(ws + WS_WIN) + (size_t)IN_COLS * 1024) + i) = (u32x4){0u, 0u, 0u, 0u};
    for (int i = gt; i < 1024 * NE; i += NGT) { const int k = i >> 5, e = i & 31; const float w = a.in[15][i] * ffn_g[k];
        const unsigned h = pk2(w, 0.f) & 0xffffu; const float wl = w - bf2f((unsigned short)h);
        ((bf16*)(ws + WS_WRH))[e * 1024 + k] = (bf16)h; ((bf16*)(ws + WS_WRL))[e * 1024 + k] = (bf16)(pk2(wl, 0.f) & 0xffffu); }
    for (int i = gt; i < SEQ * 32; i += NGT) { const int pos = i >> 5, fi = i & 31;
        const float inv = (float)::exp2(-(double)fi * (13.287712379549449 / 32.0)); const float ang = (float)pos * inv;
        double tt = (double)ang * 0.15915494309189535; tt -= __builtin_rint(tt); const double rr = tt * 6.283185307179586, r2 = rr * rr;
        double cs_ = 1.0, sn = rr, term_c = 1.0, term_s = rr;
#pragma unroll
        for (int k = 1; k <= 13; ++k) { term_c *= -r2 / (double)((2 * k - 1) * (2 * k)); term_s *= -r2 / (double)((2 * k) * (2 * k + 1)); cs_ += term_c; sn += term_s; }
        ((f32x2*)(ws + WS_ROPE))[i] = (f32x2){(float)cs_, (float)sn}; }
    for (int i = gt; i < 8 * 4096; i += NGT) { const int m = i >> 12, d = i & 4095; float v; if (d < 4095) v = a.in[1][t5_bucket(d - 2047) * 8 + m] * LOG2E; else { v = -3.0e38f; for (int b = 0; b < 32; ++b) v = fmaxf(v, a.in[1][b * 8 + m] * LOG2E); }
        ((float*)(ws + WS_BIAS))[i] = v; }
    if (gw == 0) { const float s1 = wave_sum(a.in[4][lane] * a.in[5][lane]), s2 = wave_sum(a.in[6][lane] * a.in[7][lane]);
        if (lane == 0) *(float*)(ws + WS_LAM) = __expf(s1) - __expf(s2) + 0.2f; }
    for (int m = gw; m < T; m += 2 * NGW) {
        const int m2 = m + NGW < T ? m + NGW : m;
        const f32x4* xr0 = (const f32x4*)(a.in[0] + (size_t)m * D) + lane; const f32x4* xr1 = (const f32x4*)(a.in[0] + (size_t)m2 * D) + lane; const f32x4* gr = (const f32x4*)a.in[2] + lane;
        f32x4 v0[4], v1[4]; float s0 = 0.f, s1 = 0.f;
#pragma unroll
        for (int j = 0; j < 4; ++j) { v0[j] = xr0[64 * j]; v1[j] = xr1[64 * j]; }
#pragma unroll
        for (int j = 0; j < 4; ++j) { s0 += (v0[j].x * v0[j].x + v0[j].y * v0[j].y) + (v0[j].z * v0[j].z + v0[j].w * v0[j].w); s1 += (v1[j].x * v1[j].x + v1[j].y * v1[j].y) + (v1[j].z * v1[j].z + v1[j].w * v1[j].w); }
        const float r0 = 1.f / sqrtf(wave_sum(s0) * (1.f / D) + NORM_EPS), r1 = 1.f / sqrtf(wave_sum(s1) * (1.f / D) + NORM_EPS);
        u32x2* o0 = (u32x2*)((bf16*)(ws + WS_XB) + (size_t)m * D) + lane; u32x2* o1 = (u32x2*)((bf16*)(ws + WS_XB) + (size_t)m2 * D) + lane;
#pragma unroll
        for (int j = 0; j < 4; ++j) { const f32x4 gg = gr[64 * j]; u32x2 w;
            w.x = pk2(v0[j].x * r0 * gg.x, v0[j].y * r0 * gg.y); w.y = pk2(v0[j].z * r0 * gg.z, v0[j].w * r0 * gg.w); o0[64 * j] = w;
            w.x = pk2(v1[j].x * r1 * gg.x, v1[j].y * r1 * gg.y); w.y = pk2(v1[j].z * r1 * gg.z, v1[j].w * r1 * gg.w); o1[64 * j] = w; }
    }
}

__device__ __forceinline__ void p1b_latent(const Args& a, int vcu, int G, int wave, int lane) {
    unsigned char* ws = a.ws; const int gw = vcu * NWAVES + wave, NGW = G * NWAVES;
    const float* gq = a.in[9]; const float* gkv = a.in[11];
    float gl[8];
#pragma unroll
    for (int j = 0; j < 8; ++j) gl[j] = lane < 32 ? gq[8 * lane + j] : (lane < 48 ? gkv[8 * (lane - 32) + j] : 1.f);
    constexpr int R = 8;
    const int aa = lane - 48; const bool rope_lane = lane >= 48 && lane < 56;
    float k2max = 0.f;
    float kpe2 = 0.f;
    const int rows_per_wave = T / NGW;
    for (int t0 = gw * rows_per_wave; t0 < (gw + 1) * rows_per_wave; t0 += R) {
        bf16x8 v[R], kk[R]; f32x4 cr[R][4];
#pragma unroll
        for (int q = 0; q < R; ++q) { const int t = t0 + q; v[q] = (bf16x8){0, 0, 0, 0, 0, 0, 0, 0};
#pragma unroll
            for (int j = 0; j < 4; ++j) cr[q][j] = (f32x4){0.f, 0.f, 0.f, 0.f};
            kk[q] = *(const bf16x8*)((const bf16*)(ws + WS_PROJ) + (size_t)t * PROJ_LD + 512 + 8 * lane);
            if (lane < 56) v[q] = *(const bf16x8*)((const bf16*)(ws + WS_PROJ) + (size_t)t * PROJ_LD + 1536 + 8 * lane);
            if (rope_lane) { const f32x4* cp = (const f32x4*)((const f32x2*)(ws + WS_ROPE) + (size_t)(t & (SEQ - 1)) * 32 + 8 * (aa & 3));
#pragma unroll
                for (int j = 0; j < 4; ++j) cr[q][j] = cp[j]; } }
#pragma unroll
        for (int q = 0; q < R; ++q) { float s = 0.f; float fk[8];
#pragma unroll
            for (int j = 0; j < 8; ++j) { const float f = bf2f((unsigned short)kk[q][j]); s = fmaf(f, f, s); fk[j] = f; }
            { u32x2 w8; w8.x = cvt8(fk[0], fk[1], fk[2], fk[3]); w8.y = cvt8(fk[4], fk[5], fk[6], fk[7]); *(u32x2*)(ws + WS_KD8 + (size_t)(t0 + q) * 512 + 8 * lane) = w8; }
            s += __shfl_xor(s, 1); s += __shfl_xor(s, 2); s += __shfl_xor(s, 4); k2max = fmaxf(k2max, s); }
#pragma unroll
        for (int q = 0; q < R; ++q) { const int t = t0 + q;
            float f[8], sq = 0.f;
#pragma unroll
            for (int j = 0; j < 8; ++j) { f[j] = bf2f((unsigned short)v[q][j]); sq += f[j] * f[j]; }
            { float s = sq; s += __shfl_xor(s, 1); s += __shfl_xor(s, 2); s += __shfl_xor(s, 4); kpe2 = fmaxf(kpe2, s); }
            const float sq_q = wave_sum(lane < 32 ? sq : 0.f), sq_kv = wave_sum((lane >= 32 && lane < 48) ? sq : 0.f);
            const float rq = 1.f / sqrtf(sq_q * (1.f / 256.f) + NORM_EPS), rkv = 1.f / sqrtf(sq_kv * (1.f / 128.f) + NORM_EPS);
            float part[8];
#pragma unroll
            for (int j = 0; j < 8; ++j) part[j] = __shfl_xor(f[j], 4);
            float o[8];
            if (lane < 48) { const float rr = lane < 32 ? rq : rkv;
#pragma unroll
                for (int j = 0; j < 8; ++j) o[j] = f[j] * rr * gl[j];
            } else {
#pragma unroll
                for (int j = 0; j < 8; ++j) { const float cc = cr[q][j >> 1][2 * (j & 1)], sn = cr[q][j >> 1][2 * (j & 1) + 1];
                    o[j] = (aa < 4) ? (f[j] * cc - part[j] * sn) : (part[j] * sn + f[j] * cc); }
            }
            u32x4 w; w.x = pk2(o[0], o[1]); w.y = pk2(o[2], o[3]); w.z = pk2(o[4], o[5]); w.w = pk2(o[6], o[7]);
            if (lane < 32) *(u32x4*)((bf16*)(ws + WS_CQN) + (size_t)t * 256 + 8 * lane) = w;
            else if (lane < 48) *(u32x4*)((bf16*)(ws + WS_CKVN) + (size_t)t * 128 + 8 * (lane - 32)) = w;
            else if (lane < 56) { u32x2 w8; w8.x = cvt8(o[0], o[1], o[2], o[3]); w8.y = cvt8(o[4], o[5], o[6], o[7]); *(u32x2*)(ws + WS_KPE8 + (size_t)t * 64 + 8 * (lane - 48)) = w8; }
        }
    }
    if (lane == 48) atomicMax((unsigned*)(ws + WS_KN) + ((gw * rows_per_wave) >> 11) * 32 + 16, __float_as_uint(kpe2));
    if ((lane & 7) == 0) atomicMax((unsigned*)(ws + WS_KMAX) + ((gw * rows_per_wave) >> 11) * 8 + (lane >> 3), __float_as_uint(k2max));
}

template <int WHICH  >
__device__ __forceinline__ void p2_attention(const Args& a, LAS unsigned char* lds, int vcu, int G, int wave) {
    unsigned char* ws = a.ws;
    const int tid = threadIdx.x, wid = tid >> 6, lane = tid & 63, r32 = lane & 31, hi = lane >> 5;
    const bf16* proj = (const bf16*)(ws + WS_PROJ); bf16* mixed = (bf16*)(ws + WS_MIXED);
    const float lam = *(const float*)(ws + WS_LAM);
    if constexpr (WHICH & 1) {
        const float C = 1.f;
        const float* gsub = a.in[8];
        LAS unsigned* stash = (LAS unsigned*)(lds + att::OFF_STASH) + (wid * 32) * 64 + lane;
        for (int it = 0;; ++it) {
            const int u = (it >> 1) * G + vcu, j = it & 1; if (u >= NB * 4 * 8) break;
            const int qb = u & 7, h = (u >> 3) & 3, b = u >> 5, q0 = qb * 256, mp = 2 * h + j;
            { const float* src = (const float*)(ws + WS_BIAS) + mp * 4096; LAS float* lut = (LAS float*)(lds + att::OFF_LUT);
#pragma unroll
              for (int i = 0; i < 8; ++i) lut[tid + 512 * i] = src[tid + 512 * i]; }
            const bf16* base = proj + (size_t)b * SEQ * PROJ_LD;
            f32x16 o[4];
            if (j == 0) att::attn_unit<1, false>(base + (size_t)q0 * PROJ_LD + 64 * mp, PROJ_LD, base + 512 + 64 * mp, PROJ_LD, nullptr, base + 1024 + 128 * h, PROJ_LD, SEQ,
                                 (LAS char*)lds, C, nullptr, q0, o, wave, lane, __uint_as_float(((const unsigned*)(ws + WS_KMAX))[b * 8 + mp]));
            else att::attn_unit<1, true>(base + (size_t)q0 * PROJ_LD + 64 * mp, PROJ_LD, (const bf16*)(ws + WS_KD8 + (size_t)b * SEQ * 512 + 64 * mp), 512, nullptr, base + 1024 + 128 * h, PROJ_LD, SEQ,
                                 (LAS char*)lds, C, nullptr, q0, o, wave, lane, __uint_as_float(((const unsigned*)(ws + WS_KMAX))[b * 8 + mp]));
            if (j == 0) {
#pragma unroll
                for (int d0 = 0; d0 < 4; ++d0)
#pragma unroll
                    for (int r = 0; r < 16; r += 2) stash[(d0 * 8 + (r >> 1)) * 64] = pk2(o[d0][r], o[d0][r + 1]);
            } else {
                bf16* orow = mixed + (size_t)(b * SEQ + q0 + wid * 32 + r32) * D + 128 * h + 8 * hi;
                float ss = 0.f;
#pragma unroll
                for (int d0 = 0; d0 < 4; ++d0)
#pragma unroll
                    for (int rp = 0; rp < 8; ++rp) { const unsigned w = stash[(d0 * 8 + rp) * 64];
                        const float v0 = bf2f((unsigned short)(w & 0xffffu)) - lam * o[d0][2 * rp], v1 = bf2f((unsigned short)(w >> 16)) - lam * o[d0][2 * rp + 1];
                        o[d0][2 * rp] = v0; o[d0][2 * rp + 1] = v1; ss = fmaf(v0, v0, fmaf(v1, v1, ss)); }
                { auto rr = __builtin_amdgcn_permlane32_swap(__float_as_uint(ss), __float_as_uint(ss), false, false); ss = __uint_as_float(rr[0]) + __uint_as_float(rr[1]); }
                const float rn = 0.8f / sqrtf(ss * (1.f / 128.f) + NORM_EPS);
#pragma unroll
                for (int d0 = 0; d0 < 4; ++d0)
#pragma unroll
                    for (int gp = 0; gp < 2; ++gp) {
                        const f32x4 gA = *(const f32x4*)(gsub + 32 * d0 + 16 * gp + 4 * hi), gB = *(const f32x4*)(gsub + 32 * d0 + 16 * gp + 8 + 4 * hi);
                        const int r0 = 8 * gp;
                        unsigned ax = pk2(o[d0][r0] * rn * gA.x, o[d0][r0 + 1] * rn * gA.y), ay = pk2(o[d0][r0 + 2] * rn * gA.z, o[d0][r0 + 3] * rn * gA.w);
                        unsigned bx = pk2(o[d0][r0 + 4] * rn * gB.x, o[d0][r0 + 5] * rn * gB.y), by = pk2(o[d0][r0 + 6] * rn * gB.z, o[d0][r0 + 7] * rn * gB.w);
                        { auto rr = __builtin_amdgcn_permlane32_swap(ax, bx, false, false); ax = rr[0]; bx = rr[1]; }
                        { auto rr = __builtin_amdgcn_permlane32_swap(ay, by, false, false); ay = rr[0]; by = rr[1]; }
                        u32x4 w4; w4.x = ax; w4.y = ay; w4.z = bx; w4.w = by;
                        *(u32x4*)(orow + 32 * d0 + 16 * gp) = w4; }
            }
        }
    }
    if constexpr (WHICH & 2) {
        const float C = 1.f;
        for (int it = 0;; ++it) {
            const int u = it * G + vcu; if (u >= NB * 4 * 8) break;
            const int qb = u & 7, h = (u >> 3) & 3, b = u >> 5, q0 = qb * 256;
            const bf16* qm = (const bf16*)(ws + WS_QM) + (size_t)(b * SEQ + q0) * 768 + 192 * h;
            const bf16* kv = (const bf16*)(ws + WS_KV) + (size_t)b * SEQ * 1024 + 256 * h;
            const bf16* kpe = (const bf16*)(ws + WS_KPE8 + (size_t)b * SEQ * 64);
            const bf16* kn8 = (const bf16*)(ws + WS_KN8 + (size_t)b * SEQ * 512 + 128 * h);
            f32x16 o[4];
            const unsigned* kn = (const unsigned*)(ws + WS_KN) + b * 32;
            const float k2 = __uint_as_float(kn[4 * h]) + __uint_as_float(kn[4 * h + 1]) + __uint_as_float(kn[4 * h + 2]) + __uint_as_float(kn[4 * h + 3]) + __uint_as_float(kn[16]);
            att::attn_unit<0>(qm, 768, kn8, 512, kpe, kv + 128, 1024, SEQ, (LAS char*)lds, C, (const att::f32x2*)(ws + WS_ROPE), q0, o, wave, lane, k2);
            bf16* orow = mixed + (size_t)(b * SEQ + q0 + wid * 32 + r32) * D + 512 + 128 * h + 8 * hi;
#pragma unroll
            for (int d0 = 0; d0 < 4; ++d0)
#pragma unroll
                for (int gp = 0; gp < 2; ++gp) { const int r0 = 8 * gp;
                    unsigned ax = pk2(o[d0][r0], o[d0][r0 + 1]), ay = pk2(o[d0][r0 + 2], o[d0][r0 + 3]), bx = pk2(o[d0][r0 + 4], o[d0][r0 + 5]), by = pk2(o[d0][r0 + 6], o[d0][r0 + 7]);
                    { auto rr = __builtin_amdgcn_permlane32_swap(ax, bx, false, false); ax = rr[0]; bx = rr[1]; }
                    { auto rr = __builtin_amdgcn_permlane32_swap(ay, by, false, false); ay = rr[0]; by = rr[1]; }
                    u32x4 w4; w4.x = ax; w4.y = ay; w4.z = bx; w4.w = by;
                    *(u32x4*)(orow + 32 * d0 + 16 * gp) = w4; }
        }
    }
}

constexpr int WR_PITCH = 2064;
__device__ __forceinline__ void p3b_router(const Args& a, LAS unsigned char* lds, int G, int wave) {
    unsigned char* ws = a.ws;
    const int wid = wave, lane = hw_lane(), tid = wid * 64 + lane, r32 = lane & 31, hi = lane >> 5;
    LAS unsigned char* wrh = lds; LAS unsigned char* wrl = lds + 32 * WR_PITCH; LAS unsigned* cnt = (LAS unsigned*)(lds + 64 * WR_PITCH);
    for (int i = tid; i < 2 * 32 * 128; i += NTHREADS) { const int tb = i >> 12, e = (i >> 7) & 31, c = i & 127;
        *(LAS u32x4*)(lds + (tb * 32 + e) * WR_PITCH + c * 16) = *((const u32x4*)(ws + (tb ? WS_WRL : WS_WRH)) + e * 128 + c); }
    const bf16* x1 = (const bf16*)(ws + WS_XB); unsigned char* xb = ws + WS_XB8;
    for (int c = blockIdx.x; c < T / 256; c += G) {
        if (tid < 32) cnt[tid] = 0u;
        __syncthreads();
        const int t = c * 256 + wid * 32 + r32;
        const bf16* xr = x1 + (size_t)t * D + 64 * hi; unsigned char* xo = xb + (size_t)t * D + 64 * hi;
        f32x16 acc = f32x16{}; float ss = 0.f;
#pragma unroll 2
        for (int sg = 0; sg < 8; ++sg) {
            u32x4 v[8];
#pragma unroll
            for (int q = 0; q < 8; ++q) v[q] = *(const u32x4*)(xr + 128 * sg + 8 * q);
            v16f xa0, xb0, xa1, xb1;
#pragma unroll
            for (int j = 0; j < 8; ++j) {
                const u32x4 hw = v[j];
                const float f0 = __uint_as_float(hw.x << 16), f1 = __uint_as_float(hw.x & 0xffff0000u), f2 = __uint_as_float(hw.y << 16), f3 = __uint_as_float(hw.y & 0xffff0000u);
                const float f4 = __uint_as_float(hw.z << 16), f5 = __uint_as_float(hw.z & 0xffff0000u), f6 = __uint_as_float(hw.w << 16), f7 = __uint_as_float(hw.w & 0xffff0000u);
                ss += (f0 * f0 + f1 * f1) + (f2 * f2 + f3 * f3) + (f4 * f4 + f5 * f5) + (f6 * f6 + f7 * f7);
                { v16f& dst_ = (j < 2) ? xa0 : (j < 4) ? xb0 : (j < 6) ? xa1 : xb1; const int o_ = 8 * (j & 1);
                  dst_[o_] = f0 * SC_X6; dst_[o_ + 1] = f1 * SC_X6; dst_[o_ + 2] = f2 * SC_X6; dst_[o_ + 3] = f3 * SC_X6; dst_[o_ + 4] = f4 * SC_X6; dst_[o_ + 5] = f5 * SC_X6; dst_[o_ + 6] = f6 * SC_X6; dst_[o_ + 7] = f7 * SC_X6; }
                const int kb = (128 * sg + 64 * hi + 8 * j) * 2;
                const bf16x8 wh = *(const LAS bf16x8*)(wrh + r32 * WR_PITCH + kb), wl = *(const LAS bf16x8*)(wrl + r32 * WR_PITCH + kb);
                const bf16x8 xh = __builtin_bit_cast(bf16x8, hw);
                acc = __builtin_amdgcn_mfma_f32_32x32x16_bf16(wh, xh, acc, 0, 0, 0);
                acc = __builtin_amdgcn_mfma_f32_32x32x16_bf16(wl, xh, acc, 0, 0, 0);
            }
            { const v6i p0_ = cvt_fp6x32(xa0, xb0), p1_ = cvt_fp6x32(xa1, xb1);
              unsigned char* blk_ = xb + (size_t)t * D + (size_t)(4 * sg + 2 * hi) * 32;
              store_fp6_block(blk_, p0_, false); store_fp6_block(blk_ + 32, p1_, true); }
        }
        ss += __shfl_xor(ss, 32);
        const float rinv = 1.f / sqrtf(ss * (1.f / D) + NORM_EPS);
        if (hi == 0) ((float*)(ws + WS_RINV))[t] = rinv;
        float lg[16];
#pragma unroll
        for (int r = 0; r < 16; ++r) lg[r] = acc[r] * rinv + a.in[16][att::crow(r, hi)];
        float tv[4]; int ti[4];
#pragma unroll
        for (int k = 0; k < 4; ++k) {
            float bv = lg[0]; int bi = att::crow(0, hi);
#pragma unroll
            for (int r = 1; r < 16; ++r) { const int e = att::crow(r, hi); if (lg[r] > bv) { bv = lg[r]; bi = e; } }
            const float ov = __shfl_xor(bv, 32); const int oi = __shfl_xor(bi, 32);
            const bool mine = (bv > ov) || (bv == ov && bi < oi);
            tv[k] = mine ? bv : ov; ti[k] = mine ? bi : oi;
#pragma unroll
            for (int r = 0; r < 16; ++r) if (att::crow(r, hi) == ti[k]) lg[r] = -3.0e38f;
        }
        const float e1 = __expf(tv[1] - tv[0]), e2 = __expf(tv[2] - tv[0]), e3 = __expf(tv[3] - tv[0]), rs = 1.f / (1.f + e1 + e2 + e3);
        if (hi == 0) {
            int lr[4];
#pragma unroll
            for (int k = 0; k < 4; ++k) lr[k] = (int)__hip_atomic_fetch_add(cnt + ti[k], 1u, __ATOMIC_RELAXED, __HIP_MEMORY_SCOPE_WORKGROUP);
            *((int4*)(ws + WS_EIDX) + t) = make_int4(ti[0], ti[1], ti[2], ti[3]);
            *((f32x4*)(ws + WS_GATE) + t) = (f32x4){rs, e1 * rs, e2 * rs, e3 * rs};
            *((int4*)(ws + WS_LRANK) + t) = make_int4(lr[0], lr[1], lr[2], lr[3]);
        }
        __syncthreads();
        if (tid < 32) ((int*)(ws + WS_HIST))[c * 32 + tid] = (int)cnt[tid];
        __syncthreads();
    }
}

__device__ __forceinline__ void p4_scatter(const Args& a, LAS unsigned char* lds, int G, int wave) {
    unsigned char* ws = a.ws; const int tid = wave * 64 + hw_lane();
    LAS int* hist = (LAS int*)lds;
    LAS int* cntE = hist + 256 * 32;
    LAS int* pst = cntE + 32;
    for (int i = tid; i < 256 * 32; i += NTHREADS) hist[i] = ((const int*)(ws + WS_HIST))[i];
    __syncthreads();
    LAS int* segs = pst + 32;
    { const int e = tid & 31, sg = tid >> 5; int sum = 0;
        for (int c = 16 * sg; c < 16 * sg + 16; ++c) sum += hist[c * 32 + e];
        segs[sg * 32 + e] = sum; }
    __syncthreads();
    if (tid < 32) { int run = 0;
        for (int sg = 0; sg < 16; ++sg) { const int v = segs[sg * 32 + tid]; segs[sg * 32 + tid] = run; run += v; }
        cntE[tid] = run; }
    __syncthreads();
    { const int e = tid & 31, sg = tid >> 5; int run = segs[sg * 32 + e];
        for (int c = 16 * sg; c < 16 * sg + 16; ++c) { const int v = hist[c * 32 + e]; hist[c * 32 + e] = run; run += v; } }
    __syncthreads();
    if (tid < 32) { int s = 0;
        for (int q = 0; q < tid; ++q) s += (cntE[q] + 255) & ~255;
        pst[tid] = s; }
    __syncthreads();
    int* rowa = (int*)(ws + WS_ROWA); float* rowg = (float*)(ws + WS_ROWG); float* rowri = (float*)(ws + WS_ROWRI);
    for (int c = blockIdx.x; c < T / 256; c += G) {
        for (int i = tid; i < 1024; i += NTHREADS) { const int asg = c * 1024 + i; const int e = ((const int*)(ws + WS_EIDX))[asg];
            const int p = pst[e] + hist[c * 32 + e] + ((const int*)(ws + WS_LRANK))[asg];
            rowa[p] = asg; rowg[p] = ((const float*)(ws + WS_GATE))[asg]; rowri[p] = ((const float*)(ws + WS_RINV))[asg >> 2] * (1.f / (SC_W6 * SC_X6)); } }
    if (blockIdx.x == 0 && tid < 32) { const int e = tid; const int n = cntE[e], st = pst[e], pad = (n + 255) & ~255;
        for (int p = st + n; p < st + pad; ++p) { rowa[p] = -1; rowg[p] = 0.f; rowri[p] = 0.f; }
        int* tinfo = (int*)(ws + WS_TINFO);
        for (int tt = st >> 8; tt < (st + pad) >> 8; ++tt) tinfo[tt] = e;
        if (e == 31) tinfo[2048] = (st + pad) >> 8; }
}

struct MoeOrder {
    const int* tinfo; const int* rowa; int ntiles, nN, lgN, G, c;
    __device__ __forceinline__ bool next(int i, pg8::Unit& u) const {
        const int L = i * G + c; if (L >= ntiles * nN) return false;
        const int tile = L >> lgN, pn = L & (nN - 1); const int e = tinfo[tile]; u.pm = tile; u.pn = e * nN + pn; return true;
    }
    __device__ __forceinline__ int gather_row(const pg8::Unit& u, int i) const { const int as = rowa[u.pm * 256 + i]; return as < 0 ? 0 : (as >> 2); }
};
struct EpiSwiglu {
    static constexpr bool PERM = true;
    unsigned char* act; const float* rowri; const float* bgu;
    struct Pre { float ri[8]; };
    __device__ __forceinline__ void prefetch(const pg8::Unit& u, int par, LAS unsigned char* sp, int wid, int lane, int wr, int wc, int fr, int fq, Pre& pre) const {
#pragma unroll
        for (int ai = 0; ai < 2; ++ai)
#pragma unroll
            for (int m = 0; m < 4; ++m) pre.ri[ai * 4 + m] = rowri[u.pm * 256 + ai * 128 + wr * 64 + m * 16 + fr];
        if (wid == 0) { const int e = u.pn >> 3, pn = u.pn & 7;
            PG8_DMA16((unsigned)(uintptr_t)sp + (unsigned)par * 3072u + 2048u, (const char*)(bgu + (size_t)e * 2048 + 128 * pn), (unsigned)(lane < 32 ? lane * 16 : 4096 + (lane - 32) * 16)); }
    }
    __device__ __forceinline__ void operator()(const pg8::f32x4 (&acc)[2][2][4][2], const pg8::Unit& u, int wr, int wc, int fr, int fq, const Pre& pre, int par, LAS unsigned char* sp) const {
        const int pn = u.pn & 7, col0 = 128 * pn + 32 * wc + 8 * fq;
        const LAS float* bp = (const LAS float*)(sp + par * 3072 + 2048) + 32 * wc + 8 * fq;
        f32x2 bg[4], bu[4];
#pragma unroll
        for (int q = 0; q < 4; ++q) { bg[q] = *(const LAS f32x2*)(bp + 2 * q); const f32x2 t = *(const LAS f32x2*)(bp + 128 + 2 * q); bu[q] = t * SC_A + SC_A; }
#pragma unroll
        for (int ai = 0; ai < 2; ++ai)
#pragma unroll
            for (int m = 0; m < 4; ++m) {
                const int p = u.pm * 256 + ai * 128 + wr * 64 + m * 16 + fr; const float ri = pre.ri[ai * 4 + m];
                const f32x2 rg = (f32x2){ri, ri}, ru = rg * SC_A;
                unsigned w[2];
#pragma unroll
                for (int n = 0; n < 2; ++n) {
                    f32x2 o2[2];
#pragma unroll
                    for (int h = 0; h < 2; ++h) {
                        const f32x2 ag = (f32x2){acc[ai][0][m][n][2 * h], acc[ai][0][m][n][2 * h + 1]}, au = (f32x2){acc[ai][1][m][n][2 * h], acc[ai][1][m][n][2 * h + 1]};
                        f32x2 g = ag * rg + bg[2 * n + h], up = au * ru + bu[2 * n + h];
                        g.x = fminf(g.x, 7.f); g.y = fminf(g.y, 7.f);
                        up.x = __builtin_amdgcn_fmed3f(up.x, -6.f * SC_A, 8.f * SC_A); up.y = __builtin_amdgcn_fmed3f(up.y, -6.f * SC_A, 8.f * SC_A);
                        const f32x2 t = g * (-1.702f * LOG2E);
                        f32x2 ex; ex.x = __builtin_amdgcn_exp2f(t.x); ex.y = __builtin_amdgcn_exp2f(t.y);
                        const f32x2 d = ex + 1.f;
                        f32x2 rc; rc.x = __builtin_amdgcn_rcpf(d.x); rc.y = __builtin_amdgcn_rcpf(d.y);
                        o2[h] = up * (g * rc);
                    }
                    w[n] = cvt8(o2[0].x, o2[0].y, o2[1].x, o2[1].y);
                }
                u32x2 ww; ww.x = w[0]; ww.y = w[1];
                *(u32x2*)(act + (size_t)p * 1024 + col0) = ww; }
    }
};
struct EpiDown {
    static constexpr bool PERM = true;
    unsigned char* y4; const int* rowa; const float* rowg; const float* bd;
    typedef pg8::NoPre Pre;
    __device__ __forceinline__ void prefetch(const pg8::Unit& u, int par, LAS unsigned char* sp, int wid, int lane, int, int, int, int, Pre&) const {
        const unsigned base = (unsigned)(uintptr_t)sp + (unsigned)par * 3072u;
        if (wid < 4) PG8_DMA4(base + (unsigned)wid * 256u, (const char*)(rowa + u.pm * 256 + wid * 64), (unsigned)lane * 4u);
        else PG8_DMA4(base + 1024u + (unsigned)(wid - 4) * 256u, (const char*)(rowg + u.pm * 256 + (wid - 4) * 64), (unsigned)lane * 4u);
        if (wid == 0) { const int e = u.pn >> 2, pn = u.pn & 3; PG8_DMA16(base + 2048u, (const char*)(bd + (size_t)e * 1024 + 256 * pn), (unsigned)lane * 16u); }
    }
    __device__ __forceinline__ void operator()(const pg8::f32x4 (&acc)[2][2][4][2], const pg8::Unit& u, int wr, int wc, int fr, int fq, const Pre& pre, int par, LAS unsigned char* sp) const {
        const int pn = u.pn & 3, col0 = 256 * pn + 32 * wc + 8 * fq;
        const LAS int* l_as = (const LAS int*)(sp + par * 3072); const LAS float* l_gt = (const LAS float*)(sp + par * 3072 + 1024);
        const LAS float* bp = (const LAS float*)(sp + par * 3072 + 2048) + 32 * wc + 8 * fq;
        f32x4 bv[2][2];
#pragma unroll
        for (int bj = 0; bj < 2; ++bj)
#pragma unroll
            for (int n = 0; n < 2; ++n) bv[bj][n] = *(const LAS f32x4*)(bp + 128 * bj + 4 * n);
#pragma unroll
        for (int ai = 0; ai < 2; ++ai)
#pragma unroll
            for (int m = 0; m < 4; ++m) {
                const int rt = ai * 128 + wr * 64 + m * 16 + fr; const int as = l_as[rt];
                if (as >= 0) { const float gt = l_gt[rt] * SC_Y; unsigned char* yr = y4 + (size_t)as * 1024 + col0;
                    const f32x2 gs = (f32x2){gt * (1.f / (SC_W * SC_A)), gt * (1.f / (SC_W * SC_A))}, g2 = (f32x2){gt, gt};
#pragma unroll
                    for (int bj = 0; bj < 2; ++bj) { unsigned w[2];
#pragma unroll
                        for (int n = 0; n < 2; ++n) {
                            const f32x2 a0 = (f32x2){acc[ai][bj][m][n][0], acc[ai][bj][m][n][1]}, a1 = (f32x2){acc[ai][bj][m][n][2], acc[ai][bj][m][n][3]};
                            const f32x2 b0 = (f32x2){bv[bj][n][0], bv[bj][n][1]}, b1 = (f32x2){bv[bj][n][2], bv[bj][n][3]};
                            const f32x2 v0 = a0 * gs + b0 * g2, v1 = a1 * gs + b1 * g2;
                            w[n] = cvt8(v0.x, v0.y, v1.x, v1.y); }
                        u32x2 ww; ww.x = w[0]; ww.y = w[1];
                        *(u32x2*)(yr + 128 * bj) = ww; } } }
    }
};

__device__ __forceinline__ void p7_final(const Args& a, int vcu, int G, int wave, int lane) {
    unsigned char* ws = a.ws; const int gw = vcu * NWAVES + wave, NGW = G * NWAVES;
    const f32x4* gr = (const f32x4*)a.in[21] + lane;
    constexpr int TW = 2;
    for (int t0 = gw * TW; t0 < T; t0 += NGW * TW) {
        u32x2 xw[TW][4]; unsigned yw[TW][4][4];
#pragma unroll
        for (int q = 0; q < TW; ++q) { const int t = t0 + q;
            const u32x2* xr = (const u32x2*)((const bf16*)(ws + WS_XB) + (size_t)t * D) + lane;
            const unsigned* yr = (const unsigned*)(ws + WS_Y48 + (size_t)t * 4 * D) + lane;
#pragma unroll
            for (int j = 0; j < 4; ++j) { xw[q][j] = xr[64 * j];
#pragma unroll
                for (int k = 0; k < 4; ++k) yw[q][k][j] = yr[k * 256 + 64 * j]; } }
#pragma unroll
        for (int q = 0; q < TW; ++q) { const int t = t0 + q;
            f32x4 v[4]; float s = 0.f;
#pragma unroll
            for (int j = 0; j < 4; ++j) { f32x4 ys = (f32x4){0.f, 0.f, 0.f, 0.f};
#pragma unroll
                for (int k = 0; k < 4; ++k) { const f32x2 lo = __builtin_amdgcn_cvt_pk_f32_fp8((int)yw[q][k][j], false), hi = __builtin_amdgcn_cvt_pk_f32_fp8((int)yw[q][k][j], true);
                    ys.x += lo.x; ys.y += lo.y; ys.z += hi.x; ys.w += hi.y; }
                v[j].x = __uint_as_float(xw[q][j].x << 16) + ys.x * (1.f / SC_Y); v[j].y = __uint_as_float(xw[q][j].x & 0xffff0000u) + ys.y * (1.f / SC_Y);
                v[j].z = __uint_as_float(xw[q][j].y << 16) + ys.z * (1.f / SC_Y); v[j].w = __uint_as_float(xw[q][j].y & 0xffff0000u) + ys.w * (1.f / SC_Y);
                s += (v[j].x * v[j].x + v[j].y * v[j].y) + (v[j].z * v[j].z + v[j].w * v[j].w); }
            const float r = 1.f / sqrtf(wave_sum(s) * (1.f / D) + NORM_EPS);
            f32x4* orow = (f32x4*)(a.out + (size_t)t * D) + lane;
#pragma unroll
            for (int j = 0; j < 4; ++j) { const f32x4 gg = gr[64 * j]; orow[64 * j] = (f32x4){v[j].x * r * gg.x, v[j].y * r * gg.y, v[j].z * r * gg.z, v[j].w * r * gg.w}; } }
    }
}

typedef const __attribute__((address_space(4))) Args* KArgP;
__device__ __forceinline__ Args fresh_args() { KArgP p = (KArgP)__builtin_amdgcn_kernarg_segment_ptr(); asm volatile("" : "+s"(p)); Args a;
#pragma unroll
    for (int i = 0; i < 22; ++i) a.in[i] = p->in[i];
    a.out = p->out; a.ws = p->ws; a.ph_lo = p->ph_lo; a.ph_hi = p->ph_hi; return a; }
constexpr int N_PHASES = 11;
__global__ void __launch_bounds__(NTHREADS, 2) fwd(Args args) {
    extern __shared__ __attribute__((aligned(1024))) unsigned char lds_raw[];
    LAS unsigned char* lds = (LAS unsigned char*)lds_raw;
    volatile LAS unsigned* MISC = (volatile LAS unsigned*)(lds + MISC_OFF);
    const int wave = __builtin_amdgcn_readfirstlane((int)threadIdx.x >> 6);
    const int G = gridDim.x; const int bx = blockIdx.x; const int vcu = (G % 8 == 0) ? (bx % 8) * (G / 8) + bx / 8 : bx;
    unsigned char* ws = args.ws;
    for (int u = wave * 64 + hw_lane(); u < (LDS_BYTES - MISC_OFF) / 4; u += NTHREADS) MISC[u] = 0u;
    __syncthreads();
    const int lo = args.ph_lo, hi = args.ph_hi;
#ifdef PROBE_CLK
    if (blockIdx.x == 0 && wave == 0 && hw_lane() == 0) { *(volatile unsigned*)(ws + WS_LAM + 256) = *(volatile unsigned*)(ws + WS_LAM + 128); }
#endif
    const bool use_bar = (hi - lo) > 1;
    XcdBarrier bar; bar.bar = (unsigned*)(ws + WS_CTL); bar.x = 0; bar.st = nullptr;
    if (use_bar) bar = xcd_barrier_post((unsigned*)(ws + WS_CTL), MISC + 8, (unsigned)wave);
#ifdef ONLY_PHASE
#define IN(k) ((k) == ONLY_PHASE)
#else
#define IN(k) (lo <= (k) && (k) < hi)
#endif
#ifdef PROBE_CLK
    unsigned long long pc0 = 0, pr0 = 0;
#define PCLK_BEGIN(k) do { if ((k) == PROBE_CLK) { pc0 = __builtin_readcyclecounter(); pr0 = __builtin_amdgcn_s_memrealtime(); } } while (0)
#define PCLK_END(k) do { if ((k) == PROBE_CLK) { const unsigned long long c1 = __builtin_readcyclecounter(), r1 = __builtin_amdgcn_s_memrealtime(); if (bx == 0 && wave == 0 && hw_lane() == 0) { PROBE_EXPR; } } } while (0)
#else
#define PCLK_BEGIN(k)
#define PCLK_END(k)
#endif
#define SEAM(k) do { if (IN(k) && IN((k) + 1)) xcd_barrier(bar); } while (0)

    if (IN(0)) { const Args A_ = fresh_args(); p0_prologue(A_, lds, vcu, G, wave, hw_lane()); }
    SEAM(0);
    if (IN(1)) {
        pg8::Gemm g{(const bf16*)(ws + WS_XB), (const bf16*)(ws + WS_WIN), T, PROJ_LD, D}; pg8::StaticOrder S; S.init(T, PROJ_LD, G, bx);
        pg8::EpiBf16 E{(bf16*)(ws + WS_PROJ), PROJ_LD};
        PCLK_BEGIN(1); pg8::gemm_phase<pg8::EpiBf16, pg8::StaticOrder, true, false>(lds, g, S, E, wave); PCLK_END(1);
    }
    SEAM(1);
    if (IN(2)) { const Args A_ = fresh_args(); p1b_latent(A_, vcu, G, wave, hw_lane()); }
    SEAM(2);
    if (IN(3)) {
        { pg8::Gemm g{(const bf16*)(ws + WS_CQN), (const bf16*)(ws + WS_WUQ), T, 768, 256}; pg8::StaticOrder S; S.init(T, 768, G, bx);
          pg8::EpiBf16 E{(bf16*)(ws + WS_QM), 768}; pg8::gemm_phase<pg8::EpiBf16, pg8::StaticOrder, true, false>(lds, g, S, E, wave); }
        { pg8::Gemm g{(const bf16*)(ws + WS_CKVN), (const bf16*)(ws + WS_WUKV), T, 1024, 128}; pg8::StaticOrder S; S.init(T, 1024, G, bx);
          pg8::EpiBf16KN E{(bf16*)(ws + WS_KV), 1024, (unsigned*)(ws + WS_KN), ws + WS_KN8}; pg8::gemm_phase<pg8::EpiBf16KN, pg8::StaticOrder, true, false>(lds, g, S, E, wave); }
    }
    SEAM(3);
    if (IN(4)) { const Args A_ = fresh_args(); PCLK_BEGIN(4); p2_attention<3>(A_, lds, vcu, G, wave); PCLK_END(4); }
    SEAM(4);
    if (IN(5)) {
        pg8::Gemm g{(const bf16*)(ws + WS_MIXED), (const bf16*)(ws + WS_WO), T, D, D}; pg8::StaticOrder S; S.init(T, D, G, bx);
        const Args A_ = fresh_args(); pg8::EpiResid E{A_.in[0], (bf16*)(ws + WS_XB), D};
        pg8::gemm_phase<pg8::EpiResid, pg8::StaticOrder, true, false>(lds, g, S, E, wave);
    }
    SEAM(5);
    if (IN(6)) { const Args A_ = fresh_args(); p3b_router(A_, lds, G, wave); }
    SEAM(6);
    if (IN(7)) { const Args A_ = fresh_args(); p4_scatter(A_, lds, G, wave); }
    SEAM(7);
    if (IN(8)) {
        const int* tinfo = (const int*)(ws + WS_TINFO); MoeOrder S{tinfo, (const int*)(ws + WS_ROWA), tinfo[2048], 8, 3, G, vcu};
        pg8::Gemm g{(const bf16*)(ws + WS_XB8), (const bf16*)(ws + WS_WGU8), 0, 2048, D / 2};
        const Args A_ = fresh_args(); EpiSwiglu E{ws + WS_ACT8, (const float*)(ws + WS_ROWRI), A_.in[18]};
        PCLK_BEGIN(8); pg8::gemm_phase<EpiSwiglu, MoeOrder, true, true, true, true, true>(lds, g, S, E, wave); PCLK_END(8);
    }
    SEAM(8);
    if (IN(9)) {
        const int* tinfo = (const int*)(ws + WS_TINFO); MoeOrder S{tinfo, (const int*)(ws + WS_ROWA), tinfo[2048], 4, 2, G, vcu};
        pg8::Gemm g{(const bf16*)(ws + WS_ACT8), (const bf16*)(ws + WS_WD8), 0, 1024, D / 2};
        const Args A_ = fresh_args(); EpiDown E{ws + WS_Y48, (const int*)(ws + WS_ROWA), (const float*)(ws + WS_ROWG), A_.in[20]};
        pg8::gemm_phase<EpiDown, MoeOrder, true, false, true>(lds, g, S, E, wave);
    }
    SEAM(9);
    if (IN(10)) { const Args A_ = fresh_args(); p7_final(A_, vcu, G, wave, hw_lane()); }
#ifdef PROBE_CLK
    if (blockIdx.x == 0 && wave == 0 && hw_lane() == 0) { *(volatile unsigned*)(ws + WS_LAM + 128) = 0x600DF00Du; }
#endif
#ifdef PROBE_EXTRA
    if (IN(11)) { const Args A_ = fresh_args(); p2_attention<1>(A_, lds, vcu, G, wave); }
    if (IN(12)) { const Args A_ = fresh_args(); p2_attention<2>(A_, lds, vcu, G, wave); }
#endif
#undef IN
#undef SEAM
}

#ifndef MK_N_LAUNCHES
#define MK_N_LAUNCHES 1
#endif
extern "C" void kernel_launch(void* const* d_in, const int* in_sizes, int n_in, void* d_out, int out_size, void* d_ws, size_t ws_size, hipStream_t stream) {
    static int grid = 0;
    if (grid == 0) {
        if (n_in != 22 || in_sizes[0] != T * D || out_size != T * D || ws_size < WS_END) {
            fprintf(stderr, "kernel_launch: shape / workspace mismatch (n_in %d, in0 %d, out %d, ws %zu < %zu); nothing launched\n", n_in, n_in > 0 ? in_sizes[0] : -1, out_size, ws_size, (size_t)WS_END); grid = -1; return; }
        int dev = 0, cus = 0, per_cu = 0;
        if (hipGetDevice(&dev) != hipSuccess || hipDeviceGetAttribute(&cus, hipDeviceAttributeMultiprocessorCount, dev) != hipSuccess) { grid = -1; return; }
        if (hipFuncSetAttribute((const void*)fwd, hipFuncAttributeMaxDynamicSharedMemorySize, LDS_BYTES) != hipSuccess) { fprintf(stderr, "kernel_launch: hipFuncSetAttribute failed\n"); grid = -1; return; }
        if (hipOccupancyMaxActiveBlocksPerMultiprocessor(&per_cu, (const void*)fwd, NTHREADS, LDS_BYTES) != hipSuccess || per_cu < 1) { fprintf(stderr, "kernel_launch: occupancy query says %d\n", per_cu); }
        (void)hipGetLastError();
        grid = cus;
    }
    if (grid < 0) return;
    if (hipMemsetAsync((char*)d_ws + WS_CTL, 0, CTL_ZERO_BYTES, stream) != hipSuccess) return;
    Args a{};
    for (int i = 0; i < 22; ++i) a.in[i] = (const float*)d_in[i];
    a.out = (float*)d_out; a.ws = (unsigned char*)d_ws;
#if MK_N_LAUNCHES == 1
    a.ph_lo = 0; a.ph_hi = N_PHASES;
    hipLaunchKernelGGL(fwd, dim3(grid), dim3(NTHREADS), LDS_BYTES, stream, a);
#else
#ifndef PROBE_MASK
#define PROBE_MASK 0
#endif
    for (int p = 0; p < N_PHASES; ++p) { a.ph_lo = p; a.ph_hi = p + 1; hipLaunchKernelGGL(fwd, dim3(grid), dim3(NTHREADS), LDS_BYTES, stream, a);
        if ((PROBE_MASK >> p) & 1) hipLaunchKernelGGL(fwd, dim3(grid), dim3(NTHREADS), LDS_BYTES, stream, a);
#ifdef PROBE_EXTRA
        if (p == 4) { a.ph_lo = PROBE_EXTRA; a.ph_hi = PROBE_EXTRA + 1; hipLaunchKernelGGL(fwd, dim3(grid), dim3(NTHREADS), LDS_BYTES, stream, a); }
#endif
    }
#endif
}
```
